# Optimizing an MI355X kernel written in HIP

```python
import math
import jax, jax.numpy as jnp
from jax import lax
import numpy as np

D_MODEL = 1024
BATCH = 32
SEQ = 2048
DEPTH = 4
DEC_BATCH = 16
DEC_SEQ = 2048
PAST_LEN = 128

HEAD_DIM = 64
GRID_W = 64
NA_HEADS = 4
NA_WIN_H = 8
NA_WIN_W = 16
SW_HEADS = 4
SW_KV_HEADS = 2
SW_HALF_WINDOW = 128
SW_BLOCK = 128
DIL_PAIRS = ((128, 1), (512, 4), (2048, 16))
DIL_HEADS_PER_GROUP = 2
DIL_HEADS = DIL_HEADS_PER_GROUP * len(DIL_PAIRS)
DIFF_HEADS = 4
DIFF_HALF = HEAD_DIM // 2
DIFF_Q_BLOCK = 128
T5_BUCKETS = 32
T5_MAX_DIST = 128
T5_B0 = 0
T5_C0 = T5_B0 + SW_HEADS
T5_D0 = T5_C0 + DIL_HEADS
T5_HEADS = T5_D0 + DIFF_HEADS
A_W = 3 * NA_HEADS * HEAD_DIM
B_W = (SW_HEADS + 2 * SW_KV_HEADS) * HEAD_DIM
C_W = 3 * DIL_HEADS * HEAD_DIM
D_W = 3 * DIFF_HEADS * HEAD_DIM
PROJ_WIDTH = A_W + B_W + C_W + D_W
SPLIT_POINTS = (A_W, A_W + B_W, A_W + B_W + C_W)
MIX_WIDTH = (NA_HEADS + SW_HEADS + DIL_HEADS + DIFF_HEADS) * HEAD_DIM
D_FF = 2816
RMS_EPS = 1e-6
NEG_INF = -1e30

kernel_name = 'hybrid_parallel_heads_bidir_encoder'


def rms_norm(x, g):
    xf = x.astype(jnp.float32)
    y = xf * lax.rsqrt(jnp.mean(xf * xf, axis=-1, keepdims=True) + RMS_EPS)
    return (y * g.astype(jnp.float32)).astype(x.dtype)


def t5_bucket(rel):
    nb = T5_BUCKETS // 2
    max_exact = nb // 2
    base = jnp.where(rel > 0, nb, 0)
    n = jnp.abs(rel)
    nf = jnp.maximum(n, 1).astype(jnp.float32)
    large = max_exact + (jnp.log(nf / max_exact) / math.log(T5_MAX_DIST / max_exact)
                         * (nb - max_exact)).astype(jnp.int32)
    large = jnp.minimum(large, nb - 1)
    return base + jnp.where(n < max_exact, n, large)


def banded_attention(q, k, v, half_window, block, stride, bias_table, sink):
    Bsz, L, H, d = q.shape
    Hk = k.shape[2]
    G = H // Hk
    nb = -(-L // block)
    pad = nb * block - L
    qb = jnp.pad(q, ((0, 0), (0, pad), (0, 0), (0, 0))).reshape(Bsz, nb, block, Hk, G, d)
    kp = jnp.pad(k, ((0, 0), (block, block + pad), (0, 0), (0, 0)))
    vp = jnp.pad(v, ((0, 0), (block, block + pad), (0, 0), (0, 0)))
    kidx = np.arange(nb)[:, None] * block + np.arange(3 * block)[None, :]
    kb = kp[:, kidx]
    vb = vp[:, kidx]
    qi = np.arange(nb)[:, None] * block + np.arange(block)[None, :]
    kj = kidx - block
    rel = kj[:, None, :] - qi[:, :, None]
    mask = (np.abs(rel) <= half_window) & (kj[:, None, :] >= 0) & (kj[:, None, :] < L)
    bias = bias_table.astype(jnp.float32)[t5_bucket(jnp.asarray(rel * stride, dtype=jnp.int32))]
    bias = bias.transpose(0, 3, 1, 2).reshape(nb, Hk, G, block, 3 * block)
    s = jnp.einsum('bnqhgd,bnkhd->bnhgqk', qb, kb, preferred_element_type=jnp.float32)
    s = s * (d ** -0.5) + bias[None]
    s = jnp.where(mask[None, :, None, None], s, NEG_INF)
    m = jnp.max(s, axis=-1, keepdims=True)
    if sink is not None:
        sk = sink.astype(jnp.float32).reshape(1, 1, Hk, G, 1, 1)
        m = jnp.maximum(m, sk)
        p = jnp.exp(s - m)
        denom = jnp.sum(p, axis=-1, keepdims=True) + jnp.exp(sk - m)
    else:
        p = jnp.exp(s - m)
        denom = jnp.sum(p, axis=-1, keepdims=True)
    o = jnp.einsum('bnhgqk,bnkhd->bnhgqd', p, vb.astype(jnp.float32)) / denom
    lse = (m + jnp.log(denom))[..., 0]
    o = o.transpose(0, 1, 4, 2, 3, 5).reshape(Bsz, nb * block, H, d)[:, :L]
    lse = lse.transpose(0, 1, 4, 2, 3).reshape(Bsz, nb * block, H)[:, :L]
    return o, lse


def neighborhood_attention(proj_a, qkn, rpb):
    Bsz, N, _ = proj_a.shape
    H, d = NA_HEADS, HEAD_DIM
    qkv = proj_a.reshape(Bsz, N, 3, H, d)
    q = rms_norm(qkv[:, :, 0], qkn[0])
    k = rms_norm(qkv[:, :, 1], qkn[1])
    v = qkv[:, :, 2]
    rows = N // GRID_W
    kh = min(NA_WIN_H, rows)
    n_cb = GRID_W // NA_WIN_W
    kb_w = 2 * NA_WIN_W
    r = np.arange(rows)
    rs = np.clip(r - kh // 2, 0, rows - kh)
    key_rows = rs[:, None] + np.arange(kh)[None, :]
    dr_idx = key_rows - r[:, None] + NA_WIN_H - 1
    j = np.arange(n_cb)
    kbs = np.clip(j * NA_WIN_W - NA_WIN_W // 2, 0, GRID_W - kb_w)
    key_cols = kbs[:, None] + np.arange(kb_w)[None, :]
    qc = j[:, None] * NA_WIN_W + np.arange(NA_WIN_W)[None, :]
    cs = np.clip(qc - NA_WIN_W // 2, 0, GRID_W - NA_WIN_W)
    col_ok = (key_cols[:, None, :] >= cs[:, :, None]) & (key_cols[:, None, :] < cs[:, :, None] + NA_WIN_W)
    dc_idx = np.clip(key_cols[:, None, :] - qc[:, :, None] + NA_WIN_W - 1, 0, 2 * NA_WIN_W - 2)
    n_k = kh * kb_w
    tok = (key_rows[:, None, :, None] * GRID_W + key_cols[None, :, None, :]).reshape(rows, n_cb, n_k)
    mask = np.broadcast_to(col_ok[:, :, None, :], (n_cb, NA_WIN_W, kh, kb_w)).reshape(n_cb, NA_WIN_W, n_k)
    bias = rpb.astype(jnp.float32)[:, dr_idx[:, None, None, :, None], dc_idx[None, :, :, None, :]]
    bias = bias.reshape(H, rows, n_cb, NA_WIN_W, n_k)
    qb = q.reshape(Bsz, rows, n_cb, NA_WIN_W, H, d)
    kb = k[:, tok]
    vb = v[:, tok]
    s = jnp.einsum('brjqhd,brjkhd->bhrjqk', qb, kb, preferred_element_type=jnp.float32)
    s = jnp.where(mask, s * (d ** -0.5) + bias[None], NEG_INF)
    p = jax.nn.softmax(s, axis=-1)
    o = jnp.einsum('bhrjqk,brjkhd->brjqhd', p, vb.astype(jnp.float32))
    return o.reshape(Bsz, N, H * d)


def sliding_window_gqa(proj_b, qkn, sink, t5_heads):
    Bsz, N, _ = proj_b.shape
    d = HEAD_DIM
    qw = SW_HEADS * d
    kw = SW_KV_HEADS * d
    q = rms_norm(proj_b[..., :qw].reshape(Bsz, N, SW_HEADS, d), qkn[0])
    k = rms_norm(proj_b[..., qw:qw + kw].reshape(Bsz, N, SW_KV_HEADS, d), qkn[1])
    v = proj_b[..., qw + kw:].reshape(Bsz, N, SW_KV_HEADS, d)
    o, _ = banded_attention(q, k, v, SW_HALF_WINDOW, SW_BLOCK, 1, t5_heads, sink)
    return o.reshape(Bsz, N, qw)


def dilated_attention(proj_c, qkn, t5_heads):
    Bsz, N, _ = proj_c.shape
    H, d, G = DIL_HEADS, HEAD_DIM, DIL_HEADS_PER_GROUP
    qkv = proj_c.reshape(Bsz, N, 3, H, d)
    q = rms_norm(qkv[:, :, 0], qkn[0])
    k = rms_norm(qkv[:, :, 1], qkn[1])
    v = qkv[:, :, 2]
    outs, lses = [], []
    for g, (w, r) in enumerate(DIL_PAIRS):
        L = N // r
        hw = w // (2 * r)
        hs = slice(g * G, (g + 1) * G)

        def to_sub(t):
            return t.reshape(Bsz, L, r, G, d).transpose(0, 2, 1, 3, 4).reshape(Bsz * r, L, G, d)

        o, lse = banded_attention(to_sub(q[:, :, hs]), to_sub(k[:, :, hs]), to_sub(v[:, :, hs]),
                                  hw, hw, r, t5_heads[:, hs], None)
        outs.append(o.reshape(Bsz, r, L, G, d).transpose(0, 2, 1, 3, 4).reshape(Bsz, N, G, d))
        lses.append(lse.reshape(Bsz, r, L, G).transpose(0, 2, 1, 3).reshape(Bsz, N, G))
    alpha = jax.nn.softmax(jnp.stack(lses, axis=0), axis=0)
    o = jnp.concatenate([alpha[g][..., None] * outs[g] for g in range(len(DIL_PAIRS))], axis=2)
    return o.reshape(Bsz, N, H * d)


def differential_attention(proj_d, qkn, lam_p, subln_g, t5_heads, lambda_init):
    Bsz, N, _ = proj_d.shape
    H, e, d = DIFF_HEADS, DIFF_HALF, HEAD_DIM
    qkv = proj_d.reshape(Bsz, N, 3, H, d)
    q = rms_norm(qkv[:, :, 0].reshape(Bsz, N, H, 2, e), qkn[0])
    k = rms_norm(qkv[:, :, 1].reshape(Bsz, N, H, 2, e), qkn[1])
    v = qkv[:, :, 2].astype(jnp.float32)
    lp = lam_p.astype(jnp.float32)
    lam = jnp.exp(jnp.sum(lp[0] * lp[1])) - jnp.exp(jnp.sum(lp[2] * lp[3])) + lambda_init
    nqb = N // DIFF_Q_BLOCK
    q_blocks = q.reshape(Bsz, nqb, DIFF_Q_BLOCK, H, 2, e).transpose(1, 0, 2, 3, 4, 5)
    kpos = jnp.arange(N, dtype=jnp.int32)
    table = t5_heads.astype(jnp.float32)

    def one_block(args):
        qb, q0 = args
        qpos = q0 + jnp.arange(DIFF_Q_BLOCK, dtype=jnp.int32)
        bias = table[t5_bucket(kpos[None, :] - qpos[:, None])].transpose(2, 0, 1)
        s = jnp.einsum('bqhie,bkhie->bihqk', qb, k, preferred_element_type=jnp.float32)
        p = jax.nn.softmax(s * (e ** -0.5) + bias[None, None], axis=-1)
        a = p[:, 0] - lam * p[:, 1]
        return jnp.einsum('bhqk,bkhd->bqhd', a, v)

    o = lax.map(one_block, (q_blocks, jnp.arange(nqb, dtype=jnp.int32) * DIFF_Q_BLOCK))
    o = o.transpose(1, 0, 2, 3, 4).reshape(Bsz, N, H, d)
    o = rms_norm(o, subln_g) * (1.0 - lambda_init)
    return o.reshape(Bsz, N, H * d)


def conv_glu_ffn(h, w_up, conv_w, conv_b, w_down):
    u = h @ w_up
    up = jnp.pad(u, ((0, 0), (1, 1), (0, 0)))
    u = up[:, :-2] * conv_w[0] + up[:, 1:-1] * conv_w[1] + up[:, 2:] * conv_w[2] + conv_b
    val, gate = jnp.split(u, 2, axis=-1)
    return (val * jax.nn.silu(gate)) @ w_down


def _trunk(x, c, norm_attn_g, norm_ffn_g, w_ada, b_ada, w_in, qkn_a, qkn_b, qkn_c, qkn_d,
           rpb_a, sink_b, t5_table, lam_d, subln_d, w_out, w_up, conv_w, conv_b, w_down):
    Bsz, N, D = x.shape
    for l in range(DEPTH):
        mod = (jax.nn.silu(c) @ w_ada[l] + b_ada[l]).reshape(Bsz, 6, 1, D)
        shift_a, scale_a, gate_a = mod[:, 0], mod[:, 1], mod[:, 2]
        shift_f, scale_f, gate_f = mod[:, 3], mod[:, 4], mod[:, 5]
        h = rms_norm(x, norm_attn_g[l]) * (1.0 + scale_a) + shift_a
        proj = h @ w_in[l]
        pa, pb, pc, pd = jnp.split(proj, SPLIT_POINTS, axis=-1)
        lambda_init = 0.8 - 0.6 * math.exp(-0.3 * l)
        o_a = neighborhood_attention(pa, qkn_a[l], rpb_a[l])
        o_b = sliding_window_gqa(pb, qkn_b[l], sink_b[l], t5_table[:, T5_B0:T5_C0])
        o_c = dilated_attention(pc, qkn_c[l], t5_table[:, T5_C0:T5_D0])
        o_d = differential_attention(pd, qkn_d[l], lam_d[l], subln_d[l], t5_table[:, T5_D0:T5_HEADS], lambda_init)
        mixed = jnp.concatenate([o_a, o_b, o_c, o_d], axis=-1).astype(x.dtype)
        x = x + gate_a * (mixed @ w_out[l])
        h = rms_norm(x, norm_ffn_g[l]) * (1.0 + scale_f) + shift_f
        x = x + gate_f * conv_glu_ffn(h, w_up[l], conv_w[l], conv_b[l], w_down[l])
    return x


def setup_inputs(seed: int = 0) -> dict:
    key = jax.random.key(seed)
    ks = jax.random.split(key, 24)
    D = D_MODEL

    def nrm(k, shape, scale):
        return jax.random.normal(k, shape, jnp.float32) * scale

    return {
        'x_prompt': nrm(ks[0], (BATCH, SEQ, D), 1.0),
        'x_sample': nrm(ks[1], (DEC_BATCH, DEC_SEQ, D), 1.0),
        'c_prompt': nrm(ks[2], (BATCH, D), 1.0),
        'c_sample': nrm(ks[3], (DEC_BATCH, D), 1.0),
        'norm_attn_g': 1.0 + nrm(ks[4], (DEPTH, D), 0.05),
        'norm_ffn_g': 1.0 + nrm(ks[5], (DEPTH, D), 0.05),
        'w_ada': nrm(ks[6], (DEPTH, D, 6 * D), 0.5 * D ** -0.5),
        'b_ada': nrm(ks[7], (DEPTH, 6 * D), 0.02),
        'w_in': nrm(ks[8], (DEPTH, D, PROJ_WIDTH), D ** -0.5),
        'qkn_a': 1.0 + nrm(ks[9], (DEPTH, 2, HEAD_DIM), 0.05),
        'qkn_b': 1.0 + nrm(ks[10], (DEPTH, 2, HEAD_DIM), 0.05),
        'qkn_c': 1.0 + nrm(ks[11], (DEPTH, 2, HEAD_DIM), 0.05),
        'qkn_d': 1.0 + nrm(ks[12], (DEPTH, 2, DIFF_HALF), 0.05),
        'rpb_a': nrm(ks[13], (DEPTH, NA_HEADS, 2 * NA_WIN_H - 1, 2 * NA_WIN_W - 1), 0.1),
        'sink_b': nrm(ks[14], (DEPTH, SW_HEADS), 0.5),
        't5_table': nrm(ks[15], (T5_BUCKETS, T5_HEADS), 0.1),
        'lam_d': nrm(ks[16], (DEPTH, 4, DIFF_HALF), 0.1),
        'subln_d': 1.0 + nrm(ks[17], (DEPTH, HEAD_DIM), 0.05),
        'w_out': nrm(ks[18], (DEPTH, MIX_WIDTH, D), MIX_WIDTH ** -0.5),
        'w_up': nrm(ks[19], (DEPTH, D, 2 * D_FF), D ** -0.5),
        'conv_w': nrm(ks[20], (DEPTH, 3, 2 * D_FF), 0.3) + jnp.array([0.0, 1.0, 0.0], jnp.float32)[None, :, None],
        'conv_b': nrm(ks[21], (DEPTH, 2 * D_FF), 0.02),
        'w_down': nrm(ks[22], (DEPTH, D_FF, D), D_FF ** -0.5),
    }


def reference(x_prompt, x_sample, c_prompt, c_sample, norm_attn_g, norm_ffn_g, w_ada, b_ada, w_in,
              qkn_a, qkn_b, qkn_c, qkn_d, rpb_a, sink_b, t5_table, lam_d, subln_d, w_out, w_up,
              conv_w, conv_b, w_down):
    y_prompt = _trunk(x_prompt, c_prompt, norm_attn_g, norm_ffn_g, w_ada, b_ada, w_in, qkn_a, qkn_b,
                      qkn_c, qkn_d, rpb_a, sink_b, t5_table, lam_d, subln_d, w_out, w_up, conv_w,
                      conv_b, w_down)
    y_sample = _trunk(x_sample, c_sample, norm_attn_g, norm_ffn_g, w_ada, b_ada, w_in, qkn_a, qkn_b,
                      qkn_c, qkn_d, rpb_a, sink_b, t5_table, lam_d, subln_d, w_out, w_up, conv_w,
                      conv_b, w_down)
    return (y_prompt, y_sample)
```

```cpp
#include <hip/hip_runtime.h>
#include <hip/hip_cooperative_groups.h>
#include <cstdint>
#include <cstdio>
namespace cg = cooperative_groups;

typedef unsigned short bf16_t;
typedef short bf16x8 __attribute__((ext_vector_type(8)));
typedef float f32x4 __attribute__((ext_vector_type(4)));
typedef unsigned u32x4 __attribute__((ext_vector_type(4)));
typedef unsigned u32x2 __attribute__((ext_vector_type(2)));

#define NTOK 98304
#define DM 1024
#define PW 3200
#define MW 1152
#define DFF 2816
#define NSEQ 48
#define SEQL 2048
#define LOG2E 1.4426950408889634f
#define LN2 0.6931471805599453f
#define LDSROW 72

struct Params {
  const float *x_prompt, *x_sample, *c_prompt, *c_sample, *norm_attn_g, *norm_ffn_g, *w_ada, *b_ada, *w_in;
  const float *qkn_a, *qkn_b, *qkn_c, *qkn_d, *rpb_a, *sink_b, *t5_table, *lam_d, *subln_d, *w_out, *w_up, *conv_w, *conv_b, *w_down;
  float* out;
  bf16_t* wt; float* mod; float* lut; float* lam; float* lse; bf16_t* proj; bf16_t* hbuf;
};

#define WT_IN 0
#define WT_OUT (3200 * 1024)
#define WT_UP (WT_OUT + 1024 * 1152)
#define WT_DOWN (WT_UP + 5632 * 1024)
#define WT_LAYER (WT_DOWN + 1024 * 2816)

typedef __bf16 bf16x2_t __attribute__((ext_vector_type(2)));
typedef float f32x2_t __attribute__((ext_vector_type(2)));
__device__ __forceinline__ unsigned pk_bf16(float lo, float hi) {
  const f32x2_t v = {lo, hi};
  const bf16x2_t r = __builtin_convertvector(v, bf16x2_t);
  return __builtin_bit_cast(unsigned, r);
}
__device__ __forceinline__ float bf_lo(unsigned u) { return __uint_as_float(u << 16); }
__device__ __forceinline__ float bf_hi(unsigned u) { return __uint_as_float(u & 0xffff0000u); }
__device__ __forceinline__ float fexp2(float x) { return __builtin_amdgcn_exp2f(x); }

__device__ __forceinline__ const float* xin_row(const Params& p, bool first, int tok) {
  if (first) return tok < 65536 ? p.x_prompt + (size_t)tok * DM : p.x_sample + (size_t)(tok - 65536) * DM;
  return p.out + (size_t)tok * DM;
}

__device__ __forceinline__ int opaque_tid() { int t = threadIdx.x; asm volatile("" : "+v"(t)); return t; }

__device__ __forceinline__ int t5_bucket(int rel) {
  const int n = rel < 0 ? -rel : rel;
  int v;
  if (n < 8) v = n;
  else v = 8 + (n >= 12) + (n >= 16) + (n >= 23) + (n >= 32) + (n >= 46) + (n >= 64) + (n >= 91);
  return (rel > 0 ? 16 : 0) + v;
}

__device__ __forceinline__ void prologue_phase(const Params& p, char* smem) {
  const int tid = opaque_tid(), nb = gridDim.x;
  const int N_TR = 4 * 3200, N_MOD = 384;
  for (int item = blockIdx.x; item < N_TR + N_MOD + 1; item += nb) {
    if (item < N_TR) {
      const int l = item / 3200; int r = item % 3200;
      const float* src; bf16_t* dst; int K, N, kt, nt;
      if (r < 800) { K = 1024; N = 3200; src = p.w_in + (size_t)l * K * N; dst = p.wt + (size_t)l * WT_LAYER + WT_IN; kt = r / 50; nt = r % 50; }
      else if (r < 1088) { r -= 800; K = 1152; N = 1024; src = p.w_out + (size_t)l * K * N; dst = p.wt + (size_t)l * WT_LAYER + WT_OUT; kt = r / 16; nt = r % 16; }
      else if (r < 2496) { r -= 1088; K = 1024; N = 5632; src = p.w_up + (size_t)l * K * N; dst = p.wt + (size_t)l * WT_LAYER + WT_UP; kt = r / 88; nt = r % 88; }
      else { r -= 2496; K = 2816; N = 1024; src = p.w_down + (size_t)l * K * N; dst = p.wt + (size_t)l * WT_LAYER + WT_DOWN; kt = r / 16; nt = r % 16; }
      float* tile = (float*)smem;
      const int k0 = kt * 64, n0 = nt * 64;
      __syncthreads();
#pragma unroll
      for (int i = 0; i < 16; ++i) {
        const int rr = (tid >> 6) + 4 * i, cc = tid & 63;
        tile[rr * 65 + cc] = src[(size_t)(k0 + rr) * N + n0 + cc];
      }
      __syncthreads();
#pragma unroll
      for (int i = 0; i < 8; ++i) {
        const int idx = tid + 256 * i, n = idx >> 5, k2 = (idx & 31) * 2;
        *(unsigned*)(dst + (size_t)(n0 + n) * K + k0 + k2) = pk_bf16(tile[k2 * 65 + n], tile[(k2 + 1) * 65 + n]);
      }
    } else if (item < N_TR + N_MOD) {
      int r = item - N_TR;
      const int l = r / 96; r %= 96;
      const int nc = r / 4, bg = r % 4;
      const int n = nc * 256 + tid;
      float* sc = (float*)smem;
      float acc[12];
#pragma unroll
      for (int j = 0; j < 12; ++j) acc[j] = 0.f;
      const float* W = p.w_ada + (size_t)l * 1024 * 6144 + n;
      for (int kc = 0; kc < 2; ++kc) {
        __syncthreads();
        for (int i = tid; i < 12 * 512; i += 256) {
          const int j = i >> 9, k = i & 511, b = bg * 12 + j;
          const float c = b < 32 ? p.c_prompt[b * 1024 + kc * 512 + k] : p.c_sample[(b - 32) * 1024 + kc * 512 + k];
          sc[i] = c / (1.f + __expf(-c));
        }
        __syncthreads();
#pragma unroll 2
        for (int k = 0; k < 512; k += 4) {
          const float w0 = W[(size_t)(kc * 512 + k) * 6144], w1 = W[(size_t)(kc * 512 + k + 1) * 6144];
          const float w2 = W[(size_t)(kc * 512 + k + 2) * 6144], w3 = W[(size_t)(kc * 512 + k + 3) * 6144];
#pragma unroll
          for (int j = 0; j < 12; ++j) {
            const f32x4 s = *(const f32x4*)(sc + j * 512 + k);
            acc[j] += s[0] * w0 + s[1] * w1 + s[2] * w2 + s[3] * w3;
          }
        }
      }
      const float bias = p.b_ada[l * 6144 + n];
#pragma unroll
      for (int j = 0; j < 12; ++j) p.mod[((size_t)l * 48 + bg * 12 + j) * 6144 + n] = acc[j] + bias;
    } else {
      for (int i = tid; i < 14 * 257; i += 256) {
        const int hd = i / 257, idx = i % 257;
        p.lut[i] = p.t5_table[t5_bucket(idx - 128) * 14 + hd] * LOG2E;
      }
      if (tid < 4) {
        const float* lp = p.lam_d + tid * 128;
        float s1 = 0.f, s2 = 0.f;
        for (int e = 0; e < 32; ++e) { s1 += lp[e] * lp[32 + e]; s2 += lp[64 + e] * lp[96 + e]; }
        const float li = 0.8f - 0.6f * expf(-0.3f * (float)tid);
        p.lam[tid] = expf(s1) - expf(s2) + li;
      }
    }
  }
}

__device__ __forceinline__ void norm_phase(const Params& p, int l, bool first, const float* g, int shift_off, int scale_off) {
  const int tid0 = opaque_tid();
  const int lane = tid0 & 63, w = tid0 >> 6;
  for (int row = blockIdx.x * 4 + w; row < NTOK; row += gridDim.x * 4) {
    const float* xr = xin_row(p, first, row);
    const int b = row >> 11;
    const float* md = p.mod + ((size_t)l * 48 + b) * 6144;
    f32x4 v[4];
    float ss = 0.f;
#pragma unroll
    for (int i = 0; i < 4; ++i) {
      v[i] = *(const f32x4*)(xr + i * 256 + lane * 4);
      ss += v[i][0] * v[i][0] + v[i][1] * v[i][1] + v[i][2] * v[i][2] + v[i][3] * v[i][3];
    }
#pragma unroll
    for (int o = 32; o >= 1; o >>= 1) ss += __shfl_xor(ss, o);
    const float rstd = rsqrtf(ss * (1.f / 1024.f) + 1e-6f);
#pragma unroll
    for (int i = 0; i < 4; ++i) {
      const int k = i * 256 + lane * 4;
      const f32x4 gg = *(const f32x4*)(g + k), sc = *(const f32x4*)(md + scale_off + k), sh = *(const f32x4*)(md + shift_off + k);
      f32x4 y;
#pragma unroll
      for (int j = 0; j < 4; ++j) y[j] = (v[i][j] * rstd) * gg[j] * (1.f + sc[j]) + sh[j];
      u32x2 o; o[0] = pk_bf16(y[0], y[1]); o[1] = pk_bf16(y[2], y[3]);
      *(u32x2*)(p.hbuf + (size_t)row * DM + k) = o;
    }
  }
}

__device__ __forceinline__ bool gemm_tile_id(int it, int MT, int NT, int NB, int& mt, int& nt) {
  const int nb = gridDim.x, bid = blockIdx.x;
  if ((nb & 7) == 0) {
    const int x = bid & 7, slot = bid >> 3, S = nb >> 3;
    const int TPS = 8 * NB, NSN = NT / NB, NS = (MT / 8) * NSN;
    const int pidx = slot + S * it, sidx = pidx / TPS, w = pidx % TPS, s = x + 8 * sidx;
    if (s >= NS) return false;
    mt = (s / NSN) * 8 + (w & 7); nt = (s % NSN) * NB + (w >> 3);
    return true;
  }
  const int t = bid + nb * it;
  if (t >= MT * NT) return false;
  mt = t / NT; nt = t % NT;
  return true;
}

template <int M>
__device__ __forceinline__ void up_epi_row(const f32x4 (&acc)[8][2], const f32x4 (&w0)[2], const f32x4 (&w1)[2], const f32x4 (&w2)[2],
                                           const f32x4 (&bb)[2], int lane, int fr, int s0, bf16_t* obase) {
  constexpr int MP = M > 0 ? M - 1 : 0, MN = M < 7 ? M + 1 : 7;
  const int srcp = (lane & 48) | ((fr + 15) & 15), srcn = (lane & 48) | ((fr + 1) & 15);
  float y[2][4];
#pragma unroll
  for (int n = 0; n < 2; ++n)
#pragma unroll
    for (int j = 0; j < 4; ++j) {
      const float cur = acc[M][n][j];
      const float zp = (fr == 15) ? acc[MP][n][j] : cur, zn = (fr == 0) ? acc[MN][n][j] : cur;
      const float pv = __shfl(zp, srcp), nv = __shfl(zn, srcn);
      y[n][j] = w0[n][j] * pv + w1[n][j] * cur + w2[n][j] * nv + bb[n][j];
    }
  const int row = 16 * M + fr, tpos = s0 + row;
  if (row >= 1 && row <= 126 && tpos >= 0 && tpos < SEQL) {
    float a[4];
#pragma unroll
    for (int j = 0; j < 4; ++j) { const float gte = y[1][j]; a[j] = y[0][j] * gte / (1.f + __expf(-gte)); }
    u32x2 o; o[0] = pk_bf16(a[0], a[1]); o[1] = pk_bf16(a[2], a[3]);
    *(u32x2*)(obase + (size_t)tpos * DFF) = o;
  }
}

template <int EPI>
__device__ __forceinline__ void gemm_phase(const Params& p, int l, bool first, const bf16_t* A, int lda, const bf16_t* Bt, int K, int MT, int NT, int NB,
                           bf16_t* outb, int ldc, int gate_off, char* smem) {
  const int tid = opaque_tid(), lane = tid & 63, wc = tid >> 6, fr = lane & 15, fq = lane >> 4;
  bf16_t* As = (bf16_t*)smem;
  bf16_t* Bs = As + 128 * LDSROW;
  const int nk = K / 64;
  for (int it = 0;; ++it) {
    int mt, nt;
    if (!gemm_tile_id(it, MT, NT, NB, mt, nt)) break;
    int tok0, lo = 0, hi = 128;
    if (EPI == 2) {
      const int seq = mt / 17, i = mt % 17, s0 = 126 * i - 1;
      tok0 = seq * SEQL + s0;
      lo = s0 < 0 ? -s0 : 0;
      hi = (SEQL - s0) < 128 ? (SEQL - s0) : 128;
    } else tok0 = mt * 128;
    f32x4 acc[8][2];
#pragma unroll
    for (int m = 0; m < 8; ++m)
#pragma unroll
      for (int n = 0; n < 2; ++n) acc[m][n] = (f32x4){0.f, 0.f, 0.f, 0.f};
    u32x4 ra[4], rb[4];
    const int lrow = tid >> 3, lkc = tid & 7;
    size_t aoff[4], boff[4]; bool aval[4];
#pragma unroll
    for (int i = 0; i < 4; ++i) {
      const int row = lrow + 32 * i;
      aval[i] = row >= lo && row < hi;
      aoff[i] = (size_t)(tok0 + (aval[i] ? row : lo)) * lda + lkc * 8;
      int brow;
      if (EPI == 2) brow = row < 64 ? nt * 64 + row : DFF + nt * 64 + row - 64;
      else brow = nt * 128 + row;
      boff[i] = (size_t)brow * K + lkc * 8;
    }
#pragma unroll
    for (int i = 0; i < 4; ++i) {
      ra[i] = *(const u32x4*)(A + aoff[i]);
      if (!aval[i]) ra[i] = (u32x4){0u, 0u, 0u, 0u};
      rb[i] = *(const u32x4*)(Bt + boff[i]);
    }
    for (int kt = 0; kt < nk; ++kt) {
      __syncthreads();
#pragma unroll
      for (int i = 0; i < 4; ++i) {
        *(u32x4*)(As + (lrow + 32 * i) * LDSROW + lkc * 8) = ra[i];
        *(u32x4*)(Bs + (lrow + 32 * i) * LDSROW + lkc * 8) = rb[i];
      }
      __syncthreads();
      if (kt + 1 < nk) {
#pragma unroll
        for (int i = 0; i < 4; ++i) {
          ra[i] = *(const u32x4*)(A + aoff[i] + (kt + 1) * 64);
          if (!aval[i]) ra[i] = (u32x4){0u, 0u, 0u, 0u};
          rb[i] = *(const u32x4*)(Bt + boff[i] + (kt + 1) * 64);
        }
      }
#pragma unroll
      for (int ks = 0; ks < 2; ++ks) {
        bf16x8 bfr[2];
#pragma unroll
        for (int n = 0; n < 2; ++n) {
          const int br = (EPI == 2) ? (n * 64 + 16 * wc + fr) : (32 * wc + 16 * n + fr);
          bfr[n] = *(const bf16x8*)(Bs + br * LDSROW + ks * 32 + fq * 8);
        }
#pragma unroll
        for (int m = 0; m < 8; ++m) {
          const bf16x8 af = *(const bf16x8*)(As + (16 * m + fr) * LDSROW + ks * 32 + fq * 8);
#pragma unroll
          for (int n = 0; n < 2; ++n) acc[m][n] = __builtin_amdgcn_mfma_f32_16x16x32_bf16(bfr[n], af, acc[m][n], 0, 0, 0);
        }
      }
    }
    if (EPI == 0) {
#pragma unroll
      for (int m = 0; m < 8; ++m) {
        const int tok = tok0 + 16 * m + fr;
#pragma unroll
        for (int n = 0; n < 2; ++n) {
          const int col = nt * 128 + 32 * wc + 16 * n + 4 * fq;
          u32x2 o; o[0] = pk_bf16(acc[m][n][0], acc[m][n][1]); o[1] = pk_bf16(acc[m][n][2], acc[m][n][3]);
          *(u32x2*)(outb + (size_t)tok * ldc + col) = o;
        }
      }
    } else if (EPI == 1) {
      const int b = tok0 >> 11;
      const float* gate = p.mod + ((size_t)l * 48 + b) * 6144 + gate_off;
#pragma unroll
      for (int n = 0; n < 2; ++n) {
        const int col = nt * 128 + 32 * wc + 16 * n + 4 * fq;
        const f32x4 gv = *(const f32x4*)(gate + col);
#pragma unroll
        for (int m = 0; m < 8; ++m) {
          const int tok = tok0 + 16 * m + fr;
          const f32x4 xv = *(const f32x4*)(xin_row(p, first, tok) + col);
          f32x4 o;
#pragma unroll
          for (int j = 0; j < 4; ++j) o[j] = xv[j] + gv[j] * acc[m][n][j];
          *(f32x4*)(p.out + (size_t)tok * DM + col) = o;
        }
      }
    } else {
      const float* cw = p.conv_w + (size_t)l * 3 * 5632;
      const float* cb = p.conv_b + (size_t)l * 5632;
      const int cbase = nt * 64 + 16 * wc + 4 * fq;
      f32x4 w0[2], w1[2], w2[2], bb[2];
#pragma unroll
      for (int n = 0; n < 2; ++n) {
        const int c = n * DFF + cbase;
        w0[n] = *(const f32x4*)(cw + c); w1[n] = *(const f32x4*)(cw + 5632 + c); w2[n] = *(const f32x4*)(cw + 2 * 5632 + c);
        bb[n] = *(const f32x4*)(cb + c);
      }
      const int seq = mt / 17, s0 = 126 * (mt % 17) - 1;
      bf16_t* obase = outb + (size_t)(seq * SEQL) * DFF + cbase;
      up_epi_row<0>(acc, w0, w1, w2, bb, lane, fr, s0, obase); up_epi_row<1>(acc, w0, w1, w2, bb, lane, fr, s0, obase);
      up_epi_row<2>(acc, w0, w1, w2, bb, lane, fr, s0, obase); up_epi_row<3>(acc, w0, w1, w2, bb, lane, fr, s0, obase);
      up_epi_row<4>(acc, w0, w1, w2, bb, lane, fr, s0, obase); up_epi_row<5>(acc, w0, w1, w2, bb, lane, fr, s0, obase);
      up_epi_row<6>(acc, w0, w1, w2, bb, lane, fr, s0, obase); up_epi_row<7>(acc, w0, w1, w2, bb, lane, fr, s0, obase);
    }
  }
}

struct AttnArgs {
  int qbase, qstride, qpos0;
  int ktokbase, ktokstep, kstride, kposbase, kposstep, ntiles;
  int qcol, kcol, vcol, ocol;
  const float *gq, *gk;
  float qscale;
  int hw, rmul, taboff0;
  float sinkv;
  float lam, outscale;
  const float* subg;
  int lsecol;
};

template <int NQ, int NC, int MODE>
__device__ __forceinline__ void attn_item(const Params& p, const AttnArgs& a, bf16_t* Ks, bf16_t* Vts, const float* tab) {
  const int tid = opaque_tid(), lane = tid & 63, w = tid >> 6, fr = lane & 15, fq = lane >> 4;
  const int wq0 = a.qpos0 + w * 16 * NQ;
  bf16x8 qf[NQ][2];
  int qpos[NQ];
#pragma unroll
  for (int qt = 0; qt < NQ; ++qt) {
    const int qp = wq0 + qt * 16 + fr;
    qpos[qt] = qp;
    const bf16_t* qrow = p.proj + (size_t)(a.qbase + qp * a.qstride) * PW + a.qcol;
    const u32x4 v0 = *(const u32x4*)(qrow + fq * 8), v1 = *(const u32x4*)(qrow + 32 + fq * 8);
    float f0[8], f1[8];
#pragma unroll
    for (int i = 0; i < 4; ++i) { f0[2 * i] = bf_lo(v0[i]); f0[2 * i + 1] = bf_hi(v0[i]); f1[2 * i] = bf_lo(v1[i]); f1[2 * i + 1] = bf_hi(v1[i]); }
    float s0 = 0.f, s1 = 0.f;
#pragma unroll
    for (int i = 0; i < 8; ++i) { s0 += f0[i] * f0[i]; s1 += f1[i] * f1[i]; }
    float r0, r1;
    if (NC == 1) {
      float s = s0 + s1; s += __shfl_xor(s, 16); s += __shfl_xor(s, 32);
      r0 = r1 = rsqrtf(s * (1.f / 64.f) + 1e-6f) * a.qscale;
    } else {
      s0 += __shfl_xor(s0, 16); s0 += __shfl_xor(s0, 32);
      s1 += __shfl_xor(s1, 16); s1 += __shfl_xor(s1, 32);
      r0 = rsqrtf(s0 * (1.f / 32.f) + 1e-6f) * a.qscale; r1 = rsqrtf(s1 * (1.f / 32.f) + 1e-6f) * a.qscale;
    }
    const float* g0p = a.gq + fq * 8;
    const float* g1p = (NC == 1) ? a.gq + 32 + fq * 8 : g0p;
    u32x4 q0, q1;
#pragma unroll
    for (int i = 0; i < 4; ++i) {
      q0[i] = pk_bf16(f0[2 * i] * r0 * g0p[2 * i], f0[2 * i + 1] * r0 * g0p[2 * i + 1]);
      q1[i] = pk_bf16(f1[2 * i] * r1 * g1p[2 * i], f1[2 * i + 1] * r1 * g1p[2 * i + 1]);
    }
    qf[qt][0] = __builtin_bit_cast(bf16x8, q0);
    qf[qt][1] = __builtin_bit_cast(bf16x8, q1);
  }
  f32x4 o[NC][NQ][4];
  float mrun[NC][NQ], lrun[NC][NQ];
#pragma unroll
  for (int c = 0; c < NC; ++c)
#pragma unroll
    for (int qt = 0; qt < NQ; ++qt) {
      if (MODE == 1) { mrun[c][qt] = a.sinkv; lrun[c][qt] = (fq == 0) ? 1.f : 0.f; }
      else { mrun[c][qt] = -1e30f; lrun[c][qt] = 0.f; }
#pragma unroll
      for (int dt = 0; dt < 4; ++dt) o[c][qt][dt] = (f32x4){0.f, 0.f, 0.f, 0.f};
    }
  const int lch = tid & 7;
  float gkv[8];
#pragma unroll
  for (int i = 0; i < 8; ++i) gkv[i] = a.gk[((NC == 1) ? lch : (lch & 3)) * 8 + i];

  for (int t = 0; t < a.ntiles; ++t) {
    const int ktok0 = a.ktokbase + t * a.ktokstep;
    __syncthreads();
#pragma unroll
    for (int it = 0; it < 2; ++it) {
      const int key = (tid >> 3) + 32 * it;
      const u32x4 v = *(const u32x4*)(p.proj + (size_t)(ktok0 + key * a.kstride) * PW + a.kcol + lch * 8);
      float f[8];
#pragma unroll
      for (int i = 0; i < 4; ++i) { f[2 * i] = bf_lo(v[i]); f[2 * i + 1] = bf_hi(v[i]); }
      float s = 0.f;
#pragma unroll
      for (int i = 0; i < 8; ++i) s += f[i] * f[i];
      s += __shfl_xor(s, 1); s += __shfl_xor(s, 2);
      float rs;
      if (NC == 1) { s += __shfl_xor(s, 4); rs = rsqrtf(s * (1.f / 64.f) + 1e-6f); }
      else rs = rsqrtf(s * (1.f / 32.f) + 1e-6f);
      u32x4 kq;
#pragma unroll
      for (int i = 0; i < 4; ++i) kq[i] = pk_bf16(f[2 * i] * rs * gkv[2 * i], f[2 * i + 1] * rs * gkv[2 * i + 1]);
      *(u32x4*)(Ks + key * LDSROW + lch * 8) = kq;
    }
    {
      const int key = tid & 63;
      const bf16_t* vrow = p.proj + (size_t)(ktok0 + key * a.kstride) * PW + a.vcol;
#pragma unroll
      for (int it = 0; it < 2; ++it) {
        const int ch = (tid >> 6) + 4 * it;
        const u32x4 v = *(const u32x4*)(vrow + ch * 8);
#pragma unroll
        for (int i = 0; i < 4; ++i) {
          Vts[(ch * 8 + 2 * i) * LDSROW + key] = (bf16_t)(v[i] & 0xffffu);
          Vts[(ch * 8 + 2 * i + 1) * LDSROW + key] = (bf16_t)(v[i] >> 16);
        }
      }
    }
    __syncthreads();
    const int kp0 = a.kposbase + t * a.kposstep;
    const int taboff = a.taboff0 + t * 31;
    bf16x8 pf[NC][NQ][2];
    __builtin_amdgcn_sched_barrier(0);
#pragma unroll
    for (int qt = 0; qt < NQ; ++qt) {
      const int qp = qpos[qt];
      int cs = qp - 8; cs = cs < 0 ? 0 : (cs > 48 ? 48 : cs);
      f32x4 bv[4];
#pragma unroll
      for (int kt = 0; kt < 4; ++kt)
#pragma unroll
        for (int j = 0; j < 4; ++j) {
          const int kpos = kp0 + kt * 16 + 4 * fq + j;
          const int d = kpos - qp;
          bool valid; int idx;
          if (MODE == 0) {
            valid = kpos >= cs && kpos < cs + 16;
            int dd = d + 15; dd = dd < 0 ? 0 : (dd > 30 ? 30 : dd);
            idx = taboff + dd;
          } else {
            valid = (MODE == 3) ? true : (d <= a.hw && d >= -a.hw);
            int dd = d * a.rmul; dd = dd < -128 ? -128 : (dd > 128 ? 128 : dd);
            idx = dd + 128;
          }
          const float bias = tab[idx];
          bv[kt][j] = valid ? bias : -INFINITY;
        }
#pragma unroll
      for (int c = 0; c < NC; ++c) {
        f32x4 s[4];
#pragma unroll
        for (int kt = 0; kt < 4; ++kt) {
          if (NC == 1) {
            const bf16x8 k0 = *(const bf16x8*)(Ks + (kt * 16 + fr) * LDSROW + fq * 8);
            const bf16x8 k1 = *(const bf16x8*)(Ks + (kt * 16 + fr) * LDSROW + 32 + fq * 8);
            const f32x4 r = __builtin_amdgcn_mfma_f32_16x16x32_bf16(k0, qf[qt][0], bv[kt], 0, 0, 0);
            s[kt] = __builtin_amdgcn_mfma_f32_16x16x32_bf16(k1, qf[qt][1], r, 0, 0, 0);
          } else {
            const bf16x8 k0 = *(const bf16x8*)(Ks + (kt * 16 + fr) * LDSROW + c * 32 + fq * 8);
            s[kt] = __builtin_amdgcn_mfma_f32_16x16x32_bf16(k0, qf[qt][c], bv[kt], 0, 0, 0);
          }
        }
        float mx = -INFINITY;
#pragma unroll
        for (int kt = 0; kt < 4; ++kt)
#pragma unroll
          for (int j = 0; j < 4; ++j) mx = fmaxf(mx, s[kt][j]);
        mx = fmaxf(mx, __shfl_xor(mx, 16)); mx = fmaxf(mx, __shfl_xor(mx, 32));
        const float mn = fmaxf(mrun[c][qt], mx);
        const float al = fexp2(mrun[c][qt] - mn);
        mrun[c][qt] = mn;
        float rs = 0.f;
#pragma unroll
        for (int kt = 0; kt < 4; ++kt)
#pragma unroll
          for (int j = 0; j < 4; ++j) { const float pv = fexp2(s[kt][j] - mn); s[kt][j] = pv; rs += pv; }
        lrun[c][qt] = lrun[c][qt] * al + rs;
#pragma unroll
        for (int dt = 0; dt < 4; ++dt) o[c][qt][dt] *= al;
#pragma unroll
        for (int ks = 0; ks < 2; ++ks) {
          u32x4 pk;
          pk[0] = pk_bf16(s[2 * ks][0], s[2 * ks][1]); pk[1] = pk_bf16(s[2 * ks][2], s[2 * ks][3]);
          pk[2] = pk_bf16(s[2 * ks + 1][0], s[2 * ks + 1][1]); pk[3] = pk_bf16(s[2 * ks + 1][2], s[2 * ks + 1][3]);
          pf[c][qt][ks] = __builtin_bit_cast(bf16x8, pk);
        }
        __builtin_amdgcn_sched_barrier(0);
      }
    }
#pragma unroll
    for (int ks = 0; ks < 2; ++ks) {
#pragma unroll
      for (int dt = 0; dt < 4; ++dt) {
        const u32x2 lo = *(const u32x2*)(Vts + (dt * 16 + fr) * LDSROW + ks * 32 + 4 * fq);
        const u32x2 hi = *(const u32x2*)(Vts + (dt * 16 + fr) * LDSROW + ks * 32 + 16 + 4 * fq);
        u32x4 vv; vv[0] = lo[0]; vv[1] = lo[1]; vv[2] = hi[0]; vv[3] = hi[1];
        const bf16x8 vf = __builtin_bit_cast(bf16x8, vv);
#pragma unroll
        for (int c = 0; c < NC; ++c)
#pragma unroll
          for (int qt = 0; qt < NQ; ++qt) o[c][qt][dt] = __builtin_amdgcn_mfma_f32_16x16x32_bf16(vf, pf[c][qt][ks], o[c][qt][dt], 0, 0, 0);
      }
    }
  }
#pragma unroll
  for (int qt = 0; qt < NQ; ++qt) {
    float inv[NC], ltot[NC];
#pragma unroll
    for (int c = 0; c < NC; ++c) {
      float lt = lrun[c][qt];
      lt += __shfl_xor(lt, 16); lt += __shfl_xor(lt, 32);
      ltot[c] = lt; inv[c] = 1.f / lt;
    }
    const int tok = a.qbase + qpos[qt] * a.qstride;
    bf16_t* orow = p.hbuf + (size_t)tok * MW + a.ocol;
    if (MODE == 3) {
      f32x4 v[4];
      float ss = 0.f;
#pragma unroll
      for (int dt = 0; dt < 4; ++dt)
#pragma unroll
        for (int j = 0; j < 4; ++j) {
          const float x = o[0][qt][dt][j] * inv[0] - a.lam * (o[NC - 1][qt][dt][j] * inv[NC - 1]);
          v[dt][j] = x; ss += x * x;
        }
      ss += __shfl_xor(ss, 16); ss += __shfl_xor(ss, 32);
      const float rstd = rsqrtf(ss * (1.f / 64.f) + 1e-6f) * a.outscale;
#pragma unroll
      for (int dt = 0; dt < 4; ++dt) {
        const f32x4 g = *(const f32x4*)(a.subg + dt * 16 + 4 * fq);
        u32x2 ov; ov[0] = pk_bf16(v[dt][0] * rstd * g[0], v[dt][1] * rstd * g[1]); ov[1] = pk_bf16(v[dt][2] * rstd * g[2], v[dt][3] * rstd * g[3]);
        *(u32x2*)(orow + dt * 16 + 4 * fq) = ov;
      }
    } else {
#pragma unroll
      for (int dt = 0; dt < 4; ++dt) {
        u32x2 ov;
        ov[0] = pk_bf16(o[0][qt][dt][0] * inv[0], o[0][qt][dt][1] * inv[0]);
        ov[1] = pk_bf16(o[0][qt][dt][2] * inv[0], o[0][qt][dt][3] * inv[0]);
        *(u32x2*)(orow + dt * 16 + 4 * fq) = ov;
      }
      if (MODE == 2 && fq == 0) p.lse[(size_t)tok * 6 + a.lsecol] = (mrun[0][qt] + __log2f(ltot[0])) * LN2;
    }
  }
}

__device__ __forceinline__ void attn_phase(const Params& p, int l, char* smem) {
  bf16_t* Ks = (bf16_t*)smem;
  bf16_t* Vts = Ks + 64 * LDSROW;
  float* tab = (float*)(Vts + 64 * LDSROW);
  const int tid = opaque_tid();
  const int nD = 6144, nA = 6144, nB = 3072, nC = 4608;
  for (int item = blockIdx.x; item < nD + nA + nB + nC; item += gridDim.x) {
    AttnArgs a;
    a.taboff0 = 0; a.sinkv = 0.f; a.lam = 0.f; a.outscale = 1.f; a.subg = nullptr; a.lsecol = 0; a.hw = 1 << 20; a.rmul = 1;
    __syncthreads();
    if (item < nD) {
      const int b = item >> 7, h = (item >> 5) & 3, qb = item & 31;
      for (int i = tid; i < 257; i += 256) tab[i] = p.lut[(10 + h) * 257 + i];
      a.qbase = b * SEQL; a.qstride = 1; a.qpos0 = qb * 64;
      a.ktokbase = b * SEQL; a.ktokstep = 64; a.kstride = 1; a.kposbase = 0; a.kposstep = 64; a.ntiles = 32;
      a.qcol = 2432 + h * 64; a.kcol = 2432 + 256 + h * 64; a.vcol = 2432 + 512 + h * 64; a.ocol = 896 + h * 64;
      a.gq = p.qkn_d + l * 64; a.gk = a.gq + 32;
      a.qscale = 0.17677669529663687f * LOG2E;
      a.lam = p.lam[l]; a.outscale = 1.f - (0.8f - 0.6f * expf(-0.3f * (float)l)); a.subg = p.subln_d + l * 64;
      attn_item<1, 2, 3>(p, a, Ks, Vts, tab);
    } else if (item < nD + nA) {
      const int id = item - nD;
      const int b = id >> 7, h = (id >> 5) & 3, r = id & 31;
      const float* rp = p.rpb_a + ((size_t)l * 4 + h) * 465;
      for (int i = tid; i < 465; i += 256) tab[i] = rp[i] * LOG2E;
      int rs = r - 4; rs = rs < 0 ? 0 : (rs > 24 ? 24 : rs);
      a.qbase = b * SEQL + r * 64; a.qstride = 1; a.qpos0 = 0;
      a.ktokbase = b * SEQL + rs * 64; a.ktokstep = 64; a.kstride = 1; a.kposbase = 0; a.kposstep = 0; a.ntiles = 8;
      a.qcol = h * 64; a.kcol = 256 + h * 64; a.vcol = 512 + h * 64; a.ocol = h * 64;
      a.gq = p.qkn_a + l * 128; a.gk = a.gq + 64;
      a.qscale = 0.125f * LOG2E;
      a.taboff0 = (rs - r + 7) * 31;
      attn_item<1, 1, 0>(p, a, Ks, Vts, tab);
    } else if (item < nD + nA + nB) {
      const int id = item - nD - nA;
      const int b = id >> 6, h = (id >> 4) & 3, qb = id & 15;
      for (int i = tid; i < 257; i += 256) tab[i] = p.lut[h * 257 + i];
      const int q0 = qb * 128;
      const int kstart = q0 - 128 < 0 ? 0 : q0 - 128, kend = q0 + 256 > SEQL ? SEQL : q0 + 256;
      a.qbase = b * SEQL; a.qstride = 1; a.qpos0 = q0;
      a.ktokbase = b * SEQL + kstart; a.ktokstep = 64; a.kstride = 1; a.kposbase = kstart; a.kposstep = 64; a.ntiles = (kend - kstart) >> 6;
      a.qcol = 768 + h * 64; a.kcol = 768 + 256 + (h >> 1) * 64; a.vcol = 768 + 384 + (h >> 1) * 64; a.ocol = 256 + h * 64;
      a.gq = p.qkn_b + l * 128; a.gk = a.gq + 64;
      a.qscale = 0.125f * LOG2E;
      a.hw = 128; a.rmul = 1; a.sinkv = p.sink_b[l * 4 + h] * LOG2E;
      attn_item<2, 1, 1>(p, a, Ks, Vts, tab);
    } else {
      const int id = item - nD - nA - nB;
      const int b = id / 96, rem = id % 96, g = rem >> 5, i2 = (rem >> 4) & 1, blk = rem & 15;
      const int r = g == 0 ? 1 : (g == 1 ? 4 : 16);
      const int L = SEQL / r, bps = L >> 7;
      const int pp = blk / bps, m0 = (blk % bps) * 128;
      const int hh = g * 2 + i2;
      for (int i = tid; i < 257; i += 256) tab[i] = p.lut[(4 + hh) * 257 + i];
      const int kstart = m0 - 64 < 0 ? 0 : m0 - 64, kend = m0 + 192 > L ? L : m0 + 192;
      a.qbase = b * SEQL + pp; a.qstride = r; a.qpos0 = m0;
      a.ktokbase = a.qbase + kstart * r; a.ktokstep = 64 * r; a.kstride = r; a.kposbase = kstart; a.kposstep = 64; a.ntiles = (kend - kstart) >> 6;
      a.qcol = 1280 + hh * 64; a.kcol = 1280 + 384 + hh * 64; a.vcol = 1280 + 768 + hh * 64; a.ocol = 512 + hh * 64;
      a.gq = p.qkn_c + l * 128; a.gk = a.gq + 64;
      a.qscale = 0.125f * LOG2E;
      a.hw = 64; a.rmul = r; a.lsecol = hh;
      attn_item<2, 1, 2>(p, a, Ks, Vts, tab);
    }
  }
}

__device__ __forceinline__ void combine_phase(const Params& p) {
  const int nthr = gridDim.x * 256;
  for (int i = blockIdx.x * 256 + opaque_tid(); i < NTOK * 48; i += nthr) {
    const int tok = i / 48, rem = i % 48, hh = rem >> 3, ch = rem & 7, ii = hh & 1, g = hh >> 1;
    const float* ls = p.lse + (size_t)tok * 6;
    const float l0 = ls[ii], l1 = ls[2 + ii], l2 = ls[4 + ii];
    const float mx = fmaxf(l0, fmaxf(l1, l2));
    const float e0 = __expf(l0 - mx), e1 = __expf(l1 - mx), e2 = __expf(l2 - mx);
    const float al = (g == 0 ? e0 : (g == 1 ? e1 : e2)) / (e0 + e1 + e2);
    bf16_t* ptr = p.hbuf + (size_t)tok * MW + 512 + hh * 64 + ch * 8;
    u32x4 v = *(const u32x4*)ptr;
#pragma unroll
    for (int k = 0; k < 4; ++k) v[k] = pk_bf16(bf_lo(v[k]) * al, bf_hi(v[k]) * al);
    *(u32x4*)ptr = v;
  }
}


#ifndef DBG_STOP
#define DBG_STOP 0
#endif
__device__ __forceinline__ void dbg_dump(const Params& p, const bf16_t* buf, int ld) {
  const int nthr = gridDim.x * 256;
  for (size_t i = (size_t)blockIdx.x * 256 + opaque_tid(); i < (size_t)NTOK * 1024; i += nthr) {
    const size_t tok = i >> 10; const int c = (int)(i & 1023);
    p.out[i] = __uint_as_float((unsigned)buf[tok * ld + c] << 16);
  }
}

__global__ void __launch_bounds__(256, 2) fwd_megakernel(Params p) {
  __shared__ __attribute__((aligned(16))) char smem[2 * 128 * LDSROW * 2];
  cg::grid_group grid = cg::this_grid();
  prologue_phase(p, smem);
  grid.sync();
  if (DBG_STOP == 3) {
    const int nthr = gridDim.x * 256;
    for (size_t i = (size_t)blockIdx.x * 256 + opaque_tid(); i < (size_t)NTOK * 1024; i += nthr) {
      const size_t j = (i * 7) % ((size_t)4 * WT_LAYER);
      p.out[i] = __uint_as_float((unsigned)p.wt[j] << 16) + p.mod[i % (4 * 48 * 6144)] + p.lut[i % (14 * 257)];
    }
    return;
  }
  for (int l = 0; l < 4; ++l) {
    const bool first = (l == 0);
    const bf16_t* wt = p.wt + (size_t)l * WT_LAYER;
    norm_phase(p, l, first, p.norm_attn_g + l * DM, 0, 1024);
    grid.sync();
    if (DBG_STOP == 4) { dbg_dump(p, p.hbuf, DM); return; }
    gemm_phase<0>(p, l, false, p.hbuf, DM, wt + WT_IN, 1024, 768, 25, 5, p.proj, PW, 0, smem);
    grid.sync();
    if (DBG_STOP == 2) { dbg_dump(p, p.proj, PW); return; }
    attn_phase(p, l, smem);
    grid.sync();
    combine_phase(p);
    grid.sync();
    if (DBG_STOP == 1) { dbg_dump(p, p.hbuf, MW); return; }
    gemm_phase<1>(p, l, first, p.hbuf, MW, wt + WT_OUT, 1152, 768, 8, 8, nullptr, 0, 2048, smem);
    grid.sync();
    norm_phase(p, l, false, p.norm_ffn_g + l * DM, 3072, 4096);
    grid.sync();
    gemm_phase<2>(p, l, false, p.hbuf, DM, wt + WT_UP, 1024, 816, 44, 4, p.proj, DFF, 0, smem);
    grid.sync();
    gemm_phase<1>(p, l, false, p.proj, DFF, wt + WT_DOWN, 2816, 768, 8, 8, nullptr, 0, 5120, smem);
    grid.sync();
  }
}

extern "C" void kernel_launch(void* const* d_in, const int* in_sizes, int n_in, void* d_out, int out_size, void* d_ws, size_t ws_size,
                              hipStream_t stream) {
  static int grid_blocks = 0;
  if (!grid_blocks) {
    int dev = 0, cus = 0, per_cu = 0;
    hipGetDevice(&dev);
    hipDeviceGetAttribute(&cus, hipDeviceAttributeMultiprocessorCount, dev);
    hipOccupancyMaxActiveBlocksPerMultiprocessor(&per_cu, fwd_megakernel, 256, 0);
    if (per_cu > 2) per_cu = 2;
    if (per_cu < 1) per_cu = 1;
    grid_blocks = cus * per_cu;
  }
  Params p{};
  const float* const* in = (const float* const*)d_in;
  p.x_prompt = in[0]; p.x_sample = in[1]; p.c_prompt = in[2]; p.c_sample = in[3]; p.norm_attn_g = in[4]; p.norm_ffn_g = in[5];
  p.w_ada = in[6]; p.b_ada = in[7]; p.w_in = in[8]; p.qkn_a = in[9]; p.qkn_b = in[10]; p.qkn_c = in[11]; p.qkn_d = in[12];
  p.rpb_a = in[13]; p.sink_b = in[14]; p.t5_table = in[15]; p.lam_d = in[16]; p.subln_d = in[17]; p.w_out = in[18]; p.w_up = in[19];
  p.conv_w = in[20]; p.conv_b = in[21]; p.w_down = in[22];
  p.out = (float*)d_out;
  char* ws = (char*)d_ws;
  size_t off = 0;
  p.wt = (bf16_t*)(ws + off); off += (size_t)4 * WT_LAYER * 2;
  p.mod = (float*)(ws + off); off += (size_t)4 * 48 * 6144 * 4;
  p.lut = (float*)(ws + off); off += 16384;
  p.lam = (float*)(ws + off); off += 256;
  p.lse = (float*)(ws + off); off += (size_t)NTOK * 6 * 4;
  p.proj = (bf16_t*)(ws + off); off += (size_t)NTOK * PW * 2;
  p.hbuf = (bf16_t*)(ws + off); off += (size_t)NTOK * MW * 2;
  if (off > ws_size) { fprintf(stderr, "workspace too small: need %zu have %zu\n", off, ws_size); return; }
  void* args[] = {&p};
  hipError_t e = hipLaunchCooperativeKernel((void*)fwd_megakernel, dim3(grid_blocks), dim3(256), args, 0, stream);
  if (e != hipSuccess) fprintf(stderr, "cooperative launch failed: %s (grid %d)\n", hipGetErrorString(e), grid_blocks);
}
```

```cpp
#include <hip/hip_runtime.h>
#include <hip/hip_cooperative_groups.h>
#include <cstdint>
#include <cstdio>
namespace cg = cooperative_groups;

typedef unsigned short bf16_t;
typedef short bf16x8 __attribute__((ext_vector_type(8)));
typedef float f32x4 __attribute__((ext_vector_type(4)));
typedef unsigned u32x4 __attribute__((ext_vector_type(4)));
typedef unsigned u32x2 __attribute__((ext_vector_type(2)));

#define NTOK 98304
#define DM 1024
#define PW 3200
#define MW 1152
#define DFF 2816
#define NSEQ 48
#define SEQL 2048
#define LOG2E 1.4426950408889634f
#define LN2 0.6931471805599453f
#define LDSROW 72

struct Params {
  const float *x_prompt, *x_sample, *c_prompt, *c_sample, *norm_attn_g, *norm_ffn_g, *w_ada, *b_ada, *w_in;
  const float *qkn_a, *qkn_b, *qkn_c, *qkn_d, *rpb_a, *sink_b, *t5_table, *lam_d, *subln_d, *w_out, *w_up, *conv_w, *conv_b, *w_down;
  float* out;
  bf16_t* wt; float* mod; float* lut; float* lam; float* lse; bf16_t* proj; bf16_t* hbuf; float* zeros;
};

#define WT_IN 0
#define WT_OUT (3200 * 1024)
#define WT_UP (WT_OUT + 1024 * 1152)
#define WT_DOWN (WT_UP + 5632 * 1024)
#define WT_LAYER (WT_DOWN + 1024 * 2816)

typedef __bf16 bf16x2_t __attribute__((ext_vector_type(2)));
typedef float f32x2_t __attribute__((ext_vector_type(2)));
__device__ __forceinline__ unsigned pk_bf16(float lo, float hi) {
  const f32x2_t v = {lo, hi};
  const bf16x2_t r = __builtin_convertvector(v, bf16x2_t);
  return __builtin_bit_cast(unsigned, r);
}
__device__ __forceinline__ float bf_lo(unsigned u) { return __uint_as_float(u << 16); }
__device__ __forceinline__ float bf_hi(unsigned u) { return __uint_as_float(u & 0xffff0000u); }
__device__ __forceinline__ float fexp2(float x) { return __builtin_amdgcn_exp2f(x); }

__device__ __forceinline__ const float* xin_row(const Params& p, bool first, int tok) {
  if (first) return tok < 65536 ? p.x_prompt + (size_t)tok * DM : p.x_sample + (size_t)(tok - 65536) * DM;
  return p.out + (size_t)tok * DM;
}

__device__ __forceinline__ int opaque_tid() { int t = threadIdx.x; asm volatile("" : "+v"(t)); return t; }

__device__ __forceinline__ int t5_bucket(int rel) {
  const int n = rel < 0 ? -rel : rel;
  int v;
  if (n < 8) v = n;
  else v = 8 + (n >= 12) + (n >= 16) + (n >= 23) + (n >= 32) + (n >= 46) + (n >= 64) + (n >= 91);
  return (rel > 0 ? 16 : 0) + v;
}

__device__ __forceinline__ void prologue_phase(const Params& p, char* smem) {
  const int tid = opaque_tid(), nb = gridDim.x;
  const int N_TR = 4 * 3200, N_MOD = 384;
  for (int item = blockIdx.x; item < N_TR + N_MOD + 1; item += nb) {
    if (item < N_TR) {
      const int l = item / 3200; int r = item % 3200;
      const float* src; bf16_t* dst; int K, N, kt, nt;
      if (r < 800) { K = 1024; N = 3200; src = p.w_in + (size_t)l * K * N; dst = p.wt + (size_t)l * WT_LAYER + WT_IN; kt = r / 50; nt = r % 50; }
      else if (r < 1088) { r -= 800; K = 1152; N = 1024; src = p.w_out + (size_t)l * K * N; dst = p.wt + (size_t)l * WT_LAYER + WT_OUT; kt = r / 16; nt = r % 16; }
      else if (r < 2496) { r -= 1088; K = 1024; N = 5632; src = p.w_up + (size_t)l * K * N; dst = p.wt + (size_t)l * WT_LAYER + WT_UP; kt = r / 88; nt = r % 88; }
      else { r -= 2496; K = 2816; N = 1024; src = p.w_down + (size_t)l * K * N; dst = p.wt + (size_t)l * WT_LAYER + WT_DOWN; kt = r / 16; nt = r % 16; }
      float* tile = (float*)smem;
      const int k0 = kt * 64, n0 = nt * 64;
      __syncthreads();
#pragma unroll
      for (int i = 0; i < 16; ++i) {
        const int rr = (tid >> 6) + 4 * i, cc = tid & 63;
        tile[rr * 65 + cc] = src[(size_t)(k0 + rr) * N + n0 + cc];
      }
      __syncthreads();
#pragma unroll
      for (int i = 0; i < 8; ++i) {
        const int idx = tid + 256 * i, n = idx >> 5, k2 = (idx & 31) * 2;
        *(unsigned*)(dst + (size_t)(n0 + n) * K + k0 + k2) = pk_bf16(tile[k2 * 65 + n], tile[(k2 + 1) * 65 + n]);
      }
    } else if (item < N_TR + N_MOD) {
      int r = item - N_TR;
      const int l = r / 96; r %= 96;
      const int nc = r / 4, bg = r % 4;
      const int n = nc * 256 + tid;
      float* sc = (float*)smem;
      float acc[12];
#pragma unroll
      for (int j = 0; j < 12; ++j) acc[j] = 0.f;
      const float* W = p.w_ada + (size_t)l * 1024 * 6144 + n;
      for (int kc = 0; kc < 2; ++kc) {
        __syncthreads();
        for (int i = tid; i < 12 * 512; i += 256) {
          const int j = i >> 9, k = i & 511, b = bg * 12 + j;
          const float c = b < 32 ? p.c_prompt[b * 1024 + kc * 512 + k] : p.c_sample[(b - 32) * 1024 + kc * 512 + k];
          sc[i] = c / (1.f + __expf(-c));
        }
        __syncthreads();
#pragma unroll 2
        for (int k = 0; k < 512; k += 4) {
          const float w0 = W[(size_t)(kc * 512 + k) * 6144], w1 = W[(size_t)(kc * 512 + k + 1) * 6144];
          const float w2 = W[(size_t)(kc * 512 + k + 2) * 6144], w3 = W[(size_t)(kc * 512 + k + 3) * 6144];
#pragma unroll
          for (int j = 0; j < 12; ++j) {
            const f32x4 s = *(const f32x4*)(sc + j * 512 + k);
            acc[j] += s[0] * w0 + s[1] * w1 + s[2] * w2 + s[3] * w3;
          }
        }
      }
      const float bias = p.b_ada[l * 6144 + n];
#pragma unroll
      for (int j = 0; j < 12; ++j) p.mod[((size_t)l * 48 + bg * 12 + j) * 6144 + n] = acc[j] + bias;
    } else {
      for (int i = tid; i < 14 * 257; i += 256) {
        const int hd = i / 257, idx = i % 257;
        p.lut[i] = p.t5_table[t5_bucket(idx - 128) * 14 + hd] * LOG2E;
      }
      if (tid < 64) p.zeros[tid] = 0.f;
      if (tid < 4) {
        const float* lp = p.lam_d + tid * 128;
        float s1 = 0.f, s2 = 0.f;
        for (int e = 0; e < 32; ++e) { s1 += lp[e] * lp[32 + e]; s2 += lp[64 + e] * lp[96 + e]; }
        const float li = 0.8f - 0.6f * expf(-0.3f * (float)tid);
        p.lam[tid] = expf(s1) - expf(s2) + li;
      }
    }
  }
}

__device__ __forceinline__ void norm_phase(const Params& p, int l, bool first, const float* g, int shift_off, int scale_off) {
  const int tid0 = opaque_tid();
  const int lane = tid0 & 63, w = tid0 >> 6;
  for (int row = blockIdx.x * 4 + w; row < NTOK; row += gridDim.x * 4) {
    const float* xr = xin_row(p, first, row);
    const int b = row >> 11;
    const float* md = p.mod + ((size_t)l * 48 + b) * 6144;
    f32x4 v[4];
    float ss = 0.f;
#pragma unroll
    for (int i = 0; i < 4; ++i) {
      v[i] = *(const f32x4*)(xr + i * 256 + lane * 4);
      ss += v[i][0] * v[i][0] + v[i][1] * v[i][1] + v[i][2] * v[i][2] + v[i][3] * v[i][3];
    }
#pragma unroll
    for (int o = 32; o >= 1; o >>= 1) ss += __shfl_xor(ss, o);
    const float rstd = rsqrtf(ss * (1.f / 1024.f) + 1e-6f);
#pragma unroll
    for (int i = 0; i < 4; ++i) {
      const int k = i * 256 + lane * 4;
      const f32x4 gg = *(const f32x4*)(g + k), sc = *(const f32x4*)(md + scale_off + k), sh = *(const f32x4*)(md + shift_off + k);
      f32x4 y;
#pragma unroll
      for (int j = 0; j < 4; ++j) y[j] = (v[i][j] * rstd) * gg[j] * (1.f + sc[j]) + sh[j];
      u32x2 o; o[0] = pk_bf16(y[0], y[1]); o[1] = pk_bf16(y[2], y[3]);
      *(u32x2*)(p.hbuf + (size_t)row * DM + k) = o;
    }
  }
}

__device__ __forceinline__ bool gemm_tile_id(int it, int MT, int NT, int NB, int& mt, int& nt) {
  const int nb = gridDim.x, bid = blockIdx.x;
  if ((nb & 7) == 0) {
    const int x = bid & 7, slot = bid >> 3, S = nb >> 3;
    const int TPS = 8 * NB, NSN = NT / NB, NS = (MT / 8) * NSN;
    const int pidx = slot + S * it, sidx = pidx / TPS, w = pidx % TPS, s = x + 8 * sidx;
    if (s >= NS) return false;
    mt = (s / NSN) * 8 + (w & 7); nt = (s % NSN) * NB + (w >> 3);
    return true;
  }
  const int t = bid + nb * it;
  if (t >= MT * NT) return false;
  mt = t / NT; nt = t % NT;
  return true;
}

template <int M, int NN>
__device__ __forceinline__ void up_epi_row(const f32x4 (&acc)[8][4], const f32x4 (&w0)[2], const f32x4 (&w1)[2], const f32x4 (&w2)[2],
                                           const f32x4 (&bb)[2], int lane, int fr, int s0, bf16_t* obase) {
  constexpr int MP = M > 0 ? M - 1 : 0, MN = M < 7 ? M + 1 : 7;
  const int srcp = (lane & 48) | ((fr + 15) & 15), srcn = (lane & 48) | ((fr + 1) & 15);
  float y[2][4];
#pragma unroll
  for (int n = 0; n < 2; ++n)
#pragma unroll
    for (int j = 0; j < 4; ++j) {
      const float cur = acc[M][NN + 2 * n][j];
      const float zp = (fr == 15) ? acc[MP][NN + 2 * n][j] : cur, zn = (fr == 0) ? acc[MN][NN + 2 * n][j] : cur;
      const float pv = __shfl(zp, srcp), nv = __shfl(zn, srcn);
      y[n][j] = w0[n][j] * pv + w1[n][j] * cur + w2[n][j] * nv + bb[n][j];
    }
  const int row = 16 * M + fr, tpos = s0 + row;
  if (row >= 1 && row <= 126 && tpos >= 0 && tpos < SEQL) {
    float a[4];
#pragma unroll
    for (int j = 0; j < 4; ++j) { const float gte = y[1][j]; a[j] = y[0][j] * gte / (1.f + __expf(-gte)); }
    u32x2 o; o[0] = pk_bf16(a[0], a[1]); o[1] = pk_bf16(a[2], a[3]);
    *(u32x2*)(obase + (size_t)tpos * DFF) = o;
  }
  __builtin_amdgcn_sched_barrier(0);
}

#define GB_A 16384
#define GB_BUF 24576
template <int EPI>
__device__ __forceinline__ void gemm_phase(const Params& p, int l, bool first, const bf16_t* A, int lda, const bf16_t* Bt, int K, int MT, int NT, int NB,
                           bf16_t* outb, int ldc, int gate_off, char* smem) {
  const int tid = opaque_tid(), lane = tid & 63, w = tid >> 6, wr = w >> 1, wcn = w & 1, fr = lane & 15, fq = lane >> 4;
  const int nk = K / 32;
  const int lrow = tid >> 2, lch = tid & 3;
  for (int it = 0;; ++it) {
    int mt, nt;
    if (!gemm_tile_id(it, MT, NT, NB, mt, nt)) break;
    const bf16_t* ga[4]; const bf16_t* gb[2]; int astep[4];
#pragma unroll
    for (int i = 0; i < 4; ++i) {
      const int row = i * 64 + lrow;
      if (EPI == 2) {
        const int wi = 2 * mt + (i >> 1), seq = wi / 17, tpos = 126 * (wi % 17) - 1 + (row & 127);
        const bool valid = tpos >= 0 && tpos < SEQL;
        ga[i] = valid ? A + (size_t)(seq * SEQL + tpos) * lda + lch * 8 : (const bf16_t*)p.zeros + lch * 8;
        astep[i] = valid ? 32 : 0;
      } else { ga[i] = A + (size_t)(mt * 256 + row) * lda + lch * 8; astep[i] = 32; }
    }
#pragma unroll
    for (int i = 0; i < 2; ++i) {
      const int brow = (EPI == 2) ? (i * DFF + nt * 64 + lrow) : (nt * 128 + i * 64 + lrow);
      gb[i] = Bt + (size_t)brow * K + lch * 8;
    }
    f32x4 acc[8][4];
#pragma unroll
    for (int m = 0; m < 8; ++m)
#pragma unroll
      for (int n = 0; n < 4; ++n) acc[m][n] = (f32x4){0.f, 0.f, 0.f, 0.f};
    __syncthreads();
#pragma unroll
    for (int i = 0; i < 4; ++i) __builtin_amdgcn_global_load_lds((const unsigned*)ga[i], (unsigned*)(smem + i * 4096 + tid * 16), 16, 0, 0);
#pragma unroll
    for (int i = 0; i < 2; ++i) __builtin_amdgcn_global_load_lds((const unsigned*)gb[i], (unsigned*)(smem + GB_A + i * 4096 + tid * 16), 16, 0, 0);
    for (int kt = 0; kt < nk; ++kt) {
      asm volatile("s_waitcnt vmcnt(0)" ::: "memory");
      __syncthreads();
      if (kt + 1 < nk) {
        char* dst = smem + ((kt + 1) & 1) * GB_BUF;
#pragma unroll
        for (int i = 0; i < 4; ++i)
          __builtin_amdgcn_global_load_lds((const unsigned*)(ga[i] + (kt + 1) * astep[i]), (unsigned*)(dst + i * 4096 + tid * 16), 16, 0, 0);
#pragma unroll
        for (int i = 0; i < 2; ++i)
          __builtin_amdgcn_global_load_lds((const unsigned*)(gb[i] + (kt + 1) * 32), (unsigned*)(dst + GB_A + i * 4096 + tid * 16), 16, 0, 0);
      }
      const char* Ab = smem + (kt & 1) * GB_BUF;
      const char* Bb = Ab + GB_A;
      bf16x8 af[8];
#pragma unroll
      for (int m = 0; m < 8; ++m) af[m] = *(const bf16x8*)(Ab + (wr * 128 + 16 * m + fr) * 64 + fq * 16);
#pragma unroll
      for (int n = 0; n < 4; ++n) {
        const int br = (EPI == 2) ? ((n >> 1) * 64 + 32 * wcn + 16 * (n & 1) + fr) : (64 * wcn + 16 * n + fr);
        const bf16x8 bfr = *(const bf16x8*)(Bb + br * 64 + fq * 16);
#pragma unroll
        for (int m = 0; m < 8; ++m) acc[m][n] = __builtin_amdgcn_mfma_f32_16x16x32_bf16(bfr, af[m], acc[m][n], 0, 0, 0);
      }
    }
    int lane_e = lane; asm volatile("" : "+v"(lane_e));
    const int fr_e = lane_e & 15, fq_e = lane_e >> 4;
    if (EPI == 0) {
#pragma unroll
      for (int m = 0; m < 8; ++m) {
        const int tok = mt * 256 + wr * 128 + 16 * m + fr_e;
#pragma unroll
        for (int n = 0; n < 4; ++n) {
          const int col = nt * 128 + 64 * wcn + 16 * n + 4 * fq_e;
          u32x2 o; o[0] = pk_bf16(acc[m][n][0], acc[m][n][1]); o[1] = pk_bf16(acc[m][n][2], acc[m][n][3]);
          *(u32x2*)(outb + (size_t)tok * ldc + col) = o;
        }
      }
    } else if (EPI == 1) {
      const int b = (mt * 256) >> 11;
      const float* gate = p.mod + ((size_t)l * 48 + b) * 6144 + gate_off;
#pragma unroll
      for (int n = 0; n < 4; ++n) {
        const int col = nt * 128 + 64 * wcn + 16 * n + 4 * fq_e;
        const f32x4 gv = *(const f32x4*)(gate + col);
#pragma unroll
        for (int m = 0; m < 8; ++m) {
          const int tok = mt * 256 + wr * 128 + 16 * m + fr_e;
          const f32x4 xv = *(const f32x4*)(xin_row(p, first, tok) + col);
          f32x4 o;
#pragma unroll
          for (int j = 0; j < 4; ++j) o[j] = xv[j] + gv[j] * acc[m][n][j];
          *(f32x4*)(p.out + (size_t)tok * DM + col) = o;
        }
      }
    } else {
      const float* cw = p.conv_w + (size_t)l * 3 * 5632;
      const float* cb = p.conv_b + (size_t)l * 5632;
      const int wi = 2 * mt + wr, seq = wi / 17, s0 = 126 * (wi % 17) - 1;
#define UP_EPI_NN(NN)                                                                                                      \
      {                                                                                                                    \
        const int cbase = nt * 64 + 32 * wcn + 16 * NN + 4 * fq_e;                                                           \
        f32x4 w0[2], w1[2], w2[2], bb[2];                                                                                  \
        _Pragma("unroll") for (int n = 0; n < 2; ++n) {                                                                    \
          const int c = n * DFF + cbase;                                                                                   \
          w0[n] = *(const f32x4*)(cw + c); w1[n] = *(const f32x4*)(cw + 5632 + c); w2[n] = *(const f32x4*)(cw + 2 * 5632 + c); \
          bb[n] = *(const f32x4*)(cb + c);                                                                                 \
        }                                                                                                                  \
        bf16_t* obase = outb + (size_t)(seq * SEQL) * DFF + cbase;                                                         \
        up_epi_row<0, NN>(acc, w0, w1, w2, bb, lane_e, fr_e, s0, obase); up_epi_row<1, NN>(acc, w0, w1, w2, bb, lane_e, fr_e, s0, obase); \
        up_epi_row<2, NN>(acc, w0, w1, w2, bb, lane_e, fr_e, s0, obase); up_epi_row<3, NN>(acc, w0, w1, w2, bb, lane_e, fr_e, s0, obase); \
        up_epi_row<4, NN>(acc, w0, w1, w2, bb, lane_e, fr_e, s0, obase); up_epi_row<5, NN>(acc, w0, w1, w2, bb, lane_e, fr_e, s0, obase); \
        up_epi_row<6, NN>(acc, w0, w1, w2, bb, lane_e, fr_e, s0, obase); up_epi_row<7, NN>(acc, w0, w1, w2, bb, lane_e, fr_e, s0, obase); \
      }
      UP_EPI_NN(0)
      UP_EPI_NN(1)
#undef UP_EPI_NN
    }
  }
}

struct AttnArgs {
  int qbase, qstride, qpos0;
  int ktokbase, ktokstep, kstride, kposbase, kposstep, ntiles;
  int qcol, kcol, vcol, ocol;
  const float *gq, *gk;
  float qscale;
  int hw, rmul, taboff0;
  float sinkv;
  float lam, outscale;
  const float* subg;
  int lsecol;
};

template <int NQ, int NC, int MODE>
__device__ __forceinline__ void attn_item(const Params& p, const AttnArgs& a, bf16_t* Ks, bf16_t* Vts, const float* tab) {
  const int tid = opaque_tid(), lane = tid & 63, w = tid >> 6, fr = lane & 15, fq = lane >> 4;
  const int wq0 = a.qpos0 + w * 16 * NQ;
  bf16x8 qf[NQ][2];
  int qpos[NQ];
#pragma unroll
  for (int qt = 0; qt < NQ; ++qt) {
    const int qp = wq0 + qt * 16 + fr;
    qpos[qt] = qp;
    const bf16_t* qrow = p.proj + (size_t)(a.qbase + qp * a.qstride) * PW + a.qcol;
    const u32x4 v0 = *(const u32x4*)(qrow + fq * 8), v1 = *(const u32x4*)(qrow + 32 + fq * 8);
    float f0[8], f1[8];
#pragma unroll
    for (int i = 0; i < 4; ++i) { f0[2 * i] = bf_lo(v0[i]); f0[2 * i + 1] = bf_hi(v0[i]); f1[2 * i] = bf_lo(v1[i]); f1[2 * i + 1] = bf_hi(v1[i]); }
    float s0 = 0.f, s1 = 0.f;
#pragma unroll
    for (int i = 0; i < 8; ++i) { s0 += f0[i] * f0[i]; s1 += f1[i] * f1[i]; }
    float r0, r1;
    if (NC == 1) {
      float s = s0 + s1; s += __shfl_xor(s, 16); s += __shfl_xor(s, 32);
      r0 = r1 = rsqrtf(s * (1.f / 64.f) + 1e-6f) * a.qscale;
    } else {
      s0 += __shfl_xor(s0, 16); s0 += __shfl_xor(s0, 32);
      s1 += __shfl_xor(s1, 16); s1 += __shfl_xor(s1, 32);
      r0 = rsqrtf(s0 * (1.f / 32.f) + 1e-6f) * a.qscale; r1 = rsqrtf(s1 * (1.f / 32.f) + 1e-6f) * a.qscale;
    }
    const float* g0p = a.gq + fq * 8;
    const float* g1p = (NC == 1) ? a.gq + 32 + fq * 8 : g0p;
    u32x4 q0, q1;
#pragma unroll
    for (int i = 0; i < 4; ++i) {
      q0[i] = pk_bf16(f0[2 * i] * r0 * g0p[2 * i], f0[2 * i + 1] * r0 * g0p[2 * i + 1]);
      q1[i] = pk_bf16(f1[2 * i] * r1 * g1p[2 * i], f1[2 * i + 1] * r1 * g1p[2 * i + 1]);
    }
    qf[qt][0] = __builtin_bit_cast(bf16x8, q0);
    qf[qt][1] = __builtin_bit_cast(bf16x8, q1);
  }
  f32x4 o[NC][NQ][4];
  float mrun[NC][NQ], lrun[NC][NQ];
#pragma unroll
  for (int c = 0; c < NC; ++c)
#pragma unroll
    for (int qt = 0; qt < NQ; ++qt) {
      if (MODE == 1) { mrun[c][qt] = a.sinkv; lrun[c][qt] = (fq == 0) ? 1.f : 0.f; }
      else { mrun[c][qt] = -1e30f; lrun[c][qt] = 0.f; }
#pragma unroll
      for (int dt = 0; dt < 4; ++dt) o[c][qt][dt] = (f32x4){0.f, 0.f, 0.f, 0.f};
    }
  const int lch = tid & 7;
  float gkv[8];
#pragma unroll
  for (int i = 0; i < 8; ++i) gkv[i] = a.gk[((NC == 1) ? lch : (lch & 3)) * 8 + i];

  for (int t = 0; t < a.ntiles; ++t) {
    const int ktok0 = a.ktokbase + t * a.ktokstep;
    __syncthreads();
#pragma unroll
    for (int it = 0; it < 2; ++it) {
      const int key = (tid >> 3) + 32 * it;
      const u32x4 v = *(const u32x4*)(p.proj + (size_t)(ktok0 + key * a.kstride) * PW + a.kcol + lch * 8);
      float f[8];
#pragma unroll
      for (int i = 0; i < 4; ++i) { f[2 * i] = bf_lo(v[i]); f[2 * i + 1] = bf_hi(v[i]); }
      float s = 0.f;
#pragma unroll
      for (int i = 0; i < 8; ++i) s += f[i] * f[i];
      s += __shfl_xor(s, 1); s += __shfl_xor(s, 2);
      float rs;
      if (NC == 1) { s += __shfl_xor(s, 4); rs = rsqrtf(s * (1.f / 64.f) + 1e-6f); }
      else rs = rsqrtf(s * (1.f / 32.f) + 1e-6f);
      u32x4 kq;
#pragma unroll
      for (int i = 0; i < 4; ++i) kq[i] = pk_bf16(f[2 * i] * rs * gkv[2 * i], f[2 * i + 1] * rs * gkv[2 * i + 1]);
      *(u32x4*)(Ks + key * LDSROW + lch * 8) = kq;
    }
    {
      const int key = tid & 63;
      const bf16_t* vrow = p.proj + (size_t)(ktok0 + key * a.kstride) * PW + a.vcol;
#pragma unroll
      for (int it = 0; it < 2; ++it) {
        const int ch = (tid >> 6) + 4 * it;
        const u32x4 v = *(const u32x4*)(vrow + ch * 8);
#pragma unroll
        for (int i = 0; i < 4; ++i) {
          Vts[(ch * 8 + 2 * i) * LDSROW + key] = (bf16_t)(v[i] & 0xffffu);
          Vts[(ch * 8 + 2 * i + 1) * LDSROW + key] = (bf16_t)(v[i] >> 16);
        }
      }
    }
    __syncthreads();
    const int kp0 = a.kposbase + t * a.kposstep;
    const int taboff = a.taboff0 + t * 31;
    bf16x8 pf[NC][NQ][2];
    __builtin_amdgcn_sched_barrier(0);
#pragma unroll
    for (int qt = 0; qt < NQ; ++qt) {
      const int qp = qpos[qt];
      int cs = qp - 8; cs = cs < 0 ? 0 : (cs > 48 ? 48 : cs);
      f32x4 bv[4];
#pragma unroll
      for (int kt = 0; kt < 4; ++kt)
#pragma unroll
        for (int j = 0; j < 4; ++j) {
          const int kpos = kp0 + kt * 16 + 4 * fq + j;
          const int d = kpos - qp;
          bool valid; int idx;
          if (MODE == 0) {
            valid = kpos >= cs && kpos < cs + 16;
            int dd = d + 15; dd = dd < 0 ? 0 : (dd > 30 ? 30 : dd);
            idx = taboff + dd;
          } else {
            valid = (MODE == 3) ? true : (d <= a.hw && d >= -a.hw);
            int dd = d * a.rmul; dd = dd < -128 ? -128 : (dd > 128 ? 128 : dd);
            idx = dd + 128;
          }
          const float bias = tab[idx];
          bv[kt][j] = valid ? bias : -INFINITY;
        }
#pragma unroll
      for (int c = 0; c < NC; ++c) {
        f32x4 s[4];
#pragma unroll
        for (int kt = 0; kt < 4; ++kt) {
          if (NC == 1) {
            const bf16x8 k0 = *(const bf16x8*)(Ks + (kt * 16 + fr) * LDSROW + fq * 8);
            const bf16x8 k1 = *(const bf16x8*)(Ks + (kt * 16 + fr) * LDSROW + 32 + fq * 8);
            const f32x4 r = __builtin_amdgcn_mfma_f32_16x16x32_bf16(k0, qf[qt][0], bv[kt], 0, 0, 0);
            s[kt] = __builtin_amdgcn_mfma_f32_16x16x32_bf16(k1, qf[qt][1], r, 0, 0, 0);
          } else {
            const bf16x8 k0 = *(const bf16x8*)(Ks + (kt * 16 + fr) * LDSROW + c * 32 + fq * 8);
            s[kt] = __builtin_amdgcn_mfma_f32_16x16x32_bf16(k0, qf[qt][c], bv[kt], 0, 0, 0);
          }
        }
        float mx = -INFINITY;
#pragma unroll
        for (int kt = 0; kt < 4; ++kt)
#pragma unroll
          for (int j = 0; j < 4; ++j) mx = fmaxf(mx, s[kt][j]);
        mx = fmaxf(mx, __shfl_xor(mx, 16)); mx = fmaxf(mx, __shfl_xor(mx, 32));
        const float mn = fmaxf(mrun[c][qt], mx);
        const float al = fexp2(mrun[c][qt] - mn);
        mrun[c][qt] = mn;
        float rs = 0.f;
#pragma unroll
        for (int kt = 0; kt < 4; ++kt)
#pragma unroll
          for (int j = 0; j < 4; ++j) { const float pv = fexp2(s[kt][j] - mn); s[kt][j] = pv; rs += pv; }
        lrun[c][qt] = lrun[c][qt] * al + rs;
#pragma unroll
        for (int dt = 0; dt < 4; ++dt) o[c][qt][dt] *= al;
#pragma unroll
        for (int ks = 0; ks < 2; ++ks) {
          u32x4 pk;
          pk[0] = pk_bf16(s[2 * ks][0], s[2 * ks][1]); pk[1] = pk_bf16(s[2 * ks][2], s[2 * ks][3]);
          pk[2] = pk_bf16(s[2 * ks + 1][0], s[2 * ks + 1][1]); pk[3] = pk_bf16(s[2 * ks + 1][2], s[2 * ks + 1][3]);
          pf[c][qt][ks] = __builtin_bit_cast(bf16x8, pk);
        }
        __builtin_amdgcn_sched_barrier(0);
      }
    }
#pragma unroll
    for (int ks = 0; ks < 2; ++ks) {
#pragma unroll
      for (int dt = 0; dt < 4; ++dt) {
        const u32x2 lo = *(const u32x2*)(Vts + (dt * 16 + fr) * LDSROW + ks * 32 + 4 * fq);
        const u32x2 hi = *(const u32x2*)(Vts + (dt * 16 + fr) * LDSROW + ks * 32 + 16 + 4 * fq);
        u32x4 vv; vv[0] = lo[0]; vv[1] = lo[1]; vv[2] = hi[0]; vv[3] = hi[1];
        const bf16x8 vf = __builtin_bit_cast(bf16x8, vv);
#pragma unroll
        for (int c = 0; c < NC; ++c)
#pragma unroll
          for (int qt = 0; qt < NQ; ++qt) o[c][qt][dt] = __builtin_amdgcn_mfma_f32_16x16x32_bf16(vf, pf[c][qt][ks], o[c][qt][dt], 0, 0, 0);
      }
    }
  }
#pragma unroll
  for (int qt = 0; qt < NQ; ++qt) {
    float inv[NC], ltot[NC];
#pragma unroll
    for (int c = 0; c < NC; ++c) {
      float lt = lrun[c][qt];
      lt += __shfl_xor(lt, 16); lt += __shfl_xor(lt, 32);
      ltot[c] = lt; inv[c] = 1.f / lt;
    }
    const int tok = a.qbase + qpos[qt] * a.qstride;
    bf16_t* orow = p.hbuf + (size_t)tok * MW + a.ocol;
    if (MODE == 3) {
      f32x4 v[4];
      float ss = 0.f;
#pragma unroll
      for (int dt = 0; dt < 4; ++dt)
#pragma unroll
        for (int j = 0; j < 4; ++j) {
          const float x = o[0][qt][dt][j] * inv[0] - a.lam * (o[NC - 1][qt][dt][j] * inv[NC - 1]);
          v[dt][j] = x; ss += x * x;
        }
      ss += __shfl_xor(ss, 16); ss += __shfl_xor(ss, 32);
      const float rstd = rsqrtf(ss * (1.f / 64.f) + 1e-6f) * a.outscale;
#pragma unroll
      for (int dt = 0; dt < 4; ++dt) {
        const f32x4 g = *(const f32x4*)(a.subg + dt * 16 + 4 * fq);
        u32x2 ov; ov[0] = pk_bf16(v[dt][0] * rstd * g[0], v[dt][1] * rstd * g[1]); ov[1] = pk_bf16(v[dt][2] * rstd * g[2], v[dt][3] * rstd * g[3]);
        *(u32x2*)(orow + dt * 16 + 4 * fq) = ov;
      }
    } else {
#pragma unroll
      for (int dt = 0; dt < 4; ++dt) {
        u32x2 ov;
        ov[0] = pk_bf16(o[0][qt][dt][0] * inv[0], o[0][qt][dt][1] * inv[0]);
        ov[1] = pk_bf16(o[0][qt][dt][2] * inv[0], o[0][qt][dt][3] * inv[0]);
        *(u32x2*)(orow + dt * 16 + 4 * fq) = ov;
      }
      if (MODE == 2 && fq == 0) p.lse[(size_t)tok * 6 + a.lsecol] = (mrun[0][qt] + __log2f(ltot[0])) * LN2;
    }
  }
}

__device__ __forceinline__ void attn_phase(const Params& p, int l, char* smem) {
  bf16_t* Ks = (bf16_t*)smem;
  bf16_t* Vts = Ks + 64 * LDSROW;
  float* tab = (float*)(Vts + 64 * LDSROW);
  const int tid = opaque_tid();
  const int nD = 6144, nA = 6144, nB = 3072, nC = 4608;
  for (int item = blockIdx.x; item < nD + nA + nB + nC; item += gridDim.x) {
    AttnArgs a;
    a.taboff0 = 0; a.sinkv = 0.f; a.lam = 0.f; a.outscale = 1.f; a.subg = nullptr; a.lsecol = 0; a.hw = 1 << 20; a.rmul = 1;
    __syncthreads();
    if (item < nD) {
      const int b = item >> 7, h = (item >> 5) & 3, qb = item & 31;
      for (int i = tid; i < 257; i += 256) tab[i] = p.lut[(10 + h) * 257 + i];
      a.qbase = b * SEQL; a.qstride = 1; a.qpos0 = qb * 64;
      a.ktokbase = b * SEQL; a.ktokstep = 64; a.kstride = 1; a.kposbase = 0; a.kposstep = 64; a.ntiles = 32;
      a.qcol = 2432 + h * 64; a.kcol = 2432 + 256 + h * 64; a.vcol = 2432 + 512 + h * 64; a.ocol = 896 + h * 64;
      a.gq = p.qkn_d + l * 64; a.gk = a.gq + 32;
      a.qscale = 0.17677669529663687f * LOG2E;
      a.lam = p.lam[l]; a.outscale = 1.f - (0.8f - 0.6f * expf(-0.3f * (float)l)); a.subg = p.subln_d + l * 64;
      attn_item<1, 2, 3>(p, a, Ks, Vts, tab);
    } else if (item < nD + nA) {
      const int id = item - nD;
      const int b = id >> 7, h = (id >> 5) & 3, r = id & 31;
      const float* rp = p.rpb_a + ((size_t)l * 4 + h) * 465;
      for (int i = tid; i < 465; i += 256) tab[i] = rp[i] * LOG2E;
      int rs = r - 4; rs = rs < 0 ? 0 : (rs > 24 ? 24 : rs);
      a.qbase = b * SEQL + r * 64; a.qstride = 1; a.qpos0 = 0;
      a.ktokbase = b * SEQL + rs * 64; a.ktokstep = 64; a.kstride = 1; a.kposbase = 0; a.kposstep = 0; a.ntiles = 8;
      a.qcol = h * 64; a.kcol = 256 + h * 64; a.vcol = 512 + h * 64; a.ocol = h * 64;
      a.gq = p.qkn_a + l * 128; a.gk = a.gq + 64;
      a.qscale = 0.125f * LOG2E;
      a.taboff0 = (rs - r + 7) * 31;
      attn_item<1, 1, 0>(p, a, Ks, Vts, tab);
    } else if (item < nD + nA + nB) {
      const int id = item - nD - nA;
      const int b = id >> 6, h = (id >> 4) & 3, qb = id & 15;
      for (int i = tid; i < 257; i += 256) tab[i] = p.lut[h * 257 + i];
      const int q0 = qb * 128;
      const int kstart = q0 - 128 < 0 ? 0 : q0 - 128, kend = q0 + 256 > SEQL ? SEQL : q0 + 256;
      a.qbase = b * SEQL; a.qstride = 1; a.qpos0 = q0;
      a.ktokbase = b * SEQL + kstart; a.ktokstep = 64; a.kstride = 1; a.kposbase = kstart; a.kposstep = 64; a.ntiles = (kend - kstart) >> 6;
      a.qcol = 768 + h * 64; a.kcol = 768 + 256 + (h >> 1) * 64; a.vcol = 768 + 384 + (h >> 1) * 64; a.ocol = 256 + h * 64;
      a.gq = p.qkn_b + l * 128; a.gk = a.gq + 64;
      a.qscale = 0.125f * LOG2E;
      a.hw = 128; a.rmul = 1; a.sinkv = p.sink_b[l * 4 + h] * LOG2E;
      attn_item<2, 1, 1>(p, a, Ks, Vts, tab);
    } else {
      const int id = item - nD - nA - nB;
      const int b = id / 96, rem = id % 96, g = rem >> 5, i2 = (rem >> 4) & 1, blk = rem & 15;
      const int r = g == 0 ? 1 : (g == 1 ? 4 : 16);
      const int L = SEQL / r, bps = L >> 7;
      const int pp = blk / bps, m0 = (blk % bps) * 128;
      const int hh = g * 2 + i2;
      for (int i = tid; i < 257; i += 256) tab[i] = p.lut[(4 + hh) * 257 + i];
      const int kstart = m0 - 64 < 0 ? 0 : m0 - 64, kend = m0 + 192 > L ? L : m0 + 192;
      a.qbase = b * SEQL + pp; a.qstride = r; a.qpos0 = m0;
      a.ktokbase = a.qbase + kstart * r; a.ktokstep = 64 * r; a.kstride = r; a.kposbase = kstart; a.kposstep = 64; a.ntiles = (kend - kstart) >> 6;
      a.qcol = 1280 + hh * 64; a.kcol = 1280 + 384 + hh * 64; a.vcol = 1280 + 768 + hh * 64; a.ocol = 512 + hh * 64;
      a.gq = p.qkn_c + l * 128; a.gk = a.gq + 64;
      a.qscale = 0.125f * LOG2E;
      a.hw = 64; a.rmul = r; a.lsecol = hh;
      attn_item<2, 1, 2>(p, a, Ks, Vts, tab);
    }
  }
}

__device__ __forceinline__ void combine_phase(const Params& p) {
  const int nthr = gridDim.x * 256;
  for (int i = blockIdx.x * 256 + opaque_tid(); i < NTOK * 48; i += nthr) {
    const int tok = i / 48, rem = i % 48, hh = rem >> 3, ch = rem & 7, ii = hh & 1, g = hh >> 1;
    const float* ls = p.lse + (size_t)tok * 6;
    const float l0 = ls[ii], l1 = ls[2 + ii], l2 = ls[4 + ii];
    const float mx = fmaxf(l0, fmaxf(l1, l2));
    const float e0 = __expf(l0 - mx), e1 = __expf(l1 - mx), e2 = __expf(l2 - mx);
    const float al = (g == 0 ? e0 : (g == 1 ? e1 : e2)) / (e0 + e1 + e2);
    bf16_t* ptr = p.hbuf + (size_t)tok * MW + 512 + hh * 64 + ch * 8;
    u32x4 v = *(const u32x4*)ptr;
#pragma unroll
    for (int k = 0; k < 4; ++k) v[k] = pk_bf16(bf_lo(v[k]) * al, bf_hi(v[k]) * al);
    *(u32x4*)ptr = v;
  }
}


#ifndef REP_GEMM
#define REP_GEMM 1
#endif
#ifndef REP_ATTN
#define REP_ATTN 1
#endif
#ifndef DBG_STOP
#define DBG_STOP 0
#endif
__device__ __forceinline__ void dbg_dump(const Params& p, const bf16_t* buf, int ld) {
  const int nthr = gridDim.x * 256;
  for (size_t i = (size_t)blockIdx.x * 256 + opaque_tid(); i < (size_t)NTOK * 1024; i += nthr) {
    const size_t tok = i >> 10; const int c = (int)(i & 1023);
    p.out[i] = __uint_as_float((unsigned)buf[tok * ld + c] << 16);
  }
}

__global__ void __launch_bounds__(256, 2) fwd_megakernel(Params p) {
  __shared__ __attribute__((aligned(16))) char smem[2 * GB_BUF];
  cg::grid_group grid = cg::this_grid();
  prologue_phase(p, smem);
  grid.sync();
  if (DBG_STOP == 3) {
    const int nthr = gridDim.x * 256;
    for (size_t i = (size_t)blockIdx.x * 256 + opaque_tid(); i < (size_t)NTOK * 1024; i += nthr) {
      const size_t j = (i * 7) % ((size_t)4 * WT_LAYER);
      p.out[i] = __uint_as_float((unsigned)p.wt[j] << 16) + p.mod[i % (4 * 48 * 6144)] + p.lut[i % (14 * 257)];
    }
    return;
  }
  for (int l = 0; l < 4; ++l) {
    const bool first = (l == 0);
    const bf16_t* wt = p.wt + (size_t)l * WT_LAYER;
    norm_phase(p, l, first, p.norm_attn_g + l * DM, 0, 1024);
    grid.sync();
    if (DBG_STOP == 4) { dbg_dump(p, p.hbuf, DM); return; }
    for (int rep = 0; rep < REP_GEMM; ++rep) {
    gemm_phase<0>(p, l, false, p.hbuf, DM, wt + WT_IN, 1024, 384, 25, 5, p.proj, PW, 0, smem);
    grid.sync();
    }
    if (DBG_STOP == 2) { dbg_dump(p, p.proj, PW); return; }
    for (int rep = 0; rep < REP_ATTN; ++rep) {
    attn_phase(p, l, smem);
    grid.sync();
    }
    combine_phase(p);
    grid.sync();
    if (DBG_STOP == 1) { dbg_dump(p, p.hbuf, MW); return; }
    gemm_phase<1>(p, l, first, p.hbuf, MW, wt + WT_OUT, 1152, 384, 8, 8, nullptr, 0, 2048, smem);
    grid.sync();
    norm_phase(p, l, false, p.norm_ffn_g + l * DM, 3072, 4096);
    grid.sync();
    for (int rep = 0; rep < REP_GEMM; ++rep) {
    gemm_phase<2>(p, l, false, p.hbuf, DM, wt + WT_UP, 1024, 408, 44, 4, p.proj, DFF, 0, smem);
    grid.sync();
    }
    gemm_phase<1>(p, l, false, p.proj, DFF, wt + WT_DOWN, 2816, 384, 8, 8, nullptr, 0, 5120, smem);
    grid.sync();
  }
}

extern "C" void kernel_launch(void* const* d_in, const int* in_sizes, int n_in, void* d_out, int out_size, void* d_ws, size_t ws_size,
                              hipStream_t stream) {
  static int grid_blocks = 0;
  if (!grid_blocks) {
    int dev = 0, cus = 0, per_cu = 0;
    hipGetDevice(&dev);
    hipDeviceGetAttribute(&cus, hipDeviceAttributeMultiprocessorCount, dev);
    hipOccupancyMaxActiveBlocksPerMultiprocessor(&per_cu, fwd_megakernel, 256, 0);
    if (per_cu > 2) per_cu = 2;
    if (per_cu < 1) per_cu = 1;
    grid_blocks = cus * per_cu;
  }
  Params p{};
  const float* const* in = (const float* const*)d_in;
  p.x_prompt = in[0]; p.x_sample = in[1]; p.c_prompt = in[2]; p.c_sample = in[3]; p.norm_attn_g = in[4]; p.norm_ffn_g = in[5];
  p.w_ada = in[6]; p.b_ada = in[7]; p.w_in = in[8]; p.qkn_a = in[9]; p.qkn_b = in[10]; p.qkn_c = in[11]; p.qkn_d = in[12];
  p.rpb_a = in[13]; p.sink_b = in[14]; p.t5_table = in[15]; p.lam_d = in[16]; p.subln_d = in[17]; p.w_out = in[18]; p.w_up = in[19];
  p.conv_w = in[20]; p.conv_b = in[21]; p.w_down = in[22];
  p.out = (float*)d_out;
  char* ws = (char*)d_ws;
  size_t off = 0;
  p.wt = (bf16_t*)(ws + off); off += (size_t)4 * WT_LAYER * 2;
  p.mod = (float*)(ws + off); off += (size_t)4 * 48 * 6144 * 4;
  p.lut = (float*)(ws + off); off += 16384;
  p.lam = (float*)(ws + off); off += 256;
  p.zeros = (float*)(ws + off); off += 256;
  p.lse = (float*)(ws + off); off += (size_t)NTOK * 6 * 4;
  p.proj = (bf16_t*)(ws + off); off += (size_t)NTOK * PW * 2;
  p.hbuf = (bf16_t*)(ws + off); off += (size_t)NTOK * MW * 2;
  if (off > ws_size) { fprintf(stderr, "workspace too small: need %zu have %zu\n", off, ws_size); return; }
  void* args[] = {&p};
  hipError_t e = hipLaunchCooperativeKernel((void*)fwd_megakernel, dim3(grid_blocks), dim3(256), args, 0, stream);
  if (e != hipSuccess) fprintf(stderr, "cooperative launch failed: %s (grid %d)\n", hipGetErrorString(e), grid_blocks);
}
```

```cpp
#include <hip/hip_runtime.h>
#include <hip/hip_cooperative_groups.h>
#include <cstdint>
#include <cstdio>
namespace cg = cooperative_groups;

typedef unsigned short bf16_t;
typedef short bf16x8 __attribute__((ext_vector_type(8)));
typedef float f32x4 __attribute__((ext_vector_type(4)));
typedef unsigned u32x4 __attribute__((ext_vector_type(4)));
typedef unsigned u32x2 __attribute__((ext_vector_type(2)));

#define NTOK 98304
#define DM 1024
#define PW 3200
#define MW 1152
#define DFF 2816
#define NSEQ 48
#define SEQL 2048
#define LOG2E 1.4426950408889634f
#define LN2 0.6931471805599453f
#define LDSROW 72

struct Params {
  const float *x_prompt, *x_sample, *c_prompt, *c_sample, *norm_attn_g, *norm_ffn_g, *w_ada, *b_ada, *w_in;
  const float *qkn_a, *qkn_b, *qkn_c, *qkn_d, *rpb_a, *sink_b, *t5_table, *lam_d, *subln_d, *w_out, *w_up, *conv_w, *conv_b, *w_down;
  float* out;
  bf16_t* wt; float* mod; float* lut; float* lam; float* lse; bf16_t* proj; bf16_t* hbuf; float* zeros;
};

#define WT_IN 0
#define WT_OUT (3200 * 1024)
#define WT_UP (WT_OUT + 1024 * 1152)
#define WT_DOWN (WT_UP + 5632 * 1024)
#define WT_LAYER (WT_DOWN + 1024 * 2816)

typedef __bf16 bf16x2_t __attribute__((ext_vector_type(2)));
typedef float f32x2_t __attribute__((ext_vector_type(2)));
__device__ __forceinline__ unsigned pk_bf16(float lo, float hi) {
  const f32x2_t v = {lo, hi};
  const bf16x2_t r = __builtin_convertvector(v, bf16x2_t);
  return __builtin_bit_cast(unsigned, r);
}
__device__ __forceinline__ float bf_lo(unsigned u) { return __uint_as_float(u << 16); }
__device__ __forceinline__ float bf_hi(unsigned u) { return __uint_as_float(u & 0xffff0000u); }
__device__ __forceinline__ float fexp2(float x) { return __builtin_amdgcn_exp2f(x); }

__device__ __forceinline__ const float* xin_row(const Params& p, bool first, int tok) {
  if (first) return tok < 65536 ? p.x_prompt + (size_t)tok * DM : p.x_sample + (size_t)(tok - 65536) * DM;
  return p.out + (size_t)tok * DM;
}

__device__ __forceinline__ int opaque_tid() { int t = threadIdx.x; asm volatile("" : "+v"(t)); return t; }

__device__ __forceinline__ size_t blk_off(int r, int k, int R) { return ((size_t)(k >> 5) * R + r) * 32 + (k & 31); }

__device__ __forceinline__ int t5_bucket(int rel) {
  const int n = rel < 0 ? -rel : rel;
  int v;
  if (n < 8) v = n;
  else v = 8 + (n >= 12) + (n >= 16) + (n >= 23) + (n >= 32) + (n >= 46) + (n >= 64) + (n >= 91);
  return (rel > 0 ? 16 : 0) + v;
}

__device__ __forceinline__ void prologue_phase(const Params& p, char* smem) {
  const int tid = opaque_tid(), nb = gridDim.x;
  const int N_TR = 4 * 3200, N_MOD = 384;
  for (int item = blockIdx.x; item < N_TR + N_MOD + 1; item += nb) {
    if (item < N_TR) {
      const int l = item / 3200; int r = item % 3200;
      const float* src; bf16_t* dst; int K, N, kt, nt;
      if (r < 800) { K = 1024; N = 3200; src = p.w_in + (size_t)l * K * N; dst = p.wt + (size_t)l * WT_LAYER + WT_IN; kt = r / 50; nt = r % 50; }
      else if (r < 1088) { r -= 800; K = 1152; N = 1024; src = p.w_out + (size_t)l * K * N; dst = p.wt + (size_t)l * WT_LAYER + WT_OUT; kt = r / 16; nt = r % 16; }
      else if (r < 2496) { r -= 1088; K = 1024; N = 5632; src = p.w_up + (size_t)l * K * N; dst = p.wt + (size_t)l * WT_LAYER + WT_UP; kt = r / 88; nt = r % 88; }
      else { r -= 2496; K = 2816; N = 1024; src = p.w_down + (size_t)l * K * N; dst = p.wt + (size_t)l * WT_LAYER + WT_DOWN; kt = r / 16; nt = r % 16; }
      float* tile = (float*)smem;
      const int k0 = kt * 64, n0 = nt * 64;
      __syncthreads();
#pragma unroll
      for (int i = 0; i < 16; ++i) {
        const int rr = (tid >> 6) + 4 * i, cc = tid & 63;
        tile[rr * 65 + cc] = src[(size_t)(k0 + rr) * N + n0 + cc];
      }
      __syncthreads();
#pragma unroll
      for (int i = 0; i < 8; ++i) {
        const int idx = tid + 256 * i, n = idx >> 5, k2 = (idx & 31) * 2;
        *(unsigned*)(dst + blk_off(n0 + n, k0 + k2, N)) = pk_bf16(tile[k2 * 65 + n], tile[(k2 + 1) * 65 + n]);
      }
    } else if (item < N_TR + N_MOD) {
      int r = item - N_TR;
      const int l = r / 96; r %= 96;
      const int nc = r / 4, bg = r % 4;
      const int n = nc * 256 + tid;
      float* sc = (float*)smem;
      float acc[12];
#pragma unroll
      for (int j = 0; j < 12; ++j) acc[j] = 0.f;
      const float* W = p.w_ada + (size_t)l * 1024 * 6144 + n;
      for (int kc = 0; kc < 2; ++kc) {
        __syncthreads();
        for (int i = tid; i < 12 * 512; i += 256) {
          const int j = i >> 9, k = i & 511, b = bg * 12 + j;
          const float c = b < 32 ? p.c_prompt[b * 1024 + kc * 512 + k] : p.c_sample[(b - 32) * 1024 + kc * 512 + k];
          sc[i] = c / (1.f + __expf(-c));
        }
        __syncthreads();
#pragma unroll 2
        for (int k = 0; k < 512; k += 4) {
          const float w0 = W[(size_t)(kc * 512 + k) * 6144], w1 = W[(size_t)(kc * 512 + k + 1) * 6144];
          const float w2 = W[(size_t)(kc * 512 + k + 2) * 6144], w3 = W[(size_t)(kc * 512 + k + 3) * 6144];
#pragma unroll
          for (int j = 0; j < 12; ++j) {
            const f32x4 s = *(const f32x4*)(sc + j * 512 + k);
            acc[j] += s[0] * w0 + s[1] * w1 + s[2] * w2 + s[3] * w3;
          }
        }
      }
      const float bias = p.b_ada[l * 6144 + n];
#pragma unroll
      for (int j = 0; j < 12; ++j) p.mod[((size_t)l * 48 + bg * 12 + j) * 6144 + n] = acc[j] + bias;
    } else {
      for (int i = tid; i < 14 * 257; i += 256) {
        const int hd = i / 257, idx = i % 257;
        p.lut[i] = p.t5_table[t5_bucket(idx - 128) * 14 + hd] * LOG2E;
      }
      if (tid < 64) p.zeros[tid] = 0.f;
      if (tid < 4) {
        const float* lp = p.lam_d + tid * 128;
        float s1 = 0.f, s2 = 0.f;
        for (int e = 0; e < 32; ++e) { s1 += lp[e] * lp[32 + e]; s2 += lp[64 + e] * lp[96 + e]; }
        const float li = 0.8f - 0.6f * expf(-0.3f * (float)tid);
        p.lam[tid] = expf(s1) - expf(s2) + li;
      }
    }
  }
}

__device__ __forceinline__ void norm_phase(const Params& p, int l, bool first, const float* g, int shift_off, int scale_off) {
  const int tid0 = opaque_tid();
  const int lane = tid0 & 63, w = tid0 >> 6;
  const int stride = gridDim.x * 4;
  for (int row0 = blockIdx.x * 4 + w; row0 < NTOK; row0 += 2 * stride) {
    const int row1 = row0 + stride;
    const bool has1 = row1 < NTOK;
    const int rows[2] = {row0, has1 ? row1 : row0};
    f32x4 v[2][4];
    float ss[2] = {0.f, 0.f};
#pragma unroll
    for (int r = 0; r < 2; ++r) {
      const float* xr = xin_row(p, first, rows[r]);
#pragma unroll
      for (int i = 0; i < 4; ++i) v[r][i] = *(const f32x4*)(xr + i * 256 + lane * 4);
    }
#pragma unroll
    for (int r = 0; r < 2; ++r) {
#pragma unroll
      for (int i = 0; i < 4; ++i) ss[r] += v[r][i][0] * v[r][i][0] + v[r][i][1] * v[r][i][1] + v[r][i][2] * v[r][i][2] + v[r][i][3] * v[r][i][3];
#pragma unroll
      for (int o = 32; o >= 1; o >>= 1) ss[r] += __shfl_xor(ss[r], o);
    }
#pragma unroll
    for (int r = 0; r < 2; ++r) {
      if (r == 1 && !has1) break;
      const int row = rows[r];
      const float* md = p.mod + ((size_t)l * 48 + (row >> 11)) * 6144;
      const float rstd = rsqrtf(ss[r] * (1.f / 1024.f) + 1e-6f);
#pragma unroll
      for (int i = 0; i < 4; ++i) {
        const int k = i * 256 + lane * 4;
        const f32x4 gg = *(const f32x4*)(g + k), sc = *(const f32x4*)(md + scale_off + k), sh = *(const f32x4*)(md + shift_off + k);
        f32x4 y;
#pragma unroll
        for (int j = 0; j < 4; ++j) y[j] = (v[r][i][j] * rstd) * gg[j] * (1.f + sc[j]) + sh[j];
        u32x2 o; o[0] = pk_bf16(y[0], y[1]); o[1] = pk_bf16(y[2], y[3]);
        *(u32x2*)(p.hbuf + blk_off(row, k, NTOK)) = o;
      }
    }
  }
}

__device__ __forceinline__ bool gemm_tile_id(int it, int MT, int NT, int NB, int& mt, int& nt) {
  const int nb = gridDim.x, bid = blockIdx.x;
  if ((nb & 7) == 0) {
    const int x = bid & 7, slot = bid >> 3, S = nb >> 3;
    const int TPS = 8 * NB, NSN = NT / NB, NS = (MT / 8) * NSN;
    const int pidx = slot + S * it, sidx = pidx / TPS, w = pidx % TPS, s = x + 8 * sidx;
    if (s >= NS) return false;
    mt = (s / NSN) * 8 + (w & 7); nt = (s % NSN) * NB + (w >> 3);
    return true;
  }
  const int t = bid + nb * it;
  if (t >= MT * NT) return false;
  mt = t / NT; nt = t % NT;
  return true;
}

template <int M, int NN>
__device__ __forceinline__ void up_epi_row(const f32x4 (&acc)[8][4], const float* cw, const float* cb, int cbase, int lane, int fr, int s0, bf16_t* obase) {
  constexpr int MP = M > 0 ? M - 1 : 0, MN = M < 7 ? M + 1 : 7;
  const int srcp = (lane & 48) | ((fr + 15) & 15), srcn = (lane & 48) | ((fr + 1) & 15);
  float y[2][4];
#pragma unroll
  for (int n = 0; n < 2; ++n) {
    const int c = n * DFF + cbase;
    const f32x4 w0 = *(const f32x4*)(cw + c), w1 = *(const f32x4*)(cw + 5632 + c), w2 = *(const f32x4*)(cw + 2 * 5632 + c), bb = *(const f32x4*)(cb + c);
#pragma unroll
    for (int j = 0; j < 4; ++j) {
      const float cur = acc[M][NN + 2 * n][j];
      const float zp = (fr == 15) ? acc[MP][NN + 2 * n][j] : cur, zn = (fr == 0) ? acc[MN][NN + 2 * n][j] : cur;
      const float pv = __shfl(zp, srcp), nv = __shfl(zn, srcn);
      y[n][j] = w0[j] * pv + w1[j] * cur + w2[j] * nv + bb[j];
    }
  }
  const int row = 16 * M + fr, tpos = s0 + row;
  if (row >= 1 && row <= 126 && tpos >= 0 && tpos < SEQL) {
    float a[4];
#pragma unroll
    for (int j = 0; j < 4; ++j) { const float gte = y[1][j]; a[j] = y[0][j] * gte / (1.f + __expf(-gte)); }
    u32x2 o; o[0] = pk_bf16(a[0], a[1]); o[1] = pk_bf16(a[2], a[3]);
    *(u32x2*)(obase + (size_t)tpos * 32) = o;
  }
  __builtin_amdgcn_sched_barrier(0);
}

#define GB_A 16384
#define GB_BUF 24576
template <int EPI>
__device__ __forceinline__ void gemm_phase(const Params& p, int l, bool first, const bf16_t* A, int NBROWS, const bf16_t* Bt, int K, int MT, int NT, int NB,
                           bf16_t* outb, int ldc, int gate_off, char* smem) {
  const int tid = opaque_tid(), lane = tid & 63, w = tid >> 6, wr = w >> 1, wcn = w & 1, fr = lane & 15, fq = lane >> 4;
  const int nk = K / 32;
  const int lrow = tid >> 2, lch = (tid & 3) ^ ((tid >> 4) & 3);
  const int fsw = (fq ^ ((fr >> 2) & 3)) * 16;
  for (int it = 0;; ++it) {
    int mt, nt;
    if (!gemm_tile_id(it, MT, NT, NB, mt, nt)) break;
    const bf16_t* ga0; const bf16_t* ga1; const bf16_t* gb0;
    const size_t astr = 64 * 32, apan = (size_t)NTOK * 32, bpan = (size_t)NBROWS * 32;
    size_t bstr; int vmask = 15;
    if (EPI == 2) {
      const int wi0 = 2 * mt, wi1 = wi0 + 1;
      const int t0 = 126 * (wi0 % 17) - 1 + lrow, t1 = 126 * (wi1 % 17) - 1 + lrow;
      ga0 = A + ((size_t)(wi0 / 17) * SEQL + t0) * 32 + lch * 8;
      ga1 = A + ((size_t)(wi1 / 17) * SEQL + t1) * 32 + lch * 8;
      vmask = ((t0 >= 0 && t0 < SEQL) ? 1 : 0) | ((t0 + 64 >= 0 && t0 + 64 < SEQL) ? 2 : 0) | ((t1 >= 0 && t1 < SEQL) ? 4 : 0) | ((t1 + 64 >= 0 && t1 + 64 < SEQL) ? 8 : 0);
      gb0 = Bt + (size_t)(nt * 64 + lrow) * 32 + lch * 8; bstr = (size_t)DFF * 32;
    } else {
      ga0 = A + (size_t)(mt * 256 + lrow) * 32 + lch * 8; ga1 = ga0 + (size_t)128 * 32;
      gb0 = Bt + (size_t)(nt * 128 + lrow) * 32 + lch * 8; bstr = (size_t)64 * 32;
    }
    const bf16_t* zl = (const bf16_t*)p.zeros + lch * 8;
#define GEMM_ISSUE(KT, STAGE)                                                                                                        \
    {                                                                                                                                \
      char* dst_ = smem + (STAGE) * GB_BUF + tid * 16;                                                                               \
      const size_t ko_ = (size_t)(KT) * apan, kb_ = (size_t)(KT) * bpan;                                                             \
      const bf16_t* s0_ = ga0 + ko_; const bf16_t* s1_ = ga0 + astr + ko_; const bf16_t* s2_ = ga1 + ko_; const bf16_t* s3_ = ga1 + astr + ko_; \
      if (EPI == 2) { s0_ = (vmask & 1) ? s0_ : zl; s1_ = (vmask & 2) ? s1_ : zl; s2_ = (vmask & 4) ? s2_ : zl; s3_ = (vmask & 8) ? s3_ : zl; } \
      __builtin_amdgcn_global_load_lds((const unsigned*)s0_, (unsigned*)(dst_), 16, 0, 0);                                           \
      __builtin_amdgcn_global_load_lds((const unsigned*)s1_, (unsigned*)(dst_ + 4096), 16, 0, 0);                                    \
      __builtin_amdgcn_global_load_lds((const unsigned*)s2_, (unsigned*)(dst_ + 8192), 16, 0, 0);                                    \
      __builtin_amdgcn_global_load_lds((const unsigned*)s3_, (unsigned*)(dst_ + 12288), 16, 0, 0);                                   \
      __builtin_amdgcn_global_load_lds((const unsigned*)(gb0 + kb_), (unsigned*)(dst_ + GB_A), 16, 0, 0);                            \
      __builtin_amdgcn_global_load_lds((const unsigned*)(gb0 + bstr + kb_), (unsigned*)(dst_ + GB_A + 4096), 16, 0, 0);              \
    }
    f32x4 acc[8][4];
#pragma unroll
    for (int m = 0; m < 8; ++m)
#pragma unroll
      for (int n = 0; n < 4; ++n) acc[m][n] = (f32x4){0.f, 0.f, 0.f, 0.f};
    asm volatile("s_waitcnt vmcnt(0) lgkmcnt(0)" ::: "memory");
    __builtin_amdgcn_s_barrier();
    GEMM_ISSUE(0, 0)
    GEMM_ISSUE(1, 1)
    int scur = 0, snxt = 2;
    for (int kt = 0; kt < nk; ++kt) {
      if (kt + 1 < nk) asm volatile("s_waitcnt vmcnt(6)" ::: "memory");
      else asm volatile("s_waitcnt vmcnt(0)" ::: "memory");
      asm volatile("s_waitcnt lgkmcnt(0)" ::: "memory");
      __builtin_amdgcn_s_barrier();
      if (kt + 2 < nk) GEMM_ISSUE(kt + 2, snxt)
      const char* Ab = smem + scur * GB_BUF;
      scur = (scur == 2) ? 0 : scur + 1; snxt = (snxt == 2) ? 0 : snxt + 1;
      const char* Bb = Ab + GB_A;
      bf16x8 bfr[4];
#pragma unroll
      for (int n = 0; n < 4; ++n) {
        const int br = (EPI == 2) ? ((n >> 1) * 64 + 32 * wcn + 16 * (n & 1) + fr) : (64 * wcn + 16 * n + fr);
        bfr[n] = *(const bf16x8*)(Bb + br * 64 + fsw);
      }
#pragma unroll
      for (int m = 0; m < 8; ++m) {
        const bf16x8 af = *(const bf16x8*)(Ab + (wr * 128 + 16 * m + fr) * 64 + fsw);
#pragma unroll
        for (int n = 0; n < 4; ++n) acc[m][n] = __builtin_amdgcn_mfma_f32_16x16x32_bf16(bfr[n], af, acc[m][n], 0, 0, 0);
      }
    }
#undef GEMM_ISSUE
    int lane_e = lane; asm volatile("" : "+v"(lane_e));
    const int fr_e = lane_e & 15, fq_e = lane_e >> 4;
    if (EPI == 0) {
#pragma unroll
      for (int m = 0; m < 8; ++m) {
        const int tok = mt * 256 + wr * 128 + 16 * m + fr_e;
#pragma unroll
        for (int n = 0; n < 4; ++n) {
          const int col = nt * 128 + 64 * wcn + 16 * n + 4 * fq_e;
          u32x2 o; o[0] = pk_bf16(acc[m][n][0], acc[m][n][1]); o[1] = pk_bf16(acc[m][n][2], acc[m][n][3]);
          *(u32x2*)(outb + (size_t)tok * ldc + col) = o;
        }
      }
    } else if (EPI == 1) {
      const int b = (mt * 256) >> 11;
      const float* gate = p.mod + ((size_t)l * 48 + b) * 6144 + gate_off;
#pragma unroll
      for (int n = 0; n < 4; ++n) {
        const int col = nt * 128 + 64 * wcn + 16 * n + 4 * fq_e;
        const f32x4 gv = *(const f32x4*)(gate + col);
#pragma unroll
        for (int m = 0; m < 8; ++m) {
          const int tok = mt * 256 + wr * 128 + 16 * m + fr_e;
          const f32x4 xv = *(const f32x4*)(xin_row(p, first, tok) + col);
          f32x4 o;
#pragma unroll
          for (int j = 0; j < 4; ++j) o[j] = xv[j] + gv[j] * acc[m][n][j];
          *(f32x4*)(p.out + (size_t)tok * DM + col) = o;
        }
      }
    } else {
      const float* cw = p.conv_w + (size_t)l * 3 * 5632;
      const float* cb = p.conv_b + (size_t)l * 5632;
      const int wi = 2 * mt + wr, seq = wi / 17, s0 = 126 * (wi % 17) - 1;
#define UP_EPI_NN(NN)                                                                                                      \
      {                                                                                                                    \
        const int cbase = nt * 64 + 32 * wcn + 16 * NN + 4 * fq_e;                                                         \
        bf16_t* obase = outb + blk_off(seq * SEQL, cbase, NTOK);                                                           \
        up_epi_row<0, NN>(acc, cw, cb, cbase, lane_e, fr_e, s0, obase); up_epi_row<1, NN>(acc, cw, cb, cbase, lane_e, fr_e, s0, obase); \
        up_epi_row<2, NN>(acc, cw, cb, cbase, lane_e, fr_e, s0, obase); up_epi_row<3, NN>(acc, cw, cb, cbase, lane_e, fr_e, s0, obase); \
        up_epi_row<4, NN>(acc, cw, cb, cbase, lane_e, fr_e, s0, obase); up_epi_row<5, NN>(acc, cw, cb, cbase, lane_e, fr_e, s0, obase); \
        up_epi_row<6, NN>(acc, cw, cb, cbase, lane_e, fr_e, s0, obase); up_epi_row<7, NN>(acc, cw, cb, cbase, lane_e, fr_e, s0, obase); \
      }
      UP_EPI_NN(0)
      UP_EPI_NN(1)
#undef UP_EPI_NN
    }
  }
}

struct AttnArgs {
  int qbase, qstride, qpos0;
  int ktokbase, ktokstep, kstride, kposbase, kposstep, ntiles;
  int qcol, kcol, vcol, ocol;
  const float *gq, *gk;
  float qscale;
  int hw, rmul, taboff0;
  float sinkv;
  float lam, outscale;
  const float* subg;
  int lsecol;
};

template <int NQ, int NC, int MODE>
__device__ __forceinline__ void attn_item(const Params& p, const AttnArgs& a, bf16_t* Ks, bf16_t* Vts, const float* tab) {
  const int tid = opaque_tid(), lane = tid & 63, w = tid >> 6, fr = lane & 15, fq = lane >> 4;
  const int wq0 = a.qpos0 + w * 16 * NQ;
  bf16x8 qf[NQ][2];
  int qpos[NQ];
#pragma unroll
  for (int qt = 0; qt < NQ; ++qt) {
    const int qp = wq0 + qt * 16 + fr;
    qpos[qt] = qp;
    const bf16_t* qrow = p.proj + (size_t)(a.qbase + qp * a.qstride) * PW + a.qcol;
    const u32x4 v0 = *(const u32x4*)(qrow + fq * 8), v1 = *(const u32x4*)(qrow + 32 + fq * 8);
    float f0[8], f1[8];
#pragma unroll
    for (int i = 0; i < 4; ++i) { f0[2 * i] = bf_lo(v0[i]); f0[2 * i + 1] = bf_hi(v0[i]); f1[2 * i] = bf_lo(v1[i]); f1[2 * i + 1] = bf_hi(v1[i]); }
    float s0 = 0.f, s1 = 0.f;
#pragma unroll
    for (int i = 0; i < 8; ++i) { s0 += f0[i] * f0[i]; s1 += f1[i] * f1[i]; }
    float r0, r1;
    if (NC == 1) {
      float s = s0 + s1; s += __shfl_xor(s, 16); s += __shfl_xor(s, 32);
      r0 = r1 = rsqrtf(s * (1.f / 64.f) + 1e-6f) * a.qscale;
    } else {
      s0 += __shfl_xor(s0, 16); s0 += __shfl_xor(s0, 32);
      s1 += __shfl_xor(s1, 16); s1 += __shfl_xor(s1, 32);
      r0 = rsqrtf(s0 * (1.f / 32.f) + 1e-6f) * a.qscale; r1 = rsqrtf(s1 * (1.f / 32.f) + 1e-6f) * a.qscale;
    }
    const float* g0p = a.gq + fq * 8;
    const float* g1p = (NC == 1) ? a.gq + 32 + fq * 8 : g0p;
    u32x4 q0, q1;
#pragma unroll
    for (int i = 0; i < 4; ++i) {
      q0[i] = pk_bf16(f0[2 * i] * r0 * g0p[2 * i], f0[2 * i + 1] * r0 * g0p[2 * i + 1]);
      q1[i] = pk_bf16(f1[2 * i] * r1 * g1p[2 * i], f1[2 * i + 1] * r1 * g1p[2 * i + 1]);
    }
    qf[qt][0] = __builtin_bit_cast(bf16x8, q0);
    qf[qt][1] = __builtin_bit_cast(bf16x8, q1);
  }
  f32x4 o[NC][NQ][4];
  float mrun[NC][NQ], lrun[NC][NQ];
#pragma unroll
  for (int c = 0; c < NC; ++c)
#pragma unroll
    for (int qt = 0; qt < NQ; ++qt) {
      if (MODE == 1) { mrun[c][qt] = a.sinkv; lrun[c][qt] = (fq == 0) ? 1.f : 0.f; }
      else { mrun[c][qt] = -1e30f; lrun[c][qt] = 0.f; }
#pragma unroll
      for (int dt = 0; dt < 4; ++dt) o[c][qt][dt] = (f32x4){0.f, 0.f, 0.f, 0.f};
    }
  const int lch = tid & 7;
  float gkv[8];
#pragma unroll
  for (int i = 0; i < 8; ++i) gkv[i] = a.gk[((NC == 1) ? lch : (lch & 3)) * 8 + i];

  for (int t = 0; t < a.ntiles; ++t) {
    const int ktok0 = a.ktokbase + t * a.ktokstep;
    __syncthreads();
#pragma unroll
    for (int it = 0; it < 2; ++it) {
      const int key = (tid >> 3) + 32 * it;
      const u32x4 v = *(const u32x4*)(p.proj + (size_t)(ktok0 + key * a.kstride) * PW + a.kcol + lch * 8);
      float f[8];
#pragma unroll
      for (int i = 0; i < 4; ++i) { f[2 * i] = bf_lo(v[i]); f[2 * i + 1] = bf_hi(v[i]); }
      float s = 0.f;
#pragma unroll
      for (int i = 0; i < 8; ++i) s += f[i] * f[i];
      s += __shfl_xor(s, 1); s += __shfl_xor(s, 2);
      float rs;
      if (NC == 1) { s += __shfl_xor(s, 4); rs = rsqrtf(s * (1.f / 64.f) + 1e-6f); }
      else rs = rsqrtf(s * (1.f / 32.f) + 1e-6f);
      u32x4 kq;
#pragma unroll
      for (int i = 0; i < 4; ++i) kq[i] = pk_bf16(f[2 * i] * rs * gkv[2 * i], f[2 * i + 1] * rs * gkv[2 * i + 1]);
      *(u32x4*)(Ks + key * LDSROW + lch * 8) = kq;
    }
    {
      const int key = tid & 63;
      const bf16_t* vrow = p.proj + (size_t)(ktok0 + key * a.kstride) * PW + a.vcol;
#pragma unroll
      for (int it = 0; it < 2; ++it) {
        const int ch = (tid >> 6) + 4 * it;
        const u32x4 v = *(const u32x4*)(vrow + ch * 8);
#pragma unroll
        for (int i = 0; i < 4; ++i) {
          Vts[(ch * 8 + 2 * i) * LDSROW + key] = (bf16_t)(v[i] & 0xffffu);
          Vts[(ch * 8 + 2 * i + 1) * LDSROW + key] = (bf16_t)(v[i] >> 16);
        }
      }
    }
    __syncthreads();
    const int kp0 = a.kposbase + t * a.kposstep;
    const int taboff = a.taboff0 + t * 31;
    bf16x8 pf[NC][NQ][2];
    __builtin_amdgcn_sched_barrier(0);
#pragma unroll
    for (int qt = 0; qt < NQ; ++qt) {
      const int qp = qpos[qt];
      int cs = qp - 8; cs = cs < 0 ? 0 : (cs > 48 ? 48 : cs);
      f32x4 bv[4];
#pragma unroll
      for (int kt = 0; kt < 4; ++kt)
#pragma unroll
        for (int j = 0; j < 4; ++j) {
          const int kpos = kp0 + kt * 16 + 4 * fq + j;
          const int d = kpos - qp;
          bool valid; int idx;
          if (MODE == 0) {
            valid = kpos >= cs && kpos < cs + 16;
            int dd = d + 15; dd = dd < 0 ? 0 : (dd > 30 ? 30 : dd);
            idx = taboff + dd;
          } else {
            valid = (MODE == 3) ? true : (d <= a.hw && d >= -a.hw);
            int dd = d * a.rmul; dd = dd < -128 ? -128 : (dd > 128 ? 128 : dd);
            idx = dd + 128;
          }
          const float bias = tab[idx];
          bv[kt][j] = valid ? bias : -INFINITY;
        }
#pragma unroll
      for (int c = 0; c < NC; ++c) {
        f32x4 s[4];
#pragma unroll
        for (int kt = 0; kt < 4; ++kt) {
          if (NC == 1) {
            const bf16x8 k0 = *(const bf16x8*)(Ks + (kt * 16 + fr) * LDSROW + fq * 8);
            const bf16x8 k1 = *(const bf16x8*)(Ks + (kt * 16 + fr) * LDSROW + 32 + fq * 8);
            const f32x4 r = __builtin_amdgcn_mfma_f32_16x16x32_bf16(k0, qf[qt][0], bv[kt], 0, 0, 0);
            s[kt] = __builtin_amdgcn_mfma_f32_16x16x32_bf16(k1, qf[qt][1], r, 0, 0, 0);
          } else {
            const bf16x8 k0 = *(const bf16x8*)(Ks + (kt * 16 + fr) * LDSROW + c * 32 + fq * 8);
            s[kt] = __builtin_amdgcn_mfma_f32_16x16x32_bf16(k0, qf[qt][c], bv[kt], 0, 0, 0);
          }
        }
        float mx = -INFINITY;
#pragma unroll
        for (int kt = 0; kt < 4; ++kt)
#pragma unroll
          for (int j = 0; j < 4; ++j) mx = fmaxf(mx, s[kt][j]);
        mx = fmaxf(mx, __shfl_xor(mx, 16)); mx = fmaxf(mx, __shfl_xor(mx, 32));
        const float mn = fmaxf(mrun[c][qt], mx);
        const float al = fexp2(mrun[c][qt] - mn);
        mrun[c][qt] = mn;
        float rs = 0.f;
#pragma unroll
        for (int kt = 0; kt < 4; ++kt)
#pragma unroll
          for (int j = 0; j < 4; ++j) { const float pv = fexp2(s[kt][j] - mn); s[kt][j] = pv; rs += pv; }
        lrun[c][qt] = lrun[c][qt] * al + rs;
#pragma unroll
        for (int dt = 0; dt < 4; ++dt) o[c][qt][dt] *= al;
#pragma unroll
        for (int ks = 0; ks < 2; ++ks) {
          u32x4 pk;
          pk[0] = pk_bf16(s[2 * ks][0], s[2 * ks][1]); pk[1] = pk_bf16(s[2 * ks][2], s[2 * ks][3]);
          pk[2] = pk_bf16(s[2 * ks + 1][0], s[2 * ks + 1][1]); pk[3] = pk_bf16(s[2 * ks + 1][2], s[2 * ks + 1][3]);
          pf[c][qt][ks] = __builtin_bit_cast(bf16x8, pk);
        }
        __builtin_amdgcn_sched_barrier(0);
      }
    }
#pragma unroll
    for (int ks = 0; ks < 2; ++ks) {
#pragma unroll
      for (int dt = 0; dt < 4; ++dt) {
        const u32x2 lo = *(const u32x2*)(Vts + (dt * 16 + fr) * LDSROW + ks * 32 + 4 * fq);
        const u32x2 hi = *(const u32x2*)(Vts + (dt * 16 + fr) * LDSROW + ks * 32 + 16 + 4 * fq);
        u32x4 vv; vv[0] = lo[0]; vv[1] = lo[1]; vv[2] = hi[0]; vv[3] = hi[1];
        const bf16x8 vf = __builtin_bit_cast(bf16x8, vv);
#pragma unroll
        for (int c = 0; c < NC; ++c)
#pragma unroll
          for (int qt = 0; qt < NQ; ++qt) o[c][qt][dt] = __builtin_amdgcn_mfma_f32_16x16x32_bf16(vf, pf[c][qt][ks], o[c][qt][dt], 0, 0, 0);
      }
    }
  }
#pragma unroll
  for (int qt = 0; qt < NQ; ++qt) {
    float inv[NC], ltot[NC];
#pragma unroll
    for (int c = 0; c < NC; ++c) {
      float lt = lrun[c][qt];
      lt += __shfl_xor(lt, 16); lt += __shfl_xor(lt, 32);
      ltot[c] = lt; inv[c] = 1.f / lt;
    }
    const int tok = a.qbase + qpos[qt] * a.qstride;
    if (MODE == 3) {
      f32x4 v[4];
      float ss = 0.f;
#pragma unroll
      for (int dt = 0; dt < 4; ++dt)
#pragma unroll
        for (int j = 0; j < 4; ++j) {
          const float x = o[0][qt][dt][j] * inv[0] - a.lam * (o[NC - 1][qt][dt][j] * inv[NC - 1]);
          v[dt][j] = x; ss += x * x;
        }
      ss += __shfl_xor(ss, 16); ss += __shfl_xor(ss, 32);
      const float rstd = rsqrtf(ss * (1.f / 64.f) + 1e-6f) * a.outscale;
#pragma unroll
      for (int dt = 0; dt < 4; ++dt) {
        const f32x4 g = *(const f32x4*)(a.subg + dt * 16 + 4 * fq);
        u32x2 ov; ov[0] = pk_bf16(v[dt][0] * rstd * g[0], v[dt][1] * rstd * g[1]); ov[1] = pk_bf16(v[dt][2] * rstd * g[2], v[dt][3] * rstd * g[3]);
        *(u32x2*)(p.hbuf + blk_off(tok, a.ocol + dt * 16 + 4 * fq, NTOK)) = ov;
      }
    } else {
#pragma unroll
      for (int dt = 0; dt < 4; ++dt) {
        u32x2 ov;
        ov[0] = pk_bf16(o[0][qt][dt][0] * inv[0], o[0][qt][dt][1] * inv[0]);
        ov[1] = pk_bf16(o[0][qt][dt][2] * inv[0], o[0][qt][dt][3] * inv[0]);
        *(u32x2*)(p.hbuf + blk_off(tok, a.ocol + dt * 16 + 4 * fq, NTOK)) = ov;
      }
      if (MODE == 2 && fq == 0) p.lse[(size_t)tok * 6 + a.lsecol] = (mrun[0][qt] + __log2f(ltot[0])) * LN2;
    }
  }
}

__device__ __forceinline__ void attn_phase(const Params& p, int l, char* smem) {
  bf16_t* Ks = (bf16_t*)smem;
  bf16_t* Vts = Ks + 64 * LDSROW;
  float* tab = (float*)(Vts + 64 * LDSROW);
  const int tid = opaque_tid();
  const int nD = 6144, nA = 6144, nB = 3072, nC = 4608;
  for (int item = blockIdx.x; item < nD + nA + nB + nC; item += gridDim.x) {
    AttnArgs a;
    a.taboff0 = 0; a.sinkv = 0.f; a.lam = 0.f; a.outscale = 1.f; a.subg = nullptr; a.lsecol = 0; a.hw = 1 << 20; a.rmul = 1;
    __syncthreads();
    if (item < nD) {
      const int b = item >> 7, h = (item >> 5) & 3, qb = item & 31;
      for (int i = tid; i < 257; i += 256) tab[i] = p.lut[(10 + h) * 257 + i];
      a.qbase = b * SEQL; a.qstride = 1; a.qpos0 = qb * 64;
      a.ktokbase = b * SEQL; a.ktokstep = 64; a.kstride = 1; a.kposbase = 0; a.kposstep = 64; a.ntiles = 32;
      a.qcol = 2432 + h * 64; a.kcol = 2432 + 256 + h * 64; a.vcol = 2432 + 512 + h * 64; a.ocol = 896 + h * 64;
      a.gq = p.qkn_d + l * 64; a.gk = a.gq + 32;
      a.qscale = 0.17677669529663687f * LOG2E;
      a.lam = p.lam[l]; a.outscale = 1.f - (0.8f - 0.6f * expf(-0.3f * (float)l)); a.subg = p.subln_d + l * 64;
      attn_item<1, 2, 3>(p, a, Ks, Vts, tab);
    } else if (item < nD + nA) {
      const int id = item - nD;
      const int b = id >> 7, h = (id >> 5) & 3, r = id & 31;
      const float* rp = p.rpb_a + ((size_t)l * 4 + h) * 465;
      for (int i = tid; i < 465; i += 256) tab[i] = rp[i] * LOG2E;
      int rs = r - 4; rs = rs < 0 ? 0 : (rs > 24 ? 24 : rs);
      a.qbase = b * SEQL + r * 64; a.qstride = 1; a.qpos0 = 0;
      a.ktokbase = b * SEQL + rs * 64; a.ktokstep = 64; a.kstride = 1; a.kposbase = 0; a.kposstep = 0; a.ntiles = 8;
      a.qcol = h * 64; a.kcol = 256 + h * 64; a.vcol = 512 + h * 64; a.ocol = h * 64;
      a.gq = p.qkn_a + l * 128; a.gk = a.gq + 64;
      a.qscale = 0.125f * LOG2E;
      a.taboff0 = (rs - r + 7) * 31;
      attn_item<1, 1, 0>(p, a, Ks, Vts, tab);
    } else if (item < nD + nA + nB) {
      const int id = item - nD - nA;
      const int b = id >> 6, h = (id >> 4) & 3, qb = id & 15;
      for (int i = tid; i < 257; i += 256) tab[i] = p.lut[h * 257 + i];
      const int q0 = qb * 128;
      const int kstart = q0 - 128 < 0 ? 0 : q0 - 128, kend = q0 + 256 > SEQL ? SEQL : q0 + 256;
      a.qbase = b * SEQL; a.qstride = 1; a.qpos0 = q0;
      a.ktokbase = b * SEQL + kstart; a.ktokstep = 64; a.kstride = 1; a.kposbase = kstart; a.kposstep = 64; a.ntiles = (kend - kstart) >> 6;
      a.qcol = 768 + h * 64; a.kcol = 768 + 256 + (h >> 1) * 64; a.vcol = 768 + 384 + (h >> 1) * 64; a.ocol = 256 + h * 64;
      a.gq = p.qkn_b + l * 128; a.gk = a.gq + 64;
      a.qscale = 0.125f * LOG2E;
      a.hw = 128; a.rmul = 1; a.sinkv = p.sink_b[l * 4 + h] * LOG2E;
      attn_item<2, 1, 1>(p, a, Ks, Vts, tab);
    } else {
      const int id = item - nD - nA - nB;
      const int b = id / 96, rem = id % 96, g = rem >> 5, i2 = (rem >> 4) & 1, blk = rem & 15;
      const int r = g == 0 ? 1 : (g == 1 ? 4 : 16);
      const int L = SEQL / r, bps = L >> 7;
      const int pp = blk / bps, m0 = (blk % bps) * 128;
      const int hh = g * 2 + i2;
      for (int i = tid; i < 257; i += 256) tab[i] = p.lut[(4 + hh) * 257 + i];
      const int kstart = m0 - 64 < 0 ? 0 : m0 - 64, kend = m0 + 192 > L ? L : m0 + 192;
      a.qbase = b * SEQL + pp; a.qstride = r; a.qpos0 = m0;
      a.ktokbase = a.qbase + kstart * r; a.ktokstep = 64 * r; a.kstride = r; a.kposbase = kstart; a.kposstep = 64; a.ntiles = (kend - kstart) >> 6;
      a.qcol = 1280 + hh * 64; a.kcol = 1280 + 384 + hh * 64; a.vcol = 1280 + 768 + hh * 64; a.ocol = 512 + hh * 64;
      a.gq = p.qkn_c + l * 128; a.gk = a.gq + 64;
      a.qscale = 0.125f * LOG2E;
      a.hw = 64; a.rmul = r; a.lsecol = hh;
      attn_item<2, 1, 2>(p, a, Ks, Vts, tab);
    }
  }
}

__device__ __forceinline__ void combine_phase(const Params& p) {
  const int nthr = gridDim.x * 256;
  for (int i = blockIdx.x * 256 + opaque_tid(); i < NTOK * 48; i += nthr) {
    const int tok = i / 48, rem = i % 48, hh = rem >> 3, ch = rem & 7, ii = hh & 1, g = hh >> 1;
    const float* ls = p.lse + (size_t)tok * 6;
    const float l0 = ls[ii], l1 = ls[2 + ii], l2 = ls[4 + ii];
    const float mx = fmaxf(l0, fmaxf(l1, l2));
    const float e0 = __expf(l0 - mx), e1 = __expf(l1 - mx), e2 = __expf(l2 - mx);
    const float al = (g == 0 ? e0 : (g == 1 ? e1 : e2)) / (e0 + e1 + e2);
    bf16_t* ptr = p.hbuf + blk_off(tok, 512 + hh * 64 + ch * 8, NTOK);
    u32x4 v = *(const u32x4*)ptr;
#pragma unroll
    for (int k = 0; k < 4; ++k) v[k] = pk_bf16(bf_lo(v[k]) * al, bf_hi(v[k]) * al);
    *(u32x4*)ptr = v;
  }
}


#ifndef REP_GEMM
#define REP_GEMM 1
#endif
#ifndef REP_ATTN
#define REP_ATTN 1
#endif
#ifndef DBG_STOP
#define DBG_STOP 0
#endif
__device__ __forceinline__ void dbg_dump(const Params& p, const bf16_t* buf, int ld) {
  const int nthr = gridDim.x * 256;
  for (size_t i = (size_t)blockIdx.x * 256 + opaque_tid(); i < (size_t)NTOK * 1024; i += nthr) {
    const size_t tok = i >> 10; const int c = (int)(i & 1023);
    p.out[i] = __uint_as_float((unsigned)buf[tok * ld + c] << 16);
  }
}

__global__ void __launch_bounds__(256, 2) fwd_megakernel(Params p) {
  extern __shared__ __attribute__((aligned(16))) char smem[];
  cg::grid_group grid = cg::this_grid();
  prologue_phase(p, smem);
  grid.sync();
  if (DBG_STOP == 3) {
    const int nthr = gridDim.x * 256;
    for (size_t i = (size_t)blockIdx.x * 256 + opaque_tid(); i < (size_t)NTOK * 1024; i += nthr) {
      const size_t j = (i * 7) % ((size_t)4 * WT_LAYER);
      p.out[i] = __uint_as_float((unsigned)p.wt[j] << 16) + p.mod[i % (4 * 48 * 6144)] + p.lut[i % (14 * 257)];
    }
    return;
  }
  for (int l = 0; l < 4; ++l) {
    const bool first = (l == 0);
    const bf16_t* wt = p.wt + (size_t)l * WT_LAYER;
    norm_phase(p, l, first, p.norm_attn_g + l * DM, 0, 1024);
    grid.sync();
    if (DBG_STOP == 4) { dbg_dump(p, p.hbuf, DM); return; }
    for (int rep = 0; rep < REP_GEMM; ++rep) {
    gemm_phase<0>(p, l, false, p.hbuf, 3200, wt + WT_IN, 1024, 384, 25, 5, p.proj, PW, 0, smem);
    grid.sync();
    }
    if (DBG_STOP == 2) { dbg_dump(p, p.proj, PW); return; }
    for (int rep = 0; rep < REP_ATTN; ++rep) {
    attn_phase(p, l, smem);
    grid.sync();
    }
    combine_phase(p);
    grid.sync();
    if (DBG_STOP == 1) { dbg_dump(p, p.hbuf, MW); return; }
    gemm_phase<1>(p, l, first, p.hbuf, 1024, wt + WT_OUT, 1152, 384, 8, 8, nullptr, 0, 2048, smem);
    grid.sync();
    norm_phase(p, l, false, p.norm_ffn_g + l * DM, 3072, 4096);
    grid.sync();
    for (int rep = 0; rep < REP_GEMM; ++rep) {
    gemm_phase<2>(p, l, false, p.hbuf, 5632, wt + WT_UP, 1024, 408, 44, 4, p.proj, DFF, 0, smem);
    grid.sync();
    }
    gemm_phase<1>(p, l, false, p.proj, 1024, wt + WT_DOWN, 2816, 384, 8, 8, nullptr, 0, 5120, smem);
    grid.sync();
  }
}

extern "C" void kernel_launch(void* const* d_in, const int* in_sizes, int n_in, void* d_out, int out_size, void* d_ws, size_t ws_size,
                              hipStream_t stream) {
  static int grid_blocks = 0;
  if (!grid_blocks) {
    int dev = 0, cus = 0, per_cu = 0;
    hipGetDevice(&dev);
    hipDeviceGetAttribute(&cus, hipDeviceAttributeMultiprocessorCount, dev);
    hipFuncSetAttribute((const void*)fwd_megakernel, hipFuncAttributeMaxDynamicSharedMemorySize, 3 * GB_BUF);
    hipOccupancyMaxActiveBlocksPerMultiprocessor(&per_cu, fwd_megakernel, 256, 3 * GB_BUF);
    if (per_cu > 2) per_cu = 2;
    if (per_cu < 1) per_cu = 1;
    grid_blocks = cus * per_cu;
  }
  Params p{};
  const float* const* in = (const float* const*)d_in;
  p.x_prompt = in[0]; p.x_sample = in[1]; p.c_prompt = in[2]; p.c_sample = in[3]; p.norm_attn_g = in[4]; p.norm_ffn_g = in[5];
  p.w_ada = in[6]; p.b_ada = in[7]; p.w_in = in[8]; p.qkn_a = in[9]; p.qkn_b = in[10]; p.qkn_c = in[11]; p.qkn_d = in[12];
  p.rpb_a = in[13]; p.sink_b = in[14]; p.t5_table = in[15]; p.lam_d = in[16]; p.subln_d = in[17]; p.w_out = in[18]; p.w_up = in[19];
  p.conv_w = in[20]; p.conv_b = in[21]; p.w_down = in[22];
  p.out = (float*)d_out;
  char* ws = (char*)d_ws;
  size_t off = 0;
  p.wt = (bf16_t*)(ws + off); off += (size_t)4 * WT_LAYER * 2;
  p.mod = (float*)(ws + off); off += (size_t)4 * 48 * 6144 * 4;
  p.lut = (float*)(ws + off); off += 16384;
  p.lam = (float*)(ws + off); off += 256;
  p.zeros = (float*)(ws + off); off += 256;
  p.lse = (float*)(ws + off); off += (size_t)NTOK * 6 * 4;
  p.proj = (bf16_t*)(ws + off); off += (size_t)NTOK * PW * 2;
  p.hbuf = (bf16_t*)(ws + off); off += (size_t)NTOK * MW * 2;
  if (off > ws_size) { fprintf(stderr, "workspace too small: need %zu have %zu\n", off, ws_size); return; }
  void* args[] = {&p};
  hipError_t e = hipLaunchCooperativeKernel((void*)fwd_megakernel, dim3(grid_blocks), dim3(256), args, 3 * GB_BUF, stream);
  if (e != hipSuccess) fprintf(stderr, "cooperative launch failed: %s (grid %d)\n", hipGetErrorString(e), grid_blocks);
}
```

```cpp
#include <hip/hip_runtime.h>
#include <hip/hip_cooperative_groups.h>
#include <cstdint>
#include <cstdio>
namespace cg = cooperative_groups;

typedef unsigned short bf16_t;
typedef short bf16x8 __attribute__((ext_vector_type(8)));
typedef float f32x4 __attribute__((ext_vector_type(4)));
typedef unsigned u32x4 __attribute__((ext_vector_type(4)));
typedef unsigned u32x2 __attribute__((ext_vector_type(2)));

#define NTOK 98304
#define DM 1024
#define PW 3200
#define MW 1152
#define DFF 2816
#define NSEQ 48
#define SEQL 2048
#define LOG2E 1.4426950408889634f
#define LN2 0.6931471805599453f
#define LDSROW 72
#define NTHR 512
#define NWAVE 8

struct Params {
  const float *x_prompt, *x_sample, *c_prompt, *c_sample, *norm_attn_g, *norm_ffn_g, *w_ada, *b_ada, *w_in;
  const float *qkn_a, *qkn_b, *qkn_c, *qkn_d, *rpb_a, *sink_b, *t5_table, *lam_d, *subln_d, *w_out, *w_up, *conv_w, *conv_b, *w_down;
  float* out;
  bf16_t* wt; float* mod; float* lut; float* lam; float* lse; bf16_t* proj; bf16_t* hbuf; float* zeros;
};

#define WT_IN 0
#define WT_OUT (3200 * 1024)
#define WT_UP (WT_OUT + 1024 * 1152)
#define WT_DOWN (WT_UP + 5632 * 1024)
#define WT_LAYER (WT_DOWN + 1024 * 2816)

typedef __bf16 bf16x2_t __attribute__((ext_vector_type(2)));
typedef float f32x2_t __attribute__((ext_vector_type(2)));
__device__ __forceinline__ unsigned pk_bf16(float lo, float hi) {
  const f32x2_t v = {lo, hi};
  const bf16x2_t r = __builtin_convertvector(v, bf16x2_t);
  return __builtin_bit_cast(unsigned, r);
}
__device__ __forceinline__ float bf_lo(unsigned u) { return __uint_as_float(u << 16); }
__device__ __forceinline__ float bf_hi(unsigned u) { return __uint_as_float(u & 0xffff0000u); }
__device__ __forceinline__ float fexp2(float x) { return __builtin_amdgcn_exp2f(x); }

__device__ __forceinline__ const float* xin_row(const Params& p, bool first, int tok) {
  if (first) return tok < 65536 ? p.x_prompt + (size_t)tok * DM : p.x_sample + (size_t)(tok - 65536) * DM;
  return p.out + (size_t)tok * DM;
}

__device__ __forceinline__ int opaque_tid() { int t = threadIdx.x; asm volatile("" : "+v"(t)); return t; }

__device__ __forceinline__ size_t blk_off(int r, int k, int R) { return ((size_t)(k >> 5) * R + r) * 32 + (k & 31); }

__device__ __forceinline__ int t5_bucket(int rel) {
  const int n = rel < 0 ? -rel : rel;
  int v;
  if (n < 8) v = n;
  else v = 8 + (n >= 12) + (n >= 16) + (n >= 23) + (n >= 32) + (n >= 46) + (n >= 64) + (n >= 91);
  return (rel > 0 ? 16 : 0) + v;
}

__device__ __forceinline__ void prologue_phase(const Params& p, char* smem) {
  const int tid = opaque_tid(), nb = gridDim.x;
  const int N_TR = 4 * 3200, N_MOD = 192;
  for (int item = blockIdx.x; item < N_TR + N_MOD + 1; item += nb) {
    if (item < N_TR) {
      const int l = item / 3200; int r = item % 3200;
      const float* src; bf16_t* dst; int K, N, kt, nt;
      if (r < 800) { K = 1024; N = 3200; src = p.w_in + (size_t)l * K * N; dst = p.wt + (size_t)l * WT_LAYER + WT_IN; kt = r / 50; nt = r % 50; }
      else if (r < 1088) { r -= 800; K = 1152; N = 1024; src = p.w_out + (size_t)l * K * N; dst = p.wt + (size_t)l * WT_LAYER + WT_OUT; kt = r / 16; nt = r % 16; }
      else if (r < 2496) { r -= 1088; K = 1024; N = 5632; src = p.w_up + (size_t)l * K * N; dst = p.wt + (size_t)l * WT_LAYER + WT_UP; kt = r / 88; nt = r % 88; }
      else { r -= 2496; K = 2816; N = 1024; src = p.w_down + (size_t)l * K * N; dst = p.wt + (size_t)l * WT_LAYER + WT_DOWN; kt = r / 16; nt = r % 16; }
      float* tile = (float*)smem;
      const int k0 = kt * 64, n0 = nt * 64;
      __syncthreads();
#pragma unroll
      for (int i = 0; i < 8; ++i) {
        const int rr = (tid >> 6) + 8 * i, cc = tid & 63;
        tile[rr * 65 + cc] = src[(size_t)(k0 + rr) * N + n0 + cc];
      }
      __syncthreads();
#pragma unroll
      for (int i = 0; i < 4; ++i) {
        const int idx = tid + NTHR * i, n = idx >> 5, k2 = (idx & 31) * 2;
        *(unsigned*)(dst + blk_off(n0 + n, k0 + k2, N)) = pk_bf16(tile[k2 * 65 + n], tile[(k2 + 1) * 65 + n]);
      }
    } else if (item < N_TR + N_MOD) {
      int r = item - N_TR;
      const int l = r / 48; r %= 48;
      const int nc = r / 4, bg = r % 4;
      const int n = nc * NTHR + tid;
      float* sc = (float*)smem;
      float acc[12];
#pragma unroll
      for (int j = 0; j < 12; ++j) acc[j] = 0.f;
      const float* W = p.w_ada + (size_t)l * 1024 * 6144 + n;
      for (int kc = 0; kc < 2; ++kc) {
        __syncthreads();
        for (int i = tid; i < 12 * 512; i += NTHR) {
          const int j = i >> 9, k = i & 511, b = bg * 12 + j;
          const float c = b < 32 ? p.c_prompt[b * 1024 + kc * 512 + k] : p.c_sample[(b - 32) * 1024 + kc * 512 + k];
          sc[i] = c / (1.f + __expf(-c));
        }
        __syncthreads();
#pragma unroll 2
        for (int k = 0; k < 512; k += 4) {
          const float w0 = W[(size_t)(kc * 512 + k) * 6144], w1 = W[(size_t)(kc * 512 + k + 1) * 6144];
          const float w2 = W[(size_t)(kc * 512 + k + 2) * 6144], w3 = W[(size_t)(kc * 512 + k + 3) * 6144];
#pragma unroll
          for (int j = 0; j < 12; ++j) {
            const f32x4 s = *(const f32x4*)(sc + j * 512 + k);
            acc[j] += s[0] * w0 + s[1] * w1 + s[2] * w2 + s[3] * w3;
          }
        }
      }
      const float bias = p.b_ada[l * 6144 + n];
#pragma unroll
      for (int j = 0; j < 12; ++j) p.mod[((size_t)l * 48 + bg * 12 + j) * 6144 + n] = acc[j] + bias;
    } else {
      for (int i = tid; i < 14 * 257; i += NTHR) {
        const int hd = i / 257, idx = i % 257;
        p.lut[i] = p.t5_table[t5_bucket(idx - 128) * 14 + hd] * LOG2E;
      }
      if (tid < 64) p.zeros[tid] = 0.f;
      if (tid < 4) {
        const float* lp = p.lam_d + tid * 128;
        float s1 = 0.f, s2 = 0.f;
        for (int e = 0; e < 32; ++e) { s1 += lp[e] * lp[32 + e]; s2 += lp[64 + e] * lp[96 + e]; }
        const float li = 0.8f - 0.6f * expf(-0.3f * (float)tid);
        p.lam[tid] = expf(s1) - expf(s2) + li;
      }
    }
  }
}

__device__ __forceinline__ void norm_phase(const Params& p, int l, bool first, const float* g, int shift_off, int scale_off) {
  const int tid0 = opaque_tid();
  const int lane = tid0 & 63, w = tid0 >> 6;
  const int stride = gridDim.x * NWAVE;
  for (int row0 = blockIdx.x * NWAVE + w; row0 < NTOK; row0 += 2 * stride) {
    const int row1 = row0 + stride;
    const bool has1 = row1 < NTOK;
    const int rows[2] = {row0, has1 ? row1 : row0};
    f32x4 v[2][4];
    float ss[2] = {0.f, 0.f};
#pragma unroll
    for (int r = 0; r < 2; ++r) {
      const float* xr = xin_row(p, first, rows[r]);
#pragma unroll
      for (int i = 0; i < 4; ++i) v[r][i] = *(const f32x4*)(xr + i * 256 + lane * 4);
    }
#pragma unroll
    for (int r = 0; r < 2; ++r) {
#pragma unroll
      for (int i = 0; i < 4; ++i) ss[r] += v[r][i][0] * v[r][i][0] + v[r][i][1] * v[r][i][1] + v[r][i][2] * v[r][i][2] + v[r][i][3] * v[r][i][3];
#pragma unroll
      for (int o = 32; o >= 1; o >>= 1) ss[r] += __shfl_xor(ss[r], o);
    }
#pragma unroll
    for (int r = 0; r < 2; ++r) {
      if (r == 1 && !has1) break;
      const int row = rows[r];
      const float* md = p.mod + ((size_t)l * 48 + (row >> 11)) * 6144;
      const float rstd = rsqrtf(ss[r] * (1.f / 1024.f) + 1e-6f);
#pragma unroll
      for (int i = 0; i < 4; ++i) {
        const int k = i * 256 + lane * 4;
        const f32x4 gg = *(const f32x4*)(g + k), sc = *(const f32x4*)(md + scale_off + k), sh = *(const f32x4*)(md + shift_off + k);
        f32x4 y;
#pragma unroll
        for (int j = 0; j < 4; ++j) y[j] = (v[r][i][j] * rstd) * gg[j] * (1.f + sc[j]) + sh[j];
        u32x2 o; o[0] = pk_bf16(y[0], y[1]); o[1] = pk_bf16(y[2], y[3]);
        *(u32x2*)(p.hbuf + blk_off(row, k, NTOK)) = o;
      }
    }
  }
}

__device__ __forceinline__ bool gemm_tile_id(int it, int MT, int NT, int NB, int& mt, int& nt) {
  const int nb = gridDim.x, bid = blockIdx.x;
  if ((nb & 7) == 0) {
    const int x = bid & 7, slot = bid >> 3, S = nb >> 3;
    const int TPS = 8 * NB, NSN = NT / NB, NS = (MT / 8) * NSN;
    const int pidx = slot + S * it, sidx = pidx / TPS, w = pidx % TPS, s = x + 8 * sidx;
    if (s >= NS) return false;
    mt = (s / NSN) * 8 + (w & 7); nt = (s % NSN) * NB + (w >> 3);
    return true;
  }
  const int t = bid + nb * it;
  if (t >= MT * NT) return false;
  mt = t / NT; nt = t % NT;
  return true;
}

template <int M, int NN>
__device__ __forceinline__ void up_epi_row(const f32x4 (&acc)[8][4], const float* cw, const float* cb, int cbase, int lane, int fr, int s0, bf16_t* obase) {
  constexpr int MP = M > 0 ? M - 1 : 0, MN = M < 7 ? M + 1 : 7;
  const int srcp = (lane & 48) | ((fr + 15) & 15), srcn = (lane & 48) | ((fr + 1) & 15);
  float y[2][4];
#pragma unroll
  for (int n = 0; n < 2; ++n) {
    const int c = n * DFF + cbase;
    const f32x4 w0 = *(const f32x4*)(cw + c), w1 = *(const f32x4*)(cw + 5632 + c), w2 = *(const f32x4*)(cw + 2 * 5632 + c), bb = *(const f32x4*)(cb + c);
#pragma unroll
    for (int j = 0; j < 4; ++j) {
      const float cur = acc[M][NN + 2 * n][j];
      const float zp = (fr == 15) ? acc[MP][NN + 2 * n][j] : cur, zn = (fr == 0) ? acc[MN][NN + 2 * n][j] : cur;
      const float pv = __shfl(zp, srcp), nv = __shfl(zn, srcn);
      y[n][j] = w0[j] * pv + w1[j] * cur + w2[j] * nv + bb[j];
    }
  }
  const int row = 16 * M + fr, tpos = s0 + row;
  if (row >= 1 && row <= 126 && tpos >= 0 && tpos < SEQL) {
    float a[4];
#pragma unroll
    for (int j = 0; j < 4; ++j) { const float gte = y[1][j]; a[j] = y[0][j] * gte / (1.f + __expf(-gte)); }
    u32x2 o; o[0] = pk_bf16(a[0], a[1]); o[1] = pk_bf16(a[2], a[3]);
    *(u32x2*)(obase + (size_t)tpos * 32) = o;
  }
  __builtin_amdgcn_sched_barrier(0);
}

#define GB_A 16384
#define GB_BUF 32768
#define NSTAGE 4
#define SMEM_BYTES (NSTAGE * GB_BUF)
template <int EPI>
__device__ __forceinline__ void gemm_phase(const Params& p, int l, bool first, const bf16_t* A, int NBROWS, const bf16_t* Bt, int K, int MT, int NT, int NB,
                           bf16_t* outb, int ldc, int gate_off, char* smem) {
  const int tid = opaque_tid(), lane = tid & 63, w = tid >> 6, wr = w >> 2, wcn = w & 3, fr = lane & 15, fq = lane >> 4;
  const int nk = K / 32;
  const int lrow = tid >> 2, lch = (tid & 3) ^ ((tid >> 4) & 3);
  const int fsw = (fq ^ ((fr >> 2) & 3)) * 16;
  for (int it = 0;; ++it) {
    int mt, nt;
    if (!gemm_tile_id(it, MT, NT, NB, mt, nt)) break;
    const bf16_t* ga0; const bf16_t* ga1; const bf16_t* gb0;
    const size_t apan = (size_t)NTOK * 32, bpan = (size_t)NBROWS * 32;
    size_t bstr;
    if (EPI == 2) {
      const int wi0 = 2 * mt, wi1 = wi0 + 1;
      const int t0 = 126 * (wi0 % 17) - 1 + lrow, t1 = 126 * (wi1 % 17) - 1 + lrow;
      ga0 = A + ((size_t)(wi0 / 17) * SEQL + t0) * 32 + lch * 8;
      ga1 = A + ((size_t)(wi1 / 17) * SEQL + t1) * 32 + lch * 8;
      gb0 = Bt + (size_t)(nt * 128 + lrow) * 32 + lch * 8; bstr = (size_t)DFF * 32;
    } else {
      ga0 = A + (size_t)(mt * 256 + lrow) * 32 + lch * 8; ga1 = ga0 + (size_t)128 * 32;
      gb0 = Bt + (size_t)(nt * 256 + lrow) * 32 + lch * 8; bstr = (size_t)128 * 32;
    }
#define GEMM_ISSUE(KT, STAGE)                                                                                                        \
    {                                                                                                                                \
      char* dst_ = smem + (STAGE) * GB_BUF + tid * 16;                                                                               \
      const size_t ko_ = (size_t)(KT) * apan, kb_ = (size_t)(KT) * bpan;                                                             \
      __builtin_amdgcn_global_load_lds((const unsigned*)(ga0 + ko_), (unsigned*)(dst_), 16, 0, 0);                                   \
      __builtin_amdgcn_global_load_lds((const unsigned*)(ga1 + ko_), (unsigned*)(dst_ + 8192), 16, 0, 0);                            \
      __builtin_amdgcn_global_load_lds((const unsigned*)(gb0 + kb_), (unsigned*)(dst_ + GB_A), 16, 0, 0);                            \
      __builtin_amdgcn_global_load_lds((const unsigned*)(gb0 + bstr + kb_), (unsigned*)(dst_ + GB_A + 8192), 16, 0, 0);              \
    }
    f32x4 acc[8][4];
#pragma unroll
    for (int m = 0; m < 8; ++m)
#pragma unroll
      for (int n = 0; n < 4; ++n) acc[m][n] = (f32x4){0.f, 0.f, 0.f, 0.f};
    asm volatile("s_waitcnt vmcnt(0) lgkmcnt(0)" ::: "memory");
    __builtin_amdgcn_s_barrier();
    GEMM_ISSUE(0, 0)
    GEMM_ISSUE(1, 1)
    GEMM_ISSUE(2, 2)
    int scur = 0, snxt = 3;
    for (int kt = 0; kt < nk; ++kt) {
      if (kt + 2 < nk) asm volatile("s_waitcnt vmcnt(8)" ::: "memory");
      else if (kt + 1 < nk) asm volatile("s_waitcnt vmcnt(4)" ::: "memory");
      else asm volatile("s_waitcnt vmcnt(0)" ::: "memory");
      asm volatile("s_waitcnt lgkmcnt(0)" ::: "memory");
      __builtin_amdgcn_s_barrier();
      if (kt + 3 < nk) GEMM_ISSUE(kt + 3, snxt)
      const char* Ab = smem + scur * GB_BUF;
      scur = (scur == NSTAGE - 1) ? 0 : scur + 1; snxt = (snxt == NSTAGE - 1) ? 0 : snxt + 1;
      const char* Bb = Ab + GB_A;
      bf16x8 bfr[4];
#pragma unroll
      for (int n = 0; n < 4; ++n) {
        const int br = (EPI == 2) ? ((n >> 1) * 128 + 32 * wcn + 16 * (n & 1) + fr) : (64 * wcn + 16 * n + fr);
        bfr[n] = *(const bf16x8*)(Bb + br * 64 + fsw);
      }
#pragma unroll
      for (int m = 0; m < 8; ++m) {
        const bf16x8 af = *(const bf16x8*)(Ab + (wr * 128 + 16 * m + fr) * 64 + fsw);
#pragma unroll
        for (int n = 0; n < 4; ++n) acc[m][n] = __builtin_amdgcn_mfma_f32_16x16x32_bf16(bfr[n], af, acc[m][n], 0, 0, 0);
      }
    }
#undef GEMM_ISSUE
    int lane_e = lane; asm volatile("" : "+v"(lane_e));
    const int fr_e = lane_e & 15, fq_e = lane_e >> 4;
    if (EPI == 0) {
      if (nt * 256 + 64 * wcn < NBROWS) {
#pragma unroll
        for (int m = 0; m < 8; ++m) {
          const int tok = mt * 256 + wr * 128 + 16 * m + fr_e;
#pragma unroll
          for (int n = 0; n < 4; ++n) {
            const int col = nt * 256 + 64 * wcn + 16 * n + 4 * fq_e;
            u32x2 o; o[0] = pk_bf16(acc[m][n][0], acc[m][n][1]); o[1] = pk_bf16(acc[m][n][2], acc[m][n][3]);
            *(u32x2*)(outb + (size_t)tok * ldc + col) = o;
          }
        }
      }
    } else if (EPI == 1) {
      const int b = (mt * 256) >> 11;
      const float* gate = p.mod + ((size_t)l * 48 + b) * 6144 + gate_off;
#pragma unroll
      for (int n = 0; n < 4; ++n) {
        const int col = nt * 256 + 64 * wcn + 16 * n + 4 * fq_e;
        const f32x4 gv = *(const f32x4*)(gate + col);
#pragma unroll
        for (int m = 0; m < 8; ++m) {
          const int tok = mt * 256 + wr * 128 + 16 * m + fr_e;
          const f32x4 xv = *(const f32x4*)(xin_row(p, first, tok) + col);
          f32x4 o;
#pragma unroll
          for (int j = 0; j < 4; ++j) o[j] = xv[j] + gv[j] * acc[m][n][j];
          *(f32x4*)(p.out + (size_t)tok * DM + col) = o;
        }
      }
    } else {
      const float* cw = p.conv_w + (size_t)l * 3 * 5632;
      const float* cb = p.conv_b + (size_t)l * 5632;
      const int wi = 2 * mt + wr, seq = wi / 17, s0 = 126 * (wi % 17) - 1;
      if (s0 < 0 || s0 + 127 >= SEQL) {
#pragma unroll
        for (int m = 0; m < 8; ++m) {
          const int tp = s0 + 16 * m + fr_e;
          if (tp < 0 || tp >= SEQL) {
#pragma unroll
            for (int n = 0; n < 4; ++n) acc[m][n] = (f32x4){0.f, 0.f, 0.f, 0.f};
          }
        }
      }
#define UP_EPI_NN(NN)                                                                                                      \
      {                                                                                                                    \
        const int cbase = nt * 128 + 32 * wcn + 16 * NN + 4 * fq_e;                                                        \
        bf16_t* obase = outb + blk_off(seq * SEQL, cbase, NTOK);                                                           \
        up_epi_row<0, NN>(acc, cw, cb, cbase, lane_e, fr_e, s0, obase); up_epi_row<1, NN>(acc, cw, cb, cbase, lane_e, fr_e, s0, obase); \
        up_epi_row<2, NN>(acc, cw, cb, cbase, lane_e, fr_e, s0, obase); up_epi_row<3, NN>(acc, cw, cb, cbase, lane_e, fr_e, s0, obase); \
        up_epi_row<4, NN>(acc, cw, cb, cbase, lane_e, fr_e, s0, obase); up_epi_row<5, NN>(acc, cw, cb, cbase, lane_e, fr_e, s0, obase); \
        up_epi_row<6, NN>(acc, cw, cb, cbase, lane_e, fr_e, s0, obase); up_epi_row<7, NN>(acc, cw, cb, cbase, lane_e, fr_e, s0, obase); \
      }
      UP_EPI_NN(0)
      UP_EPI_NN(1)
#undef UP_EPI_NN
    }
  }
}

struct AttnArgs {
  int qbase, qstride, qpos0;
  int ktokbase, ktokstep, kstride, kposbase, kposstep, ntiles;
  int qcol, kcol, vcol, ocol;
  const float *gq, *gk;
  float qscale;
  int hw, rmul, taboff0;
  float sinkv;
  float lam, outscale;
  const float* subg;
  int lsecol;
  int r0, rs0;
};

template <int NQ, int NC, int MODE>
__device__ __forceinline__ void attn_item(const Params& p, const AttnArgs& a, bf16_t* Ks, bf16_t* Vts, const float* tab) {
  const int tid = opaque_tid(), lane = tid & 63, w = tid >> 6, fr = lane & 15, fq = lane >> 4;
  const int wq0 = a.qpos0 + w * 16 * NQ;
  bf16x8 qf[NQ][2];
  int qpos[NQ];
#pragma unroll
  for (int qt = 0; qt < NQ; ++qt) {
    const int qp = wq0 + qt * 16 + fr;
    qpos[qt] = qp;
    const bf16_t* qrow = p.proj + (size_t)(a.qbase + qp * a.qstride) * PW + a.qcol;
    const u32x4 v0 = *(const u32x4*)(qrow + fq * 8), v1 = *(const u32x4*)(qrow + 32 + fq * 8);
    float f0[8], f1[8];
#pragma unroll
    for (int i = 0; i < 4; ++i) { f0[2 * i] = bf_lo(v0[i]); f0[2 * i + 1] = bf_hi(v0[i]); f1[2 * i] = bf_lo(v1[i]); f1[2 * i + 1] = bf_hi(v1[i]); }
    float s0 = 0.f, s1 = 0.f;
#pragma unroll
    for (int i = 0; i < 8; ++i) { s0 += f0[i] * f0[i]; s1 += f1[i] * f1[i]; }
    float r0, r1;
    if (NC == 1) {
      float s = s0 + s1; s += __shfl_xor(s, 16); s += __shfl_xor(s, 32);
      r0 = r1 = rsqrtf(s * (1.f / 64.f) + 1e-6f) * a.qscale;
    } else {
      s0 += __shfl_xor(s0, 16); s0 += __shfl_xor(s0, 32);
      s1 += __shfl_xor(s1, 16); s1 += __shfl_xor(s1, 32);
      r0 = rsqrtf(s0 * (1.f / 32.f) + 1e-6f) * a.qscale; r1 = rsqrtf(s1 * (1.f / 32.f) + 1e-6f) * a.qscale;
    }
    const float* g0p = a.gq + fq * 8;
    const float* g1p = (NC == 1) ? a.gq + 32 + fq * 8 : g0p;
    u32x4 q0, q1;
#pragma unroll
    for (int i = 0; i < 4; ++i) {
      q0[i] = pk_bf16(f0[2 * i] * r0 * g0p[2 * i], f0[2 * i + 1] * r0 * g0p[2 * i + 1]);
      q1[i] = pk_bf16(f1[2 * i] * r1 * g1p[2 * i], f1[2 * i + 1] * r1 * g1p[2 * i + 1]);
    }
    qf[qt][0] = __builtin_bit_cast(bf16x8, q0);
    qf[qt][1] = __builtin_bit_cast(bf16x8, q1);
  }
  f32x4 o[NC][NQ][4];
  float mrun[NC][NQ], lrun[NC][NQ];
#pragma unroll
  for (int c = 0; c < NC; ++c)
#pragma unroll
    for (int qt = 0; qt < NQ; ++qt) {
      if (MODE == 1) { mrun[c][qt] = a.sinkv; lrun[c][qt] = (fq == 0) ? 1.f : 0.f; }
      else { mrun[c][qt] = -1e30f; lrun[c][qt] = 0.f; }
#pragma unroll
      for (int dt = 0; dt < 4; ++dt) o[c][qt][dt] = (f32x4){0.f, 0.f, 0.f, 0.f};
    }
  const int lch = tid & 7;
  float gkv[8];
#pragma unroll
  for (int i = 0; i < 8; ++i) gkv[i] = a.gk[((NC == 1) ? lch : (lch & 3)) * 8 + i];

  const int rw = a.r0 + ((w * 16 * NQ) >> 6);
  int rsw = rw - 4; rsw = rsw < 0 ? 0 : (rsw > 24 ? 24 : rsw);
  u32x4 kreg, vreg;
  const int kkey = tid >> 3, vkey = tid & 63, vch = tid >> 6;
#define ATTN_PREFETCH(T)                                                                                         \
  {                                                                                                              \
    const int ktok0_ = a.ktokbase + (T) * a.ktokstep;                                                            \
    kreg = *(const u32x4*)(p.proj + (size_t)(ktok0_ + kkey * a.kstride) * PW + a.kcol + lch * 8);                 \
    vreg = *(const u32x4*)(p.proj + (size_t)(ktok0_ + vkey * a.kstride) * PW + a.vcol + vch * 8);                 \
  }
  ATTN_PREFETCH(0)
  for (int t = 0; t < a.ntiles; ++t) {
    __syncthreads();
    {
      const u32x4 v = kreg;
      float f[8];
#pragma unroll
      for (int i = 0; i < 4; ++i) { f[2 * i] = bf_lo(v[i]); f[2 * i + 1] = bf_hi(v[i]); }
      float s = 0.f;
#pragma unroll
      for (int i = 0; i < 8; ++i) s += f[i] * f[i];
      s += __shfl_xor(s, 1); s += __shfl_xor(s, 2);
      float rs;
      if (NC == 1) { s += __shfl_xor(s, 4); rs = rsqrtf(s * (1.f / 64.f) + 1e-6f); }
      else rs = rsqrtf(s * (1.f / 32.f) + 1e-6f);
      u32x4 kq;
#pragma unroll
      for (int i = 0; i < 4; ++i) kq[i] = pk_bf16(f[2 * i] * rs * gkv[2 * i], f[2 * i + 1] * rs * gkv[2 * i + 1]);
      *(u32x4*)(Ks + kkey * LDSROW + lch * 8) = kq;
    }
    {
      const u32x4 v = vreg;
#pragma unroll
      for (int i = 0; i < 4; ++i) {
        Vts[(vch * 8 + 2 * i) * LDSROW + vkey] = (bf16_t)(v[i] & 0xffffu);
        Vts[(vch * 8 + 2 * i + 1) * LDSROW + vkey] = (bf16_t)(v[i] >> 16);
      }
    }
    __syncthreads();
    if (t + 1 < a.ntiles) ATTN_PREFETCH(t + 1)
    if (MODE == 0) { const int kr_ = a.rs0 + t; if (kr_ < rsw || kr_ >= rsw + 8) continue; }
    const int kp0 = a.kposbase + t * a.kposstep;
    const int taboff = (a.rs0 + t - rw + 7) * 31;
    bf16x8 pf[NC][NQ][2];
    __builtin_amdgcn_sched_barrier(0);
#pragma unroll
    for (int qt = 0; qt < NQ; ++qt) {
      const int qp = (MODE == 0) ? (qpos[qt] & 63) : qpos[qt];
      int cs = qp - 8; cs = cs < 0 ? 0 : (cs > 48 ? 48 : cs);
      f32x4 bv[4];
#pragma unroll
      for (int kt = 0; kt < 4; ++kt)
#pragma unroll
        for (int j = 0; j < 4; ++j) {
          const int kpos = kp0 + kt * 16 + 4 * fq + j;
          const int d = kpos - qp;
          bool valid; int idx;
          if (MODE == 0) {
            valid = kpos >= cs && kpos < cs + 16;
            int dd = d + 15; dd = dd < 0 ? 0 : (dd > 30 ? 30 : dd);
            idx = taboff + dd;
          } else {
            valid = (MODE == 3) ? true : (d <= a.hw && d >= -a.hw);
            int dd = d * a.rmul; dd = dd < -128 ? -128 : (dd > 128 ? 128 : dd);
            idx = dd + 128;
          }
          const float bias = tab[idx];
          bv[kt][j] = valid ? bias : -INFINITY;
        }
#pragma unroll
      for (int c = 0; c < NC; ++c) {
        f32x4 s[4];
#pragma unroll
        for (int kt = 0; kt < 4; ++kt) {
          if (NC == 1) {
            const bf16x8 k0 = *(const bf16x8*)(Ks + (kt * 16 + fr) * LDSROW + fq * 8);
            const bf16x8 k1 = *(const bf16x8*)(Ks + (kt * 16 + fr) * LDSROW + 32 + fq * 8);
            const f32x4 r = __builtin_amdgcn_mfma_f32_16x16x32_bf16(k0, qf[qt][0], bv[kt], 0, 0, 0);
            s[kt] = __builtin_amdgcn_mfma_f32_16x16x32_bf16(k1, qf[qt][1], r, 0, 0, 0);
          } else {
            const bf16x8 k0 = *(const bf16x8*)(Ks + (kt * 16 + fr) * LDSROW + c * 32 + fq * 8);
            s[kt] = __builtin_amdgcn_mfma_f32_16x16x32_bf16(k0, qf[qt][c], bv[kt], 0, 0, 0);
          }
        }
        float mx = -INFINITY;
#pragma unroll
        for (int kt = 0; kt < 4; ++kt)
#pragma unroll
          for (int j = 0; j < 4; ++j) mx = fmaxf(mx, s[kt][j]);
        mx = fmaxf(mx, __shfl_xor(mx, 16)); mx = fmaxf(mx, __shfl_xor(mx, 32));
        const float mn = fmaxf(mrun[c][qt], mx);
        const float al = fexp2(mrun[c][qt] - mn);
        mrun[c][qt] = mn;
        float rs = 0.f;
#pragma unroll
        for (int kt = 0; kt < 4; ++kt)
#pragma unroll
          for (int j = 0; j < 4; ++j) { const float pv = fexp2(s[kt][j] - mn); s[kt][j] = pv; rs += pv; }
        lrun[c][qt] = lrun[c][qt] * al + rs;
#pragma unroll
        for (int dt = 0; dt < 4; ++dt) o[c][qt][dt] *= al;
#pragma unroll
        for (int ks = 0; ks < 2; ++ks) {
          u32x4 pk;
          pk[0] = pk_bf16(s[2 * ks][0], s[2 * ks][1]); pk[1] = pk_bf16(s[2 * ks][2], s[2 * ks][3]);
          pk[2] = pk_bf16(s[2 * ks + 1][0], s[2 * ks + 1][1]); pk[3] = pk_bf16(s[2 * ks + 1][2], s[2 * ks + 1][3]);
          pf[c][qt][ks] = __builtin_bit_cast(bf16x8, pk);
        }
        __builtin_amdgcn_sched_barrier(0);
      }
    }
#pragma unroll
    for (int ks = 0; ks < 2; ++ks) {
#pragma unroll
      for (int dt = 0; dt < 4; ++dt) {
        const u32x2 lo = *(const u32x2*)(Vts + (dt * 16 + fr) * LDSROW + ks * 32 + 4 * fq);
        const u32x2 hi = *(const u32x2*)(Vts + (dt * 16 + fr) * LDSROW + ks * 32 + 16 + 4 * fq);
        u32x4 vv; vv[0] = lo[0]; vv[1] = lo[1]; vv[2] = hi[0]; vv[3] = hi[1];
        const bf16x8 vf = __builtin_bit_cast(bf16x8, vv);
#pragma unroll
        for (int c = 0; c < NC; ++c)
#pragma unroll
          for (int qt = 0; qt < NQ; ++qt) o[c][qt][dt] = __builtin_amdgcn_mfma_f32_16x16x32_bf16(vf, pf[c][qt][ks], o[c][qt][dt], 0, 0, 0);
      }
    }
  }
#undef ATTN_PREFETCH
#pragma unroll
  for (int qt = 0; qt < NQ; ++qt) {
    float inv[NC], ltot[NC];
#pragma unroll
    for (int c = 0; c < NC; ++c) {
      float lt = lrun[c][qt];
      lt += __shfl_xor(lt, 16); lt += __shfl_xor(lt, 32);
      ltot[c] = lt; inv[c] = 1.f / lt;
    }
    const int tok = a.qbase + qpos[qt] * a.qstride;
    if (MODE == 3) {
      f32x4 v[4];
      float ss = 0.f;
#pragma unroll
      for (int dt = 0; dt < 4; ++dt)
#pragma unroll
        for (int j = 0; j < 4; ++j) {
          const float x = o[0][qt][dt][j] * inv[0] - a.lam * (o[NC - 1][qt][dt][j] * inv[NC - 1]);
          v[dt][j] = x; ss += x * x;
        }
      ss += __shfl_xor(ss, 16); ss += __shfl_xor(ss, 32);
      const float rstd = rsqrtf(ss * (1.f / 64.f) + 1e-6f) * a.outscale;
#pragma unroll
      for (int dt = 0; dt < 4; ++dt) {
        const f32x4 g = *(const f32x4*)(a.subg + dt * 16 + 4 * fq);
        u32x2 ov; ov[0] = pk_bf16(v[dt][0] * rstd * g[0], v[dt][1] * rstd * g[1]); ov[1] = pk_bf16(v[dt][2] * rstd * g[2], v[dt][3] * rstd * g[3]);
        *(u32x2*)(p.hbuf + blk_off(tok, a.ocol + dt * 16 + 4 * fq, NTOK)) = ov;
      }
    } else {
#pragma unroll
      for (int dt = 0; dt < 4; ++dt) {
        u32x2 ov;
        ov[0] = pk_bf16(o[0][qt][dt][0] * inv[0], o[0][qt][dt][1] * inv[0]);
        ov[1] = pk_bf16(o[0][qt][dt][2] * inv[0], o[0][qt][dt][3] * inv[0]);
        *(u32x2*)(p.hbuf + blk_off(tok, a.ocol + dt * 16 + 4 * fq, NTOK)) = ov;
      }
      if (MODE == 2 && fq == 0) p.lse[(size_t)tok * 6 + a.lsecol] = (mrun[0][qt] + __log2f(ltot[0])) * LN2;
    }
  }
}

__device__ __forceinline__ void attn_phase(const Params& p, int l, char* smem) {
  bf16_t* Ks = (bf16_t*)smem;
  bf16_t* Vts = Ks + 64 * LDSROW;
  float* tab = (float*)(Vts + 64 * LDSROW);
  const int tid = opaque_tid();
  const int nD = 3072, nA = 3072, nB = 3072, nC = 4608;
  for (int item = blockIdx.x; item < nD + nA + nB + nC; item += gridDim.x) {
    AttnArgs a;
    a.taboff0 = 0; a.r0 = 0; a.rs0 = 0; a.sinkv = 0.f; a.lam = 0.f; a.outscale = 1.f; a.subg = nullptr; a.lsecol = 0; a.hw = 1 << 20; a.rmul = 1;
    __syncthreads();
    if (item < nD) {
      const int b = item >> 6, h = (item >> 4) & 3, qb = item & 15;
      for (int i = tid; i < 257; i += NTHR) tab[i] = p.lut[(10 + h) * 257 + i];
      a.qbase = b * SEQL; a.qstride = 1; a.qpos0 = qb * 128;
      a.ktokbase = b * SEQL; a.ktokstep = 64; a.kstride = 1; a.kposbase = 0; a.kposstep = 64; a.ntiles = 32;
      a.qcol = 2432 + h * 64; a.kcol = 2432 + 256 + h * 64; a.vcol = 2432 + 512 + h * 64; a.ocol = 896 + h * 64;
      a.gq = p.qkn_d + l * 64; a.gk = a.gq + 32;
      a.qscale = 0.17677669529663687f * LOG2E;
      a.lam = p.lam[l]; a.outscale = 1.f - (0.8f - 0.6f * expf(-0.3f * (float)l)); a.subg = p.subln_d + l * 64;
      attn_item<1, 2, 3>(p, a, Ks, Vts, tab);
    } else if (item < nD + nA) {
      const int id = item - nD;
      const int b = id >> 6, h = (id >> 4) & 3, r = (id & 15) * 2;
      const float* rp = p.rpb_a + ((size_t)l * 4 + h) * 465;
      for (int i = tid; i < 465; i += NTHR) tab[i] = rp[i] * LOG2E;
      int rs = r - 4; rs = rs < 0 ? 0 : (rs > 24 ? 24 : rs);
      int rs1 = r - 3; rs1 = rs1 < 0 ? 0 : (rs1 > 24 ? 24 : rs1);
      a.qbase = b * SEQL + r * 64; a.qstride = 1; a.qpos0 = 0; a.r0 = r; a.rs0 = rs;
      a.ktokbase = b * SEQL + rs * 64; a.ktokstep = 64; a.kstride = 1; a.kposbase = 0; a.kposstep = 0; a.ntiles = rs1 - rs + 8;
      a.qcol = h * 64; a.kcol = 256 + h * 64; a.vcol = 512 + h * 64; a.ocol = h * 64;
      a.gq = p.qkn_a + l * 128; a.gk = a.gq + 64;
      a.qscale = 0.125f * LOG2E;
      attn_item<1, 1, 0>(p, a, Ks, Vts, tab);
    } else if (item < nD + nA + nB) {
      const int id = item - nD - nA;
      const int b = id >> 6, h = (id >> 4) & 3, qb = id & 15;
      for (int i = tid; i < 257; i += NTHR) tab[i] = p.lut[h * 257 + i];
      const int q0 = qb * 128;
      const int kstart = q0 - 128 < 0 ? 0 : q0 - 128, kend = q0 + 256 > SEQL ? SEQL : q0 + 256;
      a.qbase = b * SEQL; a.qstride = 1; a.qpos0 = q0;
      a.ktokbase = b * SEQL + kstart; a.ktokstep = 64; a.kstride = 1; a.kposbase = kstart; a.kposstep = 64; a.ntiles = (kend - kstart) >> 6;
      a.qcol = 768 + h * 64; a.kcol = 768 + 256 + (h >> 1) * 64; a.vcol = 768 + 384 + (h >> 1) * 64; a.ocol = 256 + h * 64;
      a.gq = p.qkn_b + l * 128; a.gk = a.gq + 64;
      a.qscale = 0.125f * LOG2E;
      a.hw = 128; a.rmul = 1; a.sinkv = p.sink_b[l * 4 + h] * LOG2E;
      attn_item<1, 1, 1>(p, a, Ks, Vts, tab);
    } else {
      const int id = item - nD - nA - nB;
      const int b = id / 96, rem = id % 96, g = rem >> 5, i2 = (rem >> 4) & 1, blk = rem & 15;
      const int r = g == 0 ? 1 : (g == 1 ? 4 : 16);
      const int L = SEQL / r, bps = L >> 7;
      const int pp = blk / bps, m0 = (blk % bps) * 128;
      const int hh = g * 2 + i2;
      for (int i = tid; i < 257; i += NTHR) tab[i] = p.lut[(4 + hh) * 257 + i];
      const int kstart = m0 - 64 < 0 ? 0 : m0 - 64, kend = m0 + 192 > L ? L : m0 + 192;
      a.qbase = b * SEQL + pp; a.qstride = r; a.qpos0 = m0;
      a.ktokbase = a.qbase + kstart * r; a.ktokstep = 64 * r; a.kstride = r; a.kposbase = kstart; a.kposstep = 64; a.ntiles = (kend - kstart) >> 6;
      a.qcol = 1280 + hh * 64; a.kcol = 1280 + 384 + hh * 64; a.vcol = 1280 + 768 + hh * 64; a.ocol = 512 + hh * 64;
      a.gq = p.qkn_c + l * 128; a.gk = a.gq + 64;
      a.qscale = 0.125f * LOG2E;
      a.hw = 64; a.rmul = r; a.lsecol = hh;
      attn_item<1, 1, 2>(p, a, Ks, Vts, tab);
    }
  }
}

__device__ __forceinline__ void combine_phase(const Params& p) {
  const int nthr = gridDim.x * NTHR;
  for (int i = blockIdx.x * NTHR + opaque_tid(); i < NTOK * 48; i += nthr) {
    const int tok = i / 48, rem = i % 48, hh = rem >> 3, ch = rem & 7, ii = hh & 1, g = hh >> 1;
    const float* ls = p.lse + (size_t)tok * 6;
    const float l0 = ls[ii], l1 = ls[2 + ii], l2 = ls[4 + ii];
    const float mx = fmaxf(l0, fmaxf(l1, l2));
    const float e0 = __expf(l0 - mx), e1 = __expf(l1 - mx), e2 = __expf(l2 - mx);
    const float al = (g == 0 ? e0 : (g == 1 ? e1 : e2)) / (e0 + e1 + e2);
    bf16_t* ptr = p.hbuf + blk_off(tok, 512 + hh * 64 + ch * 8, NTOK);
    u32x4 v = *(const u32x4*)ptr;
#pragma unroll
    for (int k = 0; k < 4; ++k) v[k] = pk_bf16(bf_lo(v[k]) * al, bf_hi(v[k]) * al);
    *(u32x4*)ptr = v;
  }
}


#ifndef REP_GEMM
#define REP_GEMM 1
#endif
#ifndef REP_ATTN
#define REP_ATTN 1
#endif
#ifndef DBG_STOP
#define DBG_STOP 0
#endif
__global__ void __launch_bounds__(NTHR, 2) fwd_megakernel(Params p) {
  extern __shared__ __attribute__((aligned(16))) char smem[];
  cg::grid_group grid = cg::this_grid();
  prologue_phase(p, smem);
  grid.sync();
  for (int l = 0; l < 4; ++l) {
    const bool first = (l == 0);
    const bf16_t* wt = p.wt + (size_t)l * WT_LAYER;
    norm_phase(p, l, first, p.norm_attn_g + l * DM, 0, 1024);
    grid.sync();
    for (int rep = 0; rep < REP_GEMM; ++rep) {
    gemm_phase<0>(p, l, false, p.hbuf, 3200, wt + WT_IN, 1024, 384, 13, 13, p.proj, PW, 0, smem);
    grid.sync();
    }
    for (int rep = 0; rep < REP_ATTN; ++rep) {
    attn_phase(p, l, smem);
    grid.sync();
    }
    combine_phase(p);
    grid.sync();
    gemm_phase<1>(p, l, first, p.hbuf, 1024, wt + WT_OUT, 1152, 384, 4, 4, nullptr, 0, 2048, smem);
    grid.sync();
    norm_phase(p, l, false, p.norm_ffn_g + l * DM, 3072, 4096);
    grid.sync();
    for (int rep = 0; rep < REP_GEMM; ++rep) {
    gemm_phase<2>(p, l, false, p.hbuf, 5632, wt + WT_UP, 1024, 408, 22, 22, p.proj, DFF, 0, smem);
    grid.sync();
    }
    gemm_phase<1>(p, l, false, p.proj, 1024, wt + WT_DOWN, 2816, 384, 4, 4, nullptr, 0, 5120, smem);
    grid.sync();
  }
}

extern "C" void kernel_launch(void* const* d_in, const int* in_sizes, int n_in, void* d_out, int out_size, void* d_ws, size_t ws_size,
                              hipStream_t stream) {
  static int grid_blocks = 0;
  if (!grid_blocks) {
    int dev = 0, cus = 0, per_cu = 0;
    hipGetDevice(&dev);
    hipDeviceGetAttribute(&cus, hipDeviceAttributeMultiprocessorCount, dev);
    hipFuncSetAttribute((const void*)fwd_megakernel, hipFuncAttributeMaxDynamicSharedMemorySize, SMEM_BYTES);
    hipOccupancyMaxActiveBlocksPerMultiprocessor(&per_cu, fwd_megakernel, NTHR, SMEM_BYTES);
    if (per_cu > 1) per_cu = 1;
    if (per_cu < 1) per_cu = 1;
    grid_blocks = cus * per_cu;
  }
  Params p{};
  const float* const* in = (const float* const*)d_in;
  p.x_prompt = in[0]; p.x_sample = in[1]; p.c_prompt = in[2]; p.c_sample = in[3]; p.norm_attn_g = in[4]; p.norm_ffn_g = in[5];
  p.w_ada = in[6]; p.b_ada = in[7]; p.w_in = in[8]; p.qkn_a = in[9]; p.qkn_b = in[10]; p.qkn_c = in[11]; p.qkn_d = in[12];
  p.rpb_a = in[13]; p.sink_b = in[14]; p.t5_table = in[15]; p.lam_d = in[16]; p.subln_d = in[17]; p.w_out = in[18]; p.w_up = in[19];
  p.conv_w = in[20]; p.conv_b = in[21]; p.w_down = in[22];
  p.out = (float*)d_out;
  char* ws = (char*)d_ws;
  size_t off = 0;
  p.wt = (bf16_t*)(ws + off); off += (size_t)4 * WT_LAYER * 2;
  p.mod = (float*)(ws + off); off += (size_t)4 * 48 * 6144 * 4;
  p.lut = (float*)(ws + off); off += 16384;
  p.lam = (float*)(ws + off); off += 256;
  p.zeros = (float*)(ws + off); off += 256;
  p.lse = (float*)(ws + off); off += (size_t)NTOK * 6 * 4;
  p.proj = (bf16_t*)(ws + off); off += (size_t)NTOK * PW * 2;
  p.hbuf = (bf16_t*)(ws + off); off += (size_t)NTOK * MW * 2;
  if (off > ws_size) { fprintf(stderr, "workspace too small: need %zu have %zu\n", off, ws_size); return; }
  void* args[] = {&p};
  hipError_t e = hipLaunchCooperativeKernel((void*)fwd_megakernel, dim3(grid_blocks), dim3(NTHR), args, SMEM_BYTES, stream);
  if (e != hipSuccess) fprintf(stderr, "cooperative launch failed: %s (grid %d)\n", hipGetErrorString(e), grid_blocks);
}
```

```cpp
#include <hip/hip_runtime.h>
#include <hip/hip_cooperative_groups.h>
#include <cstdint>
#include <cstdio>
namespace cg = cooperative_groups;

typedef unsigned short bf16_t;
typedef short bf16x8 __attribute__((ext_vector_type(8)));
typedef float f32x4 __attribute__((ext_vector_type(4)));
typedef unsigned u32x4 __attribute__((ext_vector_type(4)));
typedef unsigned u32x2 __attribute__((ext_vector_type(2)));

#define NTOK 98304
#define DM 1024
#define PW 3200
#define MW 1152
#define DFF 2816
#define NSEQ 48
#define SEQL 2048
#define LOG2E 1.4426950408889634f
#define LN2 0.6931471805599453f
#define LDSROW 72
#define NTHR 512
#define NWAVE 8

struct Params {
  const float *x_prompt, *x_sample, *c_prompt, *c_sample, *norm_attn_g, *norm_ffn_g, *w_ada, *b_ada, *w_in;
  const float *qkn_a, *qkn_b, *qkn_c, *qkn_d, *rpb_a, *sink_b, *t5_table, *lam_d, *subln_d, *w_out, *w_up, *conv_w, *conv_b, *w_down;
  float* out;
  bf16_t* wt; float* mod; float* lut; float* lam; float* lse; bf16_t* proj; bf16_t* hbuf; float* zeros;
};

#define WT_IN 0
#define WT_OUT (3200 * 1024)
#define WT_UP (WT_OUT + 1024 * 1152)
#define WT_DOWN (WT_UP + 5632 * 1024)
#define WT_LAYER (WT_DOWN + 1024 * 2816)

typedef __bf16 bf16x2_t __attribute__((ext_vector_type(2)));
typedef float f32x2_t __attribute__((ext_vector_type(2)));
__device__ __forceinline__ unsigned pk_bf16(float lo, float hi) {
  const f32x2_t v = {lo, hi};
  const bf16x2_t r = __builtin_convertvector(v, bf16x2_t);
  return __builtin_bit_cast(unsigned, r);
}
__device__ __forceinline__ float bf_lo(unsigned u) { return __uint_as_float(u << 16); }
__device__ __forceinline__ float bf_hi(unsigned u) { return __uint_as_float(u & 0xffff0000u); }
__device__ __forceinline__ float fexp2(float x) { return __builtin_amdgcn_exp2f(x); }

__device__ __forceinline__ const float* xin_row(const Params& p, bool first, int tok) {
  if (first) return tok < 65536 ? p.x_prompt + (size_t)tok * DM : p.x_sample + (size_t)(tok - 65536) * DM;
  return p.out + (size_t)tok * DM;
}

__device__ __forceinline__ int opaque_tid() { int t = threadIdx.x; asm volatile("" : "+v"(t)); return t; }

__device__ __forceinline__ size_t blk_off(int r, int k, int R) { return ((size_t)(k >> 5) * R + r) * 32 + (k & 31); }

__device__ __forceinline__ int t5_bucket(int rel) {
  const int n = rel < 0 ? -rel : rel;
  int v;
  if (n < 8) v = n;
  else v = 8 + (n >= 12) + (n >= 16) + (n >= 23) + (n >= 32) + (n >= 46) + (n >= 64) + (n >= 91);
  return (rel > 0 ? 16 : 0) + v;
}

__device__ __forceinline__ void prologue_phase(const Params& p, char* smem) {
  const int tid = opaque_tid(), nb = gridDim.x;
  const int N_TR = 4 * 3200, N_MOD = 192;
  for (int item = blockIdx.x; item < N_TR + N_MOD + 1; item += nb) {
    if (item < N_TR) {
      const int l = item / 3200; int r = item % 3200;
      const float* src; bf16_t* dst; int K, N, kt, nt;
      if (r < 800) { K = 1024; N = 3200; src = p.w_in + (size_t)l * K * N; dst = p.wt + (size_t)l * WT_LAYER + WT_IN; kt = r / 50; nt = r % 50; }
      else if (r < 1088) { r -= 800; K = 1152; N = 1024; src = p.w_out + (size_t)l * K * N; dst = p.wt + (size_t)l * WT_LAYER + WT_OUT; kt = r / 16; nt = r % 16; }
      else if (r < 2496) { r -= 1088; K = 1024; N = 5632; src = p.w_up + (size_t)l * K * N; dst = p.wt + (size_t)l * WT_LAYER + WT_UP; kt = r / 88; nt = r % 88; }
      else { r -= 2496; K = 2816; N = 1024; src = p.w_down + (size_t)l * K * N; dst = p.wt + (size_t)l * WT_LAYER + WT_DOWN; kt = r / 16; nt = r % 16; }
      float* tile = (float*)smem;
      const int k0 = kt * 64, n0 = nt * 64;
      __syncthreads();
#pragma unroll
      for (int i = 0; i < 8; ++i) {
        const int rr = (tid >> 6) + 8 * i, cc = tid & 63;
        tile[rr * 65 + cc] = src[(size_t)(k0 + rr) * N + n0 + cc];
      }
      __syncthreads();
#pragma unroll
      for (int i = 0; i < 4; ++i) {
        const int idx = tid + NTHR * i, n = idx >> 5, k2 = (idx & 31) * 2;
        *(unsigned*)(dst + blk_off(n0 + n, k0 + k2, N)) = pk_bf16(tile[k2 * 65 + n], tile[(k2 + 1) * 65 + n]);
      }
    } else if (item < N_TR + N_MOD) {
      int r = item - N_TR;
      const int l = r / 48; r %= 48;
      const int nc = r / 4, bg = r % 4;
      const int n = nc * NTHR + tid;
      float* sc = (float*)smem;
      float acc[12];
#pragma unroll
      for (int j = 0; j < 12; ++j) acc[j] = 0.f;
      const float* W = p.w_ada + (size_t)l * 1024 * 6144 + n;
      for (int kc = 0; kc < 2; ++kc) {
        __syncthreads();
        for (int i = tid; i < 12 * 512; i += NTHR) {
          const int j = i >> 9, k = i & 511, b = bg * 12 + j;
          const float c = b < 32 ? p.c_prompt[b * 1024 + kc * 512 + k] : p.c_sample[(b - 32) * 1024 + kc * 512 + k];
          sc[i] = c / (1.f + __expf(-c));
        }
        __syncthreads();
#pragma unroll 2
        for (int k = 0; k < 512; k += 4) {
          const float w0 = W[(size_t)(kc * 512 + k) * 6144], w1 = W[(size_t)(kc * 512 + k + 1) * 6144];
          const float w2 = W[(size_t)(kc * 512 + k + 2) * 6144], w3 = W[(size_t)(kc * 512 + k + 3) * 6144];
#pragma unroll
          for (int j = 0; j < 12; ++j) {
            const f32x4 s = *(const f32x4*)(sc + j * 512 + k);
            acc[j] += s[0] * w0 + s[1] * w1 + s[2] * w2 + s[3] * w3;
          }
        }
      }
      const float bias = p.b_ada[l * 6144 + n];
#pragma unroll
      for (int j = 0; j < 12; ++j) p.mod[((size_t)l * 48 + bg * 12 + j) * 6144 + n] = acc[j] + bias;
    } else {
      for (int i = tid; i < 14 * 257; i += NTHR) {
        const int hd = i / 257, idx = i % 257;
        p.lut[i] = p.t5_table[t5_bucket(idx - 128) * 14 + hd] * LOG2E;
      }
      if (tid < 64) p.zeros[tid] = 0.f;
      if (tid < 4) {
        const float* lp = p.lam_d + tid * 128;
        float s1 = 0.f, s2 = 0.f;
        for (int e = 0; e < 32; ++e) { s1 += lp[e] * lp[32 + e]; s2 += lp[64 + e] * lp[96 + e]; }
        const float li = 0.8f - 0.6f * expf(-0.3f * (float)tid);
        p.lam[tid] = expf(s1) - expf(s2) + li;
      }
    }
  }
}

__device__ __forceinline__ void norm_phase(const Params& p, int l, bool first, const float* g, int shift_off, int scale_off) {
  const int tid0 = opaque_tid();
  const int lane = tid0 & 63, w = tid0 >> 6;
  const int stride = gridDim.x * NWAVE;
  for (int row0 = blockIdx.x * NWAVE + w; row0 < NTOK; row0 += 2 * stride) {
    const int row1 = row0 + stride;
    const bool has1 = row1 < NTOK;
    const int rows[2] = {row0, has1 ? row1 : row0};
    f32x4 v[2][4];
    float ss[2] = {0.f, 0.f};
#pragma unroll
    for (int r = 0; r < 2; ++r) {
      const float* xr = xin_row(p, first, rows[r]);
#pragma unroll
      for (int i = 0; i < 4; ++i) v[r][i] = *(const f32x4*)(xr + i * 256 + lane * 4);
    }
#pragma unroll
    for (int r = 0; r < 2; ++r) {
#pragma unroll
      for (int i = 0; i < 4; ++i) ss[r] += v[r][i][0] * v[r][i][0] + v[r][i][1] * v[r][i][1] + v[r][i][2] * v[r][i][2] + v[r][i][3] * v[r][i][3];
#pragma unroll
      for (int o = 32; o >= 1; o >>= 1) ss[r] += __shfl_xor(ss[r], o);
    }
#pragma unroll
    for (int r = 0; r < 2; ++r) {
      if (r == 1 && !has1) break;
      const int row = rows[r];
      const float* md = p.mod + ((size_t)l * 48 + (row >> 11)) * 6144;
      const float rstd = rsqrtf(ss[r] * (1.f / 1024.f) + 1e-6f);
#pragma unroll
      for (int i = 0; i < 4; ++i) {
        const int k = i * 256 + lane * 4;
        const f32x4 gg = *(const f32x4*)(g + k), sc = *(const f32x4*)(md + scale_off + k), sh = *(const f32x4*)(md + shift_off + k);
        f32x4 y;
#pragma unroll
        for (int j = 0; j < 4; ++j) y[j] = (v[r][i][j] * rstd) * gg[j] * (1.f + sc[j]) + sh[j];
        u32x2 o; o[0] = pk_bf16(y[0], y[1]); o[1] = pk_bf16(y[2], y[3]);
        *(u32x2*)(p.hbuf + blk_off(row, k, NTOK)) = o;
      }
    }
  }
}

__device__ __forceinline__ bool gemm_tile_id(int it, int MT, int NT, int NB, int& mt, int& nt) {
  const int nb = gridDim.x, bid = blockIdx.x;
  if ((nb & 7) == 0) {
    const int x = bid & 7, slot = bid >> 3, S = nb >> 3;
    const int TPS = 8 * NB, NSN = NT / NB, NS = (MT / 8) * NSN;
    const int pidx = slot + S * it, sidx = pidx / TPS, w = pidx % TPS, s = x + 8 * sidx;
    if (s >= NS) return false;
    mt = (s / NSN) * 8 + (w & 7); nt = (s % NSN) * NB + (w >> 3);
    return true;
  }
  const int t = bid + nb * it;
  if (t >= MT * NT) return false;
  mt = t / NT; nt = t % NT;
  return true;
}

template <int M, int NN>
__device__ __forceinline__ void up_epi_row(const f32x4 (&acc)[8][4], const float* cw, const float* cb, int cbase, int lane, int fr, int s0, bf16_t* obase) {
  constexpr int MP = M > 0 ? M - 1 : 0, MN = M < 7 ? M + 1 : 7;
  const int srcp = (lane & 48) | ((fr + 15) & 15), srcn = (lane & 48) | ((fr + 1) & 15);
  float y[2][4];
#pragma unroll
  for (int n = 0; n < 2; ++n) {
    const int c = n * DFF + cbase;
    const f32x4 w0 = *(const f32x4*)(cw + c), w1 = *(const f32x4*)(cw + 5632 + c), w2 = *(const f32x4*)(cw + 2 * 5632 + c), bb = *(const f32x4*)(cb + c);
#pragma unroll
    for (int j = 0; j < 4; ++j) {
      const float cur = acc[M][NN + 2 * n][j];
      const float zp = (fr == 15) ? acc[MP][NN + 2 * n][j] : cur, zn = (fr == 0) ? acc[MN][NN + 2 * n][j] : cur;
      const float pv = __shfl(zp, srcp), nv = __shfl(zn, srcn);
      y[n][j] = w0[j] * pv + w1[j] * cur + w2[j] * nv + bb[j];
    }
  }
  const int row = 16 * M + fr, tpos = s0 + row;
  if (row >= 1 && row <= 126 && tpos >= 0 && tpos < SEQL) {
    float a[4];
#pragma unroll
    for (int j = 0; j < 4; ++j) { const float gte = y[1][j]; a[j] = y[0][j] * gte / (1.f + __expf(-gte)); }
    u32x2 o; o[0] = pk_bf16(a[0], a[1]); o[1] = pk_bf16(a[2], a[3]);
    *(u32x2*)(obase + (size_t)tpos * 32) = o;
  }
  __builtin_amdgcn_sched_barrier(0);
}

#define GB_A 16384
#define GB_BUF 32768
#define NSTAGE 4
#define SMEM_BYTES (NSTAGE * GB_BUF)
template <int EPI>
__device__ __forceinline__ void gemm_phase(const Params& p, int l, bool first, const bf16_t* A, int NBROWS, const bf16_t* Bt, int K, int MT, int NT, int NB,
                           bf16_t* outb, int ldc, int gate_off, char* smem) {
  const int tid = opaque_tid(), lane = tid & 63, w = tid >> 6, wr = w >> 2, wcn = w & 3, fr = lane & 15, fq = lane >> 4;
  const int nk = K / 32;
  const int lrow = tid >> 2, lch = (tid & 3) ^ ((tid >> 4) & 3);
  const int fsw = (fq ^ ((fr >> 2) & 3)) * 16;
  const size_t apan = (size_t)NTOK * 32, bpan = (size_t)NBROWS * 32;
  const bf16_t* ga0; const bf16_t* ga1; const bf16_t* gb0;
  size_t bstr;
#define GEMM_PTRS(MT_, NT_)                                                                                                          \
  {                                                                                                                                  \
    int t_ = tid; asm volatile("" : "+v"(t_));                                                                                       \
    const int lrow_ = t_ >> 2, lch_ = (t_ & 3) ^ ((t_ >> 4) & 3);                                                                    \
    if (EPI == 2) {                                                                                                                  \
      const int wi0 = 2 * (MT_), wi1 = wi0 + 1;                                                                                      \
      const int t0 = 126 * (wi0 % 17) - 1 + lrow_, t1 = 126 * (wi1 % 17) - 1 + lrow_;                                                \
      ga0 = A + ((size_t)(wi0 / 17) * SEQL + t0) * 32 + lch_ * 8;                                                                    \
      ga1 = A + ((size_t)(wi1 / 17) * SEQL + t1) * 32 + lch_ * 8;                                                                    \
      gb0 = Bt + (size_t)((NT_) * 128 + lrow_) * 32 + lch_ * 8; bstr = (size_t)DFF * 32;                                             \
    } else {                                                                                                                         \
      ga0 = A + (size_t)((MT_) * 256 + lrow_) * 32 + lch_ * 8; ga1 = ga0 + (size_t)128 * 32;                                         \
      gb0 = Bt + (size_t)((NT_) * 256 + lrow_) * 32 + lch_ * 8; bstr = (size_t)128 * 32;                                             \
    }                                                                                                                                \
  }
#define GEMM_ISSUE(KT, STAGE)                                                                                                        \
    {                                                                                                                                \
      char* dst_ = smem + (STAGE) * GB_BUF + tid * 16;                                                                               \
      const size_t ko_ = (size_t)(KT) * apan, kb_ = (size_t)(KT) * bpan;                                                             \
      __builtin_amdgcn_global_load_lds((const unsigned*)(ga0 + ko_), (unsigned*)(dst_), 16, 0, 0);                                   \
      __builtin_amdgcn_global_load_lds((const unsigned*)(ga1 + ko_), (unsigned*)(dst_ + 8192), 16, 0, 0);                            \
      __builtin_amdgcn_global_load_lds((const unsigned*)(gb0 + kb_), (unsigned*)(dst_ + GB_A), 16, 0, 0);                            \
      __builtin_amdgcn_global_load_lds((const unsigned*)(gb0 + bstr + kb_), (unsigned*)(dst_ + GB_A + 8192), 16, 0, 0);              \
    }
  int mt, nt;
  bool have = gemm_tile_id(0, MT, NT, NB, mt, nt);
  if (have) {
    GEMM_PTRS(mt, nt)
    GEMM_ISSUE(0, 0)
    GEMM_ISSUE(1, 1)
    GEMM_ISSUE(2, 2)
  }
  for (int it = 0; have; ++it) {
    GEMM_PTRS(mt, nt)
    f32x4 acc[8][4];
#pragma unroll
    for (int m = 0; m < 8; ++m)
#pragma unroll
      for (int n = 0; n < 4; ++n) acc[m][n] = (f32x4){0.f, 0.f, 0.f, 0.f};
    int scur = 0, snxt = 3;
    for (int kt = 0; kt < nk; ++kt) {
      if (kt + 2 < nk) asm volatile("s_waitcnt vmcnt(8)" ::: "memory");
      else if (kt + 1 < nk) asm volatile("s_waitcnt vmcnt(4)" ::: "memory");
      else asm volatile("s_waitcnt vmcnt(0)" ::: "memory");
      asm volatile("s_waitcnt lgkmcnt(0)" ::: "memory");
      __builtin_amdgcn_s_barrier();
      if (kt + 3 < nk) GEMM_ISSUE(kt + 3, snxt)
      const char* Ab = smem + scur * GB_BUF;
      scur = (scur == NSTAGE - 1) ? 0 : scur + 1; snxt = (snxt == NSTAGE - 1) ? 0 : snxt + 1;
      const char* Bb = Ab + GB_A;
      bf16x8 bfr[4];
#pragma unroll
      for (int n = 0; n < 4; ++n) {
        const int br = (EPI == 2) ? ((n >> 1) * 128 + 32 * wcn + 16 * (n & 1) + fr) : (64 * wcn + 16 * n + fr);
        bfr[n] = *(const bf16x8*)(Bb + br * 64 + fsw);
      }
      const char* Ap = Ab + (wr * 128 + fr) * 64 + fsw;
      bf16x8 af0 = *(const bf16x8*)(Ap), af1 = *(const bf16x8*)(Ap + 16 * 64);
#pragma unroll
      for (int pr = 0; pr < 4; ++pr) {
        bf16x8 an0 = af0, an1 = af1;
        if (pr < 3) { an0 = *(const bf16x8*)(Ap + (2 * pr + 2) * 16 * 64); an1 = *(const bf16x8*)(Ap + (2 * pr + 3) * 16 * 64); }
        __builtin_amdgcn_sched_barrier(0);
#pragma unroll
        for (int n = 0; n < 4; ++n) acc[2 * pr][n] = __builtin_amdgcn_mfma_f32_16x16x32_bf16(bfr[n], af0, acc[2 * pr][n], 0, 0, 0);
#pragma unroll
        for (int n = 0; n < 4; ++n) acc[2 * pr + 1][n] = __builtin_amdgcn_mfma_f32_16x16x32_bf16(bfr[n], af1, acc[2 * pr + 1][n], 0, 0, 0);
        __builtin_amdgcn_sched_barrier(0);
        af0 = an0; af1 = an1;
      }
    }
    const int mt_e = mt, nt_e = nt;
    have = gemm_tile_id(it + 1, MT, NT, NB, mt, nt);
    if (have) {
      GEMM_PTRS(mt, nt)
      GEMM_ISSUE(0, 0)
      GEMM_ISSUE(1, 1)
      GEMM_ISSUE(2, 2)
    }
    int lane_e = lane; asm volatile("" : "+v"(lane_e));
    const int fr_e = lane_e & 15, fq_e = lane_e >> 4;
    if (EPI == 0) {
      if (nt_e * 256 + 64 * wcn < NBROWS) {
#pragma unroll
        for (int m = 0; m < 8; ++m) {
          const int tok = mt_e * 256 + wr * 128 + 16 * m + fr_e;
#pragma unroll
          for (int n = 0; n < 4; ++n) {
            const int col = nt_e * 256 + 64 * wcn + 16 * n + 4 * fq_e;
            u32x2 o; o[0] = pk_bf16(acc[m][n][0], acc[m][n][1]); o[1] = pk_bf16(acc[m][n][2], acc[m][n][3]);
            *(u32x2*)(outb + (size_t)tok * ldc + col) = o;
          }
        }
      }
    } else if (EPI == 1) {
      const int b = (mt_e * 256) >> 11;
      const float* gate = p.mod + ((size_t)l * 48 + b) * 6144 + gate_off;
#pragma unroll
      for (int n = 0; n < 4; ++n) {
        const int col = nt_e * 256 + 64 * wcn + 16 * n + 4 * fq_e;
        const f32x4 gv = *(const f32x4*)(gate + col);
#pragma unroll
        for (int m = 0; m < 8; ++m) {
          const int tok = mt_e * 256 + wr * 128 + 16 * m + fr_e;
          const f32x4 xv = *(const f32x4*)(xin_row(p, first, tok) + col);
          f32x4 o;
#pragma unroll
          for (int j = 0; j < 4; ++j) o[j] = xv[j] + gv[j] * acc[m][n][j];
          *(f32x4*)(p.out + (size_t)tok * DM + col) = o;
        }
      }
    } else {
      const float* cw = p.conv_w + (size_t)l * 3 * 5632;
      const float* cb = p.conv_b + (size_t)l * 5632;
      const int wi = 2 * mt_e + wr, seq = wi / 17, s0 = 126 * (wi % 17) - 1;
      if (s0 < 0 || s0 + 127 >= SEQL) {
#pragma unroll
        for (int m = 0; m < 8; ++m) {
          const int tp = s0 + 16 * m + fr_e;
          if (tp < 0 || tp >= SEQL) {
#pragma unroll
            for (int n = 0; n < 4; ++n) acc[m][n] = (f32x4){0.f, 0.f, 0.f, 0.f};
          }
        }
      }
#define UP_EPI_NN(NN)                                                                                                      \
      {                                                                                                                    \
        const int cbase = nt_e * 128 + 32 * wcn + 16 * NN + 4 * fq_e;                                                        \
        bf16_t* obase = outb + blk_off(seq * SEQL, cbase, NTOK);                                                           \
        up_epi_row<0, NN>(acc, cw, cb, cbase, lane_e, fr_e, s0, obase); up_epi_row<1, NN>(acc, cw, cb, cbase, lane_e, fr_e, s0, obase); \
        up_epi_row<2, NN>(acc, cw, cb, cbase, lane_e, fr_e, s0, obase); up_epi_row<3, NN>(acc, cw, cb, cbase, lane_e, fr_e, s0, obase); \
        up_epi_row<4, NN>(acc, cw, cb, cbase, lane_e, fr_e, s0, obase); up_epi_row<5, NN>(acc, cw, cb, cbase, lane_e, fr_e, s0, obase); \
        up_epi_row<6, NN>(acc, cw, cb, cbase, lane_e, fr_e, s0, obase); up_epi_row<7, NN>(acc, cw, cb, cbase, lane_e, fr_e, s0, obase); \
      }
      UP_EPI_NN(0)
      UP_EPI_NN(1)
#undef UP_EPI_NN
    }
    asm volatile("s_waitcnt vmcnt(0)" ::: "memory");
  }
#undef GEMM_ISSUE
#undef GEMM_PTRS
}

struct AttnArgs {
  int qbase, qstride, qpos0;
  int ktokbase, ktokstep, kstride, kposbase, kposstep, ntiles;
  int qcol, kcol, vcol, ocol;
  const float *gq, *gk;
  float qscale;
  int hw, rmul, taboff0;
  float sinkv;
  float lam, outscale;
  const float* subg;
  int lsecol;
  int r0, rs0;
};

template <int NQ, int NC, int MODE>
__device__ __forceinline__ void attn_item(const Params& p, const AttnArgs& a, bf16_t* Ks, bf16_t* Vts, const float* tab) {
  const int tid = opaque_tid(), lane = tid & 63, w = tid >> 6, fr = lane & 15, fq = lane >> 4;
  const int wq0 = a.qpos0 + w * 16 * NQ;
  bf16x8 qf[NQ][2];
  int qpos[NQ];
#pragma unroll
  for (int qt = 0; qt < NQ; ++qt) {
    const int qp = wq0 + qt * 16 + fr;
    qpos[qt] = qp;
    const bf16_t* qrow = p.proj + (size_t)(a.qbase + qp * a.qstride) * PW + a.qcol;
    const u32x4 v0 = *(const u32x4*)(qrow + fq * 8), v1 = *(const u32x4*)(qrow + 32 + fq * 8);
    float f0[8], f1[8];
#pragma unroll
    for (int i = 0; i < 4; ++i) { f0[2 * i] = bf_lo(v0[i]); f0[2 * i + 1] = bf_hi(v0[i]); f1[2 * i] = bf_lo(v1[i]); f1[2 * i + 1] = bf_hi(v1[i]); }
    float s0 = 0.f, s1 = 0.f;
#pragma unroll
    for (int i = 0; i < 8; ++i) { s0 += f0[i] * f0[i]; s1 += f1[i] * f1[i]; }
    float r0, r1;
    if (NC == 1) {
      float s = s0 + s1; s += __shfl_xor(s, 16); s += __shfl_xor(s, 32);
      r0 = r1 = rsqrtf(s * (1.f / 64.f) + 1e-6f) * a.qscale;
    } else {
      s0 += __shfl_xor(s0, 16); s0 += __shfl_xor(s0, 32);
      s1 += __shfl_xor(s1, 16); s1 += __shfl_xor(s1, 32);
      r0 = rsqrtf(s0 * (1.f / 32.f) + 1e-6f) * a.qscale; r1 = rsqrtf(s1 * (1.f / 32.f) + 1e-6f) * a.qscale;
    }
    const float* g0p = a.gq + fq * 8;
    const float* g1p = (NC == 1) ? a.gq + 32 + fq * 8 : g0p;
    u32x4 q0, q1;
#pragma unroll
    for (int i = 0; i < 4; ++i) {
      q0[i] = pk_bf16(f0[2 * i] * r0 * g0p[2 * i], f0[2 * i + 1] * r0 * g0p[2 * i + 1]);
      q1[i] = pk_bf16(f1[2 * i] * r1 * g1p[2 * i], f1[2 * i + 1] * r1 * g1p[2 * i + 1]);
    }
    qf[qt][0] = __builtin_bit_cast(bf16x8, q0);
    qf[qt][1] = __builtin_bit_cast(bf16x8, q1);
  }
  f32x4 o[NC][NQ][4];
  float mrun[NC][NQ], lrun[NC][NQ];
#pragma unroll
  for (int c = 0; c < NC; ++c)
#pragma unroll
    for (int qt = 0; qt < NQ; ++qt) {
      if (MODE == 1) { mrun[c][qt] = a.sinkv; lrun[c][qt] = (fq == 0) ? 1.f : 0.f; }
      else { mrun[c][qt] = -1e30f; lrun[c][qt] = 0.f; }
#pragma unroll
      for (int dt = 0; dt < 4; ++dt) o[c][qt][dt] = (f32x4){0.f, 0.f, 0.f, 0.f};
    }
  const int lch = tid & 7;
  float gkv[8];
#pragma unroll
  for (int i = 0; i < 8; ++i) gkv[i] = a.gk[((NC == 1) ? lch : (lch & 3)) * 8 + i];

  const int rw = a.r0 + ((w * 16 * NQ) >> 6);
  int rsw = rw - 4; rsw = rsw < 0 ? 0 : (rsw > 24 ? 24 : rsw);
  u32x4 kA, vA, kB, vB;
  const int kkey = tid >> 3, vkey = tid & 63, vch = tid >> 6;
#define ATTN_PREFETCH(T, KR, VR)                                                                                 \
  {                                                                                                              \
    const int ktok0_ = a.ktokbase + (T) * a.ktokstep;                                                            \
    KR = *(const u32x4*)(p.proj + (size_t)(ktok0_ + kkey * a.kstride) * PW + a.kcol + lch * 8);                   \
    VR = *(const u32x4*)(p.proj + (size_t)(ktok0_ + vkey * a.kstride) * PW + a.vcol + vch * 8);                   \
  }
  auto stage_write = [&](const u32x4& kr, const u32x4& vr, bf16_t* Ksb, bf16_t* Vtb) __attribute__((always_inline)) {
    float f[8];
#pragma unroll
    for (int i = 0; i < 4; ++i) { f[2 * i] = bf_lo(kr[i]); f[2 * i + 1] = bf_hi(kr[i]); }
    float s = 0.f;
#pragma unroll
    for (int i = 0; i < 8; ++i) s += f[i] * f[i];
    s += __shfl_xor(s, 1); s += __shfl_xor(s, 2);
    float rs;
    if (NC == 1) { s += __shfl_xor(s, 4); rs = rsqrtf(s * (1.f / 64.f) + 1e-6f); }
    else rs = rsqrtf(s * (1.f / 32.f) + 1e-6f);
    u32x4 kq;
#pragma unroll
    for (int i = 0; i < 4; ++i) kq[i] = pk_bf16(f[2 * i] * rs * gkv[2 * i], f[2 * i + 1] * rs * gkv[2 * i + 1]);
    *(u32x4*)(Ksb + kkey * LDSROW + lch * 8) = kq;
#pragma unroll
    for (int i = 0; i < 4; ++i) {
      Vtb[(vch * 8 + 2 * i) * LDSROW + vkey] = (bf16_t)(vr[i] & 0xffffu);
      Vtb[(vch * 8 + 2 * i + 1) * LDSROW + vkey] = (bf16_t)(vr[i] >> 16);
    }
  };
  auto tile_math = [&](int t, const bf16_t* Ksb, const bf16_t* Vtb) __attribute__((always_inline)) {
    if (MODE == 0) { const int kr_ = a.rs0 + t; if (kr_ < rsw || kr_ >= rsw + 8) return; }
    const int kp0 = a.kposbase + t * a.kposstep;
    const int taboff = (a.rs0 + t - rw + 7) * 31;
    bf16x8 pf[NC][NQ][2];
    bf16x8 kf[4][2];
#pragma unroll
    for (int kt = 0; kt < 4; ++kt) {
      kf[kt][0] = *(const bf16x8*)(Ksb + (kt * 16 + fr) * LDSROW + fq * 8);
      kf[kt][1] = *(const bf16x8*)(Ksb + (kt * 16 + fr) * LDSROW + 32 + fq * 8);
    }
    bf16x8 vfr[4][2];
#pragma unroll
    for (int ks = 0; ks < 2; ++ks)
#pragma unroll
      for (int dt = 0; dt < 4; ++dt) {
        const u32x2 lo = *(const u32x2*)(Vtb + (dt * 16 + fr) * LDSROW + ks * 32 + 4 * fq);
        const u32x2 hi = *(const u32x2*)(Vtb + (dt * 16 + fr) * LDSROW + ks * 32 + 16 + 4 * fq);
        u32x4 vv; vv[0] = lo[0]; vv[1] = lo[1]; vv[2] = hi[0]; vv[3] = hi[1];
        vfr[dt][ks] = __builtin_bit_cast(bf16x8, vv);
      }
#pragma unroll
    for (int qt = 0; qt < NQ; ++qt) {
      const int qp = (MODE == 0) ? (qpos[qt] & 63) : qpos[qt];
      int cs = qp - 8; cs = cs < 0 ? 0 : (cs > 48 ? 48 : cs);
      f32x4 bv[4];
      const bool far_hi = (MODE == 3) && (kp0 - (wq0 + 16 * NQ - 1) >= 128), far_lo = (MODE == 3) && (wq0 - (kp0 + 63) >= 128);
      if (far_hi || far_lo) {
        const float bu = tab[far_hi ? 256 : 0];
#pragma unroll
        for (int kt = 0; kt < 4; ++kt) bv[kt] = (f32x4){bu, bu, bu, bu};
      } else
#pragma unroll
      for (int kt = 0; kt < 4; ++kt)
#pragma unroll
        for (int j = 0; j < 4; ++j) {
          const int kpos = kp0 + kt * 16 + 4 * fq + j;
          const int d = kpos - qp;
          bool valid; int idx;
          if (MODE == 0) {
            valid = kpos >= cs && kpos < cs + 16;
            int dd = d + 15; dd = dd < 0 ? 0 : (dd > 30 ? 30 : dd);
            idx = taboff + dd;
          } else {
            valid = (MODE == 3) ? true : (d <= a.hw && d >= -a.hw);
            int dd = d * a.rmul; dd = dd < -128 ? -128 : (dd > 128 ? 128 : dd);
            idx = dd + 128;
          }
          const float bias = tab[idx];
          bv[kt][j] = valid ? bias : -INFINITY;
        }
#pragma unroll
      for (int c = 0; c < NC; ++c) {
        f32x4 s[4];
#pragma unroll
        for (int kt = 0; kt < 4; ++kt) {
          if (NC == 1) {
            const f32x4 r = __builtin_amdgcn_mfma_f32_16x16x32_bf16(kf[kt][0], qf[qt][0], bv[kt], 0, 0, 0);
            s[kt] = __builtin_amdgcn_mfma_f32_16x16x32_bf16(kf[kt][1], qf[qt][1], r, 0, 0, 0);
          } else {
            s[kt] = __builtin_amdgcn_mfma_f32_16x16x32_bf16(kf[kt][c], qf[qt][c], bv[kt], 0, 0, 0);
          }
        }
        float mx = -INFINITY;
#pragma unroll
        for (int kt = 0; kt < 4; ++kt)
#pragma unroll
          for (int j = 0; j < 4; ++j) mx = fmaxf(mx, s[kt][j]);
        mx = fmaxf(mx, __shfl_xor(mx, 16)); mx = fmaxf(mx, __shfl_xor(mx, 32));
        const float mn = fmaxf(mrun[c][qt], mx);
        const float al = fexp2(mrun[c][qt] - mn);
        mrun[c][qt] = mn;
        float rs = 0.f;
#pragma unroll
        for (int kt = 0; kt < 4; ++kt)
#pragma unroll
          for (int j = 0; j < 4; ++j) { const float pv = fexp2(s[kt][j] - mn); s[kt][j] = pv; rs += pv; }
        lrun[c][qt] = lrun[c][qt] * al + rs;
        if (__any(al != 1.f)) {
#pragma unroll
          for (int dt = 0; dt < 4; ++dt) o[c][qt][dt] *= al;
        }
#pragma unroll
        for (int ks = 0; ks < 2; ++ks) {
          u32x4 pk;
          pk[0] = pk_bf16(s[2 * ks][0], s[2 * ks][1]); pk[1] = pk_bf16(s[2 * ks][2], s[2 * ks][3]);
          pk[2] = pk_bf16(s[2 * ks + 1][0], s[2 * ks + 1][1]); pk[3] = pk_bf16(s[2 * ks + 1][2], s[2 * ks + 1][3]);
          pf[c][qt][ks] = __builtin_bit_cast(bf16x8, pk);
        }
      }
    }
#pragma unroll
    for (int ks = 0; ks < 2; ++ks) {
#pragma unroll
      for (int dt = 0; dt < 4; ++dt) {
        const bf16x8 vf = vfr[dt][ks];
#pragma unroll
        for (int c = 0; c < NC; ++c)
#pragma unroll
          for (int qt = 0; qt < NQ; ++qt) o[c][qt][dt] = __builtin_amdgcn_mfma_f32_16x16x32_bf16(vf, pf[c][qt][ks], o[c][qt][dt], 0, 0, 0);
      }
    }
    };
  bf16_t* const Ks1 = Ks + 2 * 64 * LDSROW;
  bf16_t* const Vts1 = Vts + 2 * 64 * LDSROW;
  const int ntl = a.ntiles;
  ATTN_PREFETCH(0, kA, vA)
  if (ntl > 1) ATTN_PREFETCH(1, kB, vB)
  stage_write(kA, vA, Ks, Vts);
  if (ntl > 2) ATTN_PREFETCH(2, kA, vA)
  for (int t = 0; t < ntl; t += 2) {
    __syncthreads();
    if (t + 1 < ntl) { stage_write(kB, vB, Ks1, Vts1); if (t + 3 < ntl) ATTN_PREFETCH(t + 3, kB, vB) }
    tile_math(t, Ks, Vts);
    if (t + 1 < ntl) {
      __syncthreads();
      if (t + 2 < ntl) { stage_write(kA, vA, Ks, Vts); if (t + 4 < ntl) ATTN_PREFETCH(t + 4, kA, vA) }
      tile_math(t + 1, Ks1, Vts1);
    }
  }
#undef ATTN_PREFETCH
#pragma unroll
  for (int qt = 0; qt < NQ; ++qt) {
    float inv[NC], ltot[NC];
#pragma unroll
    for (int c = 0; c < NC; ++c) {
      float lt = lrun[c][qt];
      lt += __shfl_xor(lt, 16); lt += __shfl_xor(lt, 32);
      ltot[c] = lt; inv[c] = 1.f / lt;
    }
    const int tok = a.qbase + qpos[qt] * a.qstride;
    if (MODE == 3) {
      f32x4 v[4];
      float ss = 0.f;
#pragma unroll
      for (int dt = 0; dt < 4; ++dt)
#pragma unroll
        for (int j = 0; j < 4; ++j) {
          const float x = o[0][qt][dt][j] * inv[0] - a.lam * (o[NC - 1][qt][dt][j] * inv[NC - 1]);
          v[dt][j] = x; ss += x * x;
        }
      ss += __shfl_xor(ss, 16); ss += __shfl_xor(ss, 32);
      const float rstd = rsqrtf(ss * (1.f / 64.f) + 1e-6f) * a.outscale;
#pragma unroll
      for (int dt = 0; dt < 4; ++dt) {
        const f32x4 g = *(const f32x4*)(a.subg + dt * 16 + 4 * fq);
        u32x2 ov; ov[0] = pk_bf16(v[dt][0] * rstd * g[0], v[dt][1] * rstd * g[1]); ov[1] = pk_bf16(v[dt][2] * rstd * g[2], v[dt][3] * rstd * g[3]);
        *(u32x2*)(p.hbuf + blk_off(tok, a.ocol + dt * 16 + 4 * fq, NTOK)) = ov;
      }
    } else {
#pragma unroll
      for (int dt = 0; dt < 4; ++dt) {
        u32x2 ov;
        ov[0] = pk_bf16(o[0][qt][dt][0] * inv[0], o[0][qt][dt][1] * inv[0]);
        ov[1] = pk_bf16(o[0][qt][dt][2] * inv[0], o[0][qt][dt][3] * inv[0]);
        *(u32x2*)(p.hbuf + blk_off(tok, a.ocol + dt * 16 + 4 * fq, NTOK)) = ov;
      }
      if (MODE == 2 && fq == 0) p.lse[(size_t)tok * 6 + a.lsecol] = (mrun[0][qt] + __log2f(ltot[0])) * LN2;
    }
  }
}

__device__ __forceinline__ void attn_phase(const Params& p, int l, char* smem) {
  bf16_t* Ks = (bf16_t*)smem;
  bf16_t* Vts = Ks + 64 * LDSROW;
  float* tab = (float*)(Ks + 4 * 64 * LDSROW);
  const int tid = opaque_tid();
  const int nD = 3072, nA = 3072, nB = 3072, nC = 4608;
  for (int item = blockIdx.x; item < nD + nA + nB + nC; item += gridDim.x) {
    AttnArgs a;
    a.taboff0 = 0; a.r0 = 0; a.rs0 = 0; a.sinkv = 0.f; a.lam = 0.f; a.outscale = 1.f; a.subg = nullptr; a.lsecol = 0; a.hw = 1 << 20; a.rmul = 1;
    __syncthreads();
    if (item < nD) {
      const int b = item >> 6, h = (item >> 4) & 3, qb = item & 15;
      for (int i = tid; i < 257; i += NTHR) tab[i] = p.lut[(10 + h) * 257 + i];
      a.qbase = b * SEQL; a.qstride = 1; a.qpos0 = qb * 128;
      a.ktokbase = b * SEQL; a.ktokstep = 64; a.kstride = 1; a.kposbase = 0; a.kposstep = 64; a.ntiles = 32;
      a.qcol = 2432 + h * 64; a.kcol = 2432 + 256 + h * 64; a.vcol = 2432 + 512 + h * 64; a.ocol = 896 + h * 64;
      a.gq = p.qkn_d + l * 64; a.gk = a.gq + 32;
      a.qscale = 0.17677669529663687f * LOG2E;
      a.lam = p.lam[l]; a.outscale = 1.f - (0.8f - 0.6f * expf(-0.3f * (float)l)); a.subg = p.subln_d + l * 64;
      attn_item<1, 2, 3>(p, a, Ks, Vts, tab);
    } else if (item < nD + nA) {
      const int id = item - nD;
      const int b = id >> 6, h = (id >> 4) & 3, r = (id & 15) * 2;
      const float* rp = p.rpb_a + ((size_t)l * 4 + h) * 465;
      for (int i = tid; i < 465; i += NTHR) tab[i] = rp[i] * LOG2E;
      int rs = r - 4; rs = rs < 0 ? 0 : (rs > 24 ? 24 : rs);
      int rs1 = r - 3; rs1 = rs1 < 0 ? 0 : (rs1 > 24 ? 24 : rs1);
      a.qbase = b * SEQL + r * 64; a.qstride = 1; a.qpos0 = 0; a.r0 = r; a.rs0 = rs;
      a.ktokbase = b * SEQL + rs * 64; a.ktokstep = 64; a.kstride = 1; a.kposbase = 0; a.kposstep = 0; a.ntiles = rs1 - rs + 8;
      a.qcol = h * 64; a.kcol = 256 + h * 64; a.vcol = 512 + h * 64; a.ocol = h * 64;
      a.gq = p.qkn_a + l * 128; a.gk = a.gq + 64;
      a.qscale = 0.125f * LOG2E;
      attn_item<1, 1, 0>(p, a, Ks, Vts, tab);
    } else if (item < nD + nA + nB) {
      const int id = item - nD - nA;
      const int b = id >> 6, h = (id >> 4) & 3, qb = id & 15;
      for (int i = tid; i < 257; i += NTHR) tab[i] = p.lut[h * 257 + i];
      const int q0 = qb * 128;
      const int kstart = q0 - 128 < 0 ? 0 : q0 - 128, kend = q0 + 256 > SEQL ? SEQL : q0 + 256;
      a.qbase = b * SEQL; a.qstride = 1; a.qpos0 = q0;
      a.ktokbase = b * SEQL + kstart; a.ktokstep = 64; a.kstride = 1; a.kposbase = kstart; a.kposstep = 64; a.ntiles = (kend - kstart) >> 6;
      a.qcol = 768 + h * 64; a.kcol = 768 + 256 + (h >> 1) * 64; a.vcol = 768 + 384 + (h >> 1) * 64; a.ocol = 256 + h * 64;
      a.gq = p.qkn_b + l * 128; a.gk = a.gq + 64;
      a.qscale = 0.125f * LOG2E;
      a.hw = 128; a.rmul = 1; a.sinkv = p.sink_b[l * 4 + h] * LOG2E;
      attn_item<1, 1, 1>(p, a, Ks, Vts, tab);
    } else {
      const int id = item - nD - nA - nB;
      const int b = id / 96, rem = id % 96, g = rem >> 5, i2 = (rem >> 4) & 1, blk = rem & 15;
      const int r = g == 0 ? 1 : (g == 1 ? 4 : 16);
      const int L = SEQL / r, bps = L >> 7;
      const int pp = blk / bps, m0 = (blk % bps) * 128;
      const int hh = g * 2 + i2;
      for (int i = tid; i < 257; i += NTHR) tab[i] = p.lut[(4 + hh) * 257 + i];
      const int kstart = m0 - 64 < 0 ? 0 : m0 - 64, kend = m0 + 192 > L ? L : m0 + 192;
      a.qbase = b * SEQL + pp; a.qstride = r; a.qpos0 = m0;
      a.ktokbase = a.qbase + kstart * r; a.ktokstep = 64 * r; a.kstride = r; a.kposbase = kstart; a.kposstep = 64; a.ntiles = (kend - kstart) >> 6;
      a.qcol = 1280 + hh * 64; a.kcol = 1280 + 384 + hh * 64; a.vcol = 1280 + 768 + hh * 64; a.ocol = 512 + hh * 64;
      a.gq = p.qkn_c + l * 128; a.gk = a.gq + 64;
      a.qscale = 0.125f * LOG2E;
      a.hw = 64; a.rmul = r; a.lsecol = hh;
      attn_item<1, 1, 2>(p, a, Ks, Vts, tab);
    }
  }
}

__device__ __forceinline__ void combine_phase(const Params& p) {
  const int nthr = gridDim.x * NTHR;
  for (int i = blockIdx.x * NTHR + opaque_tid(); i < NTOK * 48; i += nthr) {
    const int tok = i / 48, rem = i % 48, hh = rem >> 3, ch = rem & 7, ii = hh & 1, g = hh >> 1;
    const float* ls = p.lse + (size_t)tok * 6;
    const float l0 = ls[ii], l1 = ls[2 + ii], l2 = ls[4 + ii];
    const float mx = fmaxf(l0, fmaxf(l1, l2));
    const float e0 = __expf(l0 - mx), e1 = __expf(l1 - mx), e2 = __expf(l2 - mx);
    const float al = (g == 0 ? e0 : (g == 1 ? e1 : e2)) / (e0 + e1 + e2);
    bf16_t* ptr = p.hbuf + blk_off(tok, 512 + hh * 64 + ch * 8, NTOK);
    u32x4 v = *(const u32x4*)ptr;
#pragma unroll
    for (int k = 0; k < 4; ++k) v[k] = pk_bf16(bf_lo(v[k]) * al, bf_hi(v[k]) * al);
    *(u32x4*)ptr = v;
  }
}


#ifndef REP_GEMM
#define REP_GEMM 1
#endif
#ifndef REP_ATTN
#define REP_ATTN 1
#endif
#ifndef DBG_STOP
#define DBG_STOP 0
#endif
__global__ void __launch_bounds__(NTHR, 2) fwd_megakernel(Params p) {
  extern __shared__ __attribute__((aligned(16))) char smem[];
  cg::grid_group grid = cg::this_grid();
  prologue_phase(p, smem);
  grid.sync();
#define LAYER(L)                                                                                                   \
  {                                                                                                                \
    constexpr int l = (L);                                                                                         \
    constexpr bool first = (l == 0);                                                                               \
    const bf16_t* wt = p.wt + (size_t)l * WT_LAYER;                                                                \
    norm_phase(p, l, first, p.norm_attn_g + l * DM, 0, 1024);                                                      \
    grid.sync();                                                                                                   \
    gemm_phase<0>(p, l, false, p.hbuf, 3200, wt + WT_IN, 1024, 384, 13, 13, p.proj, PW, 0, smem);                  \
    grid.sync();                                                                                                   \
    attn_phase(p, l, smem);                                                                                        \
    grid.sync();                                                                                                   \
    combine_phase(p);                                                                                              \
    grid.sync();                                                                                                   \
    gemm_phase<1>(p, l, first, p.hbuf, 1024, wt + WT_OUT, 1152, 384, 4, 4, nullptr, 0, 2048, smem);                \
    grid.sync();                                                                                                   \
    norm_phase(p, l, false, p.norm_ffn_g + l * DM, 3072, 4096);                                                    \
    grid.sync();                                                                                                   \
    gemm_phase<2>(p, l, false, p.hbuf, 5632, wt + WT_UP, 1024, 408, 22, 22, p.proj, DFF, 0, smem);                 \
    grid.sync();                                                                                                   \
    gemm_phase<1>(p, l, false, p.proj, 1024, wt + WT_DOWN, 2816, 384, 4, 4, nullptr, 0, 5120, smem);               \
    grid.sync();                                                                                                   \
  }
  LAYER(0)
  LAYER(1)
  LAYER(2)
  LAYER(3)
#undef LAYER
}

extern "C" void kernel_launch(void* const* d_in, const int* in_sizes, int n_in, void* d_out, int out_size, void* d_ws, size_t ws_size,
                              hipStream_t stream) {
  static int grid_blocks = 0;
  if (!grid_blocks) {
    int dev = 0, cus = 0, per_cu = 0;
    hipGetDevice(&dev);
    hipDeviceGetAttribute(&cus, hipDeviceAttributeMultiprocessorCount, dev);
    hipFuncSetAttribute((const void*)fwd_megakernel, hipFuncAttributeMaxDynamicSharedMemorySize, SMEM_BYTES);
    hipOccupancyMaxActiveBlocksPerMultiprocessor(&per_cu, fwd_megakernel, NTHR, SMEM_BYTES);
    if (per_cu > 1) per_cu = 1;
    if (per_cu < 1) per_cu = 1;
    grid_blocks = cus * per_cu;
  }
  Params p{};
  const float* const* in = (const float* const*)d_in;
  p.x_prompt = in[0]; p.x_sample = in[1]; p.c_prompt = in[2]; p.c_sample = in[3]; p.norm_attn_g = in[4]; p.norm_ffn_g = in[5];
  p.w_ada = in[6]; p.b_ada = in[7]; p.w_in = in[8]; p.qkn_a = in[9]; p.qkn_b = in[10]; p.qkn_c = in[11]; p.qkn_d = in[12];
  p.rpb_a = in[13]; p.sink_b = in[14]; p.t5_table = in[15]; p.lam_d = in[16]; p.subln_d = in[17]; p.w_out = in[18]; p.w_up = in[19];
  p.conv_w = in[20]; p.conv_b = in[21]; p.w_down = in[22];
  p.out = (float*)d_out;
  char* ws = (char*)d_ws;
  size_t off = 0;
  p.wt = (bf16_t*)(ws + off); off += (size_t)4 * WT_LAYER * 2;
  p.mod = (float*)(ws + off); off += (size_t)4 * 48 * 6144 * 4;
  p.lut = (float*)(ws + off); off += 16384;
  p.lam = (float*)(ws + off); off += 256;
  p.zeros = (float*)(ws + off); off += 256;
  p.lse = (float*)(ws + off); off += (size_t)NTOK * 6 * 4;
  p.proj = (bf16_t*)(ws + off); off += (size_t)NTOK * PW * 2;
  p.hbuf = (bf16_t*)(ws + off); off += (size_t)NTOK * MW * 2;
  if (off > ws_size) { fprintf(stderr, "workspace too small: need %zu have %zu\n", off, ws_size); return; }
  void* args[] = {&p};
  hipError_t e = hipLaunchCooperativeKernel((void*)fwd_megakernel, dim3(grid_blocks), dim3(NTHR), args, SMEM_BYTES, stream);
  if (e != hipSuccess) fprintf(stderr, "cooperative launch failed: %s (grid %d)\n", hipGetErrorString(e), grid_blocks);
}
```

```cpp
#include <hip/hip_runtime.h>
#include <hip/hip_cooperative_groups.h>
#include <cstdint>
#include <cstdio>
namespace cg = cooperative_groups;

typedef unsigned short bf16_t;
typedef short bf16x8 __attribute__((ext_vector_type(8)));
typedef float f32x4 __attribute__((ext_vector_type(4)));
typedef unsigned u32x4 __attribute__((ext_vector_type(4)));
typedef unsigned u32x2 __attribute__((ext_vector_type(2)));

#define NTOK 98304
#define DM 1024
#define PW 3200
#define MW 1152
#define DFF 2816
#define NSEQ 48
#define SEQL 2048
#define LOG2E 1.4426950408889634f
#define LN2 0.6931471805599453f
#define LDSROW 72
#define NTHR 512
#define NWAVE 8

struct Params {
  const float *x_prompt, *x_sample, *c_prompt, *c_sample, *norm_attn_g, *norm_ffn_g, *w_ada, *b_ada, *w_in;
  const float *qkn_a, *qkn_b, *qkn_c, *qkn_d, *rpb_a, *sink_b, *t5_table, *lam_d, *subln_d, *w_out, *w_up, *conv_w, *conv_b, *w_down;
  float* out;
  bf16_t* wt; float* mod; float* lut; float* lam; float* lse; bf16_t* proj; bf16_t* hbuf; float* zeros;
};

#define WT_IN 0
#define WT_OUT (3200 * 1024)
#define WT_UP (WT_OUT + 1024 * 1152)
#define WT_DOWN (WT_UP + 5632 * 1024)
#define WT_LAYER (WT_DOWN + 1024 * 2816)

typedef __bf16 bf16x2_t __attribute__((ext_vector_type(2)));
typedef float f32x2_t __attribute__((ext_vector_type(2)));
__device__ __forceinline__ unsigned pk_bf16(float lo, float hi) {
  const f32x2_t v = {lo, hi};
  const bf16x2_t r = __builtin_convertvector(v, bf16x2_t);
  return __builtin_bit_cast(unsigned, r);
}
__device__ __forceinline__ float bf_lo(unsigned u) { return __uint_as_float(u << 16); }
__device__ __forceinline__ float bf_hi(unsigned u) { return __uint_as_float(u & 0xffff0000u); }
__device__ __forceinline__ float fexp2(float x) { return __builtin_amdgcn_exp2f(x); }

__device__ __forceinline__ const float* xin_row(const Params& p, bool first, int tok) {
  if (first) return tok < 65536 ? p.x_prompt + (size_t)tok * DM : p.x_sample + (size_t)(tok - 65536) * DM;
  return p.out + (size_t)tok * DM;
}

__device__ __forceinline__ int opaque_tid() { int t = threadIdx.x; asm volatile("" : "+v"(t)); return t; }

__device__ __forceinline__ size_t blk_off(int r, int k, int R) { return ((size_t)(k >> 5) * R + r) * 32 + (k & 31); }

__device__ __forceinline__ int t5_bucket(int rel) {
  const int n = rel < 0 ? -rel : rel;
  int v;
  if (n < 8) v = n;
  else v = 8 + (n >= 12) + (n >= 16) + (n >= 23) + (n >= 32) + (n >= 46) + (n >= 64) + (n >= 91);
  return (rel > 0 ? 16 : 0) + v;
}

__device__ __forceinline__ void prologue_phase(const Params& p, char* smem) {
  const int tid = opaque_tid(), nb = gridDim.x;
  const int N_TR = 4 * 3200, N_MOD = 192;
  for (int item = blockIdx.x; item < N_TR + N_MOD + 1; item += nb) {
    if (item < N_TR) {
      const int l = item / 3200; int r = item % 3200;
      const float* src; bf16_t* dst; int K, N, kt, nt;
      if (r < 800) { K = 1024; N = 3200; src = p.w_in + (size_t)l * K * N; dst = p.wt + (size_t)l * WT_LAYER + WT_IN; kt = r / 50; nt = r % 50; }
      else if (r < 1088) { r -= 800; K = 1152; N = 1024; src = p.w_out + (size_t)l * K * N; dst = p.wt + (size_t)l * WT_LAYER + WT_OUT; kt = r / 16; nt = r % 16; }
      else if (r < 2496) { r -= 1088; K = 1024; N = 5632; src = p.w_up + (size_t)l * K * N; dst = p.wt + (size_t)l * WT_LAYER + WT_UP; kt = r / 88; nt = r % 88; }
      else { r -= 2496; K = 2816; N = 1024; src = p.w_down + (size_t)l * K * N; dst = p.wt + (size_t)l * WT_LAYER + WT_DOWN; kt = r / 16; nt = r % 16; }
      float* tile = (float*)smem;
      const int k0 = kt * 64, n0 = nt * 64;
      __syncthreads();
#pragma unroll
      for (int i = 0; i < 8; ++i) {
        const int rr = (tid >> 6) + 8 * i, cc = tid & 63;
        tile[rr * 65 + cc] = src[(size_t)(k0 + rr) * N + n0 + cc];
      }
      __syncthreads();
#pragma unroll
      for (int i = 0; i < 4; ++i) {
        const int idx = tid + NTHR * i, n = idx >> 5, k2 = (idx & 31) * 2;
        *(unsigned*)(dst + blk_off(n0 + n, k0 + k2, N)) = pk_bf16(tile[k2 * 65 + n], tile[(k2 + 1) * 65 + n]);
      }
    } else if (item < N_TR + N_MOD) {
      int r = item - N_TR;
      const int l = r / 48; r %= 48;
      const int nc = r / 4, bg = r % 4;
      const int n = nc * NTHR + tid;
      float* sc = (float*)smem;
      float acc[12];
#pragma unroll
      for (int j = 0; j < 12; ++j) acc[j] = 0.f;
      const float* W = p.w_ada + (size_t)l * 1024 * 6144 + n;
      for (int kc = 0; kc < 2; ++kc) {
        __syncthreads();
        for (int i = tid; i < 12 * 512; i += NTHR) {
          const int j = i >> 9, k = i & 511, b = bg * 12 + j;
          const float c = b < 32 ? p.c_prompt[b * 1024 + kc * 512 + k] : p.c_sample[(b - 32) * 1024 + kc * 512 + k];
          sc[i] = c / (1.f + __expf(-c));
        }
        __syncthreads();
#pragma unroll 2
        for (int k = 0; k < 512; k += 4) {
          const float w0 = W[(size_t)(kc * 512 + k) * 6144], w1 = W[(size_t)(kc * 512 + k + 1) * 6144];
          const float w2 = W[(size_t)(kc * 512 + k + 2) * 6144], w3 = W[(size_t)(kc * 512 + k + 3) * 6144];
#pragma unroll
          for (int j = 0; j < 12; ++j) {
            const f32x4 s = *(const f32x4*)(sc + j * 512 + k);
            acc[j] += s[0] * w0 + s[1] * w1 + s[2] * w2 + s[3] * w3;
          }
        }
      }
      const float bias = p.b_ada[l * 6144 + n];
#pragma unroll
      for (int j = 0; j < 12; ++j) p.mod[((size_t)l * 48 + bg * 12 + j) * 6144 + n] = acc[j] + bias;
    } else {
      for (int i = tid; i < 14 * 257; i += NTHR) {
        const int hd = i / 257, idx = i % 257;
        p.lut[i] = p.t5_table[t5_bucket(idx - 128) * 14 + hd] * LOG2E;
      }
      if (tid < 64) p.zeros[tid] = 0.f;
      if (tid < 4) {
        const float* lp = p.lam_d + tid * 128;
        float s1 = 0.f, s2 = 0.f;
        for (int e = 0; e < 32; ++e) { s1 += lp[e] * lp[32 + e]; s2 += lp[64 + e] * lp[96 + e]; }
        const float li = 0.8f - 0.6f * expf(-0.3f * (float)tid);
        p.lam[tid] = expf(s1) - expf(s2) + li;
      }
    }
  }
}

__device__ __forceinline__ void norm_phase(const Params& p, int l, bool first, const float* g, int shift_off, int scale_off) {
  const int tid0 = opaque_tid();
  const int lane = tid0 & 63, w = tid0 >> 6;
  const int stride = gridDim.x * NWAVE;
  for (int row0 = blockIdx.x * NWAVE + w; row0 < NTOK; row0 += 2 * stride) {
    const int row1 = row0 + stride;
    const bool has1 = row1 < NTOK;
    const int rows[2] = {row0, has1 ? row1 : row0};
    f32x4 v[2][4];
    float ss[2] = {0.f, 0.f};
#pragma unroll
    for (int r = 0; r < 2; ++r) {
      const float* xr = xin_row(p, first, rows[r]);
#pragma unroll
      for (int i = 0; i < 4; ++i) v[r][i] = *(const f32x4*)(xr + i * 256 + lane * 4);
    }
#pragma unroll
    for (int r = 0; r < 2; ++r) {
#pragma unroll
      for (int i = 0; i < 4; ++i) ss[r] += v[r][i][0] * v[r][i][0] + v[r][i][1] * v[r][i][1] + v[r][i][2] * v[r][i][2] + v[r][i][3] * v[r][i][3];
#pragma unroll
      for (int o = 32; o >= 1; o >>= 1) ss[r] += __shfl_xor(ss[r], o);
    }
#pragma unroll
    for (int r = 0; r < 2; ++r) {
      if (r == 1 && !has1) break;
      const int row = rows[r];
      const float* md = p.mod + ((size_t)l * 48 + (row >> 11)) * 6144;
      const float rstd = rsqrtf(ss[r] * (1.f / 1024.f) + 1e-6f);
#pragma unroll
      for (int i = 0; i < 4; ++i) {
        const int k = i * 256 + lane * 4;
        const f32x4 gg = *(const f32x4*)(g + k), sc = *(const f32x4*)(md + scale_off + k), sh = *(const f32x4*)(md + shift_off + k);
        f32x4 y;
#pragma unroll
        for (int j = 0; j < 4; ++j) y[j] = (v[r][i][j] * rstd) * gg[j] * (1.f + sc[j]) + sh[j];
        u32x2 o; o[0] = pk_bf16(y[0], y[1]); o[1] = pk_bf16(y[2], y[3]);
        *(u32x2*)(p.hbuf + blk_off(row, k, NTOK)) = o;
      }
    }
  }
}

__device__ __forceinline__ bool gemm_tile_id(int it, int MT, int NT, int NB, int& mt, int& nt) {
  const int nb = gridDim.x, bid = blockIdx.x;
  if ((nb & 7) == 0) {
    const int x = bid & 7, slot = bid >> 3, S = nb >> 3;
    const int TPS = 8 * NB, NSN = NT / NB, NS = (MT / 8) * NSN;
    const int pidx = slot + S * it, sidx = pidx / TPS, w = pidx % TPS, s = x + 8 * sidx;
    if (s >= NS) return false;
    mt = (s / NSN) * 8 + (w & 7); nt = (s % NSN) * NB + (w >> 3);
    return true;
  }
  const int t = bid + nb * it;
  if (t >= MT * NT) return false;
  mt = t / NT; nt = t % NT;
  return true;
}

template <int M, int NN>
__device__ __forceinline__ void up_epi_row(const f32x4 (&acc)[8][4], const float* cw, const float* cb, int cbase, int lane, int fr, int s0, bf16_t* obase) {
  constexpr int MP = M > 0 ? M - 1 : 0, MN = M < 7 ? M + 1 : 7;
  const int srcp = (lane & 48) | ((fr + 15) & 15), srcn = (lane & 48) | ((fr + 1) & 15);
  float y[2][4];
#pragma unroll
  for (int n = 0; n < 2; ++n) {
    const int c = n * DFF + cbase;
    const f32x4 w0 = *(const f32x4*)(cw + c), w1 = *(const f32x4*)(cw + 5632 + c), w2 = *(const f32x4*)(cw + 2 * 5632 + c), bb = *(const f32x4*)(cb + c);
#pragma unroll
    for (int j = 0; j < 4; ++j) {
      const float cur = acc[M][NN + 2 * n][j];
      const float zp = (fr == 15) ? acc[MP][NN + 2 * n][j] : cur, zn = (fr == 0) ? acc[MN][NN + 2 * n][j] : cur;
      const float pv = __shfl(zp, srcp), nv = __shfl(zn, srcn);
      y[n][j] = w0[j] * pv + w1[j] * cur + w2[j] * nv + bb[j];
    }
  }
  const int row = 16 * M + fr, tpos = s0 + row;
  if (row >= 1 && row <= 126 && tpos >= 0 && tpos < SEQL) {
    float a[4];
#pragma unroll
    for (int j = 0; j < 4; ++j) { const float gte = y[1][j]; a[j] = y[0][j] * gte / (1.f + __expf(-gte)); }
    u32x2 o; o[0] = pk_bf16(a[0], a[1]); o[1] = pk_bf16(a[2], a[3]);
    *(u32x2*)(obase + (size_t)tpos * 32) = o;
  }
  __builtin_amdgcn_sched_barrier(0);
}

#define GB_A 16384
#define GB_BUF 32768
#define NSTAGE 2
#define SMEM_BYTES (NSTAGE * GB_BUF)
template <int EPI>
__device__ __forceinline__ void gemm_phase(const Params& p, int l, bool first, const bf16_t* A, int NBROWS, const bf16_t* Bt, int K, int MT, int NT, int NB,
                           bf16_t* outb, int ldc, int gate_off, char* smem) {
  const int tid = opaque_tid(), lane = tid & 63, w = tid >> 6, wr = w >> 2, wcn = w & 3, fr = lane & 15, fq = lane >> 4;
  const int nk = K / 32;
  const int lrow = tid >> 2, lch = (tid & 3) ^ ((tid >> 4) & 3);
  const int fsw = (fq ^ ((fr >> 2) & 3)) * 16;
  const size_t apan = (size_t)NTOK * 32, bpan = (size_t)NBROWS * 32;
  const bf16_t* ga0; const bf16_t* ga1; const bf16_t* gb0;
  size_t bstr;
#define GEMM_PTRS(MT_, NT_)                                                                                                          \
  {                                                                                                                                  \
    int t_ = tid; asm volatile("" : "+v"(t_));                                                                                       \
    const int lrow_ = t_ >> 2, lch_ = (t_ & 3) ^ ((t_ >> 4) & 3);                                                                    \
    if (EPI == 2) {                                                                                                                  \
      const int wi0 = 2 * (MT_), wi1 = wi0 + 1;                                                                                      \
      const int t0 = 126 * (wi0 % 17) - 1 + lrow_, t1 = 126 * (wi1 % 17) - 1 + lrow_;                                                \
      ga0 = A + ((size_t)(wi0 / 17) * SEQL + t0) * 32 + lch_ * 8;                                                                    \
      ga1 = A + ((size_t)(wi1 / 17) * SEQL + t1) * 32 + lch_ * 8;                                                                    \
      gb0 = Bt + (size_t)((NT_) * 128 + lrow_) * 32 + lch_ * 8; bstr = (size_t)DFF * 32;                                             \
    } else {                                                                                                                         \
      ga0 = A + (size_t)((MT_) * 256 + lrow_) * 32 + lch_ * 8; ga1 = ga0 + (size_t)128 * 32;                                         \
      gb0 = Bt + (size_t)((NT_) * 256 + lrow_) * 32 + lch_ * 8; bstr = (size_t)128 * 32;                                             \
    }                                                                                                                                \
  }
#define GEMM_LOAD(KT, SET)                                                                                                           \
    {                                                                                                                                \
      const size_t ko_ = (size_t)(KT) * apan, kb_ = (size_t)(KT) * bpan;                                                             \
      asm volatile("global_load_dwordx4 %0, %1, off" : "=v"(SET[0]) : "v"(ga0 + ko_) : "memory");                                     \
      asm volatile("global_load_dwordx4 %0, %1, off" : "=v"(SET[1]) : "v"(ga1 + ko_) : "memory");                                     \
      asm volatile("global_load_dwordx4 %0, %1, off" : "=v"(SET[2]) : "v"(gb0 + kb_) : "memory");                                     \
      asm volatile("global_load_dwordx4 %0, %1, off" : "=v"(SET[3]) : "v"(gb0 + bstr + kb_) : "memory");                              \
    }
#define GEMM_WRITE(SET, STAGE)                                                                                                       \
    {                                                                                                                                \
      asm volatile("" : "+v"(SET[0]), "+v"(SET[1]), "+v"(SET[2]), "+v"(SET[3]));      \
      char* dst_ = smem + (STAGE) * GB_BUF + tid * 16;                                                                               \
      *(u32x4*)(dst_) = SET[0]; *(u32x4*)(dst_ + 8192) = SET[1]; *(u32x4*)(dst_ + GB_A) = SET[2]; *(u32x4*)(dst_ + GB_A + 8192) = SET[3]; \
    }
#define GEMM_KSTEP(KT, WSET)                                                                                                         \
    {                                                                                                                                \
      asm volatile("s_waitcnt lgkmcnt(0)" ::: "memory");                                                                             \
      __builtin_amdgcn_s_barrier();                   \
      if ((KT) + 1 < nk) {                                                                                                           \
        if ((KT) + 2 < nk) asm volatile("s_waitcnt vmcnt(4)" ::: "memory"); else asm volatile("s_waitcnt vmcnt(0)" ::: "memory");     \
        GEMM_WRITE(WSET, ((KT) + 1) & 1)                                                                                             \
        if ((KT) + 3 < nk) GEMM_LOAD((KT) + 3, WSET)                                                                                 \
      }                                                                                                                              \
      const char* Ab = smem + ((KT) & 1) * GB_BUF;                                                                                   \
      const char* Bb = Ab + GB_A;                                                                                                    \
      bf16x8 bfr[4];                                                                                                                 \
      _Pragma("unroll") for (int n = 0; n < 4; ++n) {                                                                                \
        const int br = (EPI == 2) ? ((n >> 1) * 128 + 32 * wcn + 16 * (n & 1) + fr) : (64 * wcn + 16 * n + fr);                      \
        bfr[n] = *(const bf16x8*)(Bb + br * 64 + fsw);                                                                               \
      }                                                                                                                              \
      const char* Ap = Ab + (wr * 128 + fr) * 64 + fsw;                                                                              \
      bf16x8 af0 = *(const bf16x8*)(Ap), af1 = *(const bf16x8*)(Ap + 16 * 64);                                                       \
      _Pragma("unroll") for (int pr = 0; pr < 4; ++pr) {                                                                             \
        bf16x8 an0 = af0, an1 = af1;                                                                                                 \
        if (pr < 3) { an0 = *(const bf16x8*)(Ap + (2 * pr + 2) * 16 * 64); an1 = *(const bf16x8*)(Ap + (2 * pr + 3) * 16 * 64); }    \
        __builtin_amdgcn_sched_barrier(0);                                                                                           \
        _Pragma("unroll") for (int n = 0; n < 4; ++n) acc[2 * pr][n] = __builtin_amdgcn_mfma_f32_16x16x32_bf16(bfr[n], af0, acc[2 * pr][n], 0, 0, 0); \
        _Pragma("unroll") for (int n = 0; n < 4; ++n) acc[2 * pr + 1][n] = __builtin_amdgcn_mfma_f32_16x16x32_bf16(bfr[n], af1, acc[2 * pr + 1][n], 0, 0, 0); \
        __builtin_amdgcn_sched_barrier(0);                                                                                           \
        af0 = an0; af1 = an1;                                                                                                        \
      }                                                                                                                              \
    }
  int mt, nt;
  bool have = gemm_tile_id(0, MT, NT, NB, mt, nt);
  for (int it = 0; have; ++it) {
    GEMM_PTRS(mt, nt)
    u32x4 rsA[4], rsB[4];
    f32x4 acc[8][4];
#pragma unroll
    for (int m = 0; m < 8; ++m)
#pragma unroll
      for (int n = 0; n < 4; ++n) acc[m][n] = (f32x4){0.f, 0.f, 0.f, 0.f};
    asm volatile("s_waitcnt vmcnt(0) lgkmcnt(0)" ::: "memory");
    __builtin_amdgcn_s_barrier();
    GEMM_LOAD(0, rsA)
    GEMM_LOAD(1, rsB)
    asm volatile("s_waitcnt vmcnt(4)" ::: "memory");
    GEMM_WRITE(rsA, 0)
    GEMM_LOAD(2, rsA)
    for (int kt = 0; kt < nk; kt += 2) {
      GEMM_KSTEP(kt, rsB)
      GEMM_KSTEP(kt + 1, rsA)
    }
    const int mt_e = mt, nt_e = nt;
    have = gemm_tile_id(it + 1, MT, NT, NB, mt, nt);
    int lane_e = lane; asm volatile("" : "+v"(lane_e));
    const int fr_e = lane_e & 15, fq_e = lane_e >> 4;
    if (EPI == 0) {
      if (nt_e * 256 + 64 * wcn < NBROWS) {
#pragma unroll
        for (int m = 0; m < 8; ++m) {
          const int tok = mt_e * 256 + wr * 128 + 16 * m + fr_e;
#pragma unroll
          for (int n = 0; n < 4; ++n) {
            const int col = nt_e * 256 + 64 * wcn + 16 * n + 4 * fq_e;
            u32x2 o; o[0] = pk_bf16(acc[m][n][0], acc[m][n][1]); o[1] = pk_bf16(acc[m][n][2], acc[m][n][3]);
            *(u32x2*)(outb + (size_t)tok * ldc + col) = o;
          }
        }
      }
    } else if (EPI == 1) {
      const int b = (mt_e * 256) >> 11;
      const float* gate = p.mod + ((size_t)l * 48 + b) * 6144 + gate_off;
#pragma unroll
      for (int n = 0; n < 4; ++n) {
        const int col = nt_e * 256 + 64 * wcn + 16 * n + 4 * fq_e;
        const f32x4 gv = *(const f32x4*)(gate + col);
#pragma unroll
        for (int m = 0; m < 8; ++m) {
          const int tok = mt_e * 256 + wr * 128 + 16 * m + fr_e;
          const f32x4 xv = *(const f32x4*)(xin_row(p, first, tok) + col);
          f32x4 o;
#pragma unroll
          for (int j = 0; j < 4; ++j) o[j] = xv[j] + gv[j] * acc[m][n][j];
          *(f32x4*)(p.out + (size_t)tok * DM + col) = o;
        }
      }
    } else {
      const float* cw = p.conv_w + (size_t)l * 3 * 5632;
      const float* cb = p.conv_b + (size_t)l * 5632;
      const int wi = 2 * mt_e + wr, seq = wi / 17, s0 = 126 * (wi % 17) - 1;
      if (s0 < 0 || s0 + 127 >= SEQL) {
#pragma unroll
        for (int m = 0; m < 8; ++m) {
          const int tp = s0 + 16 * m + fr_e;
          if (tp < 0 || tp >= SEQL) {
#pragma unroll
            for (int n = 0; n < 4; ++n) acc[m][n] = (f32x4){0.f, 0.f, 0.f, 0.f};
          }
        }
      }
#define UP_EPI_NN(NN)                                                                                                      \
      {                                                                                                                    \
        const int cbase = nt_e * 128 + 32 * wcn + 16 * NN + 4 * fq_e;                                                        \
        bf16_t* obase = outb + blk_off(seq * SEQL, cbase, NTOK);                                                           \
        up_epi_row<0, NN>(acc, cw, cb, cbase, lane_e, fr_e, s0, obase); up_epi_row<1, NN>(acc, cw, cb, cbase, lane_e, fr_e, s0, obase); \
        up_epi_row<2, NN>(acc, cw, cb, cbase, lane_e, fr_e, s0, obase); up_epi_row<3, NN>(acc, cw, cb, cbase, lane_e, fr_e, s0, obase); \
        up_epi_row<4, NN>(acc, cw, cb, cbase, lane_e, fr_e, s0, obase); up_epi_row<5, NN>(acc, cw, cb, cbase, lane_e, fr_e, s0, obase); \
        up_epi_row<6, NN>(acc, cw, cb, cbase, lane_e, fr_e, s0, obase); up_epi_row<7, NN>(acc, cw, cb, cbase, lane_e, fr_e, s0, obase); \
      }
      UP_EPI_NN(0)
      UP_EPI_NN(1)
#undef UP_EPI_NN
    }
  }
#undef GEMM_LOAD
#undef GEMM_WRITE
#undef GEMM_KSTEP
#undef GEMM_PTRS
}

struct AttnArgs {
  int qbase, qstride, qpos0;
  int ktokbase, ktokstep, kstride, kposbase, kposstep, ntiles;
  int qcol, kcol, vcol, ocol;
  const float *gq, *gk;
  float qscale;
  int hw, rmul, taboff0;
  float sinkv;
  float lam, outscale;
  const float* subg;
  int lsecol;
  int r0, rs0;
};

template <int NQ, int NC, int MODE>
__device__ __forceinline__ void attn_item(const Params& p, const AttnArgs& a, bf16_t* Ks, bf16_t* Vts, const float* tab) {
  const int tid = opaque_tid(), lane = tid & 63, w = tid >> 6, fr = lane & 15, fq = lane >> 4;
  const int wq0 = a.qpos0 + w * 16 * NQ;
  bf16x8 qf[NQ][2];
  int qpos[NQ];
#pragma unroll
  for (int qt = 0; qt < NQ; ++qt) {
    const int qp = wq0 + qt * 16 + fr;
    qpos[qt] = qp;
    const bf16_t* qrow = p.proj + (size_t)(a.qbase + qp * a.qstride) * PW + a.qcol;
    const u32x4 v0 = *(const u32x4*)(qrow + fq * 8), v1 = *(const u32x4*)(qrow + 32 + fq * 8);
    float f0[8], f1[8];
#pragma unroll
    for (int i = 0; i < 4; ++i) { f0[2 * i] = bf_lo(v0[i]); f0[2 * i + 1] = bf_hi(v0[i]); f1[2 * i] = bf_lo(v1[i]); f1[2 * i + 1] = bf_hi(v1[i]); }
    float s0 = 0.f, s1 = 0.f;
#pragma unroll
    for (int i = 0; i < 8; ++i) { s0 += f0[i] * f0[i]; s1 += f1[i] * f1[i]; }
    float r0, r1;
    if (NC == 1) {
      float s = s0 + s1; s += __shfl_xor(s, 16); s += __shfl_xor(s, 32);
      r0 = r1 = rsqrtf(s * (1.f / 64.f) + 1e-6f) * a.qscale;
    } else {
      s0 += __shfl_xor(s0, 16); s0 += __shfl_xor(s0, 32);
      s1 += __shfl_xor(s1, 16); s1 += __shfl_xor(s1, 32);
      r0 = rsqrtf(s0 * (1.f / 32.f) + 1e-6f) * a.qscale; r1 = rsqrtf(s1 * (1.f / 32.f) + 1e-6f) * a.qscale;
    }
    const float* g0p = a.gq + fq * 8;
    const float* g1p = (NC == 1) ? a.gq + 32 + fq * 8 : g0p;
    u32x4 q0, q1;
#pragma unroll
    for (int i = 0; i < 4; ++i) {
      q0[i] = pk_bf16(f0[2 * i] * r0 * g0p[2 * i], f0[2 * i + 1] * r0 * g0p[2 * i + 1]);
      q1[i] = pk_bf16(f1[2 * i] * r1 * g1p[2 * i], f1[2 * i + 1] * r1 * g1p[2 * i + 1]);
    }
    qf[qt][0] = __builtin_bit_cast(bf16x8, q0);
    qf[qt][1] = __builtin_bit_cast(bf16x8, q1);
  }
  f32x4 o[NC][NQ][4];
  float mrun[NC][NQ], lrun[NC][NQ];
#pragma unroll
  for (int c = 0; c < NC; ++c)
#pragma unroll
    for (int qt = 0; qt < NQ; ++qt) {
      if (MODE == 1) { mrun[c][qt] = a.sinkv; lrun[c][qt] = (fq == 0) ? 1.f : 0.f; }
      else { mrun[c][qt] = -1e30f; lrun[c][qt] = 0.f; }
#pragma unroll
      for (int dt = 0; dt < 4; ++dt) o[c][qt][dt] = (f32x4){0.f, 0.f, 0.f, 0.f};
    }
  const int lch = tid & 7;
  float gkv[8];
#pragma unroll
  for (int i = 0; i < 8; ++i) gkv[i] = a.gk[((NC == 1) ? lch : (lch & 3)) * 8 + i];

  const int rw = a.r0 + ((w * 16 * NQ) >> 6);
  int rsw = rw - 4; rsw = rsw < 0 ? 0 : (rsw > 24 ? 24 : rsw);
  u32x4 kA, vA, kB, vB;
  const int kkey = tid >> 3, vkey = tid & 63, vch = tid >> 6;
#define ATTN_PREFETCH(T, KR, VR)                                                                                 \
  {                                                                                                              \
    const int ktok0_ = a.ktokbase + (T) * a.ktokstep;                                                            \
    KR = *(const u32x4*)(p.proj + (size_t)(ktok0_ + kkey * a.kstride) * PW + a.kcol + lch * 8);                   \
    VR = *(const u32x4*)(p.proj + (size_t)(ktok0_ + vkey * a.kstride) * PW + a.vcol + vch * 8);                   \
  }
  auto stage_write = [&](const u32x4& kr, const u32x4& vr, bf16_t* Ksb, bf16_t* Vtb) __attribute__((always_inline)) {
    float f[8];
#pragma unroll
    for (int i = 0; i < 4; ++i) { f[2 * i] = bf_lo(kr[i]); f[2 * i + 1] = bf_hi(kr[i]); }
    float s = 0.f;
#pragma unroll
    for (int i = 0; i < 8; ++i) s += f[i] * f[i];
    s += __shfl_xor(s, 1); s += __shfl_xor(s, 2);
    float rs;
    if (NC == 1) { s += __shfl_xor(s, 4); rs = rsqrtf(s * (1.f / 64.f) + 1e-6f); }
    else rs = rsqrtf(s * (1.f / 32.f) + 1e-6f);
    u32x4 kq;
#pragma unroll
    for (int i = 0; i < 4; ++i) kq[i] = pk_bf16(f[2 * i] * rs * gkv[2 * i], f[2 * i + 1] * rs * gkv[2 * i + 1]);
    *(u32x4*)(Ksb + kkey * LDSROW + lch * 8) = kq;
#pragma unroll
    for (int i = 0; i < 4; ++i) {
      Vtb[(vch * 8 + 2 * i) * LDSROW + vkey] = (bf16_t)(vr[i] & 0xffffu);
      Vtb[(vch * 8 + 2 * i + 1) * LDSROW + vkey] = (bf16_t)(vr[i] >> 16);
    }
  };
  auto tile_math = [&](int t, const bf16_t* Ksb, const bf16_t* Vtb) __attribute__((always_inline)) {
    if (MODE == 0) { const int kr_ = a.rs0 + t; if (kr_ < rsw || kr_ >= rsw + 8) return; }
    const int kp0 = a.kposbase + t * a.kposstep;
    const int taboff = (a.rs0 + t - rw + 7) * 31;
    bf16x8 pf[NC][NQ][2];
    bf16x8 kf[4][2];
#pragma unroll
    for (int kt = 0; kt < 4; ++kt) {
      kf[kt][0] = *(const bf16x8*)(Ksb + (kt * 16 + fr) * LDSROW + fq * 8);
      kf[kt][1] = *(const bf16x8*)(Ksb + (kt * 16 + fr) * LDSROW + 32 + fq * 8);
    }
    bf16x8 vfr[4][2];
#pragma unroll
    for (int ks = 0; ks < 2; ++ks)
#pragma unroll
      for (int dt = 0; dt < 4; ++dt) {
        const u32x2 lo = *(const u32x2*)(Vtb + (dt * 16 + fr) * LDSROW + ks * 32 + 4 * fq);
        const u32x2 hi = *(const u32x2*)(Vtb + (dt * 16 + fr) * LDSROW + ks * 32 + 16 + 4 * fq);
        u32x4 vv; vv[0] = lo[0]; vv[1] = lo[1]; vv[2] = hi[0]; vv[3] = hi[1];
        vfr[dt][ks] = __builtin_bit_cast(bf16x8, vv);
      }
#pragma unroll
    for (int qt = 0; qt < NQ; ++qt) {
      const int qp = (MODE == 0) ? (qpos[qt] & 63) : qpos[qt];
      int cs = qp - 8; cs = cs < 0 ? 0 : (cs > 48 ? 48 : cs);
      f32x4 bv[4];
      const bool far_hi = (MODE == 3) && (kp0 - (wq0 + 16 * NQ - 1) >= 128), far_lo = (MODE == 3) && (wq0 - (kp0 + 63) >= 128);
      if (far_hi || far_lo) {
        const float bu = tab[far_hi ? 256 : 0];
#pragma unroll
        for (int kt = 0; kt < 4; ++kt) bv[kt] = (f32x4){bu, bu, bu, bu};
      } else
#pragma unroll
      for (int kt = 0; kt < 4; ++kt)
#pragma unroll
        for (int j = 0; j < 4; ++j) {
          const int kpos = kp0 + kt * 16 + 4 * fq + j;
          const int d = kpos - qp;
          bool valid; int idx;
          if (MODE == 0) {
            valid = kpos >= cs && kpos < cs + 16;
            int dd = d + 15; dd = dd < 0 ? 0 : (dd > 30 ? 30 : dd);
            idx = taboff + dd;
          } else {
            valid = (MODE == 3) ? true : (d <= a.hw && d >= -a.hw);
            int dd = d * a.rmul; dd = dd < -128 ? -128 : (dd > 128 ? 128 : dd);
            idx = dd + 128;
          }
          const float bias = tab[idx];
          bv[kt][j] = valid ? bias : -INFINITY;
        }
#pragma unroll
      for (int c = 0; c < NC; ++c) {
        f32x4 s[4];
#pragma unroll
        for (int kt = 0; kt < 4; ++kt) {
          if (NC == 1) {
            const f32x4 r = __builtin_amdgcn_mfma_f32_16x16x32_bf16(kf[kt][0], qf[qt][0], bv[kt], 0, 0, 0);
            s[kt] = __builtin_amdgcn_mfma_f32_16x16x32_bf16(kf[kt][1], qf[qt][1], r, 0, 0, 0);
          } else {
            s[kt] = __builtin_amdgcn_mfma_f32_16x16x32_bf16(kf[kt][c], qf[qt][c], bv[kt], 0, 0, 0);
          }
        }
        float mx = -INFINITY;
#pragma unroll
        for (int kt = 0; kt < 4; ++kt)
#pragma unroll
          for (int j = 0; j < 4; ++j) mx = fmaxf(mx, s[kt][j]);
        mx = fmaxf(mx, __shfl_xor(mx, 16)); mx = fmaxf(mx, __shfl_xor(mx, 32));
        const float mn = fmaxf(mrun[c][qt], mx);
        const float al = fexp2(mrun[c][qt] - mn);
        mrun[c][qt] = mn;
        float rs = 0.f;
#pragma unroll
        for (int kt = 0; kt < 4; ++kt)
#pragma unroll
          for (int j = 0; j < 4; ++j) { const float pv = fexp2(s[kt][j] - mn); s[kt][j] = pv; rs += pv; }
        lrun[c][qt] = lrun[c][qt] * al + rs;
        if (__any(al != 1.f)) {
#pragma unroll
          for (int dt = 0; dt < 4; ++dt) o[c][qt][dt] *= al;
        }
#pragma unroll
        for (int ks = 0; ks < 2; ++ks) {
          u32x4 pk;
          pk[0] = pk_bf16(s[2 * ks][0], s[2 * ks][1]); pk[1] = pk_bf16(s[2 * ks][2], s[2 * ks][3]);
          pk[2] = pk_bf16(s[2 * ks + 1][0], s[2 * ks + 1][1]); pk[3] = pk_bf16(s[2 * ks + 1][2], s[2 * ks + 1][3]);
          pf[c][qt][ks] = __builtin_bit_cast(bf16x8, pk);
        }
      }
    }
#pragma unroll
    for (int ks = 0; ks < 2; ++ks) {
#pragma unroll
      for (int dt = 0; dt < 4; ++dt) {
        const bf16x8 vf = vfr[dt][ks];
#pragma unroll
        for (int c = 0; c < NC; ++c)
#pragma unroll
          for (int qt = 0; qt < NQ; ++qt) o[c][qt][dt] = __builtin_amdgcn_mfma_f32_16x16x32_bf16(vf, pf[c][qt][ks], o[c][qt][dt], 0, 0, 0);
      }
    }
    };
  bf16_t* const Ks1 = Ks + 2 * 64 * LDSROW;
  bf16_t* const Vts1 = Vts + 2 * 64 * LDSROW;
  const int ntl = a.ntiles;
  ATTN_PREFETCH(0, kA, vA)
  if (ntl > 1) ATTN_PREFETCH(1, kB, vB)
  stage_write(kA, vA, Ks, Vts);
  if (ntl > 2) ATTN_PREFETCH(2, kA, vA)
  for (int t = 0; t < ntl; t += 2) {
    __syncthreads();
    if (t + 1 < ntl) { stage_write(kB, vB, Ks1, Vts1); if (t + 3 < ntl) ATTN_PREFETCH(t + 3, kB, vB) }
    tile_math(t, Ks, Vts);
    if (t + 1 < ntl) {
      __syncthreads();
      if (t + 2 < ntl) { stage_write(kA, vA, Ks, Vts); if (t + 4 < ntl) ATTN_PREFETCH(t + 4, kA, vA) }
      tile_math(t + 1, Ks1, Vts1);
    }
  }
#undef ATTN_PREFETCH
#pragma unroll
  for (int qt = 0; qt < NQ; ++qt) {
    float inv[NC], ltot[NC];
#pragma unroll
    for (int c = 0; c < NC; ++c) {
      float lt = lrun[c][qt];
      lt += __shfl_xor(lt, 16); lt += __shfl_xor(lt, 32);
      ltot[c] = lt; inv[c] = 1.f / lt;
    }
    const int tok = a.qbase + qpos[qt] * a.qstride;
    if (MODE == 3) {
      f32x4 v[4];
      float ss = 0.f;
#pragma unroll
      for (int dt = 0; dt < 4; ++dt)
#pragma unroll
        for (int j = 0; j < 4; ++j) {
          const float x = o[0][qt][dt][j] * inv[0] - a.lam * (o[NC - 1][qt][dt][j] * inv[NC - 1]);
          v[dt][j] = x; ss += x * x;
        }
      ss += __shfl_xor(ss, 16); ss += __shfl_xor(ss, 32);
      const float rstd = rsqrtf(ss * (1.f / 64.f) + 1e-6f) * a.outscale;
#pragma unroll
      for (int dt = 0; dt < 4; ++dt) {
        const f32x4 g = *(const f32x4*)(a.subg + dt * 16 + 4 * fq);
        u32x2 ov; ov[0] = pk_bf16(v[dt][0] * rstd * g[0], v[dt][1] * rstd * g[1]); ov[1] = pk_bf16(v[dt][2] * rstd * g[2], v[dt][3] * rstd * g[3]);
        *(u32x2*)(p.hbuf + blk_off(tok, a.ocol + dt * 16 + 4 * fq, NTOK)) = ov;
      }
    } else {
#pragma unroll
      for (int dt = 0; dt < 4; ++dt) {
        u32x2 ov;
        ov[0] = pk_bf16(o[0][qt][dt][0] * inv[0], o[0][qt][dt][1] * inv[0]);
        ov[1] = pk_bf16(o[0][qt][dt][2] * inv[0], o[0][qt][dt][3] * inv[0]);
        *(u32x2*)(p.hbuf + blk_off(tok, a.ocol + dt * 16 + 4 * fq, NTOK)) = ov;
      }
      if (MODE == 2 && fq == 0) p.lse[(size_t)tok * 6 + a.lsecol] = (mrun[0][qt] + __log2f(ltot[0])) * LN2;
    }
  }
}

__device__ __forceinline__ void attn_phase(const Params& p, int l, char* smem) {
  bf16_t* Ks = (bf16_t*)smem;
  bf16_t* Vts = Ks + 64 * LDSROW;
  float* tab = (float*)(Ks + 4 * 64 * LDSROW);
  const int tid = opaque_tid();
  const int nD = 3072, nA = 3072, nB = 3072, nC = 4608;
  for (int item = blockIdx.x; item < nD + nA + nB + nC; item += gridDim.x) {
    AttnArgs a;
    a.taboff0 = 0; a.r0 = 0; a.rs0 = 0; a.sinkv = 0.f; a.lam = 0.f; a.outscale = 1.f; a.subg = nullptr; a.lsecol = 0; a.hw = 1 << 20; a.rmul = 1;
    __syncthreads();
    if (item < nD) {
      const int b = item >> 6, h = (item >> 4) & 3, qb = item & 15;
      for (int i = tid; i < 257; i += NTHR) tab[i] = p.lut[(10 + h) * 257 + i];
      a.qbase = b * SEQL; a.qstride = 1; a.qpos0 = qb * 128;
      a.ktokbase = b * SEQL; a.ktokstep = 64; a.kstride = 1; a.kposbase = 0; a.kposstep = 64; a.ntiles = 32;
      a.qcol = 2432 + h * 64; a.kcol = 2432 + 256 + h * 64; a.vcol = 2432 + 512 + h * 64; a.ocol = 896 + h * 64;
      a.gq = p.qkn_d + l * 64; a.gk = a.gq + 32;
      a.qscale = 0.17677669529663687f * LOG2E;
      a.lam = p.lam[l]; a.outscale = 1.f - (0.8f - 0.6f * expf(-0.3f * (float)l)); a.subg = p.subln_d + l * 64;
      attn_item<1, 2, 3>(p, a, Ks, Vts, tab);
    } else if (item < nD + nA) {
      const int id = item - nD;
      const int b = id >> 6, h = (id >> 4) & 3, r = (id & 15) * 2;
      const float* rp = p.rpb_a + ((size_t)l * 4 + h) * 465;
      for (int i = tid; i < 465; i += NTHR) tab[i] = rp[i] * LOG2E;
      int rs = r - 4; rs = rs < 0 ? 0 : (rs > 24 ? 24 : rs);
      int rs1 = r - 3; rs1 = rs1 < 0 ? 0 : (rs1 > 24 ? 24 : rs1);
      a.qbase = b * SEQL + r * 64; a.qstride = 1; a.qpos0 = 0; a.r0 = r; a.rs0 = rs;
      a.ktokbase = b * SEQL + rs * 64; a.ktokstep = 64; a.kstride = 1; a.kposbase = 0; a.kposstep = 0; a.ntiles = rs1 - rs + 8;
      a.qcol = h * 64; a.kcol = 256 + h * 64; a.vcol = 512 + h * 64; a.ocol = h * 64;
      a.gq = p.qkn_a + l * 128; a.gk = a.gq + 64;
      a.qscale = 0.125f * LOG2E;
      attn_item<1, 1, 0>(p, a, Ks, Vts, tab);
    } else if (item < nD + nA + nB) {
      const int id = item - nD - nA;
      const int b = id >> 6, h = (id >> 4) & 3, qb = id & 15;
      for (int i = tid; i < 257; i += NTHR) tab[i] = p.lut[h * 257 + i];
      const int q0 = qb * 128;
      const int kstart = q0 - 128 < 0 ? 0 : q0 - 128, kend = q0 + 256 > SEQL ? SEQL : q0 + 256;
      a.qbase = b * SEQL; a.qstride = 1; a.qpos0 = q0;
      a.ktokbase = b * SEQL + kstart; a.ktokstep = 64; a.kstride = 1; a.kposbase = kstart; a.kposstep = 64; a.ntiles = (kend - kstart) >> 6;
      a.qcol = 768 + h * 64; a.kcol = 768 + 256 + (h >> 1) * 64; a.vcol = 768 + 384 + (h >> 1) * 64; a.ocol = 256 + h * 64;
      a.gq = p.qkn_b + l * 128; a.gk = a.gq + 64;
      a.qscale = 0.125f * LOG2E;
      a.hw = 128; a.rmul = 1; a.sinkv = p.sink_b[l * 4 + h] * LOG2E;
      attn_item<1, 1, 1>(p, a, Ks, Vts, tab);
    } else {
      const int id = item - nD - nA - nB;
      const int b = id / 96, rem = id % 96, g = rem >> 5, i2 = (rem >> 4) & 1, blk = rem & 15;
      const int r = g == 0 ? 1 : (g == 1 ? 4 : 16);
      const int L = SEQL / r, bps = L >> 7;
      const int pp = blk / bps, m0 = (blk % bps) * 128;
      const int hh = g * 2 + i2;
      for (int i = tid; i < 257; i += NTHR) tab[i] = p.lut[(4 + hh) * 257 + i];
      const int kstart = m0 - 64 < 0 ? 0 : m0 - 64, kend = m0 + 192 > L ? L : m0 + 192;
      a.qbase = b * SEQL + pp; a.qstride = r; a.qpos0 = m0;
      a.ktokbase = a.qbase + kstart * r; a.ktokstep = 64 * r; a.kstride = r; a.kposbase = kstart; a.kposstep = 64; a.ntiles = (kend - kstart) >> 6;
      a.qcol = 1280 + hh * 64; a.kcol = 1280 + 384 + hh * 64; a.vcol = 1280 + 768 + hh * 64; a.ocol = 512 + hh * 64;
      a.gq = p.qkn_c + l * 128; a.gk = a.gq + 64;
      a.qscale = 0.125f * LOG2E;
      a.hw = 64; a.rmul = r; a.lsecol = hh;
      attn_item<1, 1, 2>(p, a, Ks, Vts, tab);
    }
  }
}

__device__ __forceinline__ void combine_phase(const Params& p) {
  const int nthr = gridDim.x * NTHR;
  for (int i = blockIdx.x * NTHR + opaque_tid(); i < NTOK * 48; i += nthr) {
    const int tok = i / 48, rem = i % 48, hh = rem >> 3, ch = rem & 7, ii = hh & 1, g = hh >> 1;
    const float* ls = p.lse + (size_t)tok * 6;
    const float l0 = ls[ii], l1 = ls[2 + ii], l2 = ls[4 + ii];
    const float mx = fmaxf(l0, fmaxf(l1, l2));
    const float e0 = __expf(l0 - mx), e1 = __expf(l1 - mx), e2 = __expf(l2 - mx);
    const float al = (g == 0 ? e0 : (g == 1 ? e1 : e2)) / (e0 + e1 + e2);
    bf16_t* ptr = p.hbuf + blk_off(tok, 512 + hh * 64 + ch * 8, NTOK);
    u32x4 v = *(const u32x4*)ptr;
#pragma unroll
    for (int k = 0; k < 4; ++k) v[k] = pk_bf16(bf_lo(v[k]) * al, bf_hi(v[k]) * al);
    *(u32x4*)ptr = v;
  }
}


#ifndef REP_GEMM
#define REP_GEMM 1
#endif
#ifndef REP_ATTN
#define REP_ATTN 1
#endif
#ifndef DBG_STOP
#define DBG_STOP 0
#endif
__global__ void __launch_bounds__(NTHR, 2) fwd_megakernel(Params p) {
  extern __shared__ __attribute__((aligned(16))) char smem[];
  cg::grid_group grid = cg::this_grid();
  prologue_phase(p, smem);
  grid.sync();
#define LAYER(L)                                                                                                   \
  {                                                                                                                \
    constexpr int l = (L);                                                                                         \
    constexpr bool first = (l == 0);                                                                               \
    const bf16_t* wt = p.wt + (size_t)l * WT_LAYER;                                                                \
    norm_phase(p, l, first, p.norm_attn_g + l * DM, 0, 1024);                                                      \
    grid.sync();                                                                                                   \
    gemm_phase<0>(p, l, false, p.hbuf, 3200, wt + WT_IN, 1024, 384, 13, 13, p.proj, PW, 0, smem);                  \
    grid.sync();                                                                                                   \
    attn_phase(p, l, smem);                                                                                        \
    grid.sync();                                                                                                   \
    combine_phase(p);                                                                                              \
    grid.sync();                                                                                                   \
    gemm_phase<1>(p, l, first, p.hbuf, 1024, wt + WT_OUT, 1152, 384, 4, 4, nullptr, 0, 2048, smem);                \
    grid.sync();                                                                                                   \
    norm_phase(p, l, false, p.norm_ffn_g + l * DM, 3072, 4096);                                                    \
    grid.sync();                                                                                                   \
    gemm_phase<2>(p, l, false, p.hbuf, 5632, wt + WT_UP, 1024, 408, 22, 22, p.proj, DFF, 0, smem);                 \
    grid.sync();                                                                                                   \
    gemm_phase<1>(p, l, false, p.proj, 1024, wt + WT_DOWN, 2816, 384, 4, 4, nullptr, 0, 5120, smem);               \
    grid.sync();                                                                                                   \
  }
  LAYER(0)
  LAYER(1)
  LAYER(2)
  LAYER(3)
#undef LAYER
}

extern "C" void kernel_launch(void* const* d_in, const int* in_sizes, int n_in, void* d_out, int out_size, void* d_ws, size_t ws_size,
                              hipStream_t stream) {
  static int grid_blocks = 0;
  if (!grid_blocks) {
    int dev = 0, cus = 0, per_cu = 0;
    hipGetDevice(&dev);
    hipDeviceGetAttribute(&cus, hipDeviceAttributeMultiprocessorCount, dev);
    hipFuncSetAttribute((const void*)fwd_megakernel, hipFuncAttributeMaxDynamicSharedMemorySize, SMEM_BYTES);
    hipOccupancyMaxActiveBlocksPerMultiprocessor(&per_cu, fwd_megakernel, NTHR, SMEM_BYTES);
    if (per_cu > 1) per_cu = 1;
    if (per_cu < 1) per_cu = 1;
    grid_blocks = cus * per_cu;
  }
  Params p{};
  const float* const* in = (const float* const*)d_in;
  p.x_prompt = in[0]; p.x_sample = in[1]; p.c_prompt = in[2]; p.c_sample = in[3]; p.norm_attn_g = in[4]; p.norm_ffn_g = in[5];
  p.w_ada = in[6]; p.b_ada = in[7]; p.w_in = in[8]; p.qkn_a = in[9]; p.qkn_b = in[10]; p.qkn_c = in[11]; p.qkn_d = in[12];
  p.rpb_a = in[13]; p.sink_b = in[14]; p.t5_table = in[15]; p.lam_d = in[16]; p.subln_d = in[17]; p.w_out = in[18]; p.w_up = in[19];
  p.conv_w = in[20]; p.conv_b = in[21]; p.w_down = in[22];
  p.out = (float*)d_out;
  char* ws = (char*)d_ws;
  size_t off = 0;
  p.wt = (bf16_t*)(ws + off); off += (size_t)4 * WT_LAYER * 2;
  p.mod = (float*)(ws + off); off += (size_t)4 * 48 * 6144 * 4;
  p.lut = (float*)(ws + off); off += 16384;
  p.lam = (float*)(ws + off); off += 256;
  p.zeros = (float*)(ws + off); off += 256;
  p.lse = (float*)(ws + off); off += (size_t)NTOK * 6 * 4;
  p.proj = (bf16_t*)(ws + off); off += (size_t)NTOK * PW * 2;
  p.hbuf = (bf16_t*)(ws + off); off += (size_t)NTOK * MW * 2;
  if (off > ws_size) { fprintf(stderr, "workspace too small: need %zu have %zu\n", off, ws_size); return; }
  void* args[] = {&p};
  hipError_t e = hipLaunchCooperativeKernel((void*)fwd_megakernel, dim3(grid_blocks), dim3(NTHR), args, SMEM_BYTES, stream);
  if (e != hipSuccess) fprintf(stderr, "cooperative launch failed: %s (grid %d)\n", hipGetErrorString(e), grid_blocks);
}
```

```cpp
#include <hip/hip_runtime.h>
#include <hip/hip_cooperative_groups.h>
#include <cstdint>
#include <cstdio>
namespace cg = cooperative_groups;

typedef unsigned short bf16_t;
typedef short bf16x8 __attribute__((ext_vector_type(8)));
typedef float f32x4 __attribute__((ext_vector_type(4)));
typedef unsigned u32x4 __attribute__((ext_vector_type(4)));
typedef unsigned u32x2 __attribute__((ext_vector_type(2)));

#define NTOK 98304
#define DM 1024
#define PW 3200
#define MW 1152
#define DFF 2816
#define NSEQ 48
#define SEQL 2048
#define LOG2E 1.4426950408889634f
#define LN2 0.6931471805599453f
#define LDSROW 72
#define NTHR 512
#define NWAVE 8

struct Params {
  const float *x_prompt, *x_sample, *c_prompt, *c_sample, *norm_attn_g, *norm_ffn_g, *w_ada, *b_ada, *w_in;
  const float *qkn_a, *qkn_b, *qkn_c, *qkn_d, *rpb_a, *sink_b, *t5_table, *lam_d, *subln_d, *w_out, *w_up, *conv_w, *conv_b, *w_down;
  float* out;
  bf16_t* wt; float* mod; float* lut; float* lam; float* lse; bf16_t* proj; bf16_t* hbuf; float* zeros;
};

#define WT_IN 0
#define WT_OUT (3200 * 1024)
#define WT_UP (WT_OUT + 1024 * 1152)
#define WT_DOWN (WT_UP + 5632 * 1024)
#define WT_LAYER (WT_DOWN + 1024 * 2816)

typedef __bf16 bf16x2_t __attribute__((ext_vector_type(2)));
typedef float f32x2_t __attribute__((ext_vector_type(2)));
__device__ __forceinline__ unsigned pk_bf16(float lo, float hi) {
  const f32x2_t v = {lo, hi};
  const bf16x2_t r = __builtin_convertvector(v, bf16x2_t);
  return __builtin_bit_cast(unsigned, r);
}
__device__ __forceinline__ float bf_lo(unsigned u) { return __uint_as_float(u << 16); }
__device__ __forceinline__ float bf_hi(unsigned u) { return __uint_as_float(u & 0xffff0000u); }
__device__ __forceinline__ float fexp2(float x) { return __builtin_amdgcn_exp2f(x); }

__device__ __forceinline__ const float* xin_row(const Params& p, bool first, int tok) {
  if (first) return tok < 65536 ? p.x_prompt + (size_t)tok * DM : p.x_sample + (size_t)(tok - 65536) * DM;
  return p.out + (size_t)tok * DM;
}

__device__ __forceinline__ int opaque_tid() { int t = threadIdx.x; asm volatile("" : "+v"(t)); return t; }

__device__ __forceinline__ size_t blk_off(int r, int k, int R) { return ((size_t)(k >> 5) * R + r) * 32 + (k & 31); }

__device__ __forceinline__ int t5_bucket(int rel) {
  const int n = rel < 0 ? -rel : rel;
  int v;
  if (n < 8) v = n;
  else v = 8 + (n >= 12) + (n >= 16) + (n >= 23) + (n >= 32) + (n >= 46) + (n >= 64) + (n >= 91);
  return (rel > 0 ? 16 : 0) + v;
}

__device__ __forceinline__ void prologue_phase(const Params& p, char* smem) {
  const int tid = opaque_tid(), nb = gridDim.x;
  const int N_TR = 4 * 3200, N_MOD = 192;
  for (int item = blockIdx.x; item < N_TR + N_MOD + 1; item += nb) {
    if (item < N_TR) {
      const int l = item / 3200; int r = item % 3200;
      const float* src; bf16_t* dst; int K, N, kt, nt;
      if (r < 800) { K = 1024; N = 3200; src = p.w_in + (size_t)l * K * N; dst = p.wt + (size_t)l * WT_LAYER + WT_IN; kt = r / 50; nt = r % 50; }
      else if (r < 1088) { r -= 800; K = 1152; N = 1024; src = p.w_out + (size_t)l * K * N; dst = p.wt + (size_t)l * WT_LAYER + WT_OUT; kt = r / 16; nt = r % 16; }
      else if (r < 2496) { r -= 1088; K = 1024; N = 5632; src = p.w_up + (size_t)l * K * N; dst = p.wt + (size_t)l * WT_LAYER + WT_UP; kt = r / 88; nt = r % 88; }
      else { r -= 2496; K = 2816; N = 1024; src = p.w_down + (size_t)l * K * N; dst = p.wt + (size_t)l * WT_LAYER + WT_DOWN; kt = r / 16; nt = r % 16; }
      float* tile = (float*)smem;
      const int k0 = kt * 64, n0 = nt * 64;
      __syncthreads();
#pragma unroll
      for (int i = 0; i < 8; ++i) {
        const int rr = (tid >> 6) + 8 * i, cc = tid & 63;
        tile[rr * 65 + cc] = src[(size_t)(k0 + rr) * N + n0 + cc];
      }
      __syncthreads();
#pragma unroll
      for (int i = 0; i < 4; ++i) {
        const int idx = tid + NTHR * i, n = idx >> 5, k2 = (idx & 31) * 2;
        *(unsigned*)(dst + blk_off(n0 + n, k0 + k2, N)) = pk_bf16(tile[k2 * 65 + n], tile[(k2 + 1) * 65 + n]);
      }
    } else if (item < N_TR + N_MOD) {
      int r = item - N_TR;
      const int l = r / 48; r %= 48;
      const int nc = r / 4, bg = r % 4;
      const int n = nc * NTHR + tid;
      float* sc = (float*)smem;
      float acc[12];
#pragma unroll
      for (int j = 0; j < 12; ++j) acc[j] = 0.f;
      const float* W = p.w_ada + (size_t)l * 1024 * 6144 + n;
      for (int kc = 0; kc < 2; ++kc) {
        __syncthreads();
        for (int i = tid; i < 12 * 512; i += NTHR) {
          const int j = i >> 9, k = i & 511, b = bg * 12 + j;
          const float c = b < 32 ? p.c_prompt[b * 1024 + kc * 512 + k] : p.c_sample[(b - 32) * 1024 + kc * 512 + k];
          sc[i] = c / (1.f + __expf(-c));
        }
        __syncthreads();
#pragma unroll 2
        for (int k = 0; k < 512; k += 4) {
          const float w0 = W[(size_t)(kc * 512 + k) * 6144], w1 = W[(size_t)(kc * 512 + k + 1) * 6144];
          const float w2 = W[(size_t)(kc * 512 + k + 2) * 6144], w3 = W[(size_t)(kc * 512 + k + 3) * 6144];
#pragma unroll
          for (int j = 0; j < 12; ++j) {
            const f32x4 s = *(const f32x4*)(sc + j * 512 + k);
            acc[j] += s[0] * w0 + s[1] * w1 + s[2] * w2 + s[3] * w3;
          }
        }
      }
      const float bias = p.b_ada[l * 6144 + n];
#pragma unroll
      for (int j = 0; j < 12; ++j) p.mod[((size_t)l * 48 + bg * 12 + j) * 6144 + n] = acc[j] + bias;
    } else {
      for (int i = tid; i < 14 * 257; i += NTHR) {
        const int hd = i / 257, idx = i % 257;
        p.lut[i] = p.t5_table[t5_bucket(idx - 128) * 14 + hd] * LOG2E;
      }
      if (tid < 64) p.zeros[tid] = 0.f;
      if (tid < 4) {
        const float* lp = p.lam_d + tid * 128;
        float s1 = 0.f, s2 = 0.f;
        for (int e = 0; e < 32; ++e) { s1 += lp[e] * lp[32 + e]; s2 += lp[64 + e] * lp[96 + e]; }
        const float li = 0.8f - 0.6f * expf(-0.3f * (float)tid);
        p.lam[tid] = expf(s1) - expf(s2) + li;
      }
      {
        const int pr = tid >> 5, ln = tid & 31, l = pr >> 2, m = pr & 3;
        const float* g = m == 0 ? p.qkn_a + l * 128 : (m == 1 ? p.qkn_b + l * 128 : (m == 2 ? p.qkn_c + l * 128 : p.qkn_d + l * 64));
        const int dd = m == 3 ? 32 : 64;
        float gq = 0.f, gk = 0.f, bmax = 0.f;
        for (int i = ln; i < dd; i += 32) { gq = fmaxf(gq, fabsf(g[i])); gk = fmaxf(gk, fabsf(g[dd + i])); }
        if (m == 0) { const float* rp = p.rpb_a + (size_t)l * 4 * 465; for (int i = ln; i < 4 * 465; i += 32) bmax = fmaxf(bmax, rp[i]); }
        else { for (int i = ln; i < 32 * 14; i += 32) bmax = fmaxf(bmax, p.t5_table[i]); }
#pragma unroll
        for (int o = 16; o >= 1; o >>= 1) { gq = fmaxf(gq, __shfl_xor(gq, o)); gk = fmaxf(gk, __shfl_xor(gk, o)); bmax = fmaxf(bmax, __shfl_xor(bmax, o)); }
        const float scale = m == 3 ? 0.17677669529663687f : 0.125f;
        if (ln == 0) p.lam[4 + pr] = ((float)dd * gq * gk * scale + bmax) * LOG2E;
      }
    }
  }
}

__device__ __forceinline__ void norm_phase(const Params& p, int l, bool first, const float* g, int shift_off, int scale_off) {
  const int tid0 = opaque_tid();
  const int lane = tid0 & 63, w = tid0 >> 6;
  const int stride = gridDim.x * NWAVE;
  for (int row0 = blockIdx.x * NWAVE + w; row0 < NTOK; row0 += 2 * stride) {
    const int row1 = row0 + stride;
    const bool has1 = row1 < NTOK;
    const int rows[2] = {row0, has1 ? row1 : row0};
    f32x4 v[2][4];
    float ss[2] = {0.f, 0.f};
#pragma unroll
    for (int r = 0; r < 2; ++r) {
      const float* xr = xin_row(p, first, rows[r]);
#pragma unroll
      for (int i = 0; i < 4; ++i) v[r][i] = *(const f32x4*)(xr + i * 256 + lane * 4);
    }
#pragma unroll
    for (int r = 0; r < 2; ++r) {
#pragma unroll
      for (int i = 0; i < 4; ++i) ss[r] += v[r][i][0] * v[r][i][0] + v[r][i][1] * v[r][i][1] + v[r][i][2] * v[r][i][2] + v[r][i][3] * v[r][i][3];
#pragma unroll
      for (int o = 32; o >= 1; o >>= 1) ss[r] += __shfl_xor(ss[r], o);
    }
#pragma unroll
    for (int r = 0; r < 2; ++r) {
      if (r == 1 && !has1) break;
      const int row = rows[r];
      const float* md = p.mod + ((size_t)l * 48 + (row >> 11)) * 6144;
      const float rstd = rsqrtf(ss[r] * (1.f / 1024.f) + 1e-6f);
#pragma unroll
      for (int i = 0; i < 4; ++i) {
        const int k = i * 256 + lane * 4;
        const f32x4 gg = *(const f32x4*)(g + k), sc = *(const f32x4*)(md + scale_off + k), sh = *(const f32x4*)(md + shift_off + k);
        f32x4 y;
#pragma unroll
        for (int j = 0; j < 4; ++j) y[j] = (v[r][i][j] * rstd) * gg[j] * (1.f + sc[j]) + sh[j];
        u32x2 o; o[0] = pk_bf16(y[0], y[1]); o[1] = pk_bf16(y[2], y[3]);
        *(u32x2*)(p.hbuf + blk_off(row, k, NTOK)) = o;
      }
    }
  }
}

__device__ __forceinline__ bool gemm_tile_id(int it, int MT, int NT, int NB, int& mt, int& nt) {
  const int nb = gridDim.x, bid = blockIdx.x;
  if ((nb & 7) == 0) {
    const int x = bid & 7, slot = bid >> 3, S = nb >> 3;
    const int TPS = 8 * NB, NSN = NT / NB, NS = (MT / 8) * NSN;
    const int pidx = slot + S * it, sidx = pidx / TPS, w = pidx % TPS, s = x + 8 * sidx;
    if (s >= NS) return false;
    mt = (s / NSN) * 8 + (w & 7); nt = (s % NSN) * NB + (w >> 3);
    return true;
  }
  const int t = bid + nb * it;
  if (t >= MT * NT) return false;
  mt = t / NT; nt = t % NT;
  return true;
}

template <int M, int NN>
__device__ __forceinline__ void up_epi_row(const f32x4 (&acc)[8][4], const float* cw, const float* cb, int cbase, int lane, int fr, int s0, bf16_t* obase) {
  constexpr int MP = M > 0 ? M - 1 : 0, MN = M < 7 ? M + 1 : 7;
  const int srcp = (lane & 48) | ((fr + 15) & 15), srcn = (lane & 48) | ((fr + 1) & 15);
  float y[2][4];
#pragma unroll
  for (int n = 0; n < 2; ++n) {
    const int c = n * DFF + cbase;
    const f32x4 w0 = *(const f32x4*)(cw + c), w1 = *(const f32x4*)(cw + 5632 + c), w2 = *(const f32x4*)(cw + 2 * 5632 + c), bb = *(const f32x4*)(cb + c);
#pragma unroll
    for (int j = 0; j < 4; ++j) {
      const float cur = acc[M][NN + 2 * n][j];
      const float zp = (fr == 15) ? acc[MP][NN + 2 * n][j] : cur, zn = (fr == 0) ? acc[MN][NN + 2 * n][j] : cur;
      const float pv = __shfl(zp, srcp), nv = __shfl(zn, srcn);
      y[n][j] = w0[j] * pv + w1[j] * cur + w2[j] * nv + bb[j];
    }
  }
  const int row = 16 * M + fr, tpos = s0 + row;
  if (row >= 1 && row <= 126 && tpos >= 0 && tpos < SEQL) {
    float a[4];
#pragma unroll
    for (int j = 0; j < 4; ++j) { const float gte = y[1][j]; a[j] = y[0][j] * gte / (1.f + __expf(-gte)); }
    u32x2 o; o[0] = pk_bf16(a[0], a[1]); o[1] = pk_bf16(a[2], a[3]);
    *(u32x2*)(obase + (size_t)tpos * 32) = o;
  }
  __builtin_amdgcn_sched_barrier(0);
}

#define GB_A 16384
#define GB_BUF 32768
#define NSTAGE 2
#define SMEM_BYTES (NSTAGE * GB_BUF)
template <int EPI>
__device__ __forceinline__ void gemm_phase(const Params& p, int l, bool first, const bf16_t* A, int NBROWS, const bf16_t* Bt, int K, int MT, int NT, int NB,
                           bf16_t* outb, int ldc, int gate_off, char* smem) {
  const int tid = opaque_tid(), lane = tid & 63, w = tid >> 6, wr = w >> 2, wcn = w & 3, fr = lane & 15, fq = lane >> 4;
  const int nk = K / 32;
  const int lrow = tid >> 2, lch = (tid & 3) ^ ((tid >> 4) & 3);
  const int fsw = (fq ^ ((fr >> 2) & 3)) * 16;
  const size_t apan = (size_t)NTOK * 32, bpan = (size_t)NBROWS * 32;
  const bf16_t* ga0; const bf16_t* ga1; const bf16_t* gb0;
  size_t bstr;
#define GEMM_PTRS(MT_, NT_)                                                                                                          \
  {                                                                                                                                  \
    int t_ = tid; asm volatile("" : "+v"(t_));                                                                                       \
    const int lrow_ = t_ >> 2, lch_ = (t_ & 3) ^ ((t_ >> 4) & 3);                                                                    \
    if (EPI == 2) {                                                                                                                  \
      const int wi0 = 2 * (MT_), wi1 = wi0 + 1;                                                                                      \
      const int t0 = 126 * (wi0 % 17) - 1 + lrow_, t1 = 126 * (wi1 % 17) - 1 + lrow_;                                                \
      ga0 = A + ((size_t)(wi0 / 17) * SEQL + t0) * 32 + lch_ * 8;                                                                    \
      ga1 = A + ((size_t)(wi1 / 17) * SEQL + t1) * 32 + lch_ * 8;                                                                    \
      gb0 = Bt + (size_t)((NT_) * 128 + lrow_) * 32 + lch_ * 8; bstr = (size_t)DFF * 32;                                             \
    } else {                                                                                                                         \
      ga0 = A + (size_t)((MT_) * 256 + lrow_) * 32 + lch_ * 8; ga1 = ga0 + (size_t)128 * 32;                                         \
      gb0 = Bt + (size_t)((NT_) * 256 + lrow_) * 32 + lch_ * 8; bstr = (size_t)128 * 32;                                             \
    }                                                                                                                                \
  }
#define GEMM_LOAD(KT, SET)                                                                                                           \
    {                                                                                                                                \
      const size_t ko_ = (size_t)(KT) * apan, kb_ = (size_t)(KT) * bpan;                                                             \
      asm volatile("global_load_dwordx4 %0, %1, off" : "=v"(SET[0]) : "v"(ga0 + ko_) : "memory");                                     \
      asm volatile("global_load_dwordx4 %0, %1, off" : "=v"(SET[1]) : "v"(ga1 + ko_) : "memory");                                     \
      asm volatile("global_load_dwordx4 %0, %1, off" : "=v"(SET[2]) : "v"(gb0 + kb_) : "memory");                                     \
      asm volatile("global_load_dwordx4 %0, %1, off" : "=v"(SET[3]) : "v"(gb0 + bstr + kb_) : "memory");                              \
    }
#define GEMM_WRITE(SET, STAGE)                                                                                                       \
    {                                                                                                                                \
      asm volatile("" : "+v"(SET[0]), "+v"(SET[1]), "+v"(SET[2]), "+v"(SET[3]));      \
      char* dst_ = smem + (STAGE) * GB_BUF + tid * 16;                                                                               \
      *(u32x4*)(dst_) = SET[0]; *(u32x4*)(dst_ + 8192) = SET[1]; *(u32x4*)(dst_ + GB_A) = SET[2]; *(u32x4*)(dst_ + GB_A + 8192) = SET[3]; \
    }
#define GEMM_KSTEP(KT, WSET)                                                                                                         \
    {                                                                                                                                \
      asm volatile("s_waitcnt lgkmcnt(0)" ::: "memory");                                                                             \
      __builtin_amdgcn_s_barrier();                   \
      if ((KT) + 1 < nk) {                                                                                                           \
        if ((KT) + 2 < nk) asm volatile("s_waitcnt vmcnt(4)" ::: "memory"); else asm volatile("s_waitcnt vmcnt(0)" ::: "memory");     \
        GEMM_WRITE(WSET, ((KT) + 1) & 1)                                                                                             \
        if ((KT) + 3 < nk) GEMM_LOAD((KT) + 3, WSET)                                                                                 \
      }                                                                                                                              \
      const char* Ab = smem + ((KT) & 1) * GB_BUF;                                                                                   \
      const char* Bb = Ab + GB_A;                                                                                                    \
      bf16x8 bfr[4];                                                                                                                 \
      _Pragma("unroll") for (int n = 0; n < 4; ++n) {                                                                                \
        const int br = (EPI == 2) ? ((n >> 1) * 128 + 32 * wcn + 16 * (n & 1) + fr) : (64 * wcn + 16 * n + fr);                      \
        bfr[n] = *(const bf16x8*)(Bb + br * 64 + fsw);                                                                               \
      }                                                                                                                              \
      const char* Ap = Ab + (wr * 128 + fr) * 64 + fsw;                                                                              \
      bf16x8 af0 = *(const bf16x8*)(Ap), af1 = *(const bf16x8*)(Ap + 16 * 64);                                                       \
      _Pragma("unroll") for (int pr = 0; pr < 4; ++pr) {                                                                             \
        bf16x8 an0 = af0, an1 = af1;                                                                                                 \
        if (pr < 3) { an0 = *(const bf16x8*)(Ap + (2 * pr + 2) * 16 * 64); an1 = *(const bf16x8*)(Ap + (2 * pr + 3) * 16 * 64); }    \
        __builtin_amdgcn_sched_barrier(0);                                                                                           \
        _Pragma("unroll") for (int n = 0; n < 4; ++n) acc[2 * pr][n] = __builtin_amdgcn_mfma_f32_16x16x32_bf16(bfr[n], af0, acc[2 * pr][n], 0, 0, 0); \
        _Pragma("unroll") for (int n = 0; n < 4; ++n) acc[2 * pr + 1][n] = __builtin_amdgcn_mfma_f32_16x16x32_bf16(bfr[n], af1, acc[2 * pr + 1][n], 0, 0, 0); \
        __builtin_amdgcn_sched_barrier(0);                                                                                           \
        af0 = an0; af1 = an1;                                                                                                        \
      }                                                                                                                              \
    }
  int mt, nt;
  bool have = gemm_tile_id(0, MT, NT, NB, mt, nt);
  for (int it = 0; have; ++it) {
    GEMM_PTRS(mt, nt)
    u32x4 rsA[4], rsB[4];
    f32x4 acc[8][4];
#pragma unroll
    for (int m = 0; m < 8; ++m)
#pragma unroll
      for (int n = 0; n < 4; ++n) acc[m][n] = (f32x4){0.f, 0.f, 0.f, 0.f};
    asm volatile("s_waitcnt vmcnt(0) lgkmcnt(0)" ::: "memory");
    __builtin_amdgcn_s_barrier();
    GEMM_LOAD(0, rsA)
    GEMM_LOAD(1, rsB)
    asm volatile("s_waitcnt vmcnt(4)" ::: "memory");
    GEMM_WRITE(rsA, 0)
    GEMM_LOAD(2, rsA)
    for (int kt = 0; kt < nk; kt += 2) {
      GEMM_KSTEP(kt, rsB)
      GEMM_KSTEP(kt + 1, rsA)
    }
    const int mt_e = mt, nt_e = nt;
    have = gemm_tile_id(it + 1, MT, NT, NB, mt, nt);
    int lane_e = lane; asm volatile("" : "+v"(lane_e));
    const int fr_e = lane_e & 15, fq_e = lane_e >> 4;
    if (EPI == 0) {
      if (nt_e * 256 + 64 * wcn < NBROWS) {
#pragma unroll
        for (int m = 0; m < 8; ++m) {
          const int tok = mt_e * 256 + wr * 128 + 16 * m + fr_e;
#pragma unroll
          for (int n = 0; n < 4; ++n) {
            const int col = nt_e * 256 + 64 * wcn + 16 * n + 4 * fq_e;
            u32x2 o; o[0] = pk_bf16(acc[m][n][0], acc[m][n][1]); o[1] = pk_bf16(acc[m][n][2], acc[m][n][3]);
            *(u32x2*)(outb + (size_t)tok * ldc + col) = o;
          }
        }
      }
    } else if (EPI == 1) {
      const int b = (mt_e * 256) >> 11;
      const float* gate = p.mod + ((size_t)l * 48 + b) * 6144 + gate_off;
#pragma unroll
      for (int n = 0; n < 4; ++n) {
        const int col = nt_e * 256 + 64 * wcn + 16 * n + 4 * fq_e;
        const f32x4 gv = *(const f32x4*)(gate + col);
#pragma unroll
        for (int m = 0; m < 8; ++m) {
          const int tok = mt_e * 256 + wr * 128 + 16 * m + fr_e;
          const f32x4 xv = *(const f32x4*)(xin_row(p, first, tok) + col);
          f32x4 o;
#pragma unroll
          for (int j = 0; j < 4; ++j) o[j] = xv[j] + gv[j] * acc[m][n][j];
          *(f32x4*)(p.out + (size_t)tok * DM + col) = o;
        }
      }
    } else {
      const float* cw = p.conv_w + (size_t)l * 3 * 5632;
      const float* cb = p.conv_b + (size_t)l * 5632;
      const int wi = 2 * mt_e + wr, seq = wi / 17, s0 = 126 * (wi % 17) - 1;
      if (s0 < 0 || s0 + 127 >= SEQL) {
#pragma unroll
        for (int m = 0; m < 8; ++m) {
          const int tp = s0 + 16 * m + fr_e;
          if (tp < 0 || tp >= SEQL) {
#pragma unroll
            for (int n = 0; n < 4; ++n) acc[m][n] = (f32x4){0.f, 0.f, 0.f, 0.f};
          }
        }
      }
#define UP_EPI_NN(NN)                                                                                                      \
      {                                                                                                                    \
        const int cbase = nt_e * 128 + 32 * wcn + 16 * NN + 4 * fq_e;                                                        \
        bf16_t* obase = outb + blk_off(seq * SEQL, cbase, NTOK);                                                           \
        up_epi_row<0, NN>(acc, cw, cb, cbase, lane_e, fr_e, s0, obase); up_epi_row<1, NN>(acc, cw, cb, cbase, lane_e, fr_e, s0, obase); \
        up_epi_row<2, NN>(acc, cw, cb, cbase, lane_e, fr_e, s0, obase); up_epi_row<3, NN>(acc, cw, cb, cbase, lane_e, fr_e, s0, obase); \
        up_epi_row<4, NN>(acc, cw, cb, cbase, lane_e, fr_e, s0, obase); up_epi_row<5, NN>(acc, cw, cb, cbase, lane_e, fr_e, s0, obase); \
        up_epi_row<6, NN>(acc, cw, cb, cbase, lane_e, fr_e, s0, obase); up_epi_row<7, NN>(acc, cw, cb, cbase, lane_e, fr_e, s0, obase); \
      }
      UP_EPI_NN(0)
      UP_EPI_NN(1)
#undef UP_EPI_NN
    }
  }
#undef GEMM_LOAD
#undef GEMM_WRITE
#undef GEMM_KSTEP
#undef GEMM_PTRS
}

struct AttnArgs {
  int qbase, qstride, qpos0;
  int ktokbase, ktokstep, kstride, kposbase, kposstep, ntiles;
  int qcol, kcol, vcol, ocol;
  const float *gq, *gk;
  float qscale;
  int hw, rmul, taboff0;
  float sinkv;
  float lam, outscale;
  const float* subg;
  int lsecol;
  float cshift;
  int r0, rs0;
};

template <int NQ, int NC, int MODE>
__device__ __forceinline__ void attn_item(const Params& p, const AttnArgs& a, bf16_t* Ks, bf16_t* Vts, const float* tab) {
  const int tid = opaque_tid(), lane = tid & 63, w = tid >> 6, fr = lane & 15, fq = lane >> 4;
  const int wq0 = a.qpos0 + w * 16 * NQ;
  bf16x8 qf[NQ][2];
  int qpos[NQ];
#pragma unroll
  for (int qt = 0; qt < NQ; ++qt) {
    const int qp = wq0 + qt * 16 + fr;
    qpos[qt] = qp;
    const bf16_t* qrow = p.proj + (size_t)(a.qbase + qp * a.qstride) * PW + a.qcol;
    const u32x4 v0 = *(const u32x4*)(qrow + fq * 8), v1 = *(const u32x4*)(qrow + 32 + fq * 8);
    float f0[8], f1[8];
#pragma unroll
    for (int i = 0; i < 4; ++i) { f0[2 * i] = bf_lo(v0[i]); f0[2 * i + 1] = bf_hi(v0[i]); f1[2 * i] = bf_lo(v1[i]); f1[2 * i + 1] = bf_hi(v1[i]); }
    float s0 = 0.f, s1 = 0.f;
#pragma unroll
    for (int i = 0; i < 8; ++i) { s0 += f0[i] * f0[i]; s1 += f1[i] * f1[i]; }
    float r0, r1;
    if (NC == 1) {
      float s = s0 + s1; s += __shfl_xor(s, 16); s += __shfl_xor(s, 32);
      r0 = r1 = rsqrtf(s * (1.f / 64.f) + 1e-6f) * a.qscale;
    } else {
      s0 += __shfl_xor(s0, 16); s0 += __shfl_xor(s0, 32);
      s1 += __shfl_xor(s1, 16); s1 += __shfl_xor(s1, 32);
      r0 = rsqrtf(s0 * (1.f / 32.f) + 1e-6f) * a.qscale; r1 = rsqrtf(s1 * (1.f / 32.f) + 1e-6f) * a.qscale;
    }
    const float* g0p = a.gq + fq * 8;
    const float* g1p = (NC == 1) ? a.gq + 32 + fq * 8 : g0p;
    u32x4 q0, q1;
#pragma unroll
    for (int i = 0; i < 4; ++i) {
      q0[i] = pk_bf16(f0[2 * i] * r0 * g0p[2 * i], f0[2 * i + 1] * r0 * g0p[2 * i + 1]);
      q1[i] = pk_bf16(f1[2 * i] * r1 * g1p[2 * i], f1[2 * i + 1] * r1 * g1p[2 * i + 1]);
    }
    qf[qt][0] = __builtin_bit_cast(bf16x8, q0);
    qf[qt][1] = __builtin_bit_cast(bf16x8, q1);
  }
  f32x4 o[NC][NQ][4];
  float mrun[NC][NQ], lrun[NC][NQ];
#pragma unroll
  for (int c = 0; c < NC; ++c)
#pragma unroll
    for (int qt = 0; qt < NQ; ++qt) {
      mrun[c][qt] = a.cshift;
      if (MODE == 1) lrun[c][qt] = (fq == 0) ? fexp2(a.sinkv - a.cshift) : 0.f;
      else lrun[c][qt] = 0.f;
#pragma unroll
      for (int dt = 0; dt < 4; ++dt) o[c][qt][dt] = (f32x4){0.f, 0.f, 0.f, 0.f};
    }
  const int lch = tid & 7;
  float gkv[8];
#pragma unroll
  for (int i = 0; i < 8; ++i) gkv[i] = a.gk[((NC == 1) ? lch : (lch & 3)) * 8 + i];

  const int rw = a.r0 + ((w * 16 * NQ) >> 6);
  int rsw = rw - 4; rsw = rsw < 0 ? 0 : (rsw > 24 ? 24 : rsw);
  u32x4 kA, vA, kB, vB;
  const int kkey = tid >> 3, vkey = tid & 63, vch = tid >> 6;
#define ATTN_PREFETCH(T, KR, VR)                                                                                 \
  {                                                                                                              \
    const int ktok0_ = a.ktokbase + (T) * a.ktokstep;                                                            \
    KR = *(const u32x4*)(p.proj + (size_t)(ktok0_ + kkey * a.kstride) * PW + a.kcol + lch * 8);                   \
    VR = *(const u32x4*)(p.proj + (size_t)(ktok0_ + vkey * a.kstride) * PW + a.vcol + vch * 8);                   \
  }
  auto stage_write = [&](const u32x4& kr, const u32x4& vr, bf16_t* Ksb, bf16_t* Vtb) __attribute__((always_inline)) {
    float f[8];
#pragma unroll
    for (int i = 0; i < 4; ++i) { f[2 * i] = bf_lo(kr[i]); f[2 * i + 1] = bf_hi(kr[i]); }
    float s = 0.f;
#pragma unroll
    for (int i = 0; i < 8; ++i) s += f[i] * f[i];
    s += __shfl_xor(s, 1); s += __shfl_xor(s, 2);
    float rs;
    if (NC == 1) { s += __shfl_xor(s, 4); rs = rsqrtf(s * (1.f / 64.f) + 1e-6f); }
    else rs = rsqrtf(s * (1.f / 32.f) + 1e-6f);
    u32x4 kq;
#pragma unroll
    for (int i = 0; i < 4; ++i) kq[i] = pk_bf16(f[2 * i] * rs * gkv[2 * i], f[2 * i + 1] * rs * gkv[2 * i + 1]);
    *(u32x4*)(Ksb + kkey * LDSROW + lch * 8) = kq;
#pragma unroll
    for (int i = 0; i < 4; ++i) {
      Vtb[(vch * 8 + 2 * i) * LDSROW + vkey] = (bf16_t)(vr[i] & 0xffffu);
      Vtb[(vch * 8 + 2 * i + 1) * LDSROW + vkey] = (bf16_t)(vr[i] >> 16);
    }
  };
  auto tile_math = [&](int t, const bf16_t* Ksb, const bf16_t* Vtb) __attribute__((always_inline)) {
    if (MODE == 0) { const int kr_ = a.rs0 + t; if (kr_ < rsw || kr_ >= rsw + 8) return; }
    const int kp0 = a.kposbase + t * a.kposstep;
    const int taboff = (a.rs0 + t - rw + 7) * 31;
    bf16x8 pf[NC][NQ][2];
    bf16x8 kf[4][2];
#pragma unroll
    for (int kt = 0; kt < 4; ++kt) {
      kf[kt][0] = *(const bf16x8*)(Ksb + (kt * 16 + fr) * LDSROW + fq * 8);
      kf[kt][1] = *(const bf16x8*)(Ksb + (kt * 16 + fr) * LDSROW + 32 + fq * 8);
    }
    bf16x8 vfr[4][2];
#pragma unroll
    for (int ks = 0; ks < 2; ++ks)
#pragma unroll
      for (int dt = 0; dt < 4; ++dt) {
        const u32x2 lo = *(const u32x2*)(Vtb + (dt * 16 + fr) * LDSROW + ks * 32 + 4 * fq);
        const u32x2 hi = *(const u32x2*)(Vtb + (dt * 16 + fr) * LDSROW + ks * 32 + 16 + 4 * fq);
        u32x4 vv; vv[0] = lo[0]; vv[1] = lo[1]; vv[2] = hi[0]; vv[3] = hi[1];
        vfr[dt][ks] = __builtin_bit_cast(bf16x8, vv);
      }
#pragma unroll
    for (int qt = 0; qt < NQ; ++qt) {
      const int qp = (MODE == 0) ? (qpos[qt] & 63) : qpos[qt];
      int cs = qp - 8; cs = cs < 0 ? 0 : (cs > 48 ? 48 : cs);
      f32x4 bv[4];
      const bool far_hi = (MODE == 3) && (kp0 - (wq0 + 16 * NQ - 1) >= 128), far_lo = (MODE == 3) && (wq0 - (kp0 + 63) >= 128);
      if (far_hi || far_lo) {
        const float bu = tab[far_hi ? 256 : 0];
#pragma unroll
        for (int kt = 0; kt < 4; ++kt) bv[kt] = (f32x4){bu, bu, bu, bu};
      } else
#pragma unroll
      for (int kt = 0; kt < 4; ++kt)
#pragma unroll
        for (int j = 0; j < 4; ++j) {
          const int kpos = kp0 + kt * 16 + 4 * fq + j;
          const int d = kpos - qp;
          bool valid; int idx;
          if (MODE == 0) {
            valid = kpos >= cs && kpos < cs + 16;
            int dd = d + 15; dd = dd < 0 ? 0 : (dd > 30 ? 30 : dd);
            idx = taboff + dd;
          } else {
            valid = (MODE == 3) ? true : (d <= a.hw && d >= -a.hw);
            int dd = d * a.rmul; dd = dd < -128 ? -128 : (dd > 128 ? 128 : dd);
            idx = dd + 128;
          }
          const float bias = tab[idx];
          bv[kt][j] = valid ? bias : -INFINITY;
        }
#pragma unroll
      for (int c = 0; c < NC; ++c) {
        f32x4 s[4];
#pragma unroll
        for (int kt = 0; kt < 4; ++kt) {
          if (NC == 1) {
            const f32x4 r = __builtin_amdgcn_mfma_f32_16x16x32_bf16(kf[kt][0], qf[qt][0], bv[kt], 0, 0, 0);
            s[kt] = __builtin_amdgcn_mfma_f32_16x16x32_bf16(kf[kt][1], qf[qt][1], r, 0, 0, 0);
          } else {
            s[kt] = __builtin_amdgcn_mfma_f32_16x16x32_bf16(kf[kt][c], qf[qt][c], bv[kt], 0, 0, 0);
          }
        }
        float rs = 0.f;
#pragma unroll
        for (int kt = 0; kt < 4; ++kt)
#pragma unroll
          for (int j = 0; j < 4; ++j) { const float pv = fexp2(s[kt][j]); s[kt][j] = pv; rs += pv; }
        lrun[c][qt] += rs;
#pragma unroll
        for (int ks = 0; ks < 2; ++ks) {
          u32x4 pk;
          pk[0] = pk_bf16(s[2 * ks][0], s[2 * ks][1]); pk[1] = pk_bf16(s[2 * ks][2], s[2 * ks][3]);
          pk[2] = pk_bf16(s[2 * ks + 1][0], s[2 * ks + 1][1]); pk[3] = pk_bf16(s[2 * ks + 1][2], s[2 * ks + 1][3]);
          pf[c][qt][ks] = __builtin_bit_cast(bf16x8, pk);
        }
      }
    }
#pragma unroll
    for (int ks = 0; ks < 2; ++ks) {
#pragma unroll
      for (int dt = 0; dt < 4; ++dt) {
        const bf16x8 vf = vfr[dt][ks];
#pragma unroll
        for (int c = 0; c < NC; ++c)
#pragma unroll
          for (int qt = 0; qt < NQ; ++qt) o[c][qt][dt] = __builtin_amdgcn_mfma_f32_16x16x32_bf16(vf, pf[c][qt][ks], o[c][qt][dt], 0, 0, 0);
      }
    }
    };
  bf16_t* const Ks1 = Ks + 2 * 64 * LDSROW;
  bf16_t* const Vts1 = Vts + 2 * 64 * LDSROW;
  const int ntl = a.ntiles;
  ATTN_PREFETCH(0, kA, vA)
  if (ntl > 1) ATTN_PREFETCH(1, kB, vB)
  stage_write(kA, vA, Ks, Vts);
  if (ntl > 2) ATTN_PREFETCH(2, kA, vA)
  for (int t = 0; t < ntl; t += 2) {
    __syncthreads();
    if (t + 1 < ntl) { stage_write(kB, vB, Ks1, Vts1); if (t + 3 < ntl) ATTN_PREFETCH(t + 3, kB, vB) }
    tile_math(t, Ks, Vts);
    if (t + 1 < ntl) {
      __syncthreads();
      if (t + 2 < ntl) { stage_write(kA, vA, Ks, Vts); if (t + 4 < ntl) ATTN_PREFETCH(t + 4, kA, vA) }
      tile_math(t + 1, Ks1, Vts1);
    }
  }
#undef ATTN_PREFETCH
#pragma unroll
  for (int qt = 0; qt < NQ; ++qt) {
    float inv[NC], ltot[NC];
#pragma unroll
    for (int c = 0; c < NC; ++c) {
      float lt = lrun[c][qt];
      lt += __shfl_xor(lt, 16); lt += __shfl_xor(lt, 32);
      ltot[c] = lt; inv[c] = 1.f / lt;
    }
    const int tok = a.qbase + qpos[qt] * a.qstride;
    if (MODE == 3) {
      f32x4 v[4];
      float ss = 0.f;
#pragma unroll
      for (int dt = 0; dt < 4; ++dt)
#pragma unroll
        for (int j = 0; j < 4; ++j) {
          const float x = o[0][qt][dt][j] * inv[0] - a.lam * (o[NC - 1][qt][dt][j] * inv[NC - 1]);
          v[dt][j] = x; ss += x * x;
        }
      ss += __shfl_xor(ss, 16); ss += __shfl_xor(ss, 32);
      const float rstd = rsqrtf(ss * (1.f / 64.f) + 1e-6f) * a.outscale;
#pragma unroll
      for (int dt = 0; dt < 4; ++dt) {
        const f32x4 g = *(const f32x4*)(a.subg + dt * 16 + 4 * fq);
        u32x2 ov; ov[0] = pk_bf16(v[dt][0] * rstd * g[0], v[dt][1] * rstd * g[1]); ov[1] = pk_bf16(v[dt][2] * rstd * g[2], v[dt][3] * rstd * g[3]);
        *(u32x2*)(p.hbuf + blk_off(tok, a.ocol + dt * 16 + 4 * fq, NTOK)) = ov;
      }
    } else {
#pragma unroll
      for (int dt = 0; dt < 4; ++dt) {
        u32x2 ov;
        ov[0] = pk_bf16(o[0][qt][dt][0] * inv[0], o[0][qt][dt][1] * inv[0]);
        ov[1] = pk_bf16(o[0][qt][dt][2] * inv[0], o[0][qt][dt][3] * inv[0]);
        *(u32x2*)(p.hbuf + blk_off(tok, a.ocol + dt * 16 + 4 * fq, NTOK)) = ov;
      }
      if (MODE == 2 && fq == 0) p.lse[(size_t)tok * 6 + a.lsecol] = (mrun[0][qt] + __log2f(ltot[0])) * LN2;
    }
  }
}

__device__ __forceinline__ void attn_phase(const Params& p, int l, char* smem) {
  bf16_t* Ks = (bf16_t*)smem;
  bf16_t* Vts = Ks + 64 * LDSROW;
  float* tab = (float*)(Ks + 4 * 64 * LDSROW);
  const int tid = opaque_tid();
  const int nD = 3072, nA = 3072, nB = 3072, nC = 4608;
  for (int item = blockIdx.x; item < nD + nA + nB + nC; item += gridDim.x) {
    AttnArgs a;
    a.taboff0 = 0; a.r0 = 0; a.rs0 = 0; a.sinkv = 0.f; a.cshift = 0.f; a.lam = 0.f; a.outscale = 1.f; a.subg = nullptr; a.lsecol = 0; a.hw = 1 << 20; a.rmul = 1;
    __syncthreads();
    if (item < nD) {
      const int b = item >> 6, h = (item >> 4) & 3, qb = item & 15;
      a.cshift = p.lam[4 + l * 4 + 3];
      for (int i = tid; i < 257; i += NTHR) tab[i] = p.lut[(10 + h) * 257 + i] - a.cshift;
      a.qbase = b * SEQL; a.qstride = 1; a.qpos0 = qb * 128;
      a.ktokbase = b * SEQL; a.ktokstep = 64; a.kstride = 1; a.kposbase = 0; a.kposstep = 64; a.ntiles = 32;
      a.qcol = 2432 + h * 64; a.kcol = 2432 + 256 + h * 64; a.vcol = 2432 + 512 + h * 64; a.ocol = 896 + h * 64;
      a.gq = p.qkn_d + l * 64; a.gk = a.gq + 32;
      a.qscale = 0.17677669529663687f * LOG2E;
      a.lam = p.lam[l]; a.outscale = 1.f - (0.8f - 0.6f * expf(-0.3f * (float)l)); a.subg = p.subln_d + l * 64;
      attn_item<1, 2, 3>(p, a, Ks, Vts, tab);
    } else if (item < nD + nA) {
      const int id = item - nD;
      const int b = id >> 6, h = (id >> 4) & 3, r = (id & 15) * 2;
      const float* rp = p.rpb_a + ((size_t)l * 4 + h) * 465;
      a.cshift = p.lam[4 + l * 4 + 0];
      for (int i = tid; i < 465; i += NTHR) tab[i] = rp[i] * LOG2E - a.cshift;
      int rs = r - 4; rs = rs < 0 ? 0 : (rs > 24 ? 24 : rs);
      int rs1 = r - 3; rs1 = rs1 < 0 ? 0 : (rs1 > 24 ? 24 : rs1);
      a.qbase = b * SEQL + r * 64; a.qstride = 1; a.qpos0 = 0; a.r0 = r; a.rs0 = rs;
      a.ktokbase = b * SEQL + rs * 64; a.ktokstep = 64; a.kstride = 1; a.kposbase = 0; a.kposstep = 0; a.ntiles = rs1 - rs + 8;
      a.qcol = h * 64; a.kcol = 256 + h * 64; a.vcol = 512 + h * 64; a.ocol = h * 64;
      a.gq = p.qkn_a + l * 128; a.gk = a.gq + 64;
      a.qscale = 0.125f * LOG2E;
      attn_item<1, 1, 0>(p, a, Ks, Vts, tab);
    } else if (item < nD + nA + nB) {
      const int id = item - nD - nA;
      const int b = id >> 6, h = (id >> 4) & 3, qb = id & 15;
      a.cshift = p.lam[4 + l * 4 + 1];
      for (int i = tid; i < 257; i += NTHR) tab[i] = p.lut[h * 257 + i] - a.cshift;
      const int q0 = qb * 128;
      const int kstart = q0 - 128 < 0 ? 0 : q0 - 128, kend = q0 + 256 > SEQL ? SEQL : q0 + 256;
      a.qbase = b * SEQL; a.qstride = 1; a.qpos0 = q0;
      a.ktokbase = b * SEQL + kstart; a.ktokstep = 64; a.kstride = 1; a.kposbase = kstart; a.kposstep = 64; a.ntiles = (kend - kstart) >> 6;
      a.qcol = 768 + h * 64; a.kcol = 768 + 256 + (h >> 1) * 64; a.vcol = 768 + 384 + (h >> 1) * 64; a.ocol = 256 + h * 64;
      a.gq = p.qkn_b + l * 128; a.gk = a.gq + 64;
      a.qscale = 0.125f * LOG2E;
      a.hw = 128; a.rmul = 1; a.sinkv = p.sink_b[l * 4 + h] * LOG2E;
      attn_item<1, 1, 1>(p, a, Ks, Vts, tab);
    } else {
      const int id = item - nD - nA - nB;
      const int b = id / 96, rem = id % 96, g = rem >> 5, i2 = (rem >> 4) & 1, blk = rem & 15;
      const int r = g == 0 ? 1 : (g == 1 ? 4 : 16);
      const int L = SEQL / r, bps = L >> 7;
      const int pp = blk / bps, m0 = (blk % bps) * 128;
      const int hh = g * 2 + i2;
      a.cshift = p.lam[4 + l * 4 + 2];
      for (int i = tid; i < 257; i += NTHR) tab[i] = p.lut[(4 + hh) * 257 + i] - a.cshift;
      const int kstart = m0 - 64 < 0 ? 0 : m0 - 64, kend = m0 + 192 > L ? L : m0 + 192;
      a.qbase = b * SEQL + pp; a.qstride = r; a.qpos0 = m0;
      a.ktokbase = a.qbase + kstart * r; a.ktokstep = 64 * r; a.kstride = r; a.kposbase = kstart; a.kposstep = 64; a.ntiles = (kend - kstart) >> 6;
      a.qcol = 1280 + hh * 64; a.kcol = 1280 + 384 + hh * 64; a.vcol = 1280 + 768 + hh * 64; a.ocol = 512 + hh * 64;
      a.gq = p.qkn_c + l * 128; a.gk = a.gq + 64;
      a.qscale = 0.125f * LOG2E;
      a.hw = 64; a.rmul = r; a.lsecol = hh;
      attn_item<1, 1, 2>(p, a, Ks, Vts, tab);
    }
  }
}

__device__ __forceinline__ void combine_phase(const Params& p) {
  const int nthr = gridDim.x * NTHR;
  for (int i = blockIdx.x * NTHR + opaque_tid(); i < NTOK * 48; i += nthr) {
    const int tok = i / 48, rem = i % 48, hh = rem >> 3, ch = rem & 7, ii = hh & 1, g = hh >> 1;
    const float* ls = p.lse + (size_t)tok * 6;
    const float l0 = ls[ii], l1 = ls[2 + ii], l2 = ls[4 + ii];
    const float mx = fmaxf(l0, fmaxf(l1, l2));
    const float e0 = __expf(l0 - mx), e1 = __expf(l1 - mx), e2 = __expf(l2 - mx);
    const float al = (g == 0 ? e0 : (g == 1 ? e1 : e2)) / (e0 + e1 + e2);
    bf16_t* ptr = p.hbuf + blk_off(tok, 512 + hh * 64 + ch * 8, NTOK);
    u32x4 v = *(const u32x4*)ptr;
#pragma unroll
    for (int k = 0; k < 4; ++k) v[k] = pk_bf16(bf_lo(v[k]) * al, bf_hi(v[k]) * al);
    *(u32x4*)ptr = v;
  }
}


#ifndef REP_GEMM
#define REP_GEMM 1
#endif
#ifndef REP_ATTN
#define REP_ATTN 1
#endif
#ifndef DBG_STOP
#define DBG_STOP 0
#endif
__global__ void __launch_bounds__(NTHR, 2) fwd_megakernel(Params p) {
  extern __shared__ __attribute__((aligned(16))) char smem[];
  cg::grid_group grid = cg::this_grid();
  prologue_phase(p, smem);
  grid.sync();
#define LAYER(L)                                                                                                   \
  {                                                                                                                \
    constexpr int l = (L);                                                                                         \
    constexpr bool first = (l == 0);                                                                               \
    const bf16_t* wt = p.wt + (size_t)l * WT_LAYER;                                                                \
    norm_phase(p, l, first, p.norm_attn_g + l * DM, 0, 1024);                                                      \
    grid.sync();                                                                                                   \
    gemm_phase<0>(p, l, false, p.hbuf, 3200, wt + WT_IN, 1024, 384, 13, 13, p.proj, PW, 0, smem);                  \
    grid.sync();                                                                                                   \
    attn_phase(p, l, smem);                                                                                        \
    grid.sync();                                                                                                   \
    combine_phase(p);                                                                                              \
    grid.sync();                                                                                                   \
    gemm_phase<1>(p, l, first, p.hbuf, 1024, wt + WT_OUT, 1152, 384, 4, 4, nullptr, 0, 2048, smem);                \
    grid.sync();                                                                                                   \
    norm_phase(p, l, false, p.norm_ffn_g + l * DM, 3072, 4096);                                                    \
    grid.sync();                                                                                                   \
    gemm_phase<2>(p, l, false, p.hbuf, 5632, wt + WT_UP, 1024, 408, 22, 22, p.proj, DFF, 0, smem);                 \
    grid.sync();                                                                                                   \
    gemm_phase<1>(p, l, false, p.proj, 1024, wt + WT_DOWN, 2816, 384, 4, 4, nullptr, 0, 5120, smem);               \
    grid.sync();                                                                                                   \
  }
  LAYER(0)
  LAYER(1)
  LAYER(2)
  LAYER(3)
#undef LAYER
}

extern "C" void kernel_launch(void* const* d_in, const int* in_sizes, int n_in, void* d_out, int out_size, void* d_ws, size_t ws_size,
                              hipStream_t stream) {
  static int grid_blocks = 0;
  if (!grid_blocks) {
    int dev = 0, cus = 0, per_cu = 0;
    hipGetDevice(&dev);
    hipDeviceGetAttribute(&cus, hipDeviceAttributeMultiprocessorCount, dev);
    hipFuncSetAttribute((const void*)fwd_megakernel, hipFuncAttributeMaxDynamicSharedMemorySize, SMEM_BYTES);
    hipOccupancyMaxActiveBlocksPerMultiprocessor(&per_cu, fwd_megakernel, NTHR, SMEM_BYTES);
    if (per_cu > 1) per_cu = 1;
    if (per_cu < 1) per_cu = 1;
    grid_blocks = cus * per_cu;
  }
  Params p{};
  const float* const* in = (const float* const*)d_in;
  p.x_prompt = in[0]; p.x_sample = in[1]; p.c_prompt = in[2]; p.c_sample = in[3]; p.norm_attn_g = in[4]; p.norm_ffn_g = in[5];
  p.w_ada = in[6]; p.b_ada = in[7]; p.w_in = in[8]; p.qkn_a = in[9]; p.qkn_b = in[10]; p.qkn_c = in[11]; p.qkn_d = in[12];
  p.rpb_a = in[13]; p.sink_b = in[14]; p.t5_table = in[15]; p.lam_d = in[16]; p.subln_d = in[17]; p.w_out = in[18]; p.w_up = in[19];
  p.conv_w = in[20]; p.conv_b = in[21]; p.w_down = in[22];
  p.out = (float*)d_out;
  char* ws = (char*)d_ws;
  size_t off = 0;
  p.wt = (bf16_t*)(ws + off); off += (size_t)4 * WT_LAYER * 2;
  p.mod = (float*)(ws + off); off += (size_t)4 * 48 * 6144 * 4;
  p.lut = (float*)(ws + off); off += 16384;
  p.lam = (float*)(ws + off); off += 256;
  p.zeros = (float*)(ws + off); off += 256;
  p.lse = (float*)(ws + off); off += (size_t)NTOK * 6 * 4;
  p.proj = (bf16_t*)(ws + off); off += (size_t)NTOK * PW * 2;
  p.hbuf = (bf16_t*)(ws + off); off += (size_t)NTOK * MW * 2;
  if (off > ws_size) { fprintf(stderr, "workspace too small: need %zu have %zu\n", off, ws_size); return; }
  void* args[] = {&p};
  hipError_t e = hipLaunchCooperativeKernel((void*)fwd_megakernel, dim3(grid_blocks), dim3(NTHR), args, SMEM_BYTES, stream);
  if (e != hipSuccess) fprintf(stderr, "cooperative launch failed: %s (grid %d)\n", hipGetErrorString(e), grid_blocks);
}
```

```cpp
#include <hip/hip_runtime.h>
#include <hip/hip_cooperative_groups.h>
#include <cstdint>
#include <cstdio>
namespace cg = cooperative_groups;

typedef unsigned short bf16_t;
typedef short bf16x8 __attribute__((ext_vector_type(8)));
typedef float f32x4 __attribute__((ext_vector_type(4)));
typedef unsigned u32x4 __attribute__((ext_vector_type(4)));
typedef unsigned u32x2 __attribute__((ext_vector_type(2)));

#define NTOK 98304
#define DM 1024
#define PW 3200
#define MW 1152
#define DFF 2816
#define NSEQ 48
#define SEQL 2048
#define LOG2E 1.4426950408889634f
#define LN2 0.6931471805599453f
#define LDSROW 72
#define DT_OFF 320
#define DT_N 641
#define NTHR 512
#define NWAVE 8

struct Params {
  const float *x_prompt, *x_sample, *c_prompt, *c_sample, *norm_attn_g, *norm_ffn_g, *w_ada, *b_ada, *w_in;
  const float *qkn_a, *qkn_b, *qkn_c, *qkn_d, *rpb_a, *sink_b, *t5_table, *lam_d, *subln_d, *w_out, *w_up, *conv_w, *conv_b, *w_down;
  float* out;
  bf16_t* wt; float* mod; float* lut; float* lam; float* lse; bf16_t* proj; bf16_t* hbuf; float* zeros;
};

#define WT_IN 0
#define WT_OUT (3200 * 1024)
#define WT_UP (WT_OUT + 1024 * 1152)
#define WT_DOWN (WT_UP + 5632 * 1024)
#define WT_LAYER (WT_DOWN + 1024 * 2816)

typedef __bf16 bf16x2_t __attribute__((ext_vector_type(2)));
typedef float f32x2_t __attribute__((ext_vector_type(2)));
__device__ __forceinline__ unsigned pk_bf16(float lo, float hi) {
  const f32x2_t v = {lo, hi};
  const bf16x2_t r = __builtin_convertvector(v, bf16x2_t);
  return __builtin_bit_cast(unsigned, r);
}
__device__ __forceinline__ float bf_lo(unsigned u) { return __uint_as_float(u << 16); }
__device__ __forceinline__ float bf_hi(unsigned u) { return __uint_as_float(u & 0xffff0000u); }
__device__ __forceinline__ float fexp2(float x) { return __builtin_amdgcn_exp2f(x); }

__device__ __forceinline__ const float* xin_row(const Params& p, bool first, int tok) {
  if (first) return tok < 65536 ? p.x_prompt + (size_t)tok * DM : p.x_sample + (size_t)(tok - 65536) * DM;
  return p.out + (size_t)tok * DM;
}

__device__ __forceinline__ int opaque_tid() { int t = threadIdx.x; asm volatile("" : "+v"(t)); return t; }

__device__ __forceinline__ size_t blk_off(int r, int k, int R) { return ((size_t)(k >> 5) * R + r) * 32 + (k & 31); }

__device__ __forceinline__ int t5_bucket(int rel) {
  const int n = rel < 0 ? -rel : rel;
  int v;
  if (n < 8) v = n;
  else v = 8 + (n >= 12) + (n >= 16) + (n >= 23) + (n >= 32) + (n >= 46) + (n >= 64) + (n >= 91);
  return (rel > 0 ? 16 : 0) + v;
}

__device__ __forceinline__ void prologue_phase(const Params& p, char* smem) {
  const int tid = opaque_tid(), nb = gridDim.x;
  const int N_TR = 4 * 3200, N_MOD = 192;
  for (int item = blockIdx.x; item < N_TR + N_MOD + 1; item += nb) {
    if (item < N_TR) {
      const int l = item / 3200; int r = item % 3200;
      const float* src; bf16_t* dst; int K, N, kt, nt;
      if (r < 800) { K = 1024; N = 3200; src = p.w_in + (size_t)l * K * N; dst = p.wt + (size_t)l * WT_LAYER + WT_IN; kt = r / 50; nt = r % 50; }
      else if (r < 1088) { r -= 800; K = 1152; N = 1024; src = p.w_out + (size_t)l * K * N; dst = p.wt + (size_t)l * WT_LAYER + WT_OUT; kt = r / 16; nt = r % 16; }
      else if (r < 2496) { r -= 1088; K = 1024; N = 5632; src = p.w_up + (size_t)l * K * N; dst = p.wt + (size_t)l * WT_LAYER + WT_UP; kt = r / 88; nt = r % 88; }
      else { r -= 2496; K = 2816; N = 1024; src = p.w_down + (size_t)l * K * N; dst = p.wt + (size_t)l * WT_LAYER + WT_DOWN; kt = r / 16; nt = r % 16; }
      float* tile = (float*)smem;
      const int k0 = kt * 64, n0 = nt * 64;
      __syncthreads();
#pragma unroll
      for (int i = 0; i < 8; ++i) {
        const int rr = (tid >> 6) + 8 * i, cc = tid & 63;
        tile[rr * 65 + cc] = src[(size_t)(k0 + rr) * N + n0 + cc];
      }
      __syncthreads();
#pragma unroll
      for (int i = 0; i < 4; ++i) {
        const int idx = tid + NTHR * i, n = idx >> 5, k2 = (idx & 31) * 2;
        *(unsigned*)(dst + blk_off(n0 + n, k0 + k2, N)) = pk_bf16(tile[k2 * 65 + n], tile[(k2 + 1) * 65 + n]);
      }
    } else if (item < N_TR + N_MOD) {
      int r = item - N_TR;
      const int l = r / 48; r %= 48;
      const int nc = r / 4, bg = r % 4;
      const int n = nc * NTHR + tid;
      float* sc = (float*)smem;
      float acc[12];
#pragma unroll
      for (int j = 0; j < 12; ++j) acc[j] = 0.f;
      const float* W = p.w_ada + (size_t)l * 1024 * 6144 + n;
      for (int kc = 0; kc < 2; ++kc) {
        __syncthreads();
        for (int i = tid; i < 12 * 512; i += NTHR) {
          const int j = i >> 9, k = i & 511, b = bg * 12 + j;
          const float c = b < 32 ? p.c_prompt[b * 1024 + kc * 512 + k] : p.c_sample[(b - 32) * 1024 + kc * 512 + k];
          sc[i] = c / (1.f + __expf(-c));
        }
        __syncthreads();
#pragma unroll 2
        for (int k = 0; k < 512; k += 4) {
          const float w0 = W[(size_t)(kc * 512 + k) * 6144], w1 = W[(size_t)(kc * 512 + k + 1) * 6144];
          const float w2 = W[(size_t)(kc * 512 + k + 2) * 6144], w3 = W[(size_t)(kc * 512 + k + 3) * 6144];
#pragma unroll
          for (int j = 0; j < 12; ++j) {
            const f32x4 s = *(const f32x4*)(sc + j * 512 + k);
            acc[j] += s[0] * w0 + s[1] * w1 + s[2] * w2 + s[3] * w3;
          }
        }
      }
      const float bias = p.b_ada[l * 6144 + n];
#pragma unroll
      for (int j = 0; j < 12; ++j) p.mod[((size_t)l * 48 + bg * 12 + j) * 6144 + n] = acc[j] + bias;
    } else {
      for (int i = tid; i < 14 * 257; i += NTHR) {
        const int hd = i / 257, idx = i % 257;
        p.lut[i] = p.t5_table[t5_bucket(idx - 128) * 14 + hd] * LOG2E;
      }
      if (tid < 64) p.zeros[tid] = 0.f;
      if (tid < 4) {
        const float* lp = p.lam_d + tid * 128;
        float s1 = 0.f, s2 = 0.f;
        for (int e = 0; e < 32; ++e) { s1 += lp[e] * lp[32 + e]; s2 += lp[64 + e] * lp[96 + e]; }
        const float li = 0.8f - 0.6f * expf(-0.3f * (float)tid);
        p.lam[tid] = expf(s1) - expf(s2) + li;
      }
      {
        const int pr = tid >> 5, ln = tid & 31, l = pr >> 2, m = pr & 3;
        const float* g = m == 0 ? p.qkn_a + l * 128 : (m == 1 ? p.qkn_b + l * 128 : (m == 2 ? p.qkn_c + l * 128 : p.qkn_d + l * 64));
        const int dd = m == 3 ? 32 : 64;
        float gq = 0.f, gk = 0.f, bmax = 0.f;
        for (int i = ln; i < dd; i += 32) { gq = fmaxf(gq, fabsf(g[i])); gk = fmaxf(gk, fabsf(g[dd + i])); }
        if (m == 0) { const float* rp = p.rpb_a + (size_t)l * 4 * 465; for (int i = ln; i < 4 * 465; i += 32) bmax = fmaxf(bmax, rp[i]); }
        else { for (int i = ln; i < 32 * 14; i += 32) bmax = fmaxf(bmax, p.t5_table[i]); }
#pragma unroll
        for (int o = 16; o >= 1; o >>= 1) { gq = fmaxf(gq, __shfl_xor(gq, o)); gk = fmaxf(gk, __shfl_xor(gk, o)); bmax = fmaxf(bmax, __shfl_xor(bmax, o)); }
        const float scale = m == 3 ? 0.17677669529663687f : 0.125f;
        if (ln == 0) p.lam[4 + pr] = ((float)dd * gq * gk * scale + bmax) * LOG2E;
      }
    }
  }
}

__device__ __forceinline__ void norm_phase(const Params& p, int l, bool first, const float* g, int shift_off, int scale_off) {
  const int tid0 = opaque_tid();
  const int lane = tid0 & 63, w = tid0 >> 6;
  const int stride = gridDim.x * NWAVE;
  for (int row0 = blockIdx.x * NWAVE + w; row0 < NTOK; row0 += 2 * stride) {
    const int row1 = row0 + stride;
    const bool has1 = row1 < NTOK;
    const int rows[2] = {row0, has1 ? row1 : row0};
    f32x4 v[2][4];
    float ss[2] = {0.f, 0.f};
#pragma unroll
    for (int r = 0; r < 2; ++r) {
      const float* xr = xin_row(p, first, rows[r]);
#pragma unroll
      for (int i = 0; i < 4; ++i) v[r][i] = *(const f32x4*)(xr + i * 256 + lane * 4);
    }
#pragma unroll
    for (int r = 0; r < 2; ++r) {
#pragma unroll
      for (int i = 0; i < 4; ++i) ss[r] += v[r][i][0] * v[r][i][0] + v[r][i][1] * v[r][i][1] + v[r][i][2] * v[r][i][2] + v[r][i][3] * v[r][i][3];
#pragma unroll
      for (int o = 32; o >= 1; o >>= 1) ss[r] += __shfl_xor(ss[r], o);
    }
#pragma unroll
    for (int r = 0; r < 2; ++r) {
      if (r == 1 && !has1) break;
      const int row = rows[r];
      const float* md = p.mod + ((size_t)l * 48 + (row >> 11)) * 6144;
      const float rstd = rsqrtf(ss[r] * (1.f / 1024.f) + 1e-6f);
#pragma unroll
      for (int i = 0; i < 4; ++i) {
        const int k = i * 256 + lane * 4;
        const f32x4 gg = *(const f32x4*)(g + k), sc = *(const f32x4*)(md + scale_off + k), sh = *(const f32x4*)(md + shift_off + k);
        f32x4 y;
#pragma unroll
        for (int j = 0; j < 4; ++j) y[j] = (v[r][i][j] * rstd) * gg[j] * (1.f + sc[j]) + sh[j];
        u32x2 o; o[0] = pk_bf16(y[0], y[1]); o[1] = pk_bf16(y[2], y[3]);
        *(u32x2*)(p.hbuf + blk_off(row, k, NTOK)) = o;
      }
    }
  }
}

__device__ __forceinline__ bool gemm_tile_id(int it, int MT, int NT, int NB, int& mt, int& nt) {
  const int nb = gridDim.x, bid = blockIdx.x;
  if ((nb & 7) == 0) {
    const int x = bid & 7, slot = bid >> 3, S = nb >> 3;
    const int TPS = 8 * NB, NSN = NT / NB, NS = (MT / 8) * NSN;
    const int pidx = slot + S * it, sidx = pidx / TPS, w = pidx % TPS, s = x + 8 * sidx;
    if (s >= NS) return false;
    mt = (s / NSN) * 8 + (w & 7); nt = (s % NSN) * NB + (w >> 3);
    return true;
  }
  const int t = bid + nb * it;
  if (t >= MT * NT) return false;
  mt = t / NT; nt = t % NT;
  return true;
}

template <int M, int NN>
__device__ __forceinline__ void up_epi_row(const f32x4 (&acc)[8][4], const float* cw, const float* cb, int cbase, int lane, int fr, int s0, bf16_t* obase) {
  constexpr int MP = M > 0 ? M - 1 : 0, MN = M < 7 ? M + 1 : 7;
  const int srcp = (lane & 48) | ((fr + 15) & 15), srcn = (lane & 48) | ((fr + 1) & 15);
  float y[2][4];
#pragma unroll
  for (int n = 0; n < 2; ++n) {
    const int c = n * DFF + cbase;
    const f32x4 w0 = *(const f32x4*)(cw + c), w1 = *(const f32x4*)(cw + 5632 + c), w2 = *(const f32x4*)(cw + 2 * 5632 + c), bb = *(const f32x4*)(cb + c);
#pragma unroll
    for (int j = 0; j < 4; ++j) {
      const float cur = acc[M][NN + 2 * n][j];
      const float zp = (fr == 15) ? acc[MP][NN + 2 * n][j] : cur, zn = (fr == 0) ? acc[MN][NN + 2 * n][j] : cur;
      const float pv = __shfl(zp, srcp), nv = __shfl(zn, srcn);
      y[n][j] = w0[j] * pv + w1[j] * cur + w2[j] * nv + bb[j];
    }
  }
  const int row = 16 * M + fr, tpos = s0 + row;
  if (row >= 1 && row <= 126 && tpos >= 0 && tpos < SEQL) {
    float a[4];
#pragma unroll
    for (int j = 0; j < 4; ++j) { const float gte = y[1][j]; a[j] = y[0][j] * gte / (1.f + __expf(-gte)); }
    u32x2 o; o[0] = pk_bf16(a[0], a[1]); o[1] = pk_bf16(a[2], a[3]);
    *(u32x2*)(obase + (size_t)tpos * 32) = o;
  }
  __builtin_amdgcn_sched_barrier(0);
}

#define GB_A 16384
#define GB_BUF 32768
#define NSTAGE 2
#define SMEM_BYTES (NSTAGE * GB_BUF)
template <int EPI>
__device__ __forceinline__ void gemm_phase(const Params& p, int l, bool first, const bf16_t* A, int NBROWS, const bf16_t* Bt, int K, int MT, int NT, int NB,
                           bf16_t* outb, int ldc, int gate_off, char* smem) {
  const int tid = opaque_tid(), lane = tid & 63, w = tid >> 6, wr = w >> 2, wcn = w & 3, fr = lane & 15, fq = lane >> 4;
  const int nk = K / 32;
  const int lrow = tid >> 2, lch = (tid & 3) ^ ((tid >> 4) & 3);
  const int fsw = (fq ^ ((fr >> 2) & 3)) * 16;
  const size_t apan = (size_t)NTOK * 32, bpan = (size_t)NBROWS * 32;
  const bf16_t* ga0; const bf16_t* ga1; const bf16_t* gb0;
  size_t bstr;
#define GEMM_PTRS(MT_, NT_)                                                                                                          \
  {                                                                                                                                  \
    int t_ = tid; asm volatile("" : "+v"(t_));                                                                                       \
    const int lrow_ = t_ >> 2, lch_ = (t_ & 3) ^ ((t_ >> 4) & 3);                                                                    \
    if (EPI == 2) {                                                                                                                  \
      const int wi0 = 2 * (MT_), wi1 = wi0 + 1;                                                                                      \
      const int t0 = 126 * (wi0 % 17) - 1 + lrow_, t1 = 126 * (wi1 % 17) - 1 + lrow_;                                                \
      ga0 = A + ((size_t)(wi0 / 17) * SEQL + t0) * 32 + lch_ * 8;                                                                    \
      ga1 = A + ((size_t)(wi1 / 17) * SEQL + t1) * 32 + lch_ * 8;                                                                    \
      gb0 = Bt + (size_t)((NT_) * 128 + lrow_) * 32 + lch_ * 8; bstr = (size_t)DFF * 32;                                             \
    } else {                                                                                                                         \
      ga0 = A + (size_t)((MT_) * 256 + lrow_) * 32 + lch_ * 8; ga1 = ga0 + (size_t)128 * 32;                                         \
      gb0 = Bt + (size_t)((NT_) * 256 + lrow_) * 32 + lch_ * 8; bstr = (size_t)128 * 32;                                             \
    }                                                                                                                                \
  }
#define GEMM_LOAD(KT, SET)                                                                                                           \
    {                                                                                                                                \
      const size_t ko_ = (size_t)(KT) * apan, kb_ = (size_t)(KT) * bpan;                                                             \
      asm volatile("global_load_dwordx4 %0, %1, off" : "=v"(SET[0]) : "v"(ga0 + ko_) : "memory");                                     \
      asm volatile("global_load_dwordx4 %0, %1, off" : "=v"(SET[1]) : "v"(ga1 + ko_) : "memory");                                     \
      asm volatile("global_load_dwordx4 %0, %1, off" : "=v"(SET[2]) : "v"(gb0 + kb_) : "memory");                                     \
      asm volatile("global_load_dwordx4 %0, %1, off" : "=v"(SET[3]) : "v"(gb0 + bstr + kb_) : "memory");                              \
    }
#define GEMM_WRITE(SET, STAGE)                                                                                                       \
    {                                                                                                                                \
      asm volatile("" : "+v"(SET[0]), "+v"(SET[1]), "+v"(SET[2]), "+v"(SET[3]));      \
      char* dst_ = smem + (STAGE) * GB_BUF + tid * 16;                                                                               \
      *(u32x4*)(dst_) = SET[0]; *(u32x4*)(dst_ + 8192) = SET[1]; *(u32x4*)(dst_ + GB_A) = SET[2]; *(u32x4*)(dst_ + GB_A + 8192) = SET[3]; \
    }
#define GEMM_KSTEP(KT, WSET)                                                                                                         \
    {                                                                                                                                \
      asm volatile("s_waitcnt lgkmcnt(0)" ::: "memory");                                                                             \
      __builtin_amdgcn_s_barrier();                   \
      if ((KT) + 1 < nk) {                                                                                                           \
        if ((KT) + 2 < nk) asm volatile("s_waitcnt vmcnt(4)" ::: "memory"); else asm volatile("s_waitcnt vmcnt(0)" ::: "memory");     \
        GEMM_WRITE(WSET, ((KT) + 1) & 1)                                                                                             \
        if ((KT) + 3 < nk) GEMM_LOAD((KT) + 3, WSET)                                                                                 \
      }                                                                                                                              \
      const char* Ab = smem + ((KT) & 1) * GB_BUF;                                                                                   \
      const char* Bb = Ab + GB_A;                                                                                                    \
      bf16x8 bfr[4];                                                                                                                 \
      _Pragma("unroll") for (int n = 0; n < 4; ++n) {                                                                                \
        const int br = (EPI == 2) ? ((n >> 1) * 128 + 32 * wcn + 16 * (n & 1) + fr) : (64 * wcn + 16 * n + fr);                      \
        bfr[n] = *(const bf16x8*)(Bb + br * 64 + fsw);                                                                               \
      }                                                                                                                              \
      const char* Ap = Ab + (wr * 128 + fr) * 64 + fsw;                                                                              \
      bf16x8 af0 = *(const bf16x8*)(Ap), af1 = *(const bf16x8*)(Ap + 16 * 64);                                                       \
      _Pragma("unroll") for (int pr = 0; pr < 4; ++pr) {                                                                             \
        bf16x8 an0 = af0, an1 = af1;                                                                                                 \
        if (pr < 3) { an0 = *(const bf16x8*)(Ap + (2 * pr + 2) * 16 * 64); an1 = *(const bf16x8*)(Ap + (2 * pr + 3) * 16 * 64); }    \
        __builtin_amdgcn_sched_barrier(0);                                                                                           \
        _Pragma("unroll") for (int n = 0; n < 4; ++n) acc[2 * pr][n] = __builtin_amdgcn_mfma_f32_16x16x32_bf16(bfr[n], af0, acc[2 * pr][n], 0, 0, 0); \
        _Pragma("unroll") for (int n = 0; n < 4; ++n) acc[2 * pr + 1][n] = __builtin_amdgcn_mfma_f32_16x16x32_bf16(bfr[n], af1, acc[2 * pr + 1][n], 0, 0, 0); \
        __builtin_amdgcn_sched_barrier(0);                                                                                           \
        af0 = an0; af1 = an1;                                                                                                        \
      }                                                                                                                              \
    }
  int mt, nt;
  bool have = gemm_tile_id(0, MT, NT, NB, mt, nt);
  for (int it = 0; have; ++it) {
    GEMM_PTRS(mt, nt)
    u32x4 rsA[4], rsB[4];
    f32x4 acc[8][4];
#pragma unroll
    for (int m = 0; m < 8; ++m)
#pragma unroll
      for (int n = 0; n < 4; ++n) acc[m][n] = (f32x4){0.f, 0.f, 0.f, 0.f};
    asm volatile("s_waitcnt vmcnt(0) lgkmcnt(0)" ::: "memory");
    __builtin_amdgcn_s_barrier();
    GEMM_LOAD(0, rsA)
    GEMM_LOAD(1, rsB)
    asm volatile("s_waitcnt vmcnt(4)" ::: "memory");
    GEMM_WRITE(rsA, 0)
    GEMM_LOAD(2, rsA)
    for (int kt = 0; kt < nk; kt += 2) {
      GEMM_KSTEP(kt, rsB)
      GEMM_KSTEP(kt + 1, rsA)
    }
    const int mt_e = mt, nt_e = nt;
    have = gemm_tile_id(it + 1, MT, NT, NB, mt, nt);
    int lane_e = lane; asm volatile("" : "+v"(lane_e));
    const int fr_e = lane_e & 15, fq_e = lane_e >> 4;
    if (EPI == 0) {
      if (nt_e * 256 + 64 * wcn < NBROWS) {
#pragma unroll
        for (int m = 0; m < 8; ++m) {
          const int tok = mt_e * 256 + wr * 128 + 16 * m + fr_e;
#pragma unroll
          for (int n = 0; n < 4; ++n) {
            const int col = nt_e * 256 + 64 * wcn + 16 * n + 4 * fq_e;
            u32x2 o; o[0] = pk_bf16(acc[m][n][0], acc[m][n][1]); o[1] = pk_bf16(acc[m][n][2], acc[m][n][3]);
            *(u32x2*)(outb + (size_t)tok * ldc + col) = o;
          }
        }
      }
    } else if (EPI == 1) {
      const int b = (mt_e * 256) >> 11;
      const float* gate = p.mod + ((size_t)l * 48 + b) * 6144 + gate_off;
#pragma unroll
      for (int n = 0; n < 4; ++n) {
        const int col = nt_e * 256 + 64 * wcn + 16 * n + 4 * fq_e;
        const f32x4 gv = *(const f32x4*)(gate + col);
#pragma unroll
        for (int m = 0; m < 8; ++m) {
          const int tok = mt_e * 256 + wr * 128 + 16 * m + fr_e;
          const f32x4 xv = *(const f32x4*)(xin_row(p, first, tok) + col);
          f32x4 o;
#pragma unroll
          for (int j = 0; j < 4; ++j) o[j] = xv[j] + gv[j] * acc[m][n][j];
          *(f32x4*)(p.out + (size_t)tok * DM + col) = o;
        }
      }
    } else {
      const float* cw = p.conv_w + (size_t)l * 3 * 5632;
      const float* cb = p.conv_b + (size_t)l * 5632;
      const int wi = 2 * mt_e + wr, seq = wi / 17, s0 = 126 * (wi % 17) - 1;
      if (s0 < 0 || s0 + 127 >= SEQL) {
#pragma unroll
        for (int m = 0; m < 8; ++m) {
          const int tp = s0 + 16 * m + fr_e;
          if (tp < 0 || tp >= SEQL) {
#pragma unroll
            for (int n = 0; n < 4; ++n) acc[m][n] = (f32x4){0.f, 0.f, 0.f, 0.f};
          }
        }
      }
#define UP_EPI_NN(NN)                                                                                                      \
      {                                                                                                                    \
        const int cbase = nt_e * 128 + 32 * wcn + 16 * NN + 4 * fq_e;                                                        \
        bf16_t* obase = outb + blk_off(seq * SEQL, cbase, NTOK);                                                           \
        up_epi_row<0, NN>(acc, cw, cb, cbase, lane_e, fr_e, s0, obase); up_epi_row<1, NN>(acc, cw, cb, cbase, lane_e, fr_e, s0, obase); \
        up_epi_row<2, NN>(acc, cw, cb, cbase, lane_e, fr_e, s0, obase); up_epi_row<3, NN>(acc, cw, cb, cbase, lane_e, fr_e, s0, obase); \
        up_epi_row<4, NN>(acc, cw, cb, cbase, lane_e, fr_e, s0, obase); up_epi_row<5, NN>(acc, cw, cb, cbase, lane_e, fr_e, s0, obase); \
        up_epi_row<6, NN>(acc, cw, cb, cbase, lane_e, fr_e, s0, obase); up_epi_row<7, NN>(acc, cw, cb, cbase, lane_e, fr_e, s0, obase); \
      }
      UP_EPI_NN(0)
      UP_EPI_NN(1)
#undef UP_EPI_NN
    }
  }
#undef GEMM_LOAD
#undef GEMM_WRITE
#undef GEMM_KSTEP
#undef GEMM_PTRS
}

struct AttnArgs {
  int qbase, qstride, qpos0;
  int ktokbase, ktokstep, kstride, kposbase, kposstep, ntiles;
  int qcol, kcol, vcol, ocol;
  const float *gq, *gk;
  float qscale;
  int hw, rmul, taboff0;
  float sinkv;
  float lam, outscale;
  const float* subg;
  int lsecol;
  float cshift;
  int r0, rs0;
};

template <int NQ, int NC, int MODE>
__device__ __forceinline__ void attn_item(const Params& p, const AttnArgs& a, bf16_t* Ks, bf16_t* Vts, const float* tab) {
  const int tid = opaque_tid(), lane = tid & 63, w = tid >> 6, fr = lane & 15, fq = lane >> 4;
  const int wq0 = a.qpos0 + w * 16 * NQ;
  bf16x8 qf[NQ][2];
  int qpos[NQ];
#pragma unroll
  for (int qt = 0; qt < NQ; ++qt) {
    const int qp = wq0 + qt * 16 + fr;
    qpos[qt] = qp;
    const bf16_t* qrow = p.proj + (size_t)(a.qbase + qp * a.qstride) * PW + a.qcol;
    const u32x4 v0 = *(const u32x4*)(qrow + fq * 8), v1 = *(const u32x4*)(qrow + 32 + fq * 8);
    float f0[8], f1[8];
#pragma unroll
    for (int i = 0; i < 4; ++i) { f0[2 * i] = bf_lo(v0[i]); f0[2 * i + 1] = bf_hi(v0[i]); f1[2 * i] = bf_lo(v1[i]); f1[2 * i + 1] = bf_hi(v1[i]); }
    float s0 = 0.f, s1 = 0.f;
#pragma unroll
    for (int i = 0; i < 8; ++i) { s0 += f0[i] * f0[i]; s1 += f1[i] * f1[i]; }
    float r0, r1;
    if (NC == 1) {
      float s = s0 + s1; s += __shfl_xor(s, 16); s += __shfl_xor(s, 32);
      r0 = r1 = rsqrtf(s * (1.f / 64.f) + 1e-6f) * a.qscale;
    } else {
      s0 += __shfl_xor(s0, 16); s0 += __shfl_xor(s0, 32);
      s1 += __shfl_xor(s1, 16); s1 += __shfl_xor(s1, 32);
      r0 = rsqrtf(s0 * (1.f / 32.f) + 1e-6f) * a.qscale; r1 = rsqrtf(s1 * (1.f / 32.f) + 1e-6f) * a.qscale;
    }
    const float* g0p = a.gq + fq * 8;
    const float* g1p = (NC == 1) ? a.gq + 32 + fq * 8 : g0p;
    u32x4 q0, q1;
#pragma unroll
    for (int i = 0; i < 4; ++i) {
      q0[i] = pk_bf16(f0[2 * i] * r0 * g0p[2 * i], f0[2 * i + 1] * r0 * g0p[2 * i + 1]);
      q1[i] = pk_bf16(f1[2 * i] * r1 * g1p[2 * i], f1[2 * i + 1] * r1 * g1p[2 * i + 1]);
    }
    qf[qt][0] = __builtin_bit_cast(bf16x8, q0);
    qf[qt][1] = __builtin_bit_cast(bf16x8, q1);
  }
  f32x4 o[NC][NQ][4];
  float mrun[NC][NQ], lrun[NC][NQ];
#pragma unroll
  for (int c = 0; c < NC; ++c)
#pragma unroll
    for (int qt = 0; qt < NQ; ++qt) {
      mrun[c][qt] = a.cshift;
      if (MODE == 1) lrun[c][qt] = (fq == 0) ? fexp2(a.sinkv - a.cshift) : 0.f;
      else lrun[c][qt] = 0.f;
#pragma unroll
      for (int dt = 0; dt < 4; ++dt) o[c][qt][dt] = (f32x4){0.f, 0.f, 0.f, 0.f};
    }
  const int lch = tid & 7;
  float gkv[8];
#pragma unroll
  for (int i = 0; i < 8; ++i) gkv[i] = a.gk[((NC == 1) ? lch : (lch & 3)) * 8 + i];

  const int rw = a.r0 + ((w * 16 * NQ) >> 6);
  int rsw = rw - 4; rsw = rsw < 0 ? 0 : (rsw > 24 ? 24 : rsw);
  u32x4 kA, vA, kB, vB;
  const int kkey = tid >> 3, vkey = tid & 63, vch = tid >> 6;
#define ATTN_PREFETCH(T, KR, VR)                                                                                 \
  {                                                                                                              \
    const int ktok0_ = a.ktokbase + (T) * a.ktokstep;                                                            \
    KR = *(const u32x4*)(p.proj + (size_t)(ktok0_ + kkey * a.kstride) * PW + a.kcol + lch * 8);                   \
    VR = *(const u32x4*)(p.proj + (size_t)(ktok0_ + vkey * a.kstride) * PW + a.vcol + vch * 8);                   \
  }
  auto stage_write = [&](const u32x4& kr, const u32x4& vr, bf16_t* Ksb, bf16_t* Vtb) __attribute__((always_inline)) {
    float f[8];
#pragma unroll
    for (int i = 0; i < 4; ++i) { f[2 * i] = bf_lo(kr[i]); f[2 * i + 1] = bf_hi(kr[i]); }
    float s = 0.f;
#pragma unroll
    for (int i = 0; i < 8; ++i) s += f[i] * f[i];
    s += __shfl_xor(s, 1); s += __shfl_xor(s, 2);
    float rs;
    if (NC == 1) { s += __shfl_xor(s, 4); rs = rsqrtf(s * (1.f / 64.f) + 1e-6f); }
    else rs = rsqrtf(s * (1.f / 32.f) + 1e-6f);
    u32x4 kq;
#pragma unroll
    for (int i = 0; i < 4; ++i) kq[i] = pk_bf16(f[2 * i] * rs * gkv[2 * i], f[2 * i + 1] * rs * gkv[2 * i + 1]);
    *(u32x4*)(Ksb + kkey * LDSROW + lch * 8) = kq;
#pragma unroll
    for (int i = 0; i < 4; ++i) {
      Vtb[(vch * 8 + 2 * i) * LDSROW + vkey] = (bf16_t)(vr[i] & 0xffffu);
      Vtb[(vch * 8 + 2 * i + 1) * LDSROW + vkey] = (bf16_t)(vr[i] >> 16);
    }
  };
  auto tile_math = [&](int t, const bf16_t* Ksb, const bf16_t* Vtb) __attribute__((always_inline)) {
    if (MODE == 0) { const int kr_ = a.rs0 + t; if (kr_ < rsw || kr_ >= rsw + 8) return; }
    const int kp0 = a.kposbase + t * a.kposstep;
    const int taboff = (a.rs0 + t - rw + 7) * 31;
    bf16x8 pf[NC][NQ][2];
    bf16x8 kf[4][2];
#pragma unroll
    for (int kt = 0; kt < 4; ++kt) {
      kf[kt][0] = *(const bf16x8*)(Ksb + (kt * 16 + fr) * LDSROW + fq * 8);
      kf[kt][1] = *(const bf16x8*)(Ksb + (kt * 16 + fr) * LDSROW + 32 + fq * 8);
    }
    bf16x8 vfr[4][2];
#pragma unroll
    for (int ks = 0; ks < 2; ++ks)
#pragma unroll
      for (int dt = 0; dt < 4; ++dt) {
        const u32x2 lo = *(const u32x2*)(Vtb + (dt * 16 + fr) * LDSROW + ks * 32 + 4 * fq);
        const u32x2 hi = *(const u32x2*)(Vtb + (dt * 16 + fr) * LDSROW + ks * 32 + 16 + 4 * fq);
        u32x4 vv; vv[0] = lo[0]; vv[1] = lo[1]; vv[2] = hi[0]; vv[3] = hi[1];
        vfr[dt][ks] = __builtin_bit_cast(bf16x8, vv);
      }
#pragma unroll
    for (int qt = 0; qt < NQ; ++qt) {
      const int qp = (MODE == 0) ? (qpos[qt] & 63) : qpos[qt];
      int cs = qp - 8; cs = cs < 0 ? 0 : (cs > 48 ? 48 : cs);
      f32x4 bv[4];
      const bool far_hi = (MODE == 3) && (kp0 - (wq0 + 16 * NQ - 1) >= 128), far_lo = (MODE == 3) && (wq0 - (kp0 + 63) >= 128);
      if (far_hi || far_lo) {
        const float bu = tab[far_hi ? (DT_OFF + 256) : (DT_OFF - 256)];
#pragma unroll
        for (int kt = 0; kt < 4; ++kt) bv[kt] = (f32x4){bu, bu, bu, bu};
      } else if (MODE != 0) {
        const float* tb = tab + (kp0 - qp + 4 * fq + DT_OFF);
#pragma unroll
        for (int kt = 0; kt < 4; ++kt)
#pragma unroll
          for (int j = 0; j < 4; ++j) bv[kt][j] = tb[kt * 16 + j];
      } else
#pragma unroll
      for (int kt = 0; kt < 4; ++kt)
#pragma unroll
        for (int j = 0; j < 4; ++j) {
          const int kpos = kp0 + kt * 16 + 4 * fq + j;
          const int d = kpos - qp;
          const bool valid = kpos >= cs && kpos < cs + 16;
          int dd = d + 15; dd = dd < 0 ? 0 : (dd > 30 ? 30 : dd);
          const float bias = tab[taboff + dd];
          bv[kt][j] = valid ? bias : -INFINITY;
        }
#pragma unroll
      for (int c = 0; c < NC; ++c) {
        f32x4 s[4];
#pragma unroll
        for (int kt = 0; kt < 4; ++kt) {
          if (NC == 1) {
            const f32x4 r = __builtin_amdgcn_mfma_f32_16x16x32_bf16(kf[kt][0], qf[qt][0], bv[kt], 0, 0, 0);
            s[kt] = __builtin_amdgcn_mfma_f32_16x16x32_bf16(kf[kt][1], qf[qt][1], r, 0, 0, 0);
          } else {
            s[kt] = __builtin_amdgcn_mfma_f32_16x16x32_bf16(kf[kt][c], qf[qt][c], bv[kt], 0, 0, 0);
          }
        }
        float rs = 0.f;
#pragma unroll
        for (int kt = 0; kt < 4; ++kt)
#pragma unroll
          for (int j = 0; j < 4; ++j) { const float pv = fexp2(s[kt][j]); s[kt][j] = pv; rs += pv; }
        lrun[c][qt] += rs;
#pragma unroll
        for (int ks = 0; ks < 2; ++ks) {
          u32x4 pk;
          pk[0] = pk_bf16(s[2 * ks][0], s[2 * ks][1]); pk[1] = pk_bf16(s[2 * ks][2], s[2 * ks][3]);
          pk[2] = pk_bf16(s[2 * ks + 1][0], s[2 * ks + 1][1]); pk[3] = pk_bf16(s[2 * ks + 1][2], s[2 * ks + 1][3]);
          pf[c][qt][ks] = __builtin_bit_cast(bf16x8, pk);
        }
      }
    }
#pragma unroll
    for (int ks = 0; ks < 2; ++ks) {
#pragma unroll
      for (int dt = 0; dt < 4; ++dt) {
        const bf16x8 vf = vfr[dt][ks];
#pragma unroll
        for (int c = 0; c < NC; ++c)
#pragma unroll
          for (int qt = 0; qt < NQ; ++qt) o[c][qt][dt] = __builtin_amdgcn_mfma_f32_16x16x32_bf16(vf, pf[c][qt][ks], o[c][qt][dt], 0, 0, 0);
      }
    }
    };
  bf16_t* const Ks1 = Ks + 2 * 64 * LDSROW;
  bf16_t* const Vts1 = Vts + 2 * 64 * LDSROW;
  const int ntl = a.ntiles;
  ATTN_PREFETCH(0, kA, vA)
  if (ntl > 1) ATTN_PREFETCH(1, kB, vB)
  stage_write(kA, vA, Ks, Vts);
  if (ntl > 2) ATTN_PREFETCH(2, kA, vA)
  for (int t = 0; t < ntl; t += 2) {
    __syncthreads();
    if (t + 1 < ntl) { stage_write(kB, vB, Ks1, Vts1); if (t + 3 < ntl) ATTN_PREFETCH(t + 3, kB, vB) }
    tile_math(t, Ks, Vts);
    if (t + 1 < ntl) {
      __syncthreads();
      if (t + 2 < ntl) { stage_write(kA, vA, Ks, Vts); if (t + 4 < ntl) ATTN_PREFETCH(t + 4, kA, vA) }
      tile_math(t + 1, Ks1, Vts1);
    }
  }
#undef ATTN_PREFETCH
#pragma unroll
  for (int qt = 0; qt < NQ; ++qt) {
    float inv[NC], ltot[NC];
#pragma unroll
    for (int c = 0; c < NC; ++c) {
      float lt = lrun[c][qt];
      lt += __shfl_xor(lt, 16); lt += __shfl_xor(lt, 32);
      ltot[c] = lt; inv[c] = 1.f / lt;
    }
    const int tok = a.qbase + qpos[qt] * a.qstride;
    if (MODE == 3) {
      f32x4 v[4];
      float ss = 0.f;
#pragma unroll
      for (int dt = 0; dt < 4; ++dt)
#pragma unroll
        for (int j = 0; j < 4; ++j) {
          const float x = o[0][qt][dt][j] * inv[0] - a.lam * (o[NC - 1][qt][dt][j] * inv[NC - 1]);
          v[dt][j] = x; ss += x * x;
        }
      ss += __shfl_xor(ss, 16); ss += __shfl_xor(ss, 32);
      const float rstd = rsqrtf(ss * (1.f / 64.f) + 1e-6f) * a.outscale;
#pragma unroll
      for (int dt = 0; dt < 4; ++dt) {
        const f32x4 g = *(const f32x4*)(a.subg + dt * 16 + 4 * fq);
        u32x2 ov; ov[0] = pk_bf16(v[dt][0] * rstd * g[0], v[dt][1] * rstd * g[1]); ov[1] = pk_bf16(v[dt][2] * rstd * g[2], v[dt][3] * rstd * g[3]);
        *(u32x2*)(p.hbuf + blk_off(tok, a.ocol + dt * 16 + 4 * fq, NTOK)) = ov;
      }
    } else {
#pragma unroll
      for (int dt = 0; dt < 4; ++dt) {
        u32x2 ov;
        ov[0] = pk_bf16(o[0][qt][dt][0] * inv[0], o[0][qt][dt][1] * inv[0]);
        ov[1] = pk_bf16(o[0][qt][dt][2] * inv[0], o[0][qt][dt][3] * inv[0]);
        *(u32x2*)(p.hbuf + blk_off(tok, a.ocol + dt * 16 + 4 * fq, NTOK)) = ov;
      }
      if (MODE == 2 && fq == 0) p.lse[(size_t)tok * 6 + a.lsecol] = (mrun[0][qt] + __log2f(ltot[0])) * LN2;
    }
  }
}

__device__ __forceinline__ void attn_phase(const Params& p, int l, char* smem) {
  bf16_t* Ks = (bf16_t*)smem;
  bf16_t* Vts = Ks + 64 * LDSROW;
  float* tab = (float*)(Ks + 4 * 64 * LDSROW);
  const int tid = opaque_tid();
  const int nD = 3072, nA = 3072, nB = 3072, nC = 4608;
  for (int item = blockIdx.x; item < nD + nA + nB + nC; item += gridDim.x) {
    AttnArgs a;
    a.taboff0 = 0; a.r0 = 0; a.rs0 = 0; a.sinkv = 0.f; a.cshift = 0.f; a.lam = 0.f; a.outscale = 1.f; a.subg = nullptr; a.lsecol = 0; a.hw = 1 << 20; a.rmul = 1;
    __syncthreads();
    if (item < nD) {
      const int b = item >> 6, h = (item >> 4) & 3, qb = item & 15;
      a.cshift = p.lam[4 + l * 4 + 3];
      for (int i = tid; i < DT_N; i += NTHR) { int dd = i - DT_OFF; dd = dd < -128 ? -128 : (dd > 128 ? 128 : dd); tab[i] = p.lut[(10 + h) * 257 + dd + 128] - a.cshift; }
      a.qbase = b * SEQL; a.qstride = 1; a.qpos0 = qb * 128;
      a.ktokbase = b * SEQL; a.ktokstep = 64; a.kstride = 1; a.kposbase = 0; a.kposstep = 64; a.ntiles = 32;
      a.qcol = 2432 + h * 64; a.kcol = 2432 + 256 + h * 64; a.vcol = 2432 + 512 + h * 64; a.ocol = 896 + h * 64;
      a.gq = p.qkn_d + l * 64; a.gk = a.gq + 32;
      a.qscale = 0.17677669529663687f * LOG2E;
      a.lam = p.lam[l]; a.outscale = 1.f - (0.8f - 0.6f * expf(-0.3f * (float)l)); a.subg = p.subln_d + l * 64;
      attn_item<1, 2, 3>(p, a, Ks, Vts, tab);
    } else if (item < nD + nA) {
      const int id = item - nD;
      const int b = id >> 6, h = (id >> 4) & 3, r = (id & 15) * 2;
      const float* rp = p.rpb_a + ((size_t)l * 4 + h) * 465;
      a.cshift = p.lam[4 + l * 4 + 0];
      for (int i = tid; i < 465; i += NTHR) tab[i] = rp[i] * LOG2E - a.cshift;
      int rs = r - 4; rs = rs < 0 ? 0 : (rs > 24 ? 24 : rs);
      int rs1 = r - 3; rs1 = rs1 < 0 ? 0 : (rs1 > 24 ? 24 : rs1);
      a.qbase = b * SEQL + r * 64; a.qstride = 1; a.qpos0 = 0; a.r0 = r; a.rs0 = rs;
      a.ktokbase = b * SEQL + rs * 64; a.ktokstep = 64; a.kstride = 1; a.kposbase = 0; a.kposstep = 0; a.ntiles = rs1 - rs + 8;
      a.qcol = h * 64; a.kcol = 256 + h * 64; a.vcol = 512 + h * 64; a.ocol = h * 64;
      a.gq = p.qkn_a + l * 128; a.gk = a.gq + 64;
      a.qscale = 0.125f * LOG2E;
      attn_item<1, 1, 0>(p, a, Ks, Vts, tab);
    } else if (item < nD + nA + nB) {
      const int id = item - nD - nA;
      const int b = id >> 6, h = (id >> 4) & 3, qb = id & 15;
      a.cshift = p.lam[4 + l * 4 + 1];
      for (int i = tid; i < DT_N; i += NTHR) { const int d = i - DT_OFF; tab[i] = (d >= -128 && d <= 128) ? p.lut[h * 257 + d + 128] - a.cshift : -INFINITY; }
      const int q0 = qb * 128;
      const int kstart = q0 - 128 < 0 ? 0 : q0 - 128, kend = q0 + 256 > SEQL ? SEQL : q0 + 256;
      a.qbase = b * SEQL; a.qstride = 1; a.qpos0 = q0;
      a.ktokbase = b * SEQL + kstart; a.ktokstep = 64; a.kstride = 1; a.kposbase = kstart; a.kposstep = 64; a.ntiles = (kend - kstart) >> 6;
      a.qcol = 768 + h * 64; a.kcol = 768 + 256 + (h >> 1) * 64; a.vcol = 768 + 384 + (h >> 1) * 64; a.ocol = 256 + h * 64;
      a.gq = p.qkn_b + l * 128; a.gk = a.gq + 64;
      a.qscale = 0.125f * LOG2E;
      a.hw = 128; a.rmul = 1; a.sinkv = p.sink_b[l * 4 + h] * LOG2E;
      attn_item<1, 1, 1>(p, a, Ks, Vts, tab);
    } else {
      const int id = item - nD - nA - nB;
      const int b = id / 96, rem = id % 96, g = rem >> 5, i2 = (rem >> 4) & 1, blk = rem & 15;
      const int r = g == 0 ? 1 : (g == 1 ? 4 : 16);
      const int L = SEQL / r, bps = L >> 7;
      const int pp = blk / bps, m0 = (blk % bps) * 128;
      const int hh = g * 2 + i2;
      a.cshift = p.lam[4 + l * 4 + 2];
      for (int i = tid; i < DT_N; i += NTHR) { const int d = i - DT_OFF; int dd = d * r; dd = dd < -128 ? -128 : (dd > 128 ? 128 : dd);
        tab[i] = (d >= -64 && d <= 64) ? p.lut[(4 + hh) * 257 + dd + 128] - a.cshift : -INFINITY; }
      const int kstart = m0 - 64 < 0 ? 0 : m0 - 64, kend = m0 + 192 > L ? L : m0 + 192;
      a.qbase = b * SEQL + pp; a.qstride = r; a.qpos0 = m0;
      a.ktokbase = a.qbase + kstart * r; a.ktokstep = 64 * r; a.kstride = r; a.kposbase = kstart; a.kposstep = 64; a.ntiles = (kend - kstart) >> 6;
      a.qcol = 1280 + hh * 64; a.kcol = 1280 + 384 + hh * 64; a.vcol = 1280 + 768 + hh * 64; a.ocol = 512 + hh * 64;
      a.gq = p.qkn_c + l * 128; a.gk = a.gq + 64;
      a.qscale = 0.125f * LOG2E;
      a.hw = 64; a.rmul = r; a.lsecol = hh;
      attn_item<1, 1, 2>(p, a, Ks, Vts, tab);
    }
  }
}

__device__ __forceinline__ void combine_phase(const Params& p) {
  const int nthr = gridDim.x * NTHR;
  for (int i = blockIdx.x * NTHR + opaque_tid(); i < NTOK * 48; i += nthr) {
    const int tok = i / 48, rem = i % 48, hh = rem >> 3, ch = rem & 7, ii = hh & 1, g = hh >> 1;
    const float* ls = p.lse + (size_t)tok * 6;
    const float l0 = ls[ii], l1 = ls[2 + ii], l2 = ls[4 + ii];
    const float mx = fmaxf(l0, fmaxf(l1, l2));
    const float e0 = __expf(l0 - mx), e1 = __expf(l1 - mx), e2 = __expf(l2 - mx);
    const float al = (g == 0 ? e0 : (g == 1 ? e1 : e2)) / (e0 + e1 + e2);
    bf16_t* ptr = p.hbuf + blk_off(tok, 512 + hh * 64 + ch * 8, NTOK);
    u32x4 v = *(const u32x4*)ptr;
#pragma unroll
    for (int k = 0; k < 4; ++k) v[k] = pk_bf16(bf_lo(v[k]) * al, bf_hi(v[k]) * al);
    *(u32x4*)ptr = v;
  }
}


#ifndef REP_GEMM
#define REP_GEMM 1
#endif
#ifndef REP_ATTN
#define REP_ATTN 1
#endif
#ifndef DBG_STOP
#define DBG_STOP 0
#endif
__global__ void __launch_bounds__(NTHR, 2) fwd_megakernel(Params p) {
  extern __shared__ __attribute__((aligned(16))) char smem[];
  cg::grid_group grid = cg::this_grid();
  prologue_phase(p, smem);
  grid.sync();
#define LAYER(L)                                                                                                   \
  {                                                                                                                \
    constexpr int l = (L);                                                                                         \
    constexpr bool first = (l == 0);                                                                               \
    const bf16_t* wt = p.wt + (size_t)l * WT_LAYER;                                                                \
    norm_phase(p, l, first, p.norm_attn_g + l * DM, 0, 1024);                                                      \
    grid.sync();                                                                                                   \
    gemm_phase<0>(p, l, false, p.hbuf, 3200, wt + WT_IN, 1024, 384, 13, 13, p.proj, PW, 0, smem);                  \
    grid.sync();                                                                                                   \
    attn_phase(p, l, smem);                                                                                        \
    grid.sync();                                                                                                   \
    combine_phase(p);                                                                                              \
    grid.sync();                                                                                                   \
    gemm_phase<1>(p, l, first, p.hbuf, 1024, wt + WT_OUT, 1152, 384, 4, 4, nullptr, 0, 2048, smem);                \
    grid.sync();                                                                                                   \
    norm_phase(p, l, false, p.norm_ffn_g + l * DM, 3072, 4096);                                                    \
    grid.sync();                                                                                                   \
    gemm_phase<2>(p, l, false, p.hbuf, 5632, wt + WT_UP, 1024, 408, 22, 22, p.proj, DFF, 0, smem);                 \
    grid.sync();                                                                                                   \
    gemm_phase<1>(p, l, false, p.proj, 1024, wt + WT_DOWN, 2816, 384, 4, 4, nullptr, 0, 5120, smem);               \
    grid.sync();                                                                                                   \
  }
  LAYER(0)
  LAYER(1)
  LAYER(2)
  LAYER(3)
#undef LAYER
}

extern "C" void kernel_launch(void* const* d_in, const int* in_sizes, int n_in, void* d_out, int out_size, void* d_ws, size_t ws_size,
                              hipStream_t stream) {
  static int grid_blocks = 0;
  if (!grid_blocks) {
    int dev = 0, cus = 0, per_cu = 0;
    hipGetDevice(&dev);
    hipDeviceGetAttribute(&cus, hipDeviceAttributeMultiprocessorCount, dev);
    hipFuncSetAttribute((const void*)fwd_megakernel, hipFuncAttributeMaxDynamicSharedMemorySize, SMEM_BYTES);
    hipOccupancyMaxActiveBlocksPerMultiprocessor(&per_cu, fwd_megakernel, NTHR, SMEM_BYTES);
    if (per_cu > 1) per_cu = 1;
    if (per_cu < 1) per_cu = 1;
    grid_blocks = cus * per_cu;
  }
  Params p{};
  const float* const* in = (const float* const*)d_in;
  p.x_prompt = in[0]; p.x_sample = in[1]; p.c_prompt = in[2]; p.c_sample = in[3]; p.norm_attn_g = in[4]; p.norm_ffn_g = in[5];
  p.w_ada = in[6]; p.b_ada = in[7]; p.w_in = in[8]; p.qkn_a = in[9]; p.qkn_b = in[10]; p.qkn_c = in[11]; p.qkn_d = in[12];
  p.rpb_a = in[13]; p.sink_b = in[14]; p.t5_table = in[15]; p.lam_d = in[16]; p.subln_d = in[17]; p.w_out = in[18]; p.w_up = in[19];
  p.conv_w = in[20]; p.conv_b = in[21]; p.w_down = in[22];
  p.out = (float*)d_out;
  char* ws = (char*)d_ws;
  size_t off = 0;
  p.wt = (bf16_t*)(ws + off); off += (size_t)4 * WT_LAYER * 2;
  p.mod = (float*)(ws + off); off += (size_t)4 * 48 * 6144 * 4;
  p.lut = (float*)(ws + off); off += 16384;
  p.lam = (float*)(ws + off); off += 256;
  p.zeros = (float*)(ws + off); off += 256;
  p.lse = (float*)(ws + off); off += (size_t)NTOK * 6 * 4;
  p.proj = (bf16_t*)(ws + off); off += (size_t)NTOK * PW * 2;
  p.hbuf = (bf16_t*)(ws + off); off += (size_t)NTOK * MW * 2;
  if (off > ws_size) { fprintf(stderr, "workspace too small: need %zu have %zu\n", off, ws_size); return; }
  void* args[] = {&p};
  hipError_t e = hipLaunchCooperativeKernel((void*)fwd_megakernel, dim3(grid_blocks), dim3(NTHR), args, SMEM_BYTES, stream);
  if (e != hipSuccess) fprintf(stderr, "cooperative launch failed: %s (grid %d)\n", hipGetErrorString(e), grid_blocks);
}
```

```cpp
#include <hip/hip_runtime.h>
#include <hip/hip_cooperative_groups.h>
#include <cstdint>
#include <cstdio>
namespace cg = cooperative_groups;

typedef unsigned short bf16_t;
typedef short bf16x8 __attribute__((ext_vector_type(8)));
typedef float f32x4 __attribute__((ext_vector_type(4)));
typedef unsigned u32x4 __attribute__((ext_vector_type(4)));
typedef unsigned u32x2 __attribute__((ext_vector_type(2)));

#define NTOK 98304
#define DM 1024
#define PW 3200
#define MW 1152
#define DFF 2816
#define NSEQ 48
#define SEQL 2048
#define LOG2E 1.4426950408889634f
#define LN2 0.6931471805599453f
#define LDSROW 72
#define DT_OFF 320
#define DT_N 641
#define NTHR 512
#define NWAVE 8

struct Params {
  const float *x_prompt, *x_sample, *c_prompt, *c_sample, *norm_attn_g, *norm_ffn_g, *w_ada, *b_ada, *w_in;
  const float *qkn_a, *qkn_b, *qkn_c, *qkn_d, *rpb_a, *sink_b, *t5_table, *lam_d, *subln_d, *w_out, *w_up, *conv_w, *conv_b, *w_down;
  float* out;
  bf16_t* wt; float* mod; float* lut; float* lam; float* lse; bf16_t* proj; bf16_t* hbuf; float* zeros;
};

#define WT_IN 0
#define WT_OUT (3200 * 1024)
#define WT_UP (WT_OUT + 1024 * 1152)
#define WT_DOWN (WT_UP + 5632 * 1024)
#define WT_LAYER (WT_DOWN + 1024 * 2816)

typedef __bf16 bf16x2_t __attribute__((ext_vector_type(2)));
typedef float f32x2_t __attribute__((ext_vector_type(2)));
__device__ __forceinline__ unsigned pk_bf16(float lo, float hi) {
  const f32x2_t v = {lo, hi};
  const bf16x2_t r = __builtin_convertvector(v, bf16x2_t);
  return __builtin_bit_cast(unsigned, r);
}
__device__ __forceinline__ float bf_lo(unsigned u) { return __uint_as_float(u << 16); }
__device__ __forceinline__ float bf_hi(unsigned u) { return __uint_as_float(u & 0xffff0000u); }
__device__ __forceinline__ float fexp2(float x) { return __builtin_amdgcn_exp2f(x); }

__device__ __forceinline__ const float* xin_row(const Params& p, bool first, int tok) {
  if (first) return tok < 65536 ? p.x_prompt + (size_t)tok * DM : p.x_sample + (size_t)(tok - 65536) * DM;
  return p.out + (size_t)tok * DM;
}

__device__ __forceinline__ int opaque_tid() { int t = threadIdx.x; asm volatile("" : "+v"(t)); return t; }

__device__ __forceinline__ size_t blk_off(int r, int k, int R) { return ((size_t)(k >> 5) * R + r) * 32 + (k & 31); }

__device__ __forceinline__ int t5_bucket(int rel) {
  const int n = rel < 0 ? -rel : rel;
  int v;
  if (n < 8) v = n;
  else v = 8 + (n >= 12) + (n >= 16) + (n >= 23) + (n >= 32) + (n >= 46) + (n >= 64) + (n >= 91);
  return (rel > 0 ? 16 : 0) + v;
}

__device__ __forceinline__ void prologue_phase(const Params& p, char* smem) {
  const int tid = opaque_tid(), nb = gridDim.x;
  const int N_TR = 4 * 3200, N_MOD = 192;
  for (int item = blockIdx.x; item < N_TR + N_MOD + 1; item += nb) {
    if (item < N_TR) {
      const int l = item / 3200; int r = item % 3200;
      const float* src; bf16_t* dst; int K, N, kt, nt;
      if (r < 800) { K = 1024; N = 3200; src = p.w_in + (size_t)l * K * N; dst = p.wt + (size_t)l * WT_LAYER + WT_IN; kt = r / 50; nt = r % 50; }
      else if (r < 1088) { r -= 800; K = 1152; N = 1024; src = p.w_out + (size_t)l * K * N; dst = p.wt + (size_t)l * WT_LAYER + WT_OUT; kt = r / 16; nt = r % 16; }
      else if (r < 2496) { r -= 1088; K = 1024; N = 5632; src = p.w_up + (size_t)l * K * N; dst = p.wt + (size_t)l * WT_LAYER + WT_UP; kt = r / 88; nt = r % 88; }
      else { r -= 2496; K = 2816; N = 1024; src = p.w_down + (size_t)l * K * N; dst = p.wt + (size_t)l * WT_LAYER + WT_DOWN; kt = r / 16; nt = r % 16; }
      float* tile = (float*)smem;
      const int k0 = kt * 64, n0 = nt * 64;
      __syncthreads();
#pragma unroll
      for (int i = 0; i < 8; ++i) {
        const int rr = (tid >> 6) + 8 * i, cc = tid & 63;
        tile[rr * 65 + cc] = src[(size_t)(k0 + rr) * N + n0 + cc];
      }
      __syncthreads();
#pragma unroll
      for (int i = 0; i < 4; ++i) {
        const int idx = tid + NTHR * i, n = idx >> 5, k2 = (idx & 31) * 2;
        *(unsigned*)(dst + blk_off(n0 + n, k0 + k2, N)) = pk_bf16(tile[k2 * 65 + n], tile[(k2 + 1) * 65 + n]);
      }
    } else if (item < N_TR + N_MOD) {
      int r = item - N_TR;
      const int l = r / 48; r %= 48;
      const int nc = r / 4, bg = r % 4;
      const int n = nc * NTHR + tid;
      float* sc = (float*)smem;
      float acc[12];
#pragma unroll
      for (int j = 0; j < 12; ++j) acc[j] = 0.f;
      const float* W = p.w_ada + (size_t)l * 1024 * 6144 + n;
      for (int kc = 0; kc < 2; ++kc) {
        __syncthreads();
        for (int i = tid; i < 12 * 512; i += NTHR) {
          const int j = i >> 9, k = i & 511, b = bg * 12 + j;
          const float c = b < 32 ? p.c_prompt[b * 1024 + kc * 512 + k] : p.c_sample[(b - 32) * 1024 + kc * 512 + k];
          sc[i] = c / (1.f + __expf(-c));
        }
        __syncthreads();
#pragma unroll 2
        for (int k = 0; k < 512; k += 4) {
          const float w0 = W[(size_t)(kc * 512 + k) * 6144], w1 = W[(size_t)(kc * 512 + k + 1) * 6144];
          const float w2 = W[(size_t)(kc * 512 + k + 2) * 6144], w3 = W[(size_t)(kc * 512 + k + 3) * 6144];
#pragma unroll
          for (int j = 0; j < 12; ++j) {
            const f32x4 s = *(const f32x4*)(sc + j * 512 + k);
            acc[j] += s[0] * w0 + s[1] * w1 + s[2] * w2 + s[3] * w3;
          }
        }
      }
      const float bias = p.b_ada[l * 6144 + n];
#pragma unroll
      for (int j = 0; j < 12; ++j) p.mod[((size_t)l * 48 + bg * 12 + j) * 6144 + n] = acc[j] + bias;
    } else {
      for (int i = tid; i < 14 * 257; i += NTHR) {
        const int hd = i / 257, idx = i % 257;
        p.lut[i] = p.t5_table[t5_bucket(idx - 128) * 14 + hd] * LOG2E;
      }
      if (tid < 64) p.zeros[tid] = 0.f;
      if (tid < 4) {
        const float* lp = p.lam_d + tid * 128;
        float s1 = 0.f, s2 = 0.f;
        for (int e = 0; e < 32; ++e) { s1 += lp[e] * lp[32 + e]; s2 += lp[64 + e] * lp[96 + e]; }
        const float li = 0.8f - 0.6f * expf(-0.3f * (float)tid);
        p.lam[tid] = expf(s1) - expf(s2) + li;
      }
      {
        const int pr = tid >> 5, ln = tid & 31, l = pr >> 2, m = pr & 3;
        const float* g = m == 0 ? p.qkn_a + l * 128 : (m == 1 ? p.qkn_b + l * 128 : (m == 2 ? p.qkn_c + l * 128 : p.qkn_d + l * 64));
        const int dd = m == 3 ? 32 : 64;
        float gq = 0.f, gk = 0.f, bmax = 0.f;
        for (int i = ln; i < dd; i += 32) { gq = fmaxf(gq, fabsf(g[i])); gk = fmaxf(gk, fabsf(g[dd + i])); }
        if (m == 0) { const float* rp = p.rpb_a + (size_t)l * 4 * 465; for (int i = ln; i < 4 * 465; i += 32) bmax = fmaxf(bmax, rp[i]); }
        else { for (int i = ln; i < 32 * 14; i += 32) bmax = fmaxf(bmax, p.t5_table[i]); }
#pragma unroll
        for (int o = 16; o >= 1; o >>= 1) { gq = fmaxf(gq, __shfl_xor(gq, o)); gk = fmaxf(gk, __shfl_xor(gk, o)); bmax = fmaxf(bmax, __shfl_xor(bmax, o)); }
        const float scale = m == 3 ? 0.17677669529663687f : 0.125f;
        if (ln == 0) p.lam[4 + pr] = ((float)dd * gq * gk * scale + bmax) * LOG2E;
      }
    }
  }
}

__device__ __forceinline__ void norm_phase(const Params& p, int l, bool first, const float* g, int shift_off, int scale_off) {
  const int tid0 = opaque_tid();
  const int lane = tid0 & 63, w = tid0 >> 6;
  const int stride = gridDim.x * NWAVE;
  for (int row0 = blockIdx.x * NWAVE + w; row0 < NTOK; row0 += 2 * stride) {
    const int row1 = row0 + stride;
    const bool has1 = row1 < NTOK;
    const int rows[2] = {row0, has1 ? row1 : row0};
    f32x4 v[2][4];
    float ss[2] = {0.f, 0.f};
#pragma unroll
    for (int r = 0; r < 2; ++r) {
      const float* xr = xin_row(p, first, rows[r]);
#pragma unroll
      for (int i = 0; i < 4; ++i) v[r][i] = *(const f32x4*)(xr + i * 256 + lane * 4);
    }
#pragma unroll
    for (int r = 0; r < 2; ++r) {
#pragma unroll
      for (int i = 0; i < 4; ++i) ss[r] += v[r][i][0] * v[r][i][0] + v[r][i][1] * v[r][i][1] + v[r][i][2] * v[r][i][2] + v[r][i][3] * v[r][i][3];
#pragma unroll
      for (int o = 32; o >= 1; o >>= 1) ss[r] += __shfl_xor(ss[r], o);
    }
#pragma unroll
    for (int r = 0; r < 2; ++r) {
      if (r == 1 && !has1) break;
      const int row = rows[r];
      const float* md = p.mod + ((size_t)l * 48 + (row >> 11)) * 6144;
      const float rstd = rsqrtf(ss[r] * (1.f / 1024.f) + 1e-6f);
#pragma unroll
      for (int i = 0; i < 4; ++i) {
        const int k = i * 256 + lane * 4;
        const f32x4 gg = *(const f32x4*)(g + k), sc = *(const f32x4*)(md + scale_off + k), sh = *(const f32x4*)(md + shift_off + k);
        f32x4 y;
#pragma unroll
        for (int j = 0; j < 4; ++j) y[j] = (v[r][i][j] * rstd) * gg[j] * (1.f + sc[j]) + sh[j];
        u32x2 o; o[0] = pk_bf16(y[0], y[1]); o[1] = pk_bf16(y[2], y[3]);
        *(u32x2*)(p.hbuf + blk_off(row, k, NTOK)) = o;
      }
    }
  }
}

__device__ __forceinline__ bool gemm_tile_id(int it, int MT, int NT, int NB, int& mt, int& nt) {
  const int nb = gridDim.x, bid = blockIdx.x;
  if ((nb & 7) == 0) {
    const int x = bid & 7, slot = bid >> 3, S = nb >> 3;
    const int TPS = 8 * NB, NSN = NT / NB, NS = (MT / 8) * NSN;
    const int pidx = slot + S * it, sidx = pidx / TPS, w = pidx % TPS, s = x + 8 * sidx;
    if (s >= NS) return false;
    mt = (s / NSN) * 8 + (w & 7); nt = (s % NSN) * NB + (w >> 3);
    return true;
  }
  const int t = bid + nb * it;
  if (t >= MT * NT) return false;
  mt = t / NT; nt = t % NT;
  return true;
}

template <int M, int NN>
__device__ __forceinline__ void up_epi_row(const f32x4 (&acc)[8][4], const float* cw, const float* cb, int cbase, int lane, int fr, int s0, bf16_t* obase) {
  constexpr int MP = M > 0 ? M - 1 : 0, MN = M < 7 ? M + 1 : 7;
  const int srcp = (lane & 48) | ((fr + 15) & 15), srcn = (lane & 48) | ((fr + 1) & 15);
  float y[2][4];
#pragma unroll
  for (int n = 0; n < 2; ++n) {
    const int c = n * DFF + cbase;
    const f32x4 w0 = *(const f32x4*)(cw + c), w1 = *(const f32x4*)(cw + 5632 + c), w2 = *(const f32x4*)(cw + 2 * 5632 + c), bb = *(const f32x4*)(cb + c);
#pragma unroll
    for (int j = 0; j < 4; ++j) {
      const float cur = acc[M][NN + 2 * n][j];
      const float zp = (fr == 15) ? acc[MP][NN + 2 * n][j] : cur, zn = (fr == 0) ? acc[MN][NN + 2 * n][j] : cur;
      const float pv = __shfl(zp, srcp), nv = __shfl(zn, srcn);
      y[n][j] = w0[j] * pv + w1[j] * cur + w2[j] * nv + bb[j];
    }
  }
  const int row = 16 * M + fr, tpos = s0 + row;
  if (row >= 1 && row <= 126 && tpos >= 0 && tpos < SEQL) {
    float a[4];
#pragma unroll
    for (int j = 0; j < 4; ++j) { const float gte = y[1][j]; a[j] = y[0][j] * gte / (1.f + __expf(-gte)); }
    u32x2 o; o[0] = pk_bf16(a[0], a[1]); o[1] = pk_bf16(a[2], a[3]);
    *(u32x2*)(obase + (size_t)tpos * 32) = o;
  }
  __builtin_amdgcn_sched_barrier(0);
}

#define GB_A 16384
#define GB_BUF 32768
#define NSTAGE 2
#define SMEM_BYTES (NSTAGE * GB_BUF)
template <int EPI>
__device__ __forceinline__ void gemm_phase(const Params& p, int l, bool first, const bf16_t* A, int NBROWS, const bf16_t* Bt, int K, int MT, int NT, int NB,
                           bf16_t* outb, int ldc, int gate_off, char* smem) {
  const int tid = opaque_tid(), lane = tid & 63, w = tid >> 6, wr = w >> 2, wcn = w & 3, fr = lane & 15, fq = lane >> 4;
  const int nk = K / 32;
  const int lrow = tid >> 2, lch = (tid & 3) ^ ((tid >> 4) & 3);
  const int fsw = (fq ^ ((fr >> 2) & 3)) * 16;
  const size_t apan = (size_t)NTOK * 32, bpan = (size_t)NBROWS * 32;
  const bf16_t* ga0; const bf16_t* ga1; const bf16_t* gb0;
  size_t bstr;
#define GEMM_PTRS(MT_, NT_)                                                                                                          \
  {                                                                                                                                  \
    int t_ = tid; asm volatile("" : "+v"(t_));                                                                                       \
    const int lrow_ = t_ >> 2, lch_ = (t_ & 3) ^ ((t_ >> 4) & 3);                                                                    \
    if (EPI == 2) {                                                                                                                  \
      const int wi0 = 2 * (MT_), wi1 = wi0 + 1;                                                                                      \
      const int t0 = 126 * (wi0 % 17) - 1 + lrow_, t1 = 126 * (wi1 % 17) - 1 + lrow_;                                                \
      ga0 = A + ((size_t)(wi0 / 17) * SEQL + t0) * 32 + lch_ * 8;                                                                    \
      ga1 = A + ((size_t)(wi1 / 17) * SEQL + t1) * 32 + lch_ * 8;                                                                    \
      gb0 = Bt + (size_t)((NT_) * 128 + lrow_) * 32 + lch_ * 8; bstr = (size_t)DFF * 32;                                             \
    } else {                                                                                                                         \
      ga0 = A + (size_t)((MT_) * 256 + lrow_) * 32 + lch_ * 8; ga1 = ga0 + (size_t)128 * 32;                                         \
      gb0 = Bt + (size_t)((NT_) * 256 + lrow_) * 32 + lch_ * 8; bstr = (size_t)128 * 32;                                             \
    }                                                                                                                                \
  }
#define GEMM_LOAD(KT, SET)                                                                                                           \
    {                                                                                                                                \
      const size_t ko_ = (size_t)(KT) * apan, kb_ = (size_t)(KT) * bpan;                                                             \
      asm volatile("global_load_dwordx4 %0, %1, off" : "=v"(SET[0]) : "v"(ga0 + ko_) : "memory");                                     \
      asm volatile("global_load_dwordx4 %0, %1, off" : "=v"(SET[1]) : "v"(ga1 + ko_) : "memory");                                     \
      asm volatile("global_load_dwordx4 %0, %1, off" : "=v"(SET[2]) : "v"(gb0 + kb_) : "memory");                                     \
      asm volatile("global_load_dwordx4 %0, %1, off" : "=v"(SET[3]) : "v"(gb0 + bstr + kb_) : "memory");                              \
    }
#define GEMM_WRITE(SET, STAGE)                                                                                                       \
    {                                                                                                                                \
      asm volatile("" : "+v"(SET[0]), "+v"(SET[1]), "+v"(SET[2]), "+v"(SET[3]));      \
      char* dst_ = smem + (STAGE) * GB_BUF + tid * 16;                                                                               \
      *(u32x4*)(dst_) = SET[0]; *(u32x4*)(dst_ + 8192) = SET[1]; *(u32x4*)(dst_ + GB_A) = SET[2]; *(u32x4*)(dst_ + GB_A + 8192) = SET[3]; \
    }
#define GEMM_KSTEP(KT, WSET)                                                                                                         \
    {                                                                                                                                \
      asm volatile("s_waitcnt lgkmcnt(0)" ::: "memory");                                                                             \
      __builtin_amdgcn_s_barrier();                   \
      if ((KT) + 1 < nk) {                                                                                                           \
        if ((KT) + 2 < nk) asm volatile("s_waitcnt vmcnt(4)" ::: "memory"); else asm volatile("s_waitcnt vmcnt(0)" ::: "memory");     \
        GEMM_WRITE(WSET, ((KT) + 1) & 1)                                                                                             \
        if ((KT) + 3 < nk) GEMM_LOAD((KT) + 3, WSET)                                                                                 \
      }                                                                                                                              \
      const char* Ab = smem + ((KT) & 1) * GB_BUF;                                                                                   \
      const char* Bb = Ab + GB_A;                                                                                                    \
      bf16x8 bfr[4];                                                                                                                 \
      _Pragma("unroll") for (int n = 0; n < 4; ++n) {                                                                                \
        const int br = (EPI == 2) ? ((n >> 1) * 128 + 32 * wcn + 16 * (n & 1) + fr) : (64 * wcn + 16 * n + fr);                      \
        bfr[n] = *(const bf16x8*)(Bb + br * 64 + fsw);                                                                               \
      }                                                                                                                              \
      const char* Ap = Ab + (wr * 128 + fr) * 64 + fsw;                                                                              \
      bf16x8 af0 = *(const bf16x8*)(Ap), af1 = *(const bf16x8*)(Ap + 16 * 64);                                                       \
      _Pragma("unroll") for (int pr = 0; pr < 4; ++pr) {                                                                             \
        bf16x8 an0 = af0, an1 = af1;                                                                                                 \
        if (pr < 3) { an0 = *(const bf16x8*)(Ap + (2 * pr + 2) * 16 * 64); an1 = *(const bf16x8*)(Ap + (2 * pr + 3) * 16 * 64); }    \
        __builtin_amdgcn_sched_barrier(0);                                                                                           \
        _Pragma("unroll") for (int n = 0; n < 4; ++n) acc[2 * pr][n] = __builtin_amdgcn_mfma_f32_16x16x32_bf16(bfr[n], af0, acc[2 * pr][n], 0, 0, 0); \
        _Pragma("unroll") for (int n = 0; n < 4; ++n) acc[2 * pr + 1][n] = __builtin_amdgcn_mfma_f32_16x16x32_bf16(bfr[n], af1, acc[2 * pr + 1][n], 0, 0, 0); \
        __builtin_amdgcn_sched_barrier(0);                                                                                           \
        af0 = an0; af1 = an1;                                                                                                        \
      }                                                                                                                              \
    }
  int mt, nt;
  bool have = gemm_tile_id(0, MT, NT, NB, mt, nt);
  for (int it = 0; have; ++it) {
    GEMM_PTRS(mt, nt)
    u32x4 rsA[4], rsB[4];
    f32x4 acc[8][4];
#pragma unroll
    for (int m = 0; m < 8; ++m)
#pragma unroll
      for (int n = 0; n < 4; ++n) acc[m][n] = (f32x4){0.f, 0.f, 0.f, 0.f};
    asm volatile("s_waitcnt vmcnt(0) lgkmcnt(0)" ::: "memory");
    __builtin_amdgcn_s_barrier();
    GEMM_LOAD(0, rsA)
    GEMM_LOAD(1, rsB)
    asm volatile("s_waitcnt vmcnt(4)" ::: "memory");
    GEMM_WRITE(rsA, 0)
    GEMM_LOAD(2, rsA)
    for (int kt = 0; kt < nk; kt += 2) {
      GEMM_KSTEP(kt, rsB)
      GEMM_KSTEP(kt + 1, rsA)
    }
    const int mt_e = mt, nt_e = nt;
    have = gemm_tile_id(it + 1, MT, NT, NB, mt, nt);
    int lane_e = lane; asm volatile("" : "+v"(lane_e));
    const int fr_e = lane_e & 15, fq_e = lane_e >> 4;
    if (EPI == 0) {
      if (nt_e * 256 + 64 * wcn < NBROWS) {
#pragma unroll
        for (int m = 0; m < 8; ++m) {
          const int tok = mt_e * 256 + wr * 128 + 16 * m + fr_e;
#pragma unroll
          for (int n = 0; n < 4; ++n) {
            const int col = nt_e * 256 + 64 * wcn + 16 * n + 4 * fq_e;
            u32x2 o; o[0] = pk_bf16(acc[m][n][0], acc[m][n][1]); o[1] = pk_bf16(acc[m][n][2], acc[m][n][3]);
            *(u32x2*)(outb + (size_t)tok * ldc + col) = o;
          }
        }
      }
    } else if (EPI == 1) {
      const int b = (mt_e * 256) >> 11;
      const float* gate = p.mod + ((size_t)l * 48 + b) * 6144 + gate_off;
#pragma unroll
      for (int n = 0; n < 4; ++n) {
        const int col = nt_e * 256 + 64 * wcn + 16 * n + 4 * fq_e;
        const f32x4 gv = *(const f32x4*)(gate + col);
#pragma unroll
        for (int m = 0; m < 8; ++m) {
          const int tok = mt_e * 256 + wr * 128 + 16 * m + fr_e;
          const f32x4 xv = *(const f32x4*)(xin_row(p, first, tok) + col);
          f32x4 o;
#pragma unroll
          for (int j = 0; j < 4; ++j) o[j] = xv[j] + gv[j] * acc[m][n][j];
          *(f32x4*)(p.out + (size_t)tok * DM + col) = o;
        }
      }
    } else {
      const float* cw = p.conv_w + (size_t)l * 3 * 5632;
      const float* cb = p.conv_b + (size_t)l * 5632;
      const int wi = 2 * mt_e + wr, seq = wi / 17, s0 = 126 * (wi % 17) - 1;
      if (s0 < 0 || s0 + 127 >= SEQL) {
#pragma unroll
        for (int m = 0; m < 8; ++m) {
          const int tp = s0 + 16 * m + fr_e;
          if (tp < 0 || tp >= SEQL) {
#pragma unroll
            for (int n = 0; n < 4; ++n) acc[m][n] = (f32x4){0.f, 0.f, 0.f, 0.f};
          }
        }
      }
#define UP_EPI_NN(NN)                                                                                                      \
      {                                                                                                                    \
        const int cbase = nt_e * 128 + 32 * wcn + 16 * NN + 4 * fq_e;                                                        \
        bf16_t* obase = outb + blk_off(seq * SEQL, cbase, NTOK);                                                           \
        up_epi_row<0, NN>(acc, cw, cb, cbase, lane_e, fr_e, s0, obase); up_epi_row<1, NN>(acc, cw, cb, cbase, lane_e, fr_e, s0, obase); \
        up_epi_row<2, NN>(acc, cw, cb, cbase, lane_e, fr_e, s0, obase); up_epi_row<3, NN>(acc, cw, cb, cbase, lane_e, fr_e, s0, obase); \
        up_epi_row<4, NN>(acc, cw, cb, cbase, lane_e, fr_e, s0, obase); up_epi_row<5, NN>(acc, cw, cb, cbase, lane_e, fr_e, s0, obase); \
        up_epi_row<6, NN>(acc, cw, cb, cbase, lane_e, fr_e, s0, obase); up_epi_row<7, NN>(acc, cw, cb, cbase, lane_e, fr_e, s0, obase); \
      }
      UP_EPI_NN(0)
      UP_EPI_NN(1)
#undef UP_EPI_NN
    }
  }
#undef GEMM_LOAD
#undef GEMM_WRITE
#undef GEMM_KSTEP
#undef GEMM_PTRS
}

struct AttnArgs {
  int qbase, qstride, qpos0;
  int ktokbase, ktokstep, kstride, kposbase, kposstep, ntiles;
  int qcol, kcol, vcol, ocol;
  const float *gq, *gk;
  float qscale;
  int hw, rmul, taboff0;
  float sinkv;
  float lam, outscale;
  const float* subg;
  int lsecol;
  float cshift;
  int r0, rs0;
};

template <int NQ, int NC, int MODE>
__device__ __forceinline__ void attn_item(const Params& p, const AttnArgs& a, bf16_t* Ks, bf16_t* Vts, const float* tab) {
  const int tid = opaque_tid(), lane = tid & 63, w = tid >> 6, fr = lane & 15, fq = lane >> 4;
  const int wq0 = a.qpos0 + w * 16 * NQ;
  bf16x8 qf[NQ][2];
  int qpos[NQ];
#pragma unroll
  for (int qt = 0; qt < NQ; ++qt) {
    const int qp = wq0 + qt * 16 + fr;
    qpos[qt] = qp;
    const bf16_t* qrow = p.proj + (size_t)(a.qbase + qp * a.qstride) * PW + a.qcol;
    const u32x4 v0 = *(const u32x4*)(qrow + fq * 8), v1 = *(const u32x4*)(qrow + 32 + fq * 8);
    float f0[8], f1[8];
#pragma unroll
    for (int i = 0; i < 4; ++i) { f0[2 * i] = bf_lo(v0[i]); f0[2 * i + 1] = bf_hi(v0[i]); f1[2 * i] = bf_lo(v1[i]); f1[2 * i + 1] = bf_hi(v1[i]); }
    float s0 = 0.f, s1 = 0.f;
#pragma unroll
    for (int i = 0; i < 8; ++i) { s0 += f0[i] * f0[i]; s1 += f1[i] * f1[i]; }
    float r0, r1;
    if (NC == 1) {
      float s = s0 + s1; s += __shfl_xor(s, 16); s += __shfl_xor(s, 32);
      r0 = r1 = rsqrtf(s * (1.f / 64.f) + 1e-6f) * a.qscale;
    } else {
      s0 += __shfl_xor(s0, 16); s0 += __shfl_xor(s0, 32);
      s1 += __shfl_xor(s1, 16); s1 += __shfl_xor(s1, 32);
      r0 = rsqrtf(s0 * (1.f / 32.f) + 1e-6f) * a.qscale; r1 = rsqrtf(s1 * (1.f / 32.f) + 1e-6f) * a.qscale;
    }
    const float* g0p = a.gq + fq * 8;
    const float* g1p = (NC == 1) ? a.gq + 32 + fq * 8 : g0p;
    u32x4 q0, q1;
#pragma unroll
    for (int i = 0; i < 4; ++i) {
      q0[i] = pk_bf16(f0[2 * i] * r0 * g0p[2 * i], f0[2 * i + 1] * r0 * g0p[2 * i + 1]);
      q1[i] = pk_bf16(f1[2 * i] * r1 * g1p[2 * i], f1[2 * i + 1] * r1 * g1p[2 * i + 1]);
    }
    qf[qt][0] = __builtin_bit_cast(bf16x8, q0);
    qf[qt][1] = __builtin_bit_cast(bf16x8, q1);
  }
  f32x4 o[NC][NQ][4];
  float mrun[NC][NQ];
  f32x4 lsum[NC][NQ];
  const bf16x8 ones = {0x3F80, 0x3F80, 0x3F80, 0x3F80, 0x3F80, 0x3F80, 0x3F80, 0x3F80};
#pragma unroll
  for (int c = 0; c < NC; ++c)
#pragma unroll
    for (int qt = 0; qt < NQ; ++qt) {
      mrun[c][qt] = a.cshift;
      const float l0 = (MODE == 1) ? fexp2(a.sinkv - a.cshift) : 0.f;
      lsum[c][qt] = (f32x4){l0, l0, l0, l0};
#pragma unroll
      for (int dt = 0; dt < 4; ++dt) o[c][qt][dt] = (f32x4){0.f, 0.f, 0.f, 0.f};
    }
  const int lch = tid & 7;
  float gkv[8];
#pragma unroll
  for (int i = 0; i < 8; ++i) gkv[i] = a.gk[((NC == 1) ? lch : (lch & 3)) * 8 + i];

  const int rw = a.r0 + ((w * 16 * NQ) >> 6);
  int rsw = rw - 4; rsw = rsw < 0 ? 0 : (rsw > 24 ? 24 : rsw);
  u32x4 kA, vA, kB, vB;
  const int kkey = tid >> 3, vkey = tid & 63, vch = tid >> 6;
#define ATTN_PREFETCH(T, KR, VR)                                                                                 \
  {                                                                                                              \
    const int ktok0_ = a.ktokbase + (T) * a.ktokstep;                                                            \
    KR = *(const u32x4*)(p.proj + (size_t)(ktok0_ + kkey * a.kstride) * PW + a.kcol + lch * 8);                   \
    VR = *(const u32x4*)(p.proj + (size_t)(ktok0_ + vkey * a.kstride) * PW + a.vcol + vch * 8);                   \
  }
  auto stage_write = [&](const u32x4& kr, const u32x4& vr, bf16_t* Ksb, bf16_t* Vtb) __attribute__((always_inline)) {
    float f[8];
#pragma unroll
    for (int i = 0; i < 4; ++i) { f[2 * i] = bf_lo(kr[i]); f[2 * i + 1] = bf_hi(kr[i]); }
    float s = 0.f;
#pragma unroll
    for (int i = 0; i < 8; ++i) s += f[i] * f[i];
    s += __shfl_xor(s, 1); s += __shfl_xor(s, 2);
    float rs;
    if (NC == 1) { s += __shfl_xor(s, 4); rs = rsqrtf(s * (1.f / 64.f) + 1e-6f); }
    else rs = rsqrtf(s * (1.f / 32.f) + 1e-6f);
    u32x4 kq;
#pragma unroll
    for (int i = 0; i < 4; ++i) kq[i] = pk_bf16(f[2 * i] * rs * gkv[2 * i], f[2 * i + 1] * rs * gkv[2 * i + 1]);
    *(u32x4*)(Ksb + kkey * LDSROW + lch * 8) = kq;
#pragma unroll
    for (int i = 0; i < 4; ++i) {
      Vtb[(vch * 8 + 2 * i) * LDSROW + vkey] = (bf16_t)(vr[i] & 0xffffu);
      Vtb[(vch * 8 + 2 * i + 1) * LDSROW + vkey] = (bf16_t)(vr[i] >> 16);
    }
  };
  auto tile_math = [&](int t, const bf16_t* Ksb, const bf16_t* Vtb) __attribute__((always_inline)) {
    if (MODE == 0) { const int kr_ = a.rs0 + t; if (kr_ < rsw || kr_ >= rsw + 8) return; }
    const int kp0 = a.kposbase + t * a.kposstep;
    const int taboff = (a.rs0 + t - rw + 7) * 31;
    bf16x8 pf[NC][NQ][2];
    bf16x8 kf[4][2];
#pragma unroll
    for (int kt = 0; kt < 4; ++kt) {
      kf[kt][0] = *(const bf16x8*)(Ksb + (kt * 16 + fr) * LDSROW + fq * 8);
      kf[kt][1] = *(const bf16x8*)(Ksb + (kt * 16 + fr) * LDSROW + 32 + fq * 8);
    }
    bf16x8 vfr[4][2];
#pragma unroll
    for (int ks = 0; ks < 2; ++ks)
#pragma unroll
      for (int dt = 0; dt < 4; ++dt) {
        const u32x2 lo = *(const u32x2*)(Vtb + (dt * 16 + fr) * LDSROW + ks * 32 + 4 * fq);
        const u32x2 hi = *(const u32x2*)(Vtb + (dt * 16 + fr) * LDSROW + ks * 32 + 16 + 4 * fq);
        u32x4 vv; vv[0] = lo[0]; vv[1] = lo[1]; vv[2] = hi[0]; vv[3] = hi[1];
        vfr[dt][ks] = __builtin_bit_cast(bf16x8, vv);
      }
#pragma unroll
    for (int qt = 0; qt < NQ; ++qt) {
      const int qp = (MODE == 0) ? (qpos[qt] & 63) : qpos[qt];
      int cs = qp - 8; cs = cs < 0 ? 0 : (cs > 48 ? 48 : cs);
      f32x4 bv[4];
      const bool far_hi = (MODE == 3) && (kp0 - (wq0 + 16 * NQ - 1) >= 128), far_lo = (MODE == 3) && (wq0 - (kp0 + 63) >= 128);
      if (far_hi || far_lo) {
        const float bu = tab[far_hi ? (DT_OFF + 256) : (DT_OFF - 256)];
#pragma unroll
        for (int kt = 0; kt < 4; ++kt) bv[kt] = (f32x4){bu, bu, bu, bu};
      } else if (MODE != 0) {
        const float* tb = tab + (kp0 - qp + 4 * fq + DT_OFF);
#pragma unroll
        for (int kt = 0; kt < 4; ++kt)
#pragma unroll
          for (int j = 0; j < 4; ++j) bv[kt][j] = tb[kt * 16 + j];
      } else
#pragma unroll
      for (int kt = 0; kt < 4; ++kt)
#pragma unroll
        for (int j = 0; j < 4; ++j) {
          const int kpos = kp0 + kt * 16 + 4 * fq + j;
          const int d = kpos - qp;
          const bool valid = kpos >= cs && kpos < cs + 16;
          int dd = d + 15; dd = dd < 0 ? 0 : (dd > 30 ? 30 : dd);
          const float bias = tab[taboff + dd];
          bv[kt][j] = valid ? bias : -INFINITY;
        }
#pragma unroll
      for (int c = 0; c < NC; ++c) {
        f32x4 s[4];
#pragma unroll
        for (int kt = 0; kt < 4; ++kt) {
          if (NC == 1) {
            const f32x4 r = __builtin_amdgcn_mfma_f32_16x16x32_bf16(kf[kt][0], qf[qt][0], bv[kt], 0, 0, 0);
            s[kt] = __builtin_amdgcn_mfma_f32_16x16x32_bf16(kf[kt][1], qf[qt][1], r, 0, 0, 0);
          } else {
            s[kt] = __builtin_amdgcn_mfma_f32_16x16x32_bf16(kf[kt][c], qf[qt][c], bv[kt], 0, 0, 0);
          }
        }
#pragma unroll
        for (int kt = 0; kt < 4; ++kt)
#pragma unroll
          for (int j = 0; j < 4; ++j) s[kt][j] = fexp2(s[kt][j]);
#pragma unroll
        for (int ks = 0; ks < 2; ++ks) {
          u32x4 pk;
          pk[0] = pk_bf16(s[2 * ks][0], s[2 * ks][1]); pk[1] = pk_bf16(s[2 * ks][2], s[2 * ks][3]);
          pk[2] = pk_bf16(s[2 * ks + 1][0], s[2 * ks + 1][1]); pk[3] = pk_bf16(s[2 * ks + 1][2], s[2 * ks + 1][3]);
          pf[c][qt][ks] = __builtin_bit_cast(bf16x8, pk);
        }
      }
    }
#pragma unroll
    for (int ks = 0; ks < 2; ++ks) {
#pragma unroll
      for (int dt = 0; dt < 4; ++dt) {
        const bf16x8 vf = vfr[dt][ks];
#pragma unroll
        for (int c = 0; c < NC; ++c)
#pragma unroll
          for (int qt = 0; qt < NQ; ++qt) o[c][qt][dt] = __builtin_amdgcn_mfma_f32_16x16x32_bf16(vf, pf[c][qt][ks], o[c][qt][dt], 0, 0, 0);
      }
#pragma unroll
      for (int c = 0; c < NC; ++c)
#pragma unroll
        for (int qt = 0; qt < NQ; ++qt) lsum[c][qt] = __builtin_amdgcn_mfma_f32_16x16x32_bf16(ones, pf[c][qt][ks], lsum[c][qt], 0, 0, 0);
    }
    };
  bf16_t* const Ks1 = Ks + 2 * 64 * LDSROW;
  bf16_t* const Vts1 = Vts + 2 * 64 * LDSROW;
  const int ntl = a.ntiles;
  ATTN_PREFETCH(0, kA, vA)
  if (ntl > 1) ATTN_PREFETCH(1, kB, vB)
  stage_write(kA, vA, Ks, Vts);
  if (ntl > 2) ATTN_PREFETCH(2, kA, vA)
  for (int t = 0; t < ntl; t += 2) {
    __syncthreads();
    if (t + 1 < ntl) { stage_write(kB, vB, Ks1, Vts1); if (t + 3 < ntl) ATTN_PREFETCH(t + 3, kB, vB) }
    tile_math(t, Ks, Vts);
    if (t + 1 < ntl) {
      __syncthreads();
      if (t + 2 < ntl) { stage_write(kA, vA, Ks, Vts); if (t + 4 < ntl) ATTN_PREFETCH(t + 4, kA, vA) }
      tile_math(t + 1, Ks1, Vts1);
    }
  }
#undef ATTN_PREFETCH
#pragma unroll
  for (int qt = 0; qt < NQ; ++qt) {
    float inv[NC], ltot[NC];
#pragma unroll
    for (int c = 0; c < NC; ++c) {
      const float lt = lsum[c][qt][0];
      ltot[c] = lt; inv[c] = 1.f / lt;
    }
    const int tok = a.qbase + qpos[qt] * a.qstride;
    if (MODE == 3) {
      f32x4 v[4];
      float ss = 0.f;
#pragma unroll
      for (int dt = 0; dt < 4; ++dt)
#pragma unroll
        for (int j = 0; j < 4; ++j) {
          const float x = o[0][qt][dt][j] * inv[0] - a.lam * (o[NC - 1][qt][dt][j] * inv[NC - 1]);
          v[dt][j] = x; ss += x * x;
        }
      ss += __shfl_xor(ss, 16); ss += __shfl_xor(ss, 32);
      const float rstd = rsqrtf(ss * (1.f / 64.f) + 1e-6f) * a.outscale;
#pragma unroll
      for (int dt = 0; dt < 4; ++dt) {
        const f32x4 g = *(const f32x4*)(a.subg + dt * 16 + 4 * fq);
        u32x2 ov; ov[0] = pk_bf16(v[dt][0] * rstd * g[0], v[dt][1] * rstd * g[1]); ov[1] = pk_bf16(v[dt][2] * rstd * g[2], v[dt][3] * rstd * g[3]);
        *(u32x2*)(p.hbuf + blk_off(tok, a.ocol + dt * 16 + 4 * fq, NTOK)) = ov;
      }
    } else {
#pragma unroll
      for (int dt = 0; dt < 4; ++dt) {
        u32x2 ov;
        ov[0] = pk_bf16(o[0][qt][dt][0] * inv[0], o[0][qt][dt][1] * inv[0]);
        ov[1] = pk_bf16(o[0][qt][dt][2] * inv[0], o[0][qt][dt][3] * inv[0]);
        *(u32x2*)(p.hbuf + blk_off(tok, a.ocol + dt * 16 + 4 * fq, NTOK)) = ov;
      }
      if (MODE == 2 && fq == 0) p.lse[(size_t)tok * 6 + a.lsecol] = (mrun[0][qt] + __log2f(ltot[0])) * LN2;
    }
  }
}

__device__ __forceinline__ void attn_phase(const Params& p, int l, char* smem) {
  bf16_t* Ks = (bf16_t*)smem;
  bf16_t* Vts = Ks + 64 * LDSROW;
  float* tab = (float*)(Ks + 4 * 64 * LDSROW);
  const int tid = opaque_tid();
  const int nD = 3072, nA = 3072, nB = 3072, nC = 4608;
  for (int item = blockIdx.x; item < nD + nA + nB + nC; item += gridDim.x) {
    AttnArgs a;
    a.taboff0 = 0; a.r0 = 0; a.rs0 = 0; a.sinkv = 0.f; a.cshift = 0.f; a.lam = 0.f; a.outscale = 1.f; a.subg = nullptr; a.lsecol = 0; a.hw = 1 << 20; a.rmul = 1;
    __syncthreads();
    if (item < nD) {
      const int b = item >> 6, h = (item >> 4) & 3, qb = item & 15;
      a.cshift = p.lam[4 + l * 4 + 3];
      for (int i = tid; i < DT_N; i += NTHR) { int dd = i - DT_OFF; dd = dd < -128 ? -128 : (dd > 128 ? 128 : dd); tab[i] = p.lut[(10 + h) * 257 + dd + 128] - a.cshift; }
      a.qbase = b * SEQL; a.qstride = 1; a.qpos0 = qb * 128;
      a.ktokbase = b * SEQL; a.ktokstep = 64; a.kstride = 1; a.kposbase = 0; a.kposstep = 64; a.ntiles = 32;
      a.qcol = 2432 + h * 64; a.kcol = 2432 + 256 + h * 64; a.vcol = 2432 + 512 + h * 64; a.ocol = 896 + h * 64;
      a.gq = p.qkn_d + l * 64; a.gk = a.gq + 32;
      a.qscale = 0.17677669529663687f * LOG2E;
      a.lam = p.lam[l]; a.outscale = 1.f - (0.8f - 0.6f * expf(-0.3f * (float)l)); a.subg = p.subln_d + l * 64;
      attn_item<1, 2, 3>(p, a, Ks, Vts, tab);
    } else if (item < nD + nA) {
      const int id = item - nD;
      const int b = id >> 6, h = (id >> 4) & 3, r = (id & 15) * 2;
      const float* rp = p.rpb_a + ((size_t)l * 4 + h) * 465;
      a.cshift = p.lam[4 + l * 4 + 0];
      for (int i = tid; i < 465; i += NTHR) tab[i] = rp[i] * LOG2E - a.cshift;
      int rs = r - 4; rs = rs < 0 ? 0 : (rs > 24 ? 24 : rs);
      int rs1 = r - 3; rs1 = rs1 < 0 ? 0 : (rs1 > 24 ? 24 : rs1);
      a.qbase = b * SEQL + r * 64; a.qstride = 1; a.qpos0 = 0; a.r0 = r; a.rs0 = rs;
      a.ktokbase = b * SEQL + rs * 64; a.ktokstep = 64; a.kstride = 1; a.kposbase = 0; a.kposstep = 0; a.ntiles = rs1 - rs + 8;
      a.qcol = h * 64; a.kcol = 256 + h * 64; a.vcol = 512 + h * 64; a.ocol = h * 64;
      a.gq = p.qkn_a + l * 128; a.gk = a.gq + 64;
      a.qscale = 0.125f * LOG2E;
      attn_item<1, 1, 0>(p, a, Ks, Vts, tab);
    } else if (item < nD + nA + nB) {
      const int id = item - nD - nA;
      const int b = id >> 6, h = (id >> 4) & 3, qb = id & 15;
      a.cshift = p.lam[4 + l * 4 + 1];
      for (int i = tid; i < DT_N; i += NTHR) { const int d = i - DT_OFF; tab[i] = (d >= -128 && d <= 128) ? p.lut[h * 257 + d + 128] - a.cshift : -INFINITY; }
      const int q0 = qb * 128;
      const int kstart = q0 - 128 < 0 ? 0 : q0 - 128, kend = q0 + 256 > SEQL ? SEQL : q0 + 256;
      a.qbase = b * SEQL; a.qstride = 1; a.qpos0 = q0;
      a.ktokbase = b * SEQL + kstart; a.ktokstep = 64; a.kstride = 1; a.kposbase = kstart; a.kposstep = 64; a.ntiles = (kend - kstart) >> 6;
      a.qcol = 768 + h * 64; a.kcol = 768 + 256 + (h >> 1) * 64; a.vcol = 768 + 384 + (h >> 1) * 64; a.ocol = 256 + h * 64;
      a.gq = p.qkn_b + l * 128; a.gk = a.gq + 64;
      a.qscale = 0.125f * LOG2E;
      a.hw = 128; a.rmul = 1; a.sinkv = p.sink_b[l * 4 + h] * LOG2E;
      attn_item<1, 1, 1>(p, a, Ks, Vts, tab);
    } else {
      const int id = item - nD - nA - nB;
      const int b = id / 96, rem = id % 96, g = rem >> 5, i2 = (rem >> 4) & 1, blk = rem & 15;
      const int r = g == 0 ? 1 : (g == 1 ? 4 : 16);
      const int L = SEQL / r, bps = L >> 7;
      const int pp = blk / bps, m0 = (blk % bps) * 128;
      const int hh = g * 2 + i2;
      a.cshift = p.lam[4 + l * 4 + 2];
      for (int i = tid; i < DT_N; i += NTHR) { const int d = i - DT_OFF; int dd = d * r; dd = dd < -128 ? -128 : (dd > 128 ? 128 : dd);
        tab[i] = (d >= -64 && d <= 64) ? p.lut[(4 + hh) * 257 + dd + 128] - a.cshift : -INFINITY; }
      const int kstart = m0 - 64 < 0 ? 0 : m0 - 64, kend = m0 + 192 > L ? L : m0 + 192;
      a.qbase = b * SEQL + pp; a.qstride = r; a.qpos0 = m0;
      a.ktokbase = a.qbase + kstart * r; a.ktokstep = 64 * r; a.kstride = r; a.kposbase = kstart; a.kposstep = 64; a.ntiles = (kend - kstart) >> 6;
      a.qcol = 1280 + hh * 64; a.kcol = 1280 + 384 + hh * 64; a.vcol = 1280 + 768 + hh * 64; a.ocol = 512 + hh * 64;
      a.gq = p.qkn_c + l * 128; a.gk = a.gq + 64;
      a.qscale = 0.125f * LOG2E;
      a.hw = 64; a.rmul = r; a.lsecol = hh;
      attn_item<1, 1, 2>(p, a, Ks, Vts, tab);
    }
  }
}

__device__ __forceinline__ void combine_phase(const Params& p) {
  const int nthr = gridDim.x * NTHR;
  for (int i = blockIdx.x * NTHR + opaque_tid(); i < NTOK * 48; i += nthr) {
    const int tok = i / 48, rem = i % 48, hh = rem >> 3, ch = rem & 7, ii = hh & 1, g = hh >> 1;
    const float* ls = p.lse + (size_t)tok * 6;
    const float l0 = ls[ii], l1 = ls[2 + ii], l2 = ls[4 + ii];
    const float mx = fmaxf(l0, fmaxf(l1, l2));
    const float e0 = __expf(l0 - mx), e1 = __expf(l1 - mx), e2 = __expf(l2 - mx);
    const float al = (g == 0 ? e0 : (g == 1 ? e1 : e2)) / (e0 + e1 + e2);
    bf16_t* ptr = p.hbuf + blk_off(tok, 512 + hh * 64 + ch * 8, NTOK);
    u32x4 v = *(const u32x4*)ptr;
#pragma unroll
    for (int k = 0; k < 4; ++k) v[k] = pk_bf16(bf_lo(v[k]) * al, bf_hi(v[k]) * al);
    *(u32x4*)ptr = v;
  }
}


#ifndef REP_GEMM
#define REP_GEMM 1
#endif
#ifndef REP_ATTN
#define REP_ATTN 1
#endif
#ifndef DBG_STOP
#define DBG_STOP 0
#endif
__global__ void __launch_bounds__(NTHR, 2) fwd_megakernel(Params p) {
  extern __shared__ __attribute__((aligned(16))) char smem[];
  cg::grid_group grid = cg::this_grid();
  prologue_phase(p, smem);
  grid.sync();
#define LAYER(L)                                                                                                   \
  {                                                                                                                \
    constexpr int l = (L);                                                                                         \
    constexpr bool first = (l == 0);                                                                               \
    const bf16_t* wt = p.wt + (size_t)l * WT_LAYER;                                                                \
    norm_phase(p, l, first, p.norm_attn_g + l * DM, 0, 1024);                                                      \
    grid.sync();                                                                                                   \
    gemm_phase<0>(p, l, false, p.hbuf, 3200, wt + WT_IN, 1024, 384, 13, 13, p.proj, PW, 0, smem);                  \
    grid.sync();                                                                                                   \
    attn_phase(p, l, smem);                                                                                        \
    grid.sync();                                                                                                   \
    combine_phase(p);                                                                                              \
    grid.sync();                                                                                                   \
    gemm_phase<1>(p, l, first, p.hbuf, 1024, wt + WT_OUT, 1152, 384, 4, 4, nullptr, 0, 2048, smem);                \
    grid.sync();                                                                                                   \
    norm_phase(p, l, false, p.norm_ffn_g + l * DM, 3072, 4096);                                                    \
    grid.sync();                                                                                                   \
    gemm_phase<2>(p, l, false, p.hbuf, 5632, wt + WT_UP, 1024, 408, 22, 22, p.proj, DFF, 0, smem);                 \
    grid.sync();                                                                                                   \
    gemm_phase<1>(p, l, false, p.proj, 1024, wt + WT_DOWN, 2816, 384, 4, 4, nullptr, 0, 5120, smem);               \
    grid.sync();                                                                                                   \
  }
  LAYER(0)
  LAYER(1)
  LAYER(2)
  LAYER(3)
#undef LAYER
}

extern "C" void kernel_launch(void* const* d_in, const int* in_sizes, int n_in, void* d_out, int out_size, void* d_ws, size_t ws_size,
                              hipStream_t stream) {
  static int grid_blocks = 0;
  if (!grid_blocks) {
    int dev = 0, cus = 0, per_cu = 0;
    hipGetDevice(&dev);
    hipDeviceGetAttribute(&cus, hipDeviceAttributeMultiprocessorCount, dev);
    hipFuncSetAttribute((const void*)fwd_megakernel, hipFuncAttributeMaxDynamicSharedMemorySize, SMEM_BYTES);
    hipOccupancyMaxActiveBlocksPerMultiprocessor(&per_cu, fwd_megakernel, NTHR, SMEM_BYTES);
    if (per_cu > 1) per_cu = 1;
    if (per_cu < 1) per_cu = 1;
    grid_blocks = cus * per_cu;
  }
  Params p{};
  const float* const* in = (const float* const*)d_in;
  p.x_prompt = in[0]; p.x_sample = in[1]; p.c_prompt = in[2]; p.c_sample = in[3]; p.norm_attn_g = in[4]; p.norm_ffn_g = in[5];
  p.w_ada = in[6]; p.b_ada = in[7]; p.w_in = in[8]; p.qkn_a = in[9]; p.qkn_b = in[10]; p.qkn_c = in[11]; p.qkn_d = in[12];
  p.rpb_a = in[13]; p.sink_b = in[14]; p.t5_table = in[15]; p.lam_d = in[16]; p.subln_d = in[17]; p.w_out = in[18]; p.w_up = in[19];
  p.conv_w = in[20]; p.conv_b = in[21]; p.w_down = in[22];
  p.out = (float*)d_out;
  char* ws = (char*)d_ws;
  size_t off = 0;
  p.wt = (bf16_t*)(ws + off); off += (size_t)4 * WT_LAYER * 2;
  p.mod = (float*)(ws + off); off += (size_t)4 * 48 * 6144 * 4;
  p.lut = (float*)(ws + off); off += 16384;
  p.lam = (float*)(ws + off); off += 256;
  p.zeros = (float*)(ws + off); off += 256;
  p.lse = (float*)(ws + off); off += (size_t)NTOK * 6 * 4;
  p.proj = (bf16_t*)(ws + off); off += (size_t)NTOK * PW * 2;
  p.hbuf = (bf16_t*)(ws + off); off += (size_t)NTOK * MW * 2;
  if (off > ws_size) { fprintf(stderr, "workspace too small: need %zu have %zu\n", off, ws_size); return; }
  void* args[] = {&p};
  hipError_t e = hipLaunchCooperativeKernel((void*)fwd_megakernel, dim3(grid_blocks), dim3(NTHR), args, SMEM_BYTES, stream);
  if (e != hipSuccess) fprintf(stderr, "cooperative launch failed: %s (grid %d)\n", hipGetErrorString(e), grid_blocks);
}
```

```cpp
#include <hip/hip_runtime.h>
#include <hip/hip_cooperative_groups.h>
#include <cstdint>
#include <cstdio>
namespace cg = cooperative_groups;

typedef unsigned short bf16_t;
typedef short bf16x8 __attribute__((ext_vector_type(8)));
typedef float f32x4 __attribute__((ext_vector_type(4)));
typedef unsigned u32x4 __attribute__((ext_vector_type(4)));
typedef unsigned u32x2 __attribute__((ext_vector_type(2)));

#define NTOK 98304
#define DM 1024
#define PW 3200
#define MW 1152
#define DFF 2816
#define NSEQ 48
#define SEQL 2048
#define LOG2E 1.4426950408889634f
#define LN2 0.6931471805599453f
#define LDSROW 72
#define DT_OFF 320
#define DT_N 641
#define NTHR 512
#define NWAVE 8

struct Params {
  const float *x_prompt, *x_sample, *c_prompt, *c_sample, *norm_attn_g, *norm_ffn_g, *w_ada, *b_ada, *w_in;
  const float *qkn_a, *qkn_b, *qkn_c, *qkn_d, *rpb_a, *sink_b, *t5_table, *lam_d, *subln_d, *w_out, *w_up, *conv_w, *conv_b, *w_down;
  float* out;
  bf16_t* wt; float* mod; float* lut; float* lam; float* lse; bf16_t* proj; bf16_t* hbuf; float* zeros;
};

#define WT_IN 0
#define WT_OUT (3200 * 1024)
#define WT_UP (WT_OUT + 1024 * 1152)
#define WT_DOWN (WT_UP + 5632 * 1024)
#define WT_LAYER (WT_DOWN + 1024 * 2816)

typedef __bf16 bf16x2_t __attribute__((ext_vector_type(2)));
typedef float f32x2_t __attribute__((ext_vector_type(2)));
__device__ __forceinline__ unsigned pk_bf16(float lo, float hi) {
  const f32x2_t v = {lo, hi};
  const bf16x2_t r = __builtin_convertvector(v, bf16x2_t);
  return __builtin_bit_cast(unsigned, r);
}
__device__ __forceinline__ float bf_lo(unsigned u) { return __uint_as_float(u << 16); }
__device__ __forceinline__ float bf_hi(unsigned u) { return __uint_as_float(u & 0xffff0000u); }
__device__ __forceinline__ float fexp2(float x) { return __builtin_amdgcn_exp2f(x); }

__device__ __forceinline__ const float* xin_row(const Params& p, bool first, int tok) {
  if (first) return tok < 65536 ? p.x_prompt + (size_t)tok * DM : p.x_sample + (size_t)(tok - 65536) * DM;
  return p.out + (size_t)tok * DM;
}

__device__ __forceinline__ int opaque_tid() { int t = threadIdx.x; asm volatile("" : "+v"(t)); return t; }

__device__ __forceinline__ size_t blk_off(int r, int k, int R) { return ((size_t)(k >> 5) * R + r) * 32 + (k & 31); }

__device__ __forceinline__ int t5_bucket(int rel) {
  const int n = rel < 0 ? -rel : rel;
  int v;
  if (n < 8) v = n;
  else v = 8 + (n >= 12) + (n >= 16) + (n >= 23) + (n >= 32) + (n >= 46) + (n >= 64) + (n >= 91);
  return (rel > 0 ? 16 : 0) + v;
}

__device__ __forceinline__ void prologue_phase(const Params& p, char* smem) {
  const int tid = opaque_tid(), nb = gridDim.x;
  const int N_TR = 4 * 3200, N_MOD = 192;
  for (int item = blockIdx.x; item < N_TR + N_MOD + 1; item += nb) {
    if (item < N_TR) {
      const int l = item / 3200; int r = item % 3200;
      const float* src; bf16_t* dst; int K, N, kt, nt;
      if (r < 800) { K = 1024; N = 3200; src = p.w_in + (size_t)l * K * N; dst = p.wt + (size_t)l * WT_LAYER + WT_IN; kt = r / 50; nt = r % 50; }
      else if (r < 1088) { r -= 800; K = 1152; N = 1024; src = p.w_out + (size_t)l * K * N; dst = p.wt + (size_t)l * WT_LAYER + WT_OUT; kt = r / 16; nt = r % 16; }
      else if (r < 2496) { r -= 1088; K = 1024; N = 5632; src = p.w_up + (size_t)l * K * N; dst = p.wt + (size_t)l * WT_LAYER + WT_UP; kt = r / 88; nt = r % 88; }
      else { r -= 2496; K = 2816; N = 1024; src = p.w_down + (size_t)l * K * N; dst = p.wt + (size_t)l * WT_LAYER + WT_DOWN; kt = r / 16; nt = r % 16; }
      float* tile = (float*)smem;
      const int k0 = kt * 64, n0 = nt * 64;
      __syncthreads();
#pragma unroll
      for (int i = 0; i < 8; ++i) {
        const int rr = (tid >> 6) + 8 * i, cc = tid & 63;
        tile[rr * 65 + cc] = src[(size_t)(k0 + rr) * N + n0 + cc];
      }
      __syncthreads();
#pragma unroll
      for (int i = 0; i < 4; ++i) {
        const int idx = tid + NTHR * i, n = idx >> 5, k2 = (idx & 31) * 2;
        *(unsigned*)(dst + blk_off(n0 + n, k0 + k2, N)) = pk_bf16(tile[k2 * 65 + n], tile[(k2 + 1) * 65 + n]);
      }
    } else if (item < N_TR + N_MOD) {
      int r = item - N_TR;
      const int l = r / 48; r %= 48;
      const int nc = r / 4, bg = r % 4;
      const int n = nc * NTHR + tid;
      float* sc = (float*)smem;
      float acc[12];
#pragma unroll
      for (int j = 0; j < 12; ++j) acc[j] = 0.f;
      const float* W = p.w_ada + (size_t)l * 1024 * 6144 + n;
      for (int kc = 0; kc < 2; ++kc) {
        __syncthreads();
        for (int i = tid; i < 12 * 512; i += NTHR) {
          const int j = i >> 9, k = i & 511, b = bg * 12 + j;
          const float c = b < 32 ? p.c_prompt[b * 1024 + kc * 512 + k] : p.c_sample[(b - 32) * 1024 + kc * 512 + k];
          sc[i] = c / (1.f + __expf(-c));
        }
        __syncthreads();
#pragma unroll 2
        for (int k = 0; k < 512; k += 4) {
          const float w0 = W[(size_t)(kc * 512 + k) * 6144], w1 = W[(size_t)(kc * 512 + k + 1) * 6144];
          const float w2 = W[(size_t)(kc * 512 + k + 2) * 6144], w3 = W[(size_t)(kc * 512 + k + 3) * 6144];
#pragma unroll
          for (int j = 0; j < 12; ++j) {
            const f32x4 s = *(const f32x4*)(sc + j * 512 + k);
            acc[j] += s[0] * w0 + s[1] * w1 + s[2] * w2 + s[3] * w3;
          }
        }
      }
      const float bias = p.b_ada[l * 6144 + n];
#pragma unroll
      for (int j = 0; j < 12; ++j) p.mod[((size_t)l * 48 + bg * 12 + j) * 6144 + n] = acc[j] + bias;
    } else {
      for (int i = tid; i < 14 * 257; i += NTHR) {
        const int hd = i / 257, idx = i % 257;
        p.lut[i] = p.t5_table[t5_bucket(idx - 128) * 14 + hd] * LOG2E;
      }
      if (tid < 64) p.zeros[tid] = 0.f;
      if (tid < 4) {
        const float* lp = p.lam_d + tid * 128;
        float s1 = 0.f, s2 = 0.f;
        for (int e = 0; e < 32; ++e) { s1 += lp[e] * lp[32 + e]; s2 += lp[64 + e] * lp[96 + e]; }
        const float li = 0.8f - 0.6f * expf(-0.3f * (float)tid);
        p.lam[tid] = expf(s1) - expf(s2) + li;
      }
      {
        const int pr = tid >> 5, ln = tid & 31, l = pr >> 2, m = pr & 3;
        const float* g = m == 0 ? p.qkn_a + l * 128 : (m == 1 ? p.qkn_b + l * 128 : (m == 2 ? p.qkn_c + l * 128 : p.qkn_d + l * 64));
        const int dd = m == 3 ? 32 : 64;
        float gq = 0.f, gk = 0.f, bmax = 0.f;
        for (int i = ln; i < dd; i += 32) { gq = fmaxf(gq, fabsf(g[i])); gk = fmaxf(gk, fabsf(g[dd + i])); }
        if (m == 0) { const float* rp = p.rpb_a + (size_t)l * 4 * 465; for (int i = ln; i < 4 * 465; i += 32) bmax = fmaxf(bmax, rp[i]); }
        else { for (int i = ln; i < 32 * 14; i += 32) bmax = fmaxf(bmax, p.t5_table[i]); }
#pragma unroll
        for (int o = 16; o >= 1; o >>= 1) { gq = fmaxf(gq, __shfl_xor(gq, o)); gk = fmaxf(gk, __shfl_xor(gk, o)); bmax = fmaxf(bmax, __shfl_xor(bmax, o)); }
        const float scale = m == 3 ? 0.17677669529663687f : 0.125f;
        if (ln == 0) p.lam[4 + pr] = ((float)dd * gq * gk * scale + bmax) * LOG2E;
      }
    }
  }
}

__device__ __forceinline__ void norm_phase(const Params& p, int l, bool first, const float* g, int shift_off, int scale_off) {
  const int tid0 = opaque_tid();
  const int lane = tid0 & 63, w = tid0 >> 6;
  const int stride = gridDim.x * NWAVE;
  for (int row0 = blockIdx.x * NWAVE + w; row0 < NTOK; row0 += 2 * stride) {
    const int row1 = row0 + stride;
    const bool has1 = row1 < NTOK;
    const int rows[2] = {row0, has1 ? row1 : row0};
    f32x4 v[2][4];
    float ss[2] = {0.f, 0.f};
#pragma unroll
    for (int r = 0; r < 2; ++r) {
      const float* xr = xin_row(p, first, rows[r]);
#pragma unroll
      for (int i = 0; i < 4; ++i) v[r][i] = *(const f32x4*)(xr + i * 256 + lane * 4);
    }
#pragma unroll
    for (int r = 0; r < 2; ++r) {
#pragma unroll
      for (int i = 0; i < 4; ++i) ss[r] += v[r][i][0] * v[r][i][0] + v[r][i][1] * v[r][i][1] + v[r][i][2] * v[r][i][2] + v[r][i][3] * v[r][i][3];
#pragma unroll
      for (int o = 32; o >= 1; o >>= 1) ss[r] += __shfl_xor(ss[r], o);
    }
#pragma unroll
    for (int r = 0; r < 2; ++r) {
      if (r == 1 && !has1) break;
      const int row = rows[r];
      const float* md = p.mod + ((size_t)l * 48 + (row >> 11)) * 6144;
      const float rstd = rsqrtf(ss[r] * (1.f / 1024.f) + 1e-6f);
#pragma unroll
      for (int i = 0; i < 4; ++i) {
        const int k = i * 256 + lane * 4;
        const f32x4 gg = *(const f32x4*)(g + k), sc = *(const f32x4*)(md + scale_off + k), sh = *(const f32x4*)(md + shift_off + k);
        f32x4 y;
#pragma unroll
        for (int j = 0; j < 4; ++j) y[j] = (v[r][i][j] * rstd) * gg[j] * (1.f + sc[j]) + sh[j];
        u32x2 o; o[0] = pk_bf16(y[0], y[1]); o[1] = pk_bf16(y[2], y[3]);
        *(u32x2*)(p.hbuf + blk_off(row, k, NTOK)) = o;
      }
    }
  }
}

__device__ __forceinline__ bool gemm_tile_id(int it, int MT, int NT, int NB, int& mt, int& nt) {
  const int nb = gridDim.x, bid = blockIdx.x;
  if ((nb & 7) == 0) {
    const int x = bid & 7, slot = bid >> 3, S = nb >> 3;
    const int TPS = 8 * NB, NSN = NT / NB, NS = (MT / 8) * NSN;
    const int pidx = slot + S * it, sidx = pidx / TPS, w = pidx % TPS, s = x + 8 * sidx;
    if (s >= NS) return false;
    mt = (s / NSN) * 8 + (w & 7); nt = (s % NSN) * NB + (w >> 3);
    return true;
  }
  const int t = bid + nb * it;
  if (t >= MT * NT) return false;
  mt = t / NT; nt = t % NT;
  return true;
}

template <int M, int NN>
__device__ __forceinline__ void up_epi_row(const f32x4 (&acc)[8][4], const f32x4 (&cwv)[2][4], int lane, int fr, int s0, bf16_t* obase) {
  constexpr int MP = M > 0 ? M - 1 : 0, MN = M < 7 ? M + 1 : 7;
  const int srcp = (lane & 48) | ((fr + 15) & 15), srcn = (lane & 48) | ((fr + 1) & 15);
  float y[2][4];
#pragma unroll
  for (int n = 0; n < 2; ++n) {
    const f32x4 w0 = cwv[n][0], w1 = cwv[n][1], w2 = cwv[n][2], bb = cwv[n][3];
#pragma unroll
    for (int j = 0; j < 4; ++j) {
      const float cur = acc[M][NN + 2 * n][j];
      const float zp = (fr == 15) ? acc[MP][NN + 2 * n][j] : cur, zn = (fr == 0) ? acc[MN][NN + 2 * n][j] : cur;
      const float pv = __shfl(zp, srcp), nv = __shfl(zn, srcn);
      y[n][j] = w0[j] * pv + w1[j] * cur + w2[j] * nv + bb[j];
    }
  }
  const int row = 16 * M + fr, tpos = s0 + row;
  if (row >= 1 && row <= 126 && tpos >= 0 && tpos < SEQL) {
    float a[4];
#pragma unroll
    for (int j = 0; j < 4; ++j) { const float gte = y[1][j]; a[j] = y[0][j] * gte / (1.f + __expf(-gte)); }
    u32x2 o; o[0] = pk_bf16(a[0], a[1]); o[1] = pk_bf16(a[2], a[3]);
    *(u32x2*)(obase + (size_t)tpos * 32) = o;
  }
  __builtin_amdgcn_sched_barrier(0);
}

#define GB_A 16384
#define GB_BUF 32768
#define NSTAGE 2
#define SMEM_BYTES (NSTAGE * GB_BUF)
template <int EPI>
__device__ __forceinline__ void gemm_phase(const Params& p, int l, bool first, const bf16_t* A, int NBROWS, const bf16_t* Bt, int K, int MT, int NT, int NB,
                           bf16_t* outb, int ldc, int gate_off, char* smem) {
  const int tid = opaque_tid(), lane = tid & 63, w = tid >> 6, wr = w >> 2, wcn = w & 3, fr = lane & 15, fq = lane >> 4;
  const int nk = K / 32;
  const int lrow = tid >> 2, lch = (tid & 3) ^ ((tid >> 4) & 3);
  const int fsw = (fq ^ ((fr >> 2) & 3)) * 16;
  const size_t apan = (size_t)NTOK * 32, bpan = (size_t)NBROWS * 32;
  const bf16_t* ga0; const bf16_t* ga1; const bf16_t* gb0;
  size_t bstr;
#define GEMM_PTRS(MT_, NT_)                                                                                                          \
  {                                                                                                                                  \
    int t_ = tid; asm volatile("" : "+v"(t_));                                                                                       \
    const int lrow_ = t_ >> 2, lch_ = (t_ & 3) ^ ((t_ >> 4) & 3);                                                                    \
    if (EPI == 2) {                                                                                                                  \
      const int wi0 = 2 * (MT_), wi1 = wi0 + 1;                                                                                      \
      const int t0 = 126 * (wi0 % 17) - 1 + lrow_, t1 = 126 * (wi1 % 17) - 1 + lrow_;                                                \
      ga0 = A + ((size_t)(wi0 / 17) * SEQL + t0) * 32 + lch_ * 8;                                                                    \
      ga1 = A + ((size_t)(wi1 / 17) * SEQL + t1) * 32 + lch_ * 8;                                                                    \
      gb0 = Bt + (size_t)((NT_) * 128 + lrow_) * 32 + lch_ * 8; bstr = (size_t)DFF * 32;                                             \
    } else {                                                                                                                         \
      ga0 = A + (size_t)((MT_) * 256 + lrow_) * 32 + lch_ * 8; ga1 = ga0 + (size_t)128 * 32;                                         \
      gb0 = Bt + (size_t)((NT_) * 256 + lrow_) * 32 + lch_ * 8; bstr = (size_t)128 * 32;                                             \
    }                                                                                                                                \
  }
#define GEMM_LOAD(KT, SET)                                                                                                           \
    {                                                                                                                                \
      const size_t ko_ = (size_t)(KT) * apan, kb_ = (size_t)(KT) * bpan;                                                             \
      asm volatile("global_load_dwordx4 %0, %1, off" : "=v"(SET[0]) : "v"(ga0 + ko_) : "memory");                                     \
      asm volatile("global_load_dwordx4 %0, %1, off" : "=v"(SET[1]) : "v"(ga1 + ko_) : "memory");                                     \
      asm volatile("global_load_dwordx4 %0, %1, off" : "=v"(SET[2]) : "v"(gb0 + kb_) : "memory");                                     \
      asm volatile("global_load_dwordx4 %0, %1, off" : "=v"(SET[3]) : "v"(gb0 + bstr + kb_) : "memory");                              \
    }
#define GEMM_WRITE(SET, STAGE)                                                                                                       \
    {                                                                                                                                \
      asm volatile("" : "+v"(SET[0]), "+v"(SET[1]), "+v"(SET[2]), "+v"(SET[3]));      \
      char* dst_ = smem + (STAGE) * GB_BUF + tid * 16;                                                                               \
      *(u32x4*)(dst_) = SET[0]; *(u32x4*)(dst_ + 8192) = SET[1]; *(u32x4*)(dst_ + GB_A) = SET[2]; *(u32x4*)(dst_ + GB_A + 8192) = SET[3]; \
    }
#define GEMM_KSTEP(KT, WSET)                                                                                                         \
    {                                                                                                                                \
      asm volatile("s_waitcnt lgkmcnt(0)" ::: "memory");                                                                             \
      __builtin_amdgcn_s_barrier();                   \
      if ((KT) + 1 < nk) {                                                                                                           \
        if ((KT) + 2 < nk) asm volatile("s_waitcnt vmcnt(4)" ::: "memory"); else asm volatile("s_waitcnt vmcnt(0)" ::: "memory");     \
        GEMM_WRITE(WSET, ((KT) + 1) & 1)                                                                                             \
        if ((KT) + 3 < nk) GEMM_LOAD((KT) + 3, WSET)                                                                                 \
      }                                                                                                                              \
      const char* Ab = smem + ((KT) & 1) * GB_BUF;                                                                                   \
      const char* Bb = Ab + GB_A;                                                                                                    \
      bf16x8 bfr[4];                                                                                                                 \
      _Pragma("unroll") for (int n = 0; n < 4; ++n) {                                                                                \
        const int br = (EPI == 2) ? ((n >> 1) * 128 + 32 * wcn + 16 * (n & 1) + fr) : (64 * wcn + 16 * n + fr);                      \
        bfr[n] = *(const bf16x8*)(Bb + br * 64 + fsw);                                                                               \
      }                                                                                                                              \
      const char* Ap = Ab + (wr * 128 + fr) * 64 + fsw;                                                                              \
      bf16x8 af0 = *(const bf16x8*)(Ap), af1 = *(const bf16x8*)(Ap + 16 * 64);                                                       \
      _Pragma("unroll") for (int pr = 0; pr < 4; ++pr) {                                                                             \
        bf16x8 an0 = af0, an1 = af1;                                                                                                 \
        if (pr < 3) { an0 = *(const bf16x8*)(Ap + (2 * pr + 2) * 16 * 64); an1 = *(const bf16x8*)(Ap + (2 * pr + 3) * 16 * 64); }    \
        __builtin_amdgcn_sched_barrier(0);                                                                                           \
        _Pragma("unroll") for (int n = 0; n < 4; ++n) acc[2 * pr][n] = __builtin_amdgcn_mfma_f32_16x16x32_bf16(bfr[n], af0, acc[2 * pr][n], 0, 0, 0); \
        _Pragma("unroll") for (int n = 0; n < 4; ++n) acc[2 * pr + 1][n] = __builtin_amdgcn_mfma_f32_16x16x32_bf16(bfr[n], af1, acc[2 * pr + 1][n], 0, 0, 0); \
        __builtin_amdgcn_sched_barrier(0);                                                                                           \
        af0 = an0; af1 = an1;                                                                                                        \
      }                                                                                                                              \
    }
  int mt, nt;
  bool have = gemm_tile_id(0, MT, NT, NB, mt, nt);
  for (int it = 0; have; ++it) {
    GEMM_PTRS(mt, nt)
    u32x4 rsA[4], rsB[4];
    f32x4 acc[8][4];
#pragma unroll
    for (int m = 0; m < 8; ++m)
#pragma unroll
      for (int n = 0; n < 4; ++n) acc[m][n] = (f32x4){0.f, 0.f, 0.f, 0.f};
    asm volatile("s_waitcnt vmcnt(0) lgkmcnt(0)" ::: "memory");
    __builtin_amdgcn_s_barrier();
    GEMM_LOAD(0, rsA)
    GEMM_LOAD(1, rsB)
    asm volatile("s_waitcnt vmcnt(4)" ::: "memory");
    GEMM_WRITE(rsA, 0)
    GEMM_LOAD(2, rsA)
    for (int kt = 0; kt < nk; kt += 2) {
      GEMM_KSTEP(kt, rsB)
      GEMM_KSTEP(kt + 1, rsA)
    }
    const int mt_e = mt, nt_e = nt;
    have = gemm_tile_id(it + 1, MT, NT, NB, mt, nt);
    int lane_e = lane; asm volatile("" : "+v"(lane_e));
    const int fr_e = lane_e & 15, fq_e = lane_e >> 4;
    if (EPI == 0) {
      if (nt_e * 256 + 64 * wcn < NBROWS) {
#pragma unroll
        for (int m = 0; m < 8; ++m) {
          const int tok = mt_e * 256 + wr * 128 + 16 * m + fr_e;
#pragma unroll
          for (int n = 0; n < 4; ++n) {
            const int col = nt_e * 256 + 64 * wcn + 16 * n + 4 * fq_e;
            u32x2 o; o[0] = pk_bf16(acc[m][n][0], acc[m][n][1]); o[1] = pk_bf16(acc[m][n][2], acc[m][n][3]);
            *(u32x2*)(outb + (size_t)tok * ldc + col) = o;
          }
        }
      }
    } else if (EPI == 1) {
      const int b = (mt_e * 256) >> 11;
      const float* gate = p.mod + ((size_t)l * 48 + b) * 6144 + gate_off;
#pragma unroll
      for (int n = 0; n < 4; ++n) {
        const int col = nt_e * 256 + 64 * wcn + 16 * n + 4 * fq_e;
        const f32x4 gv = *(const f32x4*)(gate + col);
        f32x4 xv[8];
#pragma unroll
        for (int m = 0; m < 8; ++m) xv[m] = *(const f32x4*)(xin_row(p, first, mt_e * 256 + wr * 128 + 16 * m + fr_e) + col);
#pragma unroll
        for (int m = 0; m < 8; ++m) {
          const int tok = mt_e * 256 + wr * 128 + 16 * m + fr_e;
          f32x4 o;
#pragma unroll
          for (int j = 0; j < 4; ++j) o[j] = xv[m][j] + gv[j] * acc[m][n][j];
          *(f32x4*)(p.out + (size_t)tok * DM + col) = o;
        }
      }
    } else {
      const float* cw = p.conv_w + (size_t)l * 3 * 5632;
      const float* cb = p.conv_b + (size_t)l * 5632;
      const int wi = 2 * mt_e + wr, seq = wi / 17, s0 = 126 * (wi % 17) - 1;
      if (s0 < 0 || s0 + 127 >= SEQL) {
#pragma unroll
        for (int m = 0; m < 8; ++m) {
          const int tp = s0 + 16 * m + fr_e;
          if (tp < 0 || tp >= SEQL) {
#pragma unroll
            for (int n = 0; n < 4; ++n) acc[m][n] = (f32x4){0.f, 0.f, 0.f, 0.f};
          }
        }
      }
#define UP_EPI_NN(NN)                                                                                                      \
      {                                                                                                                    \
        const int cbase = nt_e * 128 + 32 * wcn + 16 * NN + 4 * fq_e;                                                        \
        bf16_t* obase = outb + blk_off(seq * SEQL, cbase, NTOK);                                                           \
                   \
        f32x4 cwv[2][4];                                                                                                   \
        _Pragma("unroll") for (int n = 0; n < 2; ++n) {                                                                    \
          const int c = n * DFF + cbase;                                                                                   \
          cwv[n][0] = *(const f32x4*)(cw + c); cwv[n][1] = *(const f32x4*)(cw + 5632 + c);                                 \
          cwv[n][2] = *(const f32x4*)(cw + 2 * 5632 + c); cwv[n][3] = *(const f32x4*)(cb + c);                             \
        }                                                                                                                  \
        up_epi_row<0, NN>(acc, cwv, lane_e, fr_e, s0, obase); up_epi_row<1, NN>(acc, cwv, lane_e, fr_e, s0, obase);          \
        up_epi_row<2, NN>(acc, cwv, lane_e, fr_e, s0, obase); up_epi_row<3, NN>(acc, cwv, lane_e, fr_e, s0, obase);          \
        up_epi_row<4, NN>(acc, cwv, lane_e, fr_e, s0, obase); up_epi_row<5, NN>(acc, cwv, lane_e, fr_e, s0, obase);          \
        up_epi_row<6, NN>(acc, cwv, lane_e, fr_e, s0, obase); up_epi_row<7, NN>(acc, cwv, lane_e, fr_e, s0, obase);          \
      }
      UP_EPI_NN(0)
      UP_EPI_NN(1)
#undef UP_EPI_NN
    }
  }
#undef GEMM_LOAD
#undef GEMM_WRITE
#undef GEMM_KSTEP
#undef GEMM_PTRS
}

struct AttnArgs {
  int qbase, qstride, qpos0;
  int ktokbase, ktokstep, kstride, kposbase, kposstep, ntiles;
  int qcol, kcol, vcol, ocol;
  const float *gq, *gk;
  float qscale;
  int hw, rmul, taboff0;
  float sinkv;
  float lam, outscale;
  const float* subg;
  int lsecol;
  float cshift;
  int r0, rs0;
};

template <int NQ, int NC, int MODE>
__device__ __forceinline__ void attn_item(const Params& p, const AttnArgs& a, bf16_t* Ks, bf16_t* Vts, const float* tab) {
  const int tid = opaque_tid(), lane = tid & 63, w = tid >> 6, fr = lane & 15, fq = lane >> 4;
  const int wq0 = a.qpos0 + w * 16 * NQ;
  bf16x8 qf[NQ][2];
  int qpos[NQ];
#pragma unroll
  for (int qt = 0; qt < NQ; ++qt) {
    const int qp = wq0 + qt * 16 + fr;
    qpos[qt] = qp;
    const bf16_t* qrow = p.proj + (size_t)(a.qbase + qp * a.qstride) * PW + a.qcol;
    const u32x4 v0 = *(const u32x4*)(qrow + fq * 8), v1 = *(const u32x4*)(qrow + 32 + fq * 8);
    float f0[8], f1[8];
#pragma unroll
    for (int i = 0; i < 4; ++i) { f0[2 * i] = bf_lo(v0[i]); f0[2 * i + 1] = bf_hi(v0[i]); f1[2 * i] = bf_lo(v1[i]); f1[2 * i + 1] = bf_hi(v1[i]); }
    float s0 = 0.f, s1 = 0.f;
#pragma unroll
    for (int i = 0; i < 8; ++i) { s0 += f0[i] * f0[i]; s1 += f1[i] * f1[i]; }
    float r0, r1;
    if (NC == 1) {
      float s = s0 + s1; s += __shfl_xor(s, 16); s += __shfl_xor(s, 32);
      r0 = r1 = rsqrtf(s * (1.f / 64.f) + 1e-6f) * a.qscale;
    } else {
      s0 += __shfl_xor(s0, 16); s0 += __shfl_xor(s0, 32);
      s1 += __shfl_xor(s1, 16); s1 += __shfl_xor(s1, 32);
      r0 = rsqrtf(s0 * (1.f / 32.f) + 1e-6f) * a.qscale; r1 = rsqrtf(s1 * (1.f / 32.f) + 1e-6f) * a.qscale;
    }
    const float* g0p = a.gq + fq * 8;
    const float* g1p = (NC == 1) ? a.gq + 32 + fq * 8 : g0p;
    u32x4 q0, q1;
#pragma unroll
    for (int i = 0; i < 4; ++i) {
      q0[i] = pk_bf16(f0[2 * i] * r0 * g0p[2 * i], f0[2 * i + 1] * r0 * g0p[2 * i + 1]);
      q1[i] = pk_bf16(f1[2 * i] * r1 * g1p[2 * i], f1[2 * i + 1] * r1 * g1p[2 * i + 1]);
    }
    qf[qt][0] = __builtin_bit_cast(bf16x8, q0);
    qf[qt][1] = __builtin_bit_cast(bf16x8, q1);
  }
  f32x4 o[NC][NQ][4];
  float mrun[NC][NQ];
  f32x4 lsum[NC][NQ];
  const bf16x8 ones = {0x3F80, 0x3F80, 0x3F80, 0x3F80, 0x3F80, 0x3F80, 0x3F80, 0x3F80};
#pragma unroll
  for (int c = 0; c < NC; ++c)
#pragma unroll
    for (int qt = 0; qt < NQ; ++qt) {
      mrun[c][qt] = a.cshift;
      const float l0 = (MODE == 1) ? fexp2(a.sinkv - a.cshift) : 0.f;
      lsum[c][qt] = (f32x4){l0, l0, l0, l0};
#pragma unroll
      for (int dt = 0; dt < 4; ++dt) o[c][qt][dt] = (f32x4){0.f, 0.f, 0.f, 0.f};
    }
  const int lch = tid & 7;
  float gkv[8];
#pragma unroll
  for (int i = 0; i < 8; ++i) gkv[i] = a.gk[((NC == 1) ? lch : (lch & 3)) * 8 + i];

  const int rw = a.r0 + ((w * 16 * NQ) >> 6);
  int rsw = rw - 4; rsw = rsw < 0 ? 0 : (rsw > 24 ? 24 : rsw);
  u32x4 kA, vA, kB, vB;
  const int kkey = tid >> 3, vkey = tid & 63, vch = tid >> 6;
#define ATTN_PREFETCH(T, KR, VR)                                                                                 \
  {                                                                                                              \
    const int ktok0_ = a.ktokbase + (T) * a.ktokstep;                                                            \
    KR = *(const u32x4*)(p.proj + (size_t)(ktok0_ + kkey * a.kstride) * PW + a.kcol + lch * 8);                   \
    VR = *(const u32x4*)(p.proj + (size_t)(ktok0_ + vkey * a.kstride) * PW + a.vcol + vch * 8);                   \
  }
  auto stage_write = [&](const u32x4& kr, const u32x4& vr, bf16_t* Ksb, bf16_t* Vtb) __attribute__((always_inline)) {
    float f[8];
#pragma unroll
    for (int i = 0; i < 4; ++i) { f[2 * i] = bf_lo(kr[i]); f[2 * i + 1] = bf_hi(kr[i]); }
    float s = 0.f;
#pragma unroll
    for (int i = 0; i < 8; ++i) s += f[i] * f[i];
    s += __shfl_xor(s, 1); s += __shfl_xor(s, 2);
    float rs;
    if (NC == 1) { s += __shfl_xor(s, 4); rs = rsqrtf(s * (1.f / 64.f) + 1e-6f); }
    else rs = rsqrtf(s * (1.f / 32.f) + 1e-6f);
    u32x4 kq;
#pragma unroll
    for (int i = 0; i < 4; ++i) kq[i] = pk_bf16(f[2 * i] * rs * gkv[2 * i], f[2 * i + 1] * rs * gkv[2 * i + 1]);
    *(u32x4*)(Ksb + kkey * LDSROW + lch * 8) = kq;
#pragma unroll
    for (int i = 0; i < 4; ++i) {
      Vtb[(vch * 8 + 2 * i) * LDSROW + vkey] = (bf16_t)(vr[i] & 0xffffu);
      Vtb[(vch * 8 + 2 * i + 1) * LDSROW + vkey] = (bf16_t)(vr[i] >> 16);
    }
  };
  auto tile_math = [&](int t, const bf16_t* Ksb, const bf16_t* Vtb) __attribute__((always_inline)) {
    if (MODE == 0) { const int kr_ = a.rs0 + t; if (kr_ < rsw || kr_ >= rsw + 8) return; }
    const int kp0 = a.kposbase + t * a.kposstep;
    const int taboff = (a.rs0 + t - rw + 7) * 31;
    bf16x8 pf[NC][NQ][2];
    bf16x8 kf[4][2];
#pragma unroll
    for (int kt = 0; kt < 4; ++kt) {
      kf[kt][0] = *(const bf16x8*)(Ksb + (kt * 16 + fr) * LDSROW + fq * 8);
      kf[kt][1] = *(const bf16x8*)(Ksb + (kt * 16 + fr) * LDSROW + 32 + fq * 8);
    }
    bf16x8 vfr[4][2];
#pragma unroll
    for (int ks = 0; ks < 2; ++ks)
#pragma unroll
      for (int dt = 0; dt < 4; ++dt) {
        const u32x2 lo = *(const u32x2*)(Vtb + (dt * 16 + fr) * LDSROW + ks * 32 + 4 * fq);
        const u32x2 hi = *(const u32x2*)(Vtb + (dt * 16 + fr) * LDSROW + ks * 32 + 16 + 4 * fq);
        u32x4 vv; vv[0] = lo[0]; vv[1] = lo[1]; vv[2] = hi[0]; vv[3] = hi[1];
        vfr[dt][ks] = __builtin_bit_cast(bf16x8, vv);
      }
#pragma unroll
    for (int qt = 0; qt < NQ; ++qt) {
      const int qp = (MODE == 0) ? (qpos[qt] & 63) : qpos[qt];
      int cs = qp - 8; cs = cs < 0 ? 0 : (cs > 48 ? 48 : cs);
      f32x4 bv[4];
      const bool far_hi = (MODE == 3) && (kp0 - (wq0 + 16 * NQ - 1) >= 128), far_lo = (MODE == 3) && (wq0 - (kp0 + 63) >= 128);
      if (far_hi || far_lo) {
        const float bu = tab[far_hi ? (DT_OFF + 256) : (DT_OFF - 256)];
#pragma unroll
        for (int kt = 0; kt < 4; ++kt) bv[kt] = (f32x4){bu, bu, bu, bu};
      } else if (MODE != 0) {
        const float* tb = tab + (kp0 - qp + 4 * fq + DT_OFF);
#pragma unroll
        for (int kt = 0; kt < 4; ++kt)
#pragma unroll
          for (int j = 0; j < 4; ++j) bv[kt][j] = tb[kt * 16 + j];
      } else
#pragma unroll
      for (int kt = 0; kt < 4; ++kt)
#pragma unroll
        for (int j = 0; j < 4; ++j) {
          const int kpos = kp0 + kt * 16 + 4 * fq + j;
          const int d = kpos - qp;
          const bool valid = kpos >= cs && kpos < cs + 16;
          int dd = d + 15; dd = dd < 0 ? 0 : (dd > 30 ? 30 : dd);
          const float bias = tab[taboff + dd];
          bv[kt][j] = valid ? bias : -INFINITY;
        }
#pragma unroll
      for (int c = 0; c < NC; ++c) {
        f32x4 s[4];
#pragma unroll
        for (int kt = 0; kt < 4; ++kt) {
          if (NC == 1) {
            const f32x4 r = __builtin_amdgcn_mfma_f32_16x16x32_bf16(kf[kt][0], qf[qt][0], bv[kt], 0, 0, 0);
            s[kt] = __builtin_amdgcn_mfma_f32_16x16x32_bf16(kf[kt][1], qf[qt][1], r, 0, 0, 0);
          } else {
            s[kt] = __builtin_amdgcn_mfma_f32_16x16x32_bf16(kf[kt][c], qf[qt][c], bv[kt], 0, 0, 0);
          }
        }
#pragma unroll
        for (int kt = 0; kt < 4; ++kt)
#pragma unroll
          for (int j = 0; j < 4; ++j) s[kt][j] = fexp2(s[kt][j]);
#pragma unroll
        for (int ks = 0; ks < 2; ++ks) {
          u32x4 pk;
          pk[0] = pk_bf16(s[2 * ks][0], s[2 * ks][1]); pk[1] = pk_bf16(s[2 * ks][2], s[2 * ks][3]);
          pk[2] = pk_bf16(s[2 * ks + 1][0], s[2 * ks + 1][1]); pk[3] = pk_bf16(s[2 * ks + 1][2], s[2 * ks + 1][3]);
          pf[c][qt][ks] = __builtin_bit_cast(bf16x8, pk);
        }
      }
    }
#pragma unroll
    for (int ks = 0; ks < 2; ++ks) {
#pragma unroll
      for (int dt = 0; dt < 4; ++dt) {
        const bf16x8 vf = vfr[dt][ks];
#pragma unroll
        for (int c = 0; c < NC; ++c)
#pragma unroll
          for (int qt = 0; qt < NQ; ++qt) o[c][qt][dt] = __builtin_amdgcn_mfma_f32_16x16x32_bf16(vf, pf[c][qt][ks], o[c][qt][dt], 0, 0, 0);
      }
#pragma unroll
      for (int c = 0; c < NC; ++c)
#pragma unroll
        for (int qt = 0; qt < NQ; ++qt) lsum[c][qt] = __builtin_amdgcn_mfma_f32_16x16x32_bf16(ones, pf[c][qt][ks], lsum[c][qt], 0, 0, 0);
    }
    };
  bf16_t* const Ks1 = Ks + 2 * 64 * LDSROW;
  bf16_t* const Vts1 = Vts + 2 * 64 * LDSROW;
  const int ntl = a.ntiles;
  ATTN_PREFETCH(0, kA, vA)
  if (ntl > 1) ATTN_PREFETCH(1, kB, vB)
  stage_write(kA, vA, Ks, Vts);
  if (ntl > 2) ATTN_PREFETCH(2, kA, vA)
  for (int t = 0; t < ntl; t += 2) {
    __syncthreads();
    if (t + 1 < ntl) { stage_write(kB, vB, Ks1, Vts1); if (t + 3 < ntl) ATTN_PREFETCH(t + 3, kB, vB) }
    tile_math(t, Ks, Vts);
    if (t + 1 < ntl) {
      __syncthreads();
      if (t + 2 < ntl) { stage_write(kA, vA, Ks, Vts); if (t + 4 < ntl) ATTN_PREFETCH(t + 4, kA, vA) }
      tile_math(t + 1, Ks1, Vts1);
    }
  }
#undef ATTN_PREFETCH
#pragma unroll
  for (int qt = 0; qt < NQ; ++qt) {
    float inv[NC], ltot[NC];
#pragma unroll
    for (int c = 0; c < NC; ++c) {
      const float lt = lsum[c][qt][0];
      ltot[c] = lt; inv[c] = 1.f / lt;
    }
    const int tok = a.qbase + qpos[qt] * a.qstride;
    if (MODE == 3) {
      f32x4 v[4];
      float ss = 0.f;
#pragma unroll
      for (int dt = 0; dt < 4; ++dt)
#pragma unroll
        for (int j = 0; j < 4; ++j) {
          const float x = o[0][qt][dt][j] * inv[0] - a.lam * (o[NC - 1][qt][dt][j] * inv[NC - 1]);
          v[dt][j] = x; ss += x * x;
        }
      ss += __shfl_xor(ss, 16); ss += __shfl_xor(ss, 32);
      const float rstd = rsqrtf(ss * (1.f / 64.f) + 1e-6f) * a.outscale;
#pragma unroll
      for (int dt = 0; dt < 4; ++dt) {
        const f32x4 g = *(const f32x4*)(a.subg + dt * 16 + 4 * fq);
        u32x2 ov; ov[0] = pk_bf16(v[dt][0] * rstd * g[0], v[dt][1] * rstd * g[1]); ov[1] = pk_bf16(v[dt][2] * rstd * g[2], v[dt][3] * rstd * g[3]);
        *(u32x2*)(p.hbuf + blk_off(tok, a.ocol + dt * 16 + 4 * fq, NTOK)) = ov;
      }
    } else {
#pragma unroll
      for (int dt = 0; dt < 4; ++dt) {
        u32x2 ov;
        ov[0] = pk_bf16(o[0][qt][dt][0] * inv[0], o[0][qt][dt][1] * inv[0]);
        ov[1] = pk_bf16(o[0][qt][dt][2] * inv[0], o[0][qt][dt][3] * inv[0]);
        *(u32x2*)(p.hbuf + blk_off(tok, a.ocol + dt * 16 + 4 * fq, NTOK)) = ov;
      }
      if (MODE == 2 && fq == 0) p.lse[(size_t)tok * 6 + a.lsecol] = (mrun[0][qt] + __log2f(ltot[0])) * LN2;
    }
  }
}

__device__ __forceinline__ void attn_phase(const Params& p, int l, char* smem) {
  bf16_t* Ks = (bf16_t*)smem;
  bf16_t* Vts = Ks + 64 * LDSROW;
  float* tab = (float*)(Ks + 4 * 64 * LDSROW);
  const int tid = opaque_tid();
  const int nD = 3072, nA = 3072, nB = 3072, nC = 4608;
  for (int item = blockIdx.x; item < nD + nA + nB + nC; item += gridDim.x) {
    AttnArgs a;
    a.taboff0 = 0; a.r0 = 0; a.rs0 = 0; a.sinkv = 0.f; a.cshift = 0.f; a.lam = 0.f; a.outscale = 1.f; a.subg = nullptr; a.lsecol = 0; a.hw = 1 << 20; a.rmul = 1;
    __syncthreads();
    if (item < nD) {
      const int b = item >> 6, h = (item >> 4) & 3, qb = item & 15;
      a.cshift = p.lam[4 + l * 4 + 3];
      for (int i = tid; i < DT_N; i += NTHR) { int dd = i - DT_OFF; dd = dd < -128 ? -128 : (dd > 128 ? 128 : dd); tab[i] = p.lut[(10 + h) * 257 + dd + 128] - a.cshift; }
      a.qbase = b * SEQL; a.qstride = 1; a.qpos0 = qb * 128;
      a.ktokbase = b * SEQL; a.ktokstep = 64; a.kstride = 1; a.kposbase = 0; a.kposstep = 64; a.ntiles = 32;
      a.qcol = 2432 + h * 64; a.kcol = 2432 + 256 + h * 64; a.vcol = 2432 + 512 + h * 64; a.ocol = 896 + h * 64;
      a.gq = p.qkn_d + l * 64; a.gk = a.gq + 32;
      a.qscale = 0.17677669529663687f * LOG2E;
      a.lam = p.lam[l]; a.outscale = 1.f - (0.8f - 0.6f * expf(-0.3f * (float)l)); a.subg = p.subln_d + l * 64;
      attn_item<1, 2, 3>(p, a, Ks, Vts, tab);
    } else if (item < nD + nA) {
      const int id = item - nD;
      const int b = id >> 6, h = (id >> 4) & 3, r = (id & 15) * 2;
      const float* rp = p.rpb_a + ((size_t)l * 4 + h) * 465;
      a.cshift = p.lam[4 + l * 4 + 0];
      for (int i = tid; i < 465; i += NTHR) tab[i] = rp[i] * LOG2E - a.cshift;
      int rs = r - 4; rs = rs < 0 ? 0 : (rs > 24 ? 24 : rs);
      int rs1 = r - 3; rs1 = rs1 < 0 ? 0 : (rs1 > 24 ? 24 : rs1);
      a.qbase = b * SEQL + r * 64; a.qstride = 1; a.qpos0 = 0; a.r0 = r; a.rs0 = rs;
      a.ktokbase = b * SEQL + rs * 64; a.ktokstep = 64; a.kstride = 1; a.kposbase = 0; a.kposstep = 0; a.ntiles = rs1 - rs + 8;
      a.qcol = h * 64; a.kcol = 256 + h * 64; a.vcol = 512 + h * 64; a.ocol = h * 64;
      a.gq = p.qkn_a + l * 128; a.gk = a.gq + 64;
      a.qscale = 0.125f * LOG2E;
      attn_item<1, 1, 0>(p, a, Ks, Vts, tab);
    } else if (item < nD + nA + nB) {
      const int id = item - nD - nA;
      const int b = id >> 6, h = (id >> 4) & 3, qb = id & 15;
      a.cshift = p.lam[4 + l * 4 + 1];
      for (int i = tid; i < DT_N; i += NTHR) { const int d = i - DT_OFF; tab[i] = (d >= -128 && d <= 128) ? p.lut[h * 257 + d + 128] - a.cshift : -INFINITY; }
      const int q0 = qb * 128;
      const int kstart = q0 - 128 < 0 ? 0 : q0 - 128, kend = q0 + 256 > SEQL ? SEQL : q0 + 256;
      a.qbase = b * SEQL; a.qstride = 1; a.qpos0 = q0;
      a.ktokbase = b * SEQL + kstart; a.ktokstep = 64; a.kstride = 1; a.kposbase = kstart; a.kposstep = 64; a.ntiles = (kend - kstart) >> 6;
      a.qcol = 768 + h * 64; a.kcol = 768 + 256 + (h >> 1) * 64; a.vcol = 768 + 384 + (h >> 1) * 64; a.ocol = 256 + h * 64;
      a.gq = p.qkn_b + l * 128; a.gk = a.gq + 64;
      a.qscale = 0.125f * LOG2E;
      a.hw = 128; a.rmul = 1; a.sinkv = p.sink_b[l * 4 + h] * LOG2E;
      attn_item<1, 1, 1>(p, a, Ks, Vts, tab);
    } else {
      const int id = item - nD - nA - nB;
      const int b = id / 96, rem = id % 96, g = rem >> 5, i2 = (rem >> 4) & 1, blk = rem & 15;
      const int r = g == 0 ? 1 : (g == 1 ? 4 : 16);
      const int L = SEQL / r, bps = L >> 7;
      const int pp = blk / bps, m0 = (blk % bps) * 128;
      const int hh = g * 2 + i2;
      a.cshift = p.lam[4 + l * 4 + 2];
      for (int i = tid; i < DT_N; i += NTHR) { const int d = i - DT_OFF; int dd = d * r; dd = dd < -128 ? -128 : (dd > 128 ? 128 : dd);
        tab[i] = (d >= -64 && d <= 64) ? p.lut[(4 + hh) * 257 + dd + 128] - a.cshift : -INFINITY; }
      const int kstart = m0 - 64 < 0 ? 0 : m0 - 64, kend = m0 + 192 > L ? L : m0 + 192;
      a.qbase = b * SEQL + pp; a.qstride = r; a.qpos0 = m0;
      a.ktokbase = a.qbase + kstart * r; a.ktokstep = 64 * r; a.kstride = r; a.kposbase = kstart; a.kposstep = 64; a.ntiles = (kend - kstart) >> 6;
      a.qcol = 1280 + hh * 64; a.kcol = 1280 + 384 + hh * 64; a.vcol = 1280 + 768 + hh * 64; a.ocol = 512 + hh * 64;
      a.gq = p.qkn_c + l * 128; a.gk = a.gq + 64;
      a.qscale = 0.125f * LOG2E;
      a.hw = 64; a.rmul = r; a.lsecol = hh;
      attn_item<1, 1, 2>(p, a, Ks, Vts, tab);
    }
  }
}

__device__ __forceinline__ void combine_phase(const Params& p) {
  const int nthr = gridDim.x * NTHR;
  for (int i = blockIdx.x * NTHR + opaque_tid(); i < NTOK * 48; i += nthr) {
    const int tok = i / 48, rem = i % 48, hh = rem >> 3, ch = rem & 7, ii = hh & 1, g = hh >> 1;
    const float* ls = p.lse + (size_t)tok * 6;
    const float l0 = ls[ii], l1 = ls[2 + ii], l2 = ls[4 + ii];
    const float mx = fmaxf(l0, fmaxf(l1, l2));
    const float e0 = __expf(l0 - mx), e1 = __expf(l1 - mx), e2 = __expf(l2 - mx);
    const float al = (g == 0 ? e0 : (g == 1 ? e1 : e2)) / (e0 + e1 + e2);
    bf16_t* ptr = p.hbuf + blk_off(tok, 512 + hh * 64 + ch * 8, NTOK);
    u32x4 v = *(const u32x4*)ptr;
#pragma unroll
    for (int k = 0; k < 4; ++k) v[k] = pk_bf16(bf_lo(v[k]) * al, bf_hi(v[k]) * al);
    *(u32x4*)ptr = v;
  }
}


#ifndef REP_GEMM
#define REP_GEMM 1
#endif
#ifndef REP_ATTN
#define REP_ATTN 1
#endif
#ifndef DBG_STOP
#define DBG_STOP 0
#endif
__global__ void __launch_bounds__(NTHR, 2) fwd_megakernel(Params p) {
  extern __shared__ __attribute__((aligned(16))) char smem[];
  cg::grid_group grid = cg::this_grid();
  prologue_phase(p, smem);
  grid.sync();
#define LAYER(L)                                                                                                   \
  {                                                                                                                \
    constexpr int l = (L);                                                                                         \
    constexpr bool first = (l == 0);                                                                               \
    const bf16_t* wt = p.wt + (size_t)l * WT_LAYER;                                                                \
    norm_phase(p, l, first, p.norm_attn_g + l * DM, 0, 1024);                                                      \
    grid.sync();                                                                                                   \
    gemm_phase<0>(p, l, false, p.hbuf, 3200, wt + WT_IN, 1024, 384, 13, 13, p.proj, PW, 0, smem);                  \
    grid.sync();                                                                                                   \
    attn_phase(p, l, smem);                                                                                        \
    grid.sync();                                                                                                   \
    combine_phase(p);                                                                                              \
    grid.sync();                                                                                                   \
    gemm_phase<1>(p, l, first, p.hbuf, 1024, wt + WT_OUT, 1152, 384, 4, 4, nullptr, 0, 2048, smem);                \
    grid.sync();                                                                                                   \
    norm_phase(p, l, false, p.norm_ffn_g + l * DM, 3072, 4096);                                                    \
    grid.sync();                                                                                                   \
    gemm_phase<2>(p, l, false, p.hbuf, 5632, wt + WT_UP, 1024, 408, 22, 22, p.proj, DFF, 0, smem);                 \
    grid.sync();                                                                                                   \
    gemm_phase<1>(p, l, false, p.proj, 1024, wt + WT_DOWN, 2816, 384, 4, 4, nullptr, 0, 5120, smem);               \
    grid.sync();                                                                                                   \
  }
  LAYER(0)
  LAYER(1)
  LAYER(2)
  LAYER(3)
#undef LAYER
}

extern "C" void kernel_launch(void* const* d_in, const int* in_sizes, int n_in, void* d_out, int out_size, void* d_ws, size_t ws_size,
                              hipStream_t stream) {
  static int grid_blocks = 0;
  if (!grid_blocks) {
    int dev = 0, cus = 0, per_cu = 0;
    hipGetDevice(&dev);
    hipDeviceGetAttribute(&cus, hipDeviceAttributeMultiprocessorCount, dev);
    hipFuncSetAttribute((const void*)fwd_megakernel, hipFuncAttributeMaxDynamicSharedMemorySize, SMEM_BYTES);
    hipOccupancyMaxActiveBlocksPerMultiprocessor(&per_cu, fwd_megakernel, NTHR, SMEM_BYTES);
    if (per_cu > 1) per_cu = 1;
    if (per_cu < 1) per_cu = 1;
    grid_blocks = cus * per_cu;
  }
  Params p{};
  const float* const* in = (const float* const*)d_in;
  p.x_prompt = in[0]; p.x_sample = in[1]; p.c_prompt = in[2]; p.c_sample = in[3]; p.norm_attn_g = in[4]; p.norm_ffn_g = in[5];
  p.w_ada = in[6]; p.b_ada = in[7]; p.w_in = in[8]; p.qkn_a = in[9]; p.qkn_b = in[10]; p.qkn_c = in[11]; p.qkn_d = in[12];
  p.rpb_a = in[13]; p.sink_b = in[14]; p.t5_table = in[15]; p.lam_d = in[16]; p.subln_d = in[17]; p.w_out = in[18]; p.w_up = in[19];
  p.conv_w = in[20]; p.conv_b = in[21]; p.w_down = in[22];
  p.out = (float*)d_out;
  char* ws = (char*)d_ws;
  size_t off = 0;
  p.wt = (bf16_t*)(ws + off); off += (size_t)4 * WT_LAYER * 2;
  p.mod = (float*)(ws + off); off += (size_t)4 * 48 * 6144 * 4;
  p.lut = (float*)(ws + off); off += 16384;
  p.lam = (float*)(ws + off); off += 256;
  p.zeros = (float*)(ws + off); off += 256;
  p.lse = (float*)(ws + off); off += (size_t)NTOK * 6 * 4;
  p.proj = (bf16_t*)(ws + off); off += (size_t)NTOK * PW * 2;
  p.hbuf = (bf16_t*)(ws + off); off += (size_t)NTOK * MW * 2;
  if (off > ws_size) { fprintf(stderr, "workspace too small: need %zu have %zu\n", off, ws_size); return; }
  void* args[] = {&p};
  hipError_t e = hipLaunchCooperativeKernel((void*)fwd_megakernel, dim3(grid_blocks), dim3(NTHR), args, SMEM_BYTES, stream);
  if (e != hipSuccess) fprintf(stderr, "cooperative launch failed: %s (grid %d)\n", hipGetErrorString(e), grid_blocks);
}
```

```cpp
#include <hip/hip_runtime.h>
#include <hip/hip_cooperative_groups.h>
#include <cstdint>
#include <cstdio>
namespace cg = cooperative_groups;

typedef unsigned short bf16_t;
typedef short bf16x8 __attribute__((ext_vector_type(8)));
typedef float f32x4 __attribute__((ext_vector_type(4)));
typedef unsigned u32x4 __attribute__((ext_vector_type(4)));
typedef unsigned u32x2 __attribute__((ext_vector_type(2)));

#define NTOK 98304
#define DM 1024
#define PW 3200
#define MW 1152
#define DFF 2816
#define NSEQ 48
#define SEQL 2048
#define LOG2E 1.4426950408889634f
#define LN2 0.6931471805599453f
#define LDSROW 72
#define DT_OFF 320
#define DT_N 641
#define NTHR 512
#define NWAVE 8

struct Params {
  const float *x_prompt, *x_sample, *c_prompt, *c_sample, *norm_attn_g, *norm_ffn_g, *w_ada, *b_ada, *w_in;
  const float *qkn_a, *qkn_b, *qkn_c, *qkn_d, *rpb_a, *sink_b, *t5_table, *lam_d, *subln_d, *w_out, *w_up, *conv_w, *conv_b, *w_down;
  float* out;
  bf16_t* wt; float* mod; float* lut; float* lam; float* lse; bf16_t* proj; bf16_t* hbuf; float* zeros;
};

#define WT_IN 0
#define WT_OUT (3200 * 1024)
#define WT_UP (WT_OUT + 1024 * 1152)
#define WT_DOWN (WT_UP + 5632 * 1024)
#define WT_LAYER (WT_DOWN + 1024 * 2816)

typedef __bf16 bf16x2_t __attribute__((ext_vector_type(2)));
typedef float f32x2_t __attribute__((ext_vector_type(2)));
__device__ __forceinline__ unsigned pk_bf16(float lo, float hi) {
  const f32x2_t v = {lo, hi};
  const bf16x2_t r = __builtin_convertvector(v, bf16x2_t);
  return __builtin_bit_cast(unsigned, r);
}
__device__ __forceinline__ float bf_lo(unsigned u) { return __uint_as_float(u << 16); }
__device__ __forceinline__ float bf_hi(unsigned u) { return __uint_as_float(u & 0xffff0000u); }
__device__ __forceinline__ float fexp2(float x) { return __builtin_amdgcn_exp2f(x); }

__device__ __forceinline__ const float* xin_row(const Params& p, bool first, int tok) {
  if (first) return tok < 65536 ? p.x_prompt + (size_t)tok * DM : p.x_sample + (size_t)(tok - 65536) * DM;
  return p.out + (size_t)tok * DM;
}

__device__ __forceinline__ int opaque_tid() { int t = threadIdx.x; asm volatile("" : "+v"(t)); return t; }

__device__ __forceinline__ size_t blk_off(int r, int k, int R) { return ((size_t)(k >> 5) * R + r) * 32 + (k & 31); }

__device__ __forceinline__ int t5_bucket(int rel) {
  const int n = rel < 0 ? -rel : rel;
  int v;
  if (n < 8) v = n;
  else v = 8 + (n >= 12) + (n >= 16) + (n >= 23) + (n >= 32) + (n >= 46) + (n >= 64) + (n >= 91);
  return (rel > 0 ? 16 : 0) + v;
}

__device__ __forceinline__ void prologue_phase(const Params& p, char* smem) {
  const int tid = opaque_tid(), nb = gridDim.x;
  const int N_TR = 4 * 3200, N_MOD = 192;
  for (int item = blockIdx.x; item < N_TR + N_MOD + 1; item += nb) {
    if (item < N_TR) {
      const int l = item / 3200; int r = item % 3200;
      const float* src; bf16_t* dst; int K, N, kt, nt;
      if (r < 800) { K = 1024; N = 3200; src = p.w_in + (size_t)l * K * N; dst = p.wt + (size_t)l * WT_LAYER + WT_IN; kt = r / 50; nt = r % 50; }
      else if (r < 1088) { r -= 800; K = 1152; N = 1024; src = p.w_out + (size_t)l * K * N; dst = p.wt + (size_t)l * WT_LAYER + WT_OUT; kt = r / 16; nt = r % 16; }
      else if (r < 2496) { r -= 1088; K = 1024; N = 5632; src = p.w_up + (size_t)l * K * N; dst = p.wt + (size_t)l * WT_LAYER + WT_UP; kt = r / 88; nt = r % 88; }
      else { r -= 2496; K = 2816; N = 1024; src = p.w_down + (size_t)l * K * N; dst = p.wt + (size_t)l * WT_LAYER + WT_DOWN; kt = r / 16; nt = r % 16; }
      float* tile = (float*)smem;
      const int k0 = kt * 64, n0 = nt * 64;
      __syncthreads();
#pragma unroll
      for (int i = 0; i < 8; ++i) {
        const int rr = (tid >> 6) + 8 * i, cc = tid & 63;
        tile[rr * 65 + cc] = src[(size_t)(k0 + rr) * N + n0 + cc];
      }
      __syncthreads();
#pragma unroll
      for (int i = 0; i < 4; ++i) {
        const int idx = tid + NTHR * i, n = idx >> 5, k2 = (idx & 31) * 2;
        *(unsigned*)(dst + blk_off(n0 + n, k0 + k2, N)) = pk_bf16(tile[k2 * 65 + n], tile[(k2 + 1) * 65 + n]);
      }
    } else if (item < N_TR + N_MOD) {
      int r = item - N_TR;
      const int l = r / 48; r %= 48;
      const int nc = r / 4, bg = r % 4;
      const int n = nc * NTHR + tid;
      float* sc = (float*)smem;
      float acc[12];
#pragma unroll
      for (int j = 0; j < 12; ++j) acc[j] = 0.f;
      const float* W = p.w_ada + (size_t)l * 1024 * 6144 + n;
      for (int kc = 0; kc < 2; ++kc) {
        __syncthreads();
        for (int i = tid; i < 12 * 512; i += NTHR) {
          const int j = i >> 9, k = i & 511, b = bg * 12 + j;
          const float c = b < 32 ? p.c_prompt[b * 1024 + kc * 512 + k] : p.c_sample[(b - 32) * 1024 + kc * 512 + k];
          sc[i] = c / (1.f + __expf(-c));
        }
        __syncthreads();
#pragma unroll 2
        for (int k = 0; k < 512; k += 4) {
          const float w0 = W[(size_t)(kc * 512 + k) * 6144], w1 = W[(size_t)(kc * 512 + k + 1) * 6144];
          const float w2 = W[(size_t)(kc * 512 + k + 2) * 6144], w3 = W[(size_t)(kc * 512 + k + 3) * 6144];
#pragma unroll
          for (int j = 0; j < 12; ++j) {
            const f32x4 s = *(const f32x4*)(sc + j * 512 + k);
            acc[j] += s[0] * w0 + s[1] * w1 + s[2] * w2 + s[3] * w3;
          }
        }
      }
      const float bias = p.b_ada[l * 6144 + n];
#pragma unroll
      for (int j = 0; j < 12; ++j) p.mod[((size_t)l * 48 + bg * 12 + j) * 6144 + n] = acc[j] + bias;
    } else {
      for (int i = tid; i < 14 * 257; i += NTHR) {
        const int hd = i / 257, idx = i % 257;
        p.lut[i] = p.t5_table[t5_bucket(idx - 128) * 14 + hd] * LOG2E;
      }
      if (tid < 64) p.zeros[tid] = 0.f;
      if (tid < 4) {
        const float* lp = p.lam_d + tid * 128;
        float s1 = 0.f, s2 = 0.f;
        for (int e = 0; e < 32; ++e) { s1 += lp[e] * lp[32 + e]; s2 += lp[64 + e] * lp[96 + e]; }
        const float li = 0.8f - 0.6f * expf(-0.3f * (float)tid);
        p.lam[tid] = expf(s1) - expf(s2) + li;
      }
      {
        const int pr = tid >> 5, ln = tid & 31, l = pr >> 2, m = pr & 3;
        const float* g = m == 0 ? p.qkn_a + l * 128 : (m == 1 ? p.qkn_b + l * 128 : (m == 2 ? p.qkn_c + l * 128 : p.qkn_d + l * 64));
        const int dd = m == 3 ? 32 : 64;
        float gq = 0.f, gk = 0.f, bmax = 0.f;
        for (int i = ln; i < dd; i += 32) { gq = fmaxf(gq, fabsf(g[i])); gk = fmaxf(gk, fabsf(g[dd + i])); }
        if (m == 0) { const float* rp = p.rpb_a + (size_t)l * 4 * 465; for (int i = ln; i < 4 * 465; i += 32) bmax = fmaxf(bmax, rp[i]); }
        else { for (int i = ln; i < 32 * 14; i += 32) bmax = fmaxf(bmax, p.t5_table[i]); }
#pragma unroll
        for (int o = 16; o >= 1; o >>= 1) { gq = fmaxf(gq, __shfl_xor(gq, o)); gk = fmaxf(gk, __shfl_xor(gk, o)); bmax = fmaxf(bmax, __shfl_xor(bmax, o)); }
        const float scale = m == 3 ? 0.17677669529663687f : 0.125f;
        if (ln == 0) p.lam[4 + pr] = ((float)dd * gq * gk * scale + bmax) * LOG2E;
      }
    }
  }
}

__device__ __forceinline__ void norm_phase(const Params& p, int l, bool first, const float* g, int shift_off, int scale_off) {
  const int tid0 = opaque_tid();
  const int lane = tid0 & 63, w = tid0 >> 6;
  const int stride = gridDim.x * NWAVE;
  for (int row0 = blockIdx.x * NWAVE + w; row0 < NTOK; row0 += 2 * stride) {
    const int row1 = row0 + stride;
    const bool has1 = row1 < NTOK;
    const int rows[2] = {row0, has1 ? row1 : row0};
    f32x4 v[2][4];
    float ss[2] = {0.f, 0.f};
#pragma unroll
    for (int r = 0; r < 2; ++r) {
      const float* xr = xin_row(p, first, rows[r]);
#pragma unroll
      for (int i = 0; i < 4; ++i) v[r][i] = *(const f32x4*)(xr + i * 256 + lane * 4);
    }
#pragma unroll
    for (int r = 0; r < 2; ++r) {
#pragma unroll
      for (int i = 0; i < 4; ++i) ss[r] += v[r][i][0] * v[r][i][0] + v[r][i][1] * v[r][i][1] + v[r][i][2] * v[r][i][2] + v[r][i][3] * v[r][i][3];
#pragma unroll
      for (int o = 32; o >= 1; o >>= 1) ss[r] += __shfl_xor(ss[r], o);
    }
#pragma unroll
    for (int r = 0; r < 2; ++r) {
      if (r == 1 && !has1) break;
      const int row = rows[r];
      const float* md = p.mod + ((size_t)l * 48 + (row >> 11)) * 6144;
      const float rstd = rsqrtf(ss[r] * (1.f / 1024.f) + 1e-6f);
#pragma unroll
      for (int i = 0; i < 4; ++i) {
        const int k = i * 256 + lane * 4;
        const f32x4 gg = *(const f32x4*)(g + k), sc = *(const f32x4*)(md + scale_off + k), sh = *(const f32x4*)(md + shift_off + k);
        f32x4 y;
#pragma unroll
        for (int j = 0; j < 4; ++j) y[j] = (v[r][i][j] * rstd) * gg[j] * (1.f + sc[j]) + sh[j];
        u32x2 o; o[0] = pk_bf16(y[0], y[1]); o[1] = pk_bf16(y[2], y[3]);
        *(u32x2*)(p.hbuf + blk_off(row, k, NTOK)) = o;
      }
    }
  }
}

__device__ __forceinline__ bool gemm_tile_id(int it, int MT, int NT, int NB, int& mt, int& nt) {
  const int nb = gridDim.x, bid = blockIdx.x;
  if ((nb & 7) == 0) {
    const int x = bid & 7, slot = bid >> 3, S = nb >> 3;
    const int TPS = 8 * NB, NSN = NT / NB, NS = (MT / 8) * NSN;
    const int pidx = slot + S * it, sidx = pidx / TPS, w = pidx % TPS, s = x + 8 * sidx;
    if (s >= NS) return false;
    mt = (s / NSN) * 8 + (w & 7); nt = (s % NSN) * NB + (w >> 3);
    return true;
  }
  const int t = bid + nb * it;
  if (t >= MT * NT) return false;
  mt = t / NT; nt = t % NT;
  return true;
}

template <int M, int NN>
__device__ __forceinline__ void up_epi_row(const f32x4 (&acc)[8][4], const f32x4 (&cwv)[2][4], int lane, int fr, int s0, bf16_t* obase) {
  constexpr int MP = M > 0 ? M - 1 : 0, MN = M < 7 ? M + 1 : 7;
  const int srcp = (lane & 48) | ((fr + 15) & 15), srcn = (lane & 48) | ((fr + 1) & 15);
  float y[2][4];
#pragma unroll
  for (int n = 0; n < 2; ++n) {
    const f32x4 w0 = cwv[n][0], w1 = cwv[n][1], w2 = cwv[n][2], bb = cwv[n][3];
#pragma unroll
    for (int j = 0; j < 4; ++j) {
      const float cur = acc[M][NN + 2 * n][j];
      const float zp = (fr == 15) ? acc[MP][NN + 2 * n][j] : cur, zn = (fr == 0) ? acc[MN][NN + 2 * n][j] : cur;
      const float pv = __shfl(zp, srcp), nv = __shfl(zn, srcn);
      y[n][j] = w0[j] * pv + w1[j] * cur + w2[j] * nv + bb[j];
    }
  }
  const int row = 16 * M + fr, tpos = s0 + row;
  if (row >= 1 && row <= 126 && tpos >= 0 && tpos < SEQL) {
    float a[4];
#pragma unroll
    for (int j = 0; j < 4; ++j) { const float gte = y[1][j]; a[j] = y[0][j] * gte / (1.f + __expf(-gte)); }
    u32x2 o; o[0] = pk_bf16(a[0], a[1]); o[1] = pk_bf16(a[2], a[3]);
    *(u32x2*)(obase + (size_t)tpos * 32) = o;
  }
  __builtin_amdgcn_sched_barrier(0);
}

#define GB_A 16384
#define GB_BUF 32768
#define NSTAGE 2
#define SMEM_BYTES (NSTAGE * GB_BUF)
template <int EPI>
__device__ __forceinline__ void gemm_phase(const Params& p, int l, bool first, const bf16_t* A, int NBROWS, const bf16_t* Bt, int K, int MT, int NT, int NB,
                           bf16_t* outb, int ldc, int gate_off, char* smem) {
  const int tid = opaque_tid(), lane = tid & 63, w = tid >> 6, wr = w >> 2, wcn = w & 3, fr = lane & 15, fq = lane >> 4;
  const int nk = K / 32;
  const int lrow = tid >> 2, lch = (tid & 3) ^ ((tid >> 4) & 3);
  const int fsw = (fq ^ ((fr >> 2) & 3)) * 16;
  const size_t apan = (size_t)NTOK * 32, bpan = (size_t)NBROWS * 32;
  const bf16_t* ga0; const bf16_t* ga1; const bf16_t* gb0;
  size_t bstr;
#define GEMM_PTRS(MT_, NT_)                                                                                                          \
  {                                                                                                                                  \
    int t_ = tid; asm volatile("" : "+v"(t_));                                                                                       \
    const int lrow_ = t_ >> 2, lch_ = (t_ & 3) ^ ((t_ >> 4) & 3);                                                                    \
    if (EPI == 2) {                                                                                                                  \
      const int wi0 = 2 * (MT_), wi1 = wi0 + 1;                                                                                      \
      const int t0 = 126 * (wi0 % 17) - 1 + lrow_, t1 = 126 * (wi1 % 17) - 1 + lrow_;                                                \
      ga0 = A + ((size_t)(wi0 / 17) * SEQL + t0) * 32 + lch_ * 8;                                                                    \
      ga1 = A + ((size_t)(wi1 / 17) * SEQL + t1) * 32 + lch_ * 8;                                                                    \
      gb0 = Bt + (size_t)((NT_) * 128 + lrow_) * 32 + lch_ * 8; bstr = (size_t)DFF * 32;                                             \
    } else {                                                                                                                         \
      ga0 = A + (size_t)((MT_) * 256 + lrow_) * 32 + lch_ * 8; ga1 = ga0 + (size_t)128 * 32;                                         \
      const int rho_ = lrow_ & 31, prow_ = (lrow_ & ~31) | (8 * ((rho_ & 15) >> 2) + 4 * (rho_ >> 4) + (rho_ & 3));                  \
      gb0 = Bt + (size_t)((NT_) * 256 + prow_) * 32 + lch_ * 8; bstr = (size_t)128 * 32;                                             \
    }                                                                                                                                \
  }
#define GEMM_LOAD(KT, SET)                                                                                                           \
    {                                                                                                                                \
      const size_t ko_ = (size_t)(KT) * apan, kb_ = (size_t)(KT) * bpan;                                                             \
      asm volatile("global_load_dwordx4 %0, %1, off" : "=v"(SET[0]) : "v"(ga0 + ko_) : "memory");                                     \
      asm volatile("global_load_dwordx4 %0, %1, off" : "=v"(SET[1]) : "v"(ga1 + ko_) : "memory");                                     \
      asm volatile("global_load_dwordx4 %0, %1, off" : "=v"(SET[2]) : "v"(gb0 + kb_) : "memory");                                     \
      asm volatile("global_load_dwordx4 %0, %1, off" : "=v"(SET[3]) : "v"(gb0 + bstr + kb_) : "memory");                              \
    }
#define GEMM_WRITE(SET, STAGE)                                                                                                       \
    {                                                                                                                                \
      asm volatile("" : "+v"(SET[0]), "+v"(SET[1]), "+v"(SET[2]), "+v"(SET[3]));      \
      char* dst_ = smem + (STAGE) * GB_BUF + tid * 16;                                                                               \
      *(u32x4*)(dst_) = SET[0]; *(u32x4*)(dst_ + 8192) = SET[1]; *(u32x4*)(dst_ + GB_A) = SET[2]; *(u32x4*)(dst_ + GB_A + 8192) = SET[3]; \
    }
#define GEMM_KSTEP(KT, WSET)                                                                                                         \
    {                                                                                                                                \
      asm volatile("s_waitcnt lgkmcnt(0)" ::: "memory");                                                                             \
      __builtin_amdgcn_s_barrier();                   \
      if ((KT) + 1 < nk) {                                                                                                           \
        if ((KT) + 2 < nk) asm volatile("s_waitcnt vmcnt(4)" ::: "memory"); else asm volatile("s_waitcnt vmcnt(0)" ::: "memory");     \
        GEMM_WRITE(WSET, ((KT) + 1) & 1)                                                                                             \
        if ((KT) + 3 < nk) GEMM_LOAD((KT) + 3, WSET)                                                                                 \
      }                                                                                                                              \
      const char* Ab = smem + ((KT) & 1) * GB_BUF;                                                                                   \
      const char* Bb = Ab + GB_A;                                                                                                    \
      bf16x8 bfr[4];                                                                                                                 \
      _Pragma("unroll") for (int n = 0; n < 4; ++n) {                                                                                \
        const int br = (EPI == 2) ? ((n >> 1) * 128 + 32 * wcn + 16 * (n & 1) + fr) : (64 * wcn + 16 * n + fr);                      \
        bfr[n] = *(const bf16x8*)(Bb + br * 64 + fsw);                                                                               \
      }                                                                                                                              \
      const char* Ap = Ab + (wr * 128 + fr) * 64 + fsw;                                                                              \
      bf16x8 af0 = *(const bf16x8*)(Ap), af1 = *(const bf16x8*)(Ap + 16 * 64);                                                       \
      _Pragma("unroll") for (int pr = 0; pr < 4; ++pr) {                                                                             \
        bf16x8 an0 = af0, an1 = af1;                                                                                                 \
        if (pr < 3) { an0 = *(const bf16x8*)(Ap + (2 * pr + 2) * 16 * 64); an1 = *(const bf16x8*)(Ap + (2 * pr + 3) * 16 * 64); }    \
        __builtin_amdgcn_sched_barrier(0);                                                                                           \
        _Pragma("unroll") for (int n = 0; n < 4; ++n) acc[2 * pr][n] = __builtin_amdgcn_mfma_f32_16x16x32_bf16(bfr[n], af0, acc[2 * pr][n], 0, 0, 0); \
        _Pragma("unroll") for (int n = 0; n < 4; ++n) acc[2 * pr + 1][n] = __builtin_amdgcn_mfma_f32_16x16x32_bf16(bfr[n], af1, acc[2 * pr + 1][n], 0, 0, 0); \
        __builtin_amdgcn_sched_barrier(0);                                                                                           \
        af0 = an0; af1 = an1;                                                                                                        \
      }                                                                                                                              \
    }
  int mt, nt;
  bool have = gemm_tile_id(0, MT, NT, NB, mt, nt);
  for (int it = 0; have; ++it) {
    GEMM_PTRS(mt, nt)
    u32x4 rsA[4], rsB[4];
    f32x4 acc[8][4];
#pragma unroll
    for (int m = 0; m < 8; ++m)
#pragma unroll
      for (int n = 0; n < 4; ++n) acc[m][n] = (f32x4){0.f, 0.f, 0.f, 0.f};
    asm volatile("s_waitcnt vmcnt(0) lgkmcnt(0)" ::: "memory");
    __builtin_amdgcn_s_barrier();
    GEMM_LOAD(0, rsA)
    GEMM_LOAD(1, rsB)
    asm volatile("s_waitcnt vmcnt(4)" ::: "memory");
    GEMM_WRITE(rsA, 0)
    GEMM_LOAD(2, rsA)
    for (int kt = 0; kt < nk; kt += 2) {
      GEMM_KSTEP(kt, rsB)
      GEMM_KSTEP(kt + 1, rsA)
    }
    const int mt_e = mt, nt_e = nt;
    have = gemm_tile_id(it + 1, MT, NT, NB, mt, nt);
    int lane_e = lane; asm volatile("" : "+v"(lane_e));
    const int fr_e = lane_e & 15, fq_e = lane_e >> 4;
    if (EPI == 0) {
      if (nt_e * 256 + 64 * wcn < NBROWS) {
#pragma unroll
        for (int m = 0; m < 8; ++m) {
          const int tok = mt_e * 256 + wr * 128 + 16 * m + fr_e;
#pragma unroll
          for (int q = 0; q < 2; ++q) {
            const int col = nt_e * 256 + 64 * wcn + 32 * q + 8 * fq_e;
            u32x4 o;
            o[0] = pk_bf16(acc[m][2 * q][0], acc[m][2 * q][1]); o[1] = pk_bf16(acc[m][2 * q][2], acc[m][2 * q][3]);
            o[2] = pk_bf16(acc[m][2 * q + 1][0], acc[m][2 * q + 1][1]); o[3] = pk_bf16(acc[m][2 * q + 1][2], acc[m][2 * q + 1][3]);
            *(u32x4*)(outb + (size_t)tok * ldc + col) = o;
          }
        }
      }
    } else if (EPI == 1) {
      const int b = (mt_e * 256) >> 11;
      const float* gate = p.mod + ((size_t)l * 48 + b) * 6144 + gate_off;
#pragma unroll
      for (int q = 0; q < 2; ++q) {
        const int col = nt_e * 256 + 64 * wcn + 32 * q + 8 * fq_e;
        const f32x4 gv0 = *(const f32x4*)(gate + col), gv1 = *(const f32x4*)(gate + col + 4);
#pragma unroll
        for (int mh = 0; mh < 2; ++mh) {
          f32x4 xv[4][2];
#pragma unroll
          for (int mm = 0; mm < 4; ++mm) {
            const float* xr = xin_row(p, first, mt_e * 256 + wr * 128 + 16 * (4 * mh + mm) + fr_e) + col;
            xv[mm][0] = *(const f32x4*)xr; xv[mm][1] = *(const f32x4*)(xr + 4);
          }
#pragma unroll
          for (int mm = 0; mm < 4; ++mm) {
            const int m = 4 * mh + mm, tok = mt_e * 256 + wr * 128 + 16 * m + fr_e;
            f32x4 o0, o1;
#pragma unroll
            for (int j = 0; j < 4; ++j) { o0[j] = xv[mm][0][j] + gv0[j] * acc[m][2 * q][j]; o1[j] = xv[mm][1][j] + gv1[j] * acc[m][2 * q + 1][j]; }
            float* orow = p.out + (size_t)tok * DM + col;
            *(f32x4*)orow = o0; *(f32x4*)(orow + 4) = o1;
          }
        }
      }
    } else {
      const float* cw = p.conv_w + (size_t)l * 3 * 5632;
      const float* cb = p.conv_b + (size_t)l * 5632;
      const int wi = 2 * mt_e + wr, seq = wi / 17, s0 = 126 * (wi % 17) - 1;
      if (s0 < 0 || s0 + 127 >= SEQL) {
#pragma unroll
        for (int m = 0; m < 8; ++m) {
          const int tp = s0 + 16 * m + fr_e;
          if (tp < 0 || tp >= SEQL) {
#pragma unroll
            for (int n = 0; n < 4; ++n) acc[m][n] = (f32x4){0.f, 0.f, 0.f, 0.f};
          }
        }
      }
#define UP_EPI_NN(NN)                                                                                                      \
      {                                                                                                                    \
        const int cbase = nt_e * 128 + 32 * wcn + 16 * NN + 4 * fq_e;                                                        \
        bf16_t* obase = outb + blk_off(seq * SEQL, cbase, NTOK);                                                           \
                   \
        f32x4 cwv[2][4];                                                                                                   \
        _Pragma("unroll") for (int n = 0; n < 2; ++n) {                                                                    \
          const int c = n * DFF + cbase;                                                                                   \
          cwv[n][0] = *(const f32x4*)(cw + c); cwv[n][1] = *(const f32x4*)(cw + 5632 + c);                                 \
          cwv[n][2] = *(const f32x4*)(cw + 2 * 5632 + c); cwv[n][3] = *(const f32x4*)(cb + c);                             \
        }                                                                                                                  \
        up_epi_row<0, NN>(acc, cwv, lane_e, fr_e, s0, obase); up_epi_row<1, NN>(acc, cwv, lane_e, fr_e, s0, obase);          \
        up_epi_row<2, NN>(acc, cwv, lane_e, fr_e, s0, obase); up_epi_row<3, NN>(acc, cwv, lane_e, fr_e, s0, obase);          \
        up_epi_row<4, NN>(acc, cwv, lane_e, fr_e, s0, obase); up_epi_row<5, NN>(acc, cwv, lane_e, fr_e, s0, obase);          \
        up_epi_row<6, NN>(acc, cwv, lane_e, fr_e, s0, obase); up_epi_row<7, NN>(acc, cwv, lane_e, fr_e, s0, obase);          \
      }
      UP_EPI_NN(0)
      UP_EPI_NN(1)
#undef UP_EPI_NN
    }
  }
#undef GEMM_LOAD
#undef GEMM_WRITE
#undef GEMM_KSTEP
#undef GEMM_PTRS
}

struct AttnArgs {
  int qbase, qstride, qpos0;
  int ktokbase, ktokstep, kstride, kposbase, kposstep, ntiles;
  int qcol, kcol, vcol, ocol;
  const float *gq, *gk;
  float qscale;
  int hw, rmul, taboff0;
  float sinkv;
  float lam, outscale;
  const float* subg;
  int lsecol;
  float cshift;
  int r0, rs0;
};

template <int NQ, int NC, int MODE>
__device__ __forceinline__ void attn_item(const Params& p, const AttnArgs& a, bf16_t* Ks, bf16_t* Vts, const float* tab) {
  const int tid = opaque_tid(), lane = tid & 63, w = tid >> 6, fr = lane & 15, fq = lane >> 4;
  const int wq0 = a.qpos0 + w * 16 * NQ;
  const int lch = tid & 7;
  const int ntl = a.ntiles;
  u32x4 kA, vA, kB, vB;
  const int kkey = tid >> 3, vkey = tid & 63, vch = tid >> 6;
#define ATTN_PREFETCH(T, KR, VR)                                                                                 \
  {                                                                                                              \
    const int ktok0_ = a.ktokbase + (T) * a.ktokstep;                                                            \
    KR = *(const u32x4*)(p.proj + (size_t)(ktok0_ + kkey * a.kstride) * PW + a.kcol + lch * 8);                   \
    VR = *(const u32x4*)(p.proj + (size_t)(ktok0_ + vkey * a.kstride) * PW + a.vcol + vch * 8);                   \
  }
  ATTN_PREFETCH(0, kA, vA)
  if (ntl > 1) ATTN_PREFETCH(1, kB, vB)
  bf16x8 qf[NQ][2];
  int qpos[NQ];
#pragma unroll
  for (int qt = 0; qt < NQ; ++qt) {
    const int qp = wq0 + qt * 16 + fr;
    qpos[qt] = qp;
    const bf16_t* qrow = p.proj + (size_t)(a.qbase + qp * a.qstride) * PW + a.qcol;
    const u32x4 v0 = *(const u32x4*)(qrow + fq * 8), v1 = *(const u32x4*)(qrow + 32 + fq * 8);
    float f0[8], f1[8];
#pragma unroll
    for (int i = 0; i < 4; ++i) { f0[2 * i] = bf_lo(v0[i]); f0[2 * i + 1] = bf_hi(v0[i]); f1[2 * i] = bf_lo(v1[i]); f1[2 * i + 1] = bf_hi(v1[i]); }
    float s0 = 0.f, s1 = 0.f;
#pragma unroll
    for (int i = 0; i < 8; ++i) { s0 += f0[i] * f0[i]; s1 += f1[i] * f1[i]; }
    float r0, r1;
    if (NC == 1) {
      float s = s0 + s1; s += __shfl_xor(s, 16); s += __shfl_xor(s, 32);
      r0 = r1 = rsqrtf(s * (1.f / 64.f) + 1e-6f) * a.qscale;
    } else {
      s0 += __shfl_xor(s0, 16); s0 += __shfl_xor(s0, 32);
      s1 += __shfl_xor(s1, 16); s1 += __shfl_xor(s1, 32);
      r0 = rsqrtf(s0 * (1.f / 32.f) + 1e-6f) * a.qscale; r1 = rsqrtf(s1 * (1.f / 32.f) + 1e-6f) * a.qscale;
    }
    const float* g0p = a.gq + fq * 8;
    const float* g1p = (NC == 1) ? a.gq + 32 + fq * 8 : g0p;
    u32x4 q0, q1;
#pragma unroll
    for (int i = 0; i < 4; ++i) {
      q0[i] = pk_bf16(f0[2 * i] * r0 * g0p[2 * i], f0[2 * i + 1] * r0 * g0p[2 * i + 1]);
      q1[i] = pk_bf16(f1[2 * i] * r1 * g1p[2 * i], f1[2 * i + 1] * r1 * g1p[2 * i + 1]);
    }
    qf[qt][0] = __builtin_bit_cast(bf16x8, q0);
    qf[qt][1] = __builtin_bit_cast(bf16x8, q1);
  }
  f32x4 o[NC][NQ][4];
  float mrun[NC][NQ];
  f32x4 lsum[NC][NQ];
  const bf16x8 ones = {0x3F80, 0x3F80, 0x3F80, 0x3F80, 0x3F80, 0x3F80, 0x3F80, 0x3F80};
#pragma unroll
  for (int c = 0; c < NC; ++c)
#pragma unroll
    for (int qt = 0; qt < NQ; ++qt) {
      mrun[c][qt] = a.cshift;
      const float l0 = (MODE == 1) ? fexp2(a.sinkv - a.cshift) : 0.f;
      lsum[c][qt] = (f32x4){l0, l0, l0, l0};
#pragma unroll
      for (int dt = 0; dt < 4; ++dt) o[c][qt][dt] = (f32x4){0.f, 0.f, 0.f, 0.f};
    }
  float gkv[8];
#pragma unroll
  for (int i = 0; i < 8; ++i) gkv[i] = a.gk[((NC == 1) ? lch : (lch & 3)) * 8 + i];

  const int rw = a.r0 + ((w * 16 * NQ) >> 6);
  int rsw = rw - 4; rsw = rsw < 0 ? 0 : (rsw > 24 ? 24 : rsw);
  auto stage_write = [&](const u32x4& kr, const u32x4& vr, bf16_t* Ksb, bf16_t* Vtb) __attribute__((always_inline)) {
    float f[8];
#pragma unroll
    for (int i = 0; i < 4; ++i) { f[2 * i] = bf_lo(kr[i]); f[2 * i + 1] = bf_hi(kr[i]); }
    float s = 0.f;
#pragma unroll
    for (int i = 0; i < 8; ++i) s += f[i] * f[i];
    s += __shfl_xor(s, 1); s += __shfl_xor(s, 2);
    float rs;
    if (NC == 1) { s += __shfl_xor(s, 4); rs = rsqrtf(s * (1.f / 64.f) + 1e-6f); }
    else rs = rsqrtf(s * (1.f / 32.f) + 1e-6f);
    u32x4 kq;
#pragma unroll
    for (int i = 0; i < 4; ++i) kq[i] = pk_bf16(f[2 * i] * rs * gkv[2 * i], f[2 * i + 1] * rs * gkv[2 * i + 1]);
    *(u32x4*)(Ksb + kkey * LDSROW + lch * 8) = kq;
#pragma unroll
    for (int i = 0; i < 4; ++i) {
      Vtb[(vch * 8 + 2 * i) * LDSROW + vkey] = (bf16_t)(vr[i] & 0xffffu);
      Vtb[(vch * 8 + 2 * i + 1) * LDSROW + vkey] = (bf16_t)(vr[i] >> 16);
    }
  };
  auto tile_math = [&](int t, const bf16_t* Ksb, const bf16_t* Vtb) __attribute__((always_inline)) {
    if (MODE == 0) { const int kr_ = a.rs0 + t; if (kr_ < rsw || kr_ >= rsw + 8) return; }
    const int kp0 = a.kposbase + t * a.kposstep;
    const int taboff = (a.rs0 + t - rw + 7) * 31;
    bf16x8 pf[NC][NQ][2];
    bf16x8 kf[4][2];
#pragma unroll
    for (int kt = 0; kt < 4; ++kt) {
      kf[kt][0] = *(const bf16x8*)(Ksb + (kt * 16 + fr) * LDSROW + fq * 8);
      kf[kt][1] = *(const bf16x8*)(Ksb + (kt * 16 + fr) * LDSROW + 32 + fq * 8);
    }
    bf16x8 vfr[4][2];
#pragma unroll
    for (int ks = 0; ks < 2; ++ks)
#pragma unroll
      for (int dt = 0; dt < 4; ++dt) {
        const u32x2 lo = *(const u32x2*)(Vtb + (dt * 16 + fr) * LDSROW + ks * 32 + 4 * fq);
        const u32x2 hi = *(const u32x2*)(Vtb + (dt * 16 + fr) * LDSROW + ks * 32 + 16 + 4 * fq);
        u32x4 vv; vv[0] = lo[0]; vv[1] = lo[1]; vv[2] = hi[0]; vv[3] = hi[1];
        vfr[dt][ks] = __builtin_bit_cast(bf16x8, vv);
      }
#pragma unroll
    for (int qt = 0; qt < NQ; ++qt) {
      const int qp = (MODE == 0) ? (qpos[qt] & 63) : qpos[qt];
      int cs = qp - 8; cs = cs < 0 ? 0 : (cs > 48 ? 48 : cs);
      f32x4 bv[4];
      const bool far_hi = (MODE == 3) && (kp0 - (wq0 + 16 * NQ - 1) >= 128), far_lo = (MODE == 3) && (wq0 - (kp0 + 63) >= 128);
      if (far_hi || far_lo) {
        const float bu = tab[far_hi ? (DT_OFF + 256) : (DT_OFF - 256)];
#pragma unroll
        for (int kt = 0; kt < 4; ++kt) bv[kt] = (f32x4){bu, bu, bu, bu};
      } else if (MODE != 0) {
        const float* tb = tab + (kp0 - qp + 4 * fq + DT_OFF);
#pragma unroll
        for (int kt = 0; kt < 4; ++kt)
#pragma unroll
          for (int j = 0; j < 4; ++j) bv[kt][j] = tb[kt * 16 + j];
      } else
#pragma unroll
      for (int kt = 0; kt < 4; ++kt)
#pragma unroll
        for (int j = 0; j < 4; ++j) {
          const int kpos = kp0 + kt * 16 + 4 * fq + j;
          const int d = kpos - qp;
          const bool valid = kpos >= cs && kpos < cs + 16;
          int dd = d + 15; dd = dd < 0 ? 0 : (dd > 30 ? 30 : dd);
          const float bias = tab[taboff + dd];
          bv[kt][j] = valid ? bias : -INFINITY;
        }
#pragma unroll
      for (int c = 0; c < NC; ++c) {
        f32x4 s[4];
#pragma unroll
        for (int kt = 0; kt < 4; ++kt) {
          if (NC == 1) {
            const f32x4 r = __builtin_amdgcn_mfma_f32_16x16x32_bf16(kf[kt][0], qf[qt][0], bv[kt], 0, 0, 0);
            s[kt] = __builtin_amdgcn_mfma_f32_16x16x32_bf16(kf[kt][1], qf[qt][1], r, 0, 0, 0);
          } else {
            s[kt] = __builtin_amdgcn_mfma_f32_16x16x32_bf16(kf[kt][c], qf[qt][c], bv[kt], 0, 0, 0);
          }
        }
#pragma unroll
        for (int kt = 0; kt < 4; ++kt)
#pragma unroll
          for (int j = 0; j < 4; ++j) s[kt][j] = fexp2(s[kt][j]);
#pragma unroll
        for (int ks = 0; ks < 2; ++ks) {
          u32x4 pk;
          pk[0] = pk_bf16(s[2 * ks][0], s[2 * ks][1]); pk[1] = pk_bf16(s[2 * ks][2], s[2 * ks][3]);
          pk[2] = pk_bf16(s[2 * ks + 1][0], s[2 * ks + 1][1]); pk[3] = pk_bf16(s[2 * ks + 1][2], s[2 * ks + 1][3]);
          pf[c][qt][ks] = __builtin_bit_cast(bf16x8, pk);
        }
      }
    }
#pragma unroll
    for (int ks = 0; ks < 2; ++ks) {
#pragma unroll
      for (int dt = 0; dt < 4; ++dt) {
        const bf16x8 vf = vfr[dt][ks];
#pragma unroll
        for (int c = 0; c < NC; ++c)
#pragma unroll
          for (int qt = 0; qt < NQ; ++qt) o[c][qt][dt] = __builtin_amdgcn_mfma_f32_16x16x32_bf16(vf, pf[c][qt][ks], o[c][qt][dt], 0, 0, 0);
      }
#pragma unroll
      for (int c = 0; c < NC; ++c)
#pragma unroll
        for (int qt = 0; qt < NQ; ++qt) lsum[c][qt] = __builtin_amdgcn_mfma_f32_16x16x32_bf16(ones, pf[c][qt][ks], lsum[c][qt], 0, 0, 0);
    }
    };
  bf16_t* const Ks1 = Ks + 2 * 64 * LDSROW;
  bf16_t* const Vts1 = Vts + 2 * 64 * LDSROW;
  stage_write(kA, vA, Ks, Vts);
  if (ntl > 2) ATTN_PREFETCH(2, kA, vA)
  for (int t = 0; t < ntl; t += 2) {
    __syncthreads();
    if (t + 1 < ntl) { stage_write(kB, vB, Ks1, Vts1); if (t + 3 < ntl) ATTN_PREFETCH(t + 3, kB, vB) }
    tile_math(t, Ks, Vts);
    if (t + 1 < ntl) {
      __syncthreads();
      if (t + 2 < ntl) { stage_write(kA, vA, Ks, Vts); if (t + 4 < ntl) ATTN_PREFETCH(t + 4, kA, vA) }
      tile_math(t + 1, Ks1, Vts1);
    }
  }
#undef ATTN_PREFETCH
#pragma unroll
  for (int qt = 0; qt < NQ; ++qt) {
    float inv[NC], ltot[NC];
#pragma unroll
    for (int c = 0; c < NC; ++c) {
      const float lt = lsum[c][qt][0];
      ltot[c] = lt; inv[c] = 1.f / lt;
    }
    const int tok = a.qbase + qpos[qt] * a.qstride;
    if (MODE == 3) {
      f32x4 v[4];
      float ss = 0.f;
#pragma unroll
      for (int dt = 0; dt < 4; ++dt)
#pragma unroll
        for (int j = 0; j < 4; ++j) {
          const float x = o[0][qt][dt][j] * inv[0] - a.lam * (o[NC - 1][qt][dt][j] * inv[NC - 1]);
          v[dt][j] = x; ss += x * x;
        }
      ss += __shfl_xor(ss, 16); ss += __shfl_xor(ss, 32);
      const float rstd = rsqrtf(ss * (1.f / 64.f) + 1e-6f) * a.outscale;
#pragma unroll
      for (int dt = 0; dt < 4; ++dt) {
        const f32x4 g = *(const f32x4*)(a.subg + dt * 16 + 4 * fq);
        u32x2 ov; ov[0] = pk_bf16(v[dt][0] * rstd * g[0], v[dt][1] * rstd * g[1]); ov[1] = pk_bf16(v[dt][2] * rstd * g[2], v[dt][3] * rstd * g[3]);
        *(u32x2*)(p.hbuf + blk_off(tok, a.ocol + dt * 16 + 4 * fq, NTOK)) = ov;
      }
    } else {
#pragma unroll
      for (int dt = 0; dt < 4; ++dt) {
        u32x2 ov;
        ov[0] = pk_bf16(o[0][qt][dt][0] * inv[0], o[0][qt][dt][1] * inv[0]);
        ov[1] = pk_bf16(o[0][qt][dt][2] * inv[0], o[0][qt][dt][3] * inv[0]);
        *(u32x2*)(p.hbuf + blk_off(tok, a.ocol + dt * 16 + 4 * fq, NTOK)) = ov;
      }
      if (MODE == 2 && fq == 0) p.lse[(size_t)tok * 6 + a.lsecol] = (mrun[0][qt] + __log2f(ltot[0])) * LN2;
    }
  }
}

__device__ __forceinline__ void attn_phase(const Params& p, int l, char* smem) {
  bf16_t* Ks = (bf16_t*)smem;
  bf16_t* Vts = Ks + 64 * LDSROW;
  float* tab = (float*)(Ks + 4 * 64 * LDSROW);
  const int tid = opaque_tid();
  const int nD = 3072, nA = 3072, nB = 3072, nC = 4608;
  for (int item = blockIdx.x; item < nD + nA + nB + nC; item += gridDim.x) {
    AttnArgs a;
    a.taboff0 = 0; a.r0 = 0; a.rs0 = 0; a.sinkv = 0.f; a.cshift = 0.f; a.lam = 0.f; a.outscale = 1.f; a.subg = nullptr; a.lsecol = 0; a.hw = 1 << 20; a.rmul = 1;
    __syncthreads();
    if (item < nD) {
      const int b = item >> 6, h = (item >> 4) & 3, qb = item & 15;
      a.cshift = p.lam[4 + l * 4 + 3];
      for (int i = tid; i < DT_N; i += NTHR) { int dd = i - DT_OFF; dd = dd < -128 ? -128 : (dd > 128 ? 128 : dd); tab[i] = p.lut[(10 + h) * 257 + dd + 128] - a.cshift; }
      a.qbase = b * SEQL; a.qstride = 1; a.qpos0 = qb * 128;
      a.ktokbase = b * SEQL; a.ktokstep = 64; a.kstride = 1; a.kposbase = 0; a.kposstep = 64; a.ntiles = 32;
      a.qcol = 2432 + h * 64; a.kcol = 2432 + 256 + h * 64; a.vcol = 2432 + 512 + h * 64; a.ocol = 896 + h * 64;
      a.gq = p.qkn_d + l * 64; a.gk = a.gq + 32;
      a.qscale = 0.17677669529663687f * LOG2E;
      a.lam = p.lam[l]; a.outscale = 1.f - (0.8f - 0.6f * expf(-0.3f * (float)l)); a.subg = p.subln_d + l * 64;
      attn_item<1, 2, 3>(p, a, Ks, Vts, tab);
    } else if (item < nD + nA) {
      const int id = item - nD;
      const int b = id >> 6, h = (id >> 4) & 3, r = (id & 15) * 2;
      const float* rp = p.rpb_a + ((size_t)l * 4 + h) * 465;
      a.cshift = p.lam[4 + l * 4 + 0];
      for (int i = tid; i < 465; i += NTHR) tab[i] = rp[i] * LOG2E - a.cshift;
      int rs = r - 4; rs = rs < 0 ? 0 : (rs > 24 ? 24 : rs);
      int rs1 = r - 3; rs1 = rs1 < 0 ? 0 : (rs1 > 24 ? 24 : rs1);
      a.qbase = b * SEQL + r * 64; a.qstride = 1; a.qpos0 = 0; a.r0 = r; a.rs0 = rs;
      a.ktokbase = b * SEQL + rs * 64; a.ktokstep = 64; a.kstride = 1; a.kposbase = 0; a.kposstep = 0; a.ntiles = rs1 - rs + 8;
      a.qcol = h * 64; a.kcol = 256 + h * 64; a.vcol = 512 + h * 64; a.ocol = h * 64;
      a.gq = p.qkn_a + l * 128; a.gk = a.gq + 64;
      a.qscale = 0.125f * LOG2E;
      attn_item<1, 1, 0>(p, a, Ks, Vts, tab);
    } else if (item < nD + nA + nB) {
      const int id = item - nD - nA;
      const int b = id >> 6, h = (id >> 4) & 3, qb = id & 15;
      a.cshift = p.lam[4 + l * 4 + 1];
      for (int i = tid; i < DT_N; i += NTHR) { const int d = i - DT_OFF; tab[i] = (d >= -128 && d <= 128) ? p.lut[h * 257 + d + 128] - a.cshift : -INFINITY; }
      const int q0 = qb * 128;
      const int kstart = q0 - 128 < 0 ? 0 : q0 - 128, kend = q0 + 256 > SEQL ? SEQL : q0 + 256;
      a.qbase = b * SEQL; a.qstride = 1; a.qpos0 = q0;
      a.ktokbase = b * SEQL + kstart; a.ktokstep = 64; a.kstride = 1; a.kposbase = kstart; a.kposstep = 64; a.ntiles = (kend - kstart) >> 6;
      a.qcol = 768 + h * 64; a.kcol = 768 + 256 + (h >> 1) * 64; a.vcol = 768 + 384 + (h >> 1) * 64; a.ocol = 256 + h * 64;
      a.gq = p.qkn_b + l * 128; a.gk = a.gq + 64;
      a.qscale = 0.125f * LOG2E;
      a.hw = 128; a.rmul = 1; a.sinkv = p.sink_b[l * 4 + h] * LOG2E;
      attn_item<1, 1, 1>(p, a, Ks, Vts, tab);
    } else {
      const int id = item - nD - nA - nB;
      const int b = id / 96, rem = id % 96, g = rem >> 5, i2 = (rem >> 4) & 1, blk = rem & 15;
      const int r = g == 0 ? 1 : (g == 1 ? 4 : 16);
      const int L = SEQL / r, bps = L >> 7;
      const int pp = blk / bps, m0 = (blk % bps) * 128;
      const int hh = g * 2 + i2;
      a.cshift = p.lam[4 + l * 4 + 2];
      for (int i = tid; i < DT_N; i += NTHR) { const int d = i - DT_OFF; int dd = d * r; dd = dd < -128 ? -128 : (dd > 128 ? 128 : dd);
        tab[i] = (d >= -64 && d <= 64) ? p.lut[(4 + hh) * 257 + dd + 128] - a.cshift : -INFINITY; }
      const int kstart = m0 - 64 < 0 ? 0 : m0 - 64, kend = m0 + 192 > L ? L : m0 + 192;
      a.qbase = b * SEQL + pp; a.qstride = r; a.qpos0 = m0;
      a.ktokbase = a.qbase + kstart * r; a.ktokstep = 64 * r; a.kstride = r; a.kposbase = kstart; a.kposstep = 64; a.ntiles = (kend - kstart) >> 6;
      a.qcol = 1280 + hh * 64; a.kcol = 1280 + 384 + hh * 64; a.vcol = 1280 + 768 + hh * 64; a.ocol = 512 + hh * 64;
      a.gq = p.qkn_c + l * 128; a.gk = a.gq + 64;
      a.qscale = 0.125f * LOG2E;
      a.hw = 64; a.rmul = r; a.lsecol = hh;
      attn_item<1, 1, 2>(p, a, Ks, Vts, tab);
    }
  }
}

__device__ __forceinline__ void combine_phase(const Params& p) {
  const int nthr = gridDim.x * NTHR;
  for (int i = blockIdx.x * NTHR + opaque_tid(); i < NTOK * 48; i += nthr) {
    const int tok = i / 48, rem = i % 48, hh = rem >> 3, ch = rem & 7, ii = hh & 1, g = hh >> 1;
    const float* ls = p.lse + (size_t)tok * 6;
    const float l0 = ls[ii], l1 = ls[2 + ii], l2 = ls[4 + ii];
    const float mx = fmaxf(l0, fmaxf(l1, l2));
    const float e0 = __expf(l0 - mx), e1 = __expf(l1 - mx), e2 = __expf(l2 - mx);
    const float al = (g == 0 ? e0 : (g == 1 ? e1 : e2)) / (e0 + e1 + e2);
    bf16_t* ptr = p.hbuf + blk_off(tok, 512 + hh * 64 + ch * 8, NTOK);
    u32x4 v = *(const u32x4*)ptr;
#pragma unroll
    for (int k = 0; k < 4; ++k) v[k] = pk_bf16(bf_lo(v[k]) * al, bf_hi(v[k]) * al);
    *(u32x4*)ptr = v;
  }
}


#ifndef REP_GEMM
#define REP_GEMM 1
#endif
#ifndef REP_ATTN
#define REP_ATTN 1
#endif
#ifndef DBG_STOP
#define DBG_STOP 0
#endif
__global__ void __launch_bounds__(NTHR, 2) fwd_megakernel(Params p) {
  extern __shared__ __attribute__((aligned(16))) char smem[];
  cg::grid_group grid = cg::this_grid();
  prologue_phase(p, smem);
  grid.sync();
#define LAYER(L)                                                                                                   \
  {                                                                                                                \
    constexpr int l = (L);                                                                                         \
    constexpr bool first = (l == 0);                                                                               \
    const bf16_t* wt = p.wt + (size_t)l * WT_LAYER;                                                                \
    norm_phase(p, l, first, p.norm_attn_g + l * DM, 0, 1024);                                                      \
    grid.sync();                                                                                                   \
    gemm_phase<0>(p, l, false, p.hbuf, 3200, wt + WT_IN, 1024, 384, 13, 13, p.proj, PW, 0, smem);                  \
    grid.sync();                                                                                                   \
    attn_phase(p, l, smem);                                                                                        \
    grid.sync();                                                                                                   \
    combine_phase(p);                                                                                              \
    grid.sync();                                                                                                   \
    gemm_phase<1>(p, l, first, p.hbuf, 1024, wt + WT_OUT, 1152, 384, 4, 4, nullptr, 0, 2048, smem);                \
    grid.sync();                                                                                                   \
    norm_phase(p, l, false, p.norm_ffn_g + l * DM, 3072, 4096);                                                    \
    grid.sync();                                                                                                   \
    gemm_phase<2>(p, l, false, p.hbuf, 5632, wt + WT_UP, 1024, 408, 22, 22, p.proj, DFF, 0, smem);                 \
    grid.sync();                                                                                                   \
    gemm_phase<1>(p, l, false, p.proj, 1024, wt + WT_DOWN, 2816, 384, 4, 4, nullptr, 0, 5120, smem);               \
    grid.sync();                                                                                                   \
  }
  LAYER(0)
  LAYER(1)
  LAYER(2)
  LAYER(3)
#undef LAYER
}

extern "C" void kernel_launch(void* const* d_in, const int* in_sizes, int n_in, void* d_out, int out_size, void* d_ws, size_t ws_size,
                              hipStream_t stream) {
  static int grid_blocks = 0;
  if (!grid_blocks) {
    int dev = 0, cus = 0, per_cu = 0;
    hipGetDevice(&dev);
    hipDeviceGetAttribute(&cus, hipDeviceAttributeMultiprocessorCount, dev);
    hipFuncSetAttribute((const void*)fwd_megakernel, hipFuncAttributeMaxDynamicSharedMemorySize, SMEM_BYTES);
    hipOccupancyMaxActiveBlocksPerMultiprocessor(&per_cu, fwd_megakernel, NTHR, SMEM_BYTES);
    if (per_cu > 1) per_cu = 1;
    if (per_cu < 1) per_cu = 1;
    grid_blocks = cus * per_cu;
  }
  Params p{};
  const float* const* in = (const float* const*)d_in;
  p.x_prompt = in[0]; p.x_sample = in[1]; p.c_prompt = in[2]; p.c_sample = in[3]; p.norm_attn_g = in[4]; p.norm_ffn_g = in[5];
  p.w_ada = in[6]; p.b_ada = in[7]; p.w_in = in[8]; p.qkn_a = in[9]; p.qkn_b = in[10]; p.qkn_c = in[11]; p.qkn_d = in[12];
  p.rpb_a = in[13]; p.sink_b = in[14]; p.t5_table = in[15]; p.lam_d = in[16]; p.subln_d = in[17]; p.w_out = in[18]; p.w_up = in[19];
  p.conv_w = in[20]; p.conv_b = in[21]; p.w_down = in[22];
  p.out = (float*)d_out;
  char* ws = (char*)d_ws;
  size_t off = 0;
  p.wt = (bf16_t*)(ws + off); off += (size_t)4 * WT_LAYER * 2;
  p.mod = (float*)(ws + off); off += (size_t)4 * 48 * 6144 * 4;
  p.lut = (float*)(ws + off); off += 16384;
  p.lam = (float*)(ws + off); off += 256;
  p.zeros = (float*)(ws + off); off += 256;
  p.lse = (float*)(ws + off); off += (size_t)NTOK * 6 * 4;
  p.proj = (bf16_t*)(ws + off); off += (size_t)NTOK * PW * 2;
  p.hbuf = (bf16_t*)(ws + off); off += (size_t)NTOK * MW * 2;
  if (off > ws_size) { fprintf(stderr, "workspace too small: need %zu have %zu\n", off, ws_size); return; }
  void* args[] = {&p};
  hipError_t e = hipLaunchCooperativeKernel((void*)fwd_megakernel, dim3(grid_blocks), dim3(NTHR), args, SMEM_BYTES, stream);
  if (e != hipSuccess) fprintf(stderr, "cooperative launch failed: %s (grid %d)\n", hipGetErrorString(e), grid_blocks);
}
```

```cpp
#include <hip/hip_runtime.h>
#include <hip/hip_cooperative_groups.h>
#include <cstdint>
#include <cstdio>
namespace cg = cooperative_groups;

typedef unsigned short bf16_t;
typedef short bf16x8 __attribute__((ext_vector_type(8)));
typedef float f32x4 __attribute__((ext_vector_type(4)));
typedef unsigned u32x4 __attribute__((ext_vector_type(4)));
typedef unsigned u32x2 __attribute__((ext_vector_type(2)));

#define NTOK 98304
#define DM 1024
#define PW 3200
#define MW 1152
#define DFF 2816
#define NSEQ 48
#define SEQL 2048
#define LOG2E 1.4426950408889634f
#define LN2 0.6931471805599453f
#define LDSROW 72
#define DT_OFF 320
#define DT_N 641
#define NTHR 512
#define NWAVE 8

struct Params {
  const float *x_prompt, *x_sample, *c_prompt, *c_sample, *norm_attn_g, *norm_ffn_g, *w_ada, *b_ada, *w_in;
  const float *qkn_a, *qkn_b, *qkn_c, *qkn_d, *rpb_a, *sink_b, *t5_table, *lam_d, *subln_d, *w_out, *w_up, *conv_w, *conv_b, *w_down;
  float* out;
  bf16_t* wt; float* mod; float* lut; float* lam; float* lse; bf16_t* proj; bf16_t* hbuf; float* zeros;
};

#define WT_IN 0
#define WT_OUT (3200 * 1024)
#define WT_UP (WT_OUT + 1024 * 1152)
#define WT_DOWN (WT_UP + 5632 * 1024)
#define WT_LAYER (WT_DOWN + 1024 * 2816)

typedef __bf16 bf16x2_t __attribute__((ext_vector_type(2)));
typedef float f32x2_t __attribute__((ext_vector_type(2)));
__device__ __forceinline__ unsigned pk_bf16(float lo, float hi) {
  const f32x2_t v = {lo, hi};
  const bf16x2_t r = __builtin_convertvector(v, bf16x2_t);
  return __builtin_bit_cast(unsigned, r);
}
__device__ __forceinline__ float bf_lo(unsigned u) { return __uint_as_float(u << 16); }
__device__ __forceinline__ float bf_hi(unsigned u) { return __uint_as_float(u & 0xffff0000u); }
__device__ __forceinline__ float fexp2(float x) { return __builtin_amdgcn_exp2f(x); }

__device__ __forceinline__ const float* xin_row(const Params& p, bool first, int tok) {
  if (first) return tok < 65536 ? p.x_prompt + (size_t)tok * DM : p.x_sample + (size_t)(tok - 65536) * DM;
  return p.out + (size_t)tok * DM;
}

__device__ __forceinline__ int opaque_tid() { int t = threadIdx.x; asm volatile("" : "+v"(t)); return t; }

__device__ __forceinline__ size_t blk_off(int r, int k, int R) { return ((size_t)(k >> 5) * R + r) * 32 + (k & 31); }

__device__ __forceinline__ int t5_bucket(int rel) {
  const int n = rel < 0 ? -rel : rel;
  int v;
  if (n < 8) v = n;
  else v = 8 + (n >= 12) + (n >= 16) + (n >= 23) + (n >= 32) + (n >= 46) + (n >= 64) + (n >= 91);
  return (rel > 0 ? 16 : 0) + v;
}

__device__ __forceinline__ void prologue_phase(const Params& p, char* smem) {
  const int tid = opaque_tid(), nb = gridDim.x;
  const int N_TR = 4 * 3200, N_MOD = 192;
  for (int item = blockIdx.x; item < N_TR + N_MOD + 1; item += nb) {
    if (item < N_TR) {
      const int l = item / 3200; int r = item % 3200;
      const float* src; bf16_t* dst; int K, N, kt, nt;
      if (r < 800) { K = 1024; N = 3200; src = p.w_in + (size_t)l * K * N; dst = p.wt + (size_t)l * WT_LAYER + WT_IN; kt = r / 50; nt = r % 50; }
      else if (r < 1088) { r -= 800; K = 1152; N = 1024; src = p.w_out + (size_t)l * K * N; dst = p.wt + (size_t)l * WT_LAYER + WT_OUT; kt = r / 16; nt = r % 16; }
      else if (r < 2496) { r -= 1088; K = 1024; N = 5632; src = p.w_up + (size_t)l * K * N; dst = p.wt + (size_t)l * WT_LAYER + WT_UP; kt = r / 88; nt = r % 88; }
      else { r -= 2496; K = 2816; N = 1024; src = p.w_down + (size_t)l * K * N; dst = p.wt + (size_t)l * WT_LAYER + WT_DOWN; kt = r / 16; nt = r % 16; }
      float* tile = (float*)smem;
      const int k0 = kt * 64, n0 = nt * 64;
      __syncthreads();
#pragma unroll
      for (int i = 0; i < 8; ++i) {
        const int rr = (tid >> 6) + 8 * i, cc = tid & 63;
        tile[rr * 65 + cc] = src[(size_t)(k0 + rr) * N + n0 + cc];
      }
      __syncthreads();
#pragma unroll
      for (int i = 0; i < 4; ++i) {
        const int idx = tid + NTHR * i, n = idx >> 5, k2 = (idx & 31) * 2;
        *(unsigned*)(dst + blk_off(n0 + n, k0 + k2, N)) = pk_bf16(tile[k2 * 65 + n], tile[(k2 + 1) * 65 + n]);
      }
    } else if (item < N_TR + N_MOD) {
      int r = item - N_TR;
      const int l = r / 48; r %= 48;
      const int nc = r / 4, bg = r % 4;
      const int n = nc * NTHR + tid;
      float* sc = (float*)smem;
      float acc[12];
#pragma unroll
      for (int j = 0; j < 12; ++j) acc[j] = 0.f;
      const float* W = p.w_ada + (size_t)l * 1024 * 6144 + n;
      for (int kc = 0; kc < 2; ++kc) {
        __syncthreads();
        for (int i = tid; i < 12 * 512; i += NTHR) {
          const int j = i >> 9, k = i & 511, b = bg * 12 + j;
          const float c = b < 32 ? p.c_prompt[b * 1024 + kc * 512 + k] : p.c_sample[(b - 32) * 1024 + kc * 512 + k];
          sc[i] = c / (1.f + __expf(-c));
        }
        __syncthreads();
#pragma unroll 2
        for (int k = 0; k < 512; k += 4) {
          const float w0 = W[(size_t)(kc * 512 + k) * 6144], w1 = W[(size_t)(kc * 512 + k + 1) * 6144];
          const float w2 = W[(size_t)(kc * 512 + k + 2) * 6144], w3 = W[(size_t)(kc * 512 + k + 3) * 6144];
#pragma unroll
          for (int j = 0; j < 12; ++j) {
            const f32x4 s = *(const f32x4*)(sc + j * 512 + k);
            acc[j] += s[0] * w0 + s[1] * w1 + s[2] * w2 + s[3] * w3;
          }
        }
      }
      const float bias = p.b_ada[l * 6144 + n];
#pragma unroll
      for (int j = 0; j < 12; ++j) p.mod[((size_t)l * 48 + bg * 12 + j) * 6144 + n] = acc[j] + bias;
    } else {
      for (int i = tid; i < 14 * 257; i += NTHR) {
        const int hd = i / 257, idx = i % 257;
        p.lut[i] = p.t5_table[t5_bucket(idx - 128) * 14 + hd] * LOG2E;
      }
      if (tid < 64) p.zeros[tid] = 0.f;
      if (tid < 4) {
        const float* lp = p.lam_d + tid * 128;
        float s1 = 0.f, s2 = 0.f;
        for (int e = 0; e < 32; ++e) { s1 += lp[e] * lp[32 + e]; s2 += lp[64 + e] * lp[96 + e]; }
        const float li = 0.8f - 0.6f * expf(-0.3f * (float)tid);
        p.lam[tid] = expf(s1) - expf(s2) + li;
      }
      {
        const int pr = tid >> 5, ln = tid & 31, l = pr >> 2, m = pr & 3;
        const float* g = m == 0 ? p.qkn_a + l * 128 : (m == 1 ? p.qkn_b + l * 128 : (m == 2 ? p.qkn_c + l * 128 : p.qkn_d + l * 64));
        const int dd = m == 3 ? 32 : 64;
        float gq = 0.f, gk = 0.f, bmax = 0.f;
        for (int i = ln; i < dd; i += 32) { gq = fmaxf(gq, fabsf(g[i])); gk = fmaxf(gk, fabsf(g[dd + i])); }
        if (m == 0) { const float* rp = p.rpb_a + (size_t)l * 4 * 465; for (int i = ln; i < 4 * 465; i += 32) bmax = fmaxf(bmax, rp[i]); }
        else { for (int i = ln; i < 32 * 14; i += 32) bmax = fmaxf(bmax, p.t5_table[i]); }
#pragma unroll
        for (int o = 16; o >= 1; o >>= 1) { gq = fmaxf(gq, __shfl_xor(gq, o)); gk = fmaxf(gk, __shfl_xor(gk, o)); bmax = fmaxf(bmax, __shfl_xor(bmax, o)); }
        const float scale = m == 3 ? 0.17677669529663687f : 0.125f;
        if (ln == 0) p.lam[4 + pr] = ((float)dd * gq * gk * scale + bmax) * LOG2E;
      }
    }
  }
}

__device__ __forceinline__ void norm_phase(const Params& p, int l, bool first, const float* g, int shift_off, int scale_off) {
  const int tid0 = opaque_tid();
  const int lane = tid0 & 63, w = tid0 >> 6;
  const int stride = gridDim.x * NWAVE;
  for (int row0 = blockIdx.x * NWAVE + w; row0 < NTOK; row0 += 2 * stride) {
    const int row1 = row0 + stride;
    const bool has1 = row1 < NTOK;
    const int rows[2] = {row0, has1 ? row1 : row0};
    f32x4 v[2][4];
    float ss[2] = {0.f, 0.f};
#pragma unroll
    for (int r = 0; r < 2; ++r) {
      const float* xr = xin_row(p, first, rows[r]);
#pragma unroll
      for (int i = 0; i < 4; ++i) v[r][i] = *(const f32x4*)(xr + i * 256 + lane * 4);
    }
#pragma unroll
    for (int r = 0; r < 2; ++r) {
#pragma unroll
      for (int i = 0; i < 4; ++i) ss[r] += v[r][i][0] * v[r][i][0] + v[r][i][1] * v[r][i][1] + v[r][i][2] * v[r][i][2] + v[r][i][3] * v[r][i][3];
#pragma unroll
      for (int o = 32; o >= 1; o >>= 1) ss[r] += __shfl_xor(ss[r], o);
    }
#pragma unroll
    for (int r = 0; r < 2; ++r) {
      if (r == 1 && !has1) break;
      const int row = rows[r];
      const float* md = p.mod + ((size_t)l * 48 + (row >> 11)) * 6144;
      const float rstd = rsqrtf(ss[r] * (1.f / 1024.f) + 1e-6f);
#pragma unroll
      for (int i = 0; i < 4; ++i) {
        const int k = i * 256 + lane * 4;
        const f32x4 gg = *(const f32x4*)(g + k), sc = *(const f32x4*)(md + scale_off + k), sh = *(const f32x4*)(md + shift_off + k);
        f32x4 y;
#pragma unroll
        for (int j = 0; j < 4; ++j) y[j] = (v[r][i][j] * rstd) * gg[j] * (1.f + sc[j]) + sh[j];
        u32x2 o; o[0] = pk_bf16(y[0], y[1]); o[1] = pk_bf16(y[2], y[3]);
        *(u32x2*)(p.hbuf + blk_off(row, k, NTOK)) = o;
      }
    }
  }
}

__device__ __forceinline__ bool gemm_tile_id(int it, int MT, int NT, int NB, int& mt, int& nt) {
  const int nb = gridDim.x, bid = blockIdx.x;
  if ((nb & 7) == 0) {
    const int x = bid & 7, slot = bid >> 3, S = nb >> 3;
    const int TPS = 8 * NB, NSN = NT / NB, NS = (MT / 8) * NSN;
    const int pidx = slot + S * it, sidx = pidx / TPS, w = pidx % TPS, s = x + 8 * sidx;
    if (s >= NS) return false;
    mt = (s / NSN) * 8 + (w & 7); nt = (s % NSN) * NB + (w >> 3);
    return true;
  }
  const int t = bid + nb * it;
  if (t >= MT * NT) return false;
  mt = t / NT; nt = t % NT;
  return true;
}

template <int M, int NN>
__device__ __forceinline__ void up_epi_row(const f32x4 (&acc)[8][4], const f32x4 (&cwv)[2][4], int lane, int fr, int s0, bf16_t* obase) {
  constexpr int MP = M > 0 ? M - 1 : 0, MN = M < 7 ? M + 1 : 7;
  float y[2][4];
#pragma unroll
  for (int n = 0; n < 2; ++n) {
    const f32x4 w0 = cwv[n][0], w1 = cwv[n][1], w2 = cwv[n][2], bb = cwv[n][3];
#pragma unroll
    for (int j = 0; j < 4; ++j) {
      const float cur = acc[M][NN + 2 * n][j];
      const float zp = (fr == 15) ? acc[MP][NN + 2 * n][j] : cur, zn = (fr == 0) ? acc[MN][NN + 2 * n][j] : cur;
      const float pv = __builtin_bit_cast(float, __builtin_amdgcn_update_dpp(0, __builtin_bit_cast(int, zp), 0x121, 0xf, 0xf, false));
      const float nv = __builtin_bit_cast(float, __builtin_amdgcn_update_dpp(0, __builtin_bit_cast(int, zn), 0x12F, 0xf, 0xf, false));
      y[n][j] = w0[j] * pv + w1[j] * cur + w2[j] * nv + bb[j];
    }
  }
  const int row = 16 * M + fr, tpos = s0 + row;
  if (row >= 1 && row <= 126 && tpos >= 0 && tpos < SEQL) {
    float a[4];
#pragma unroll
    for (int j = 0; j < 4; ++j) { const float gte = y[1][j]; a[j] = y[0][j] * gte / (1.f + __expf(-gte)); }
    u32x2 o; o[0] = pk_bf16(a[0], a[1]); o[1] = pk_bf16(a[2], a[3]);
    *(u32x2*)(obase + (size_t)tpos * 32) = o;
  }
  __builtin_amdgcn_sched_barrier(0);
}

#define GB_A 16384
#define GB_BUF 32768
#define NSTAGE 2
#define SMEM_BYTES (NSTAGE * GB_BUF)
template <int EPI>
__device__ __forceinline__ void gemm_phase(const Params& p, int l, bool first, const bf16_t* A, int NBROWS, const bf16_t* Bt, int K, int MT, int NT, int NB,
                           bf16_t* outb, int ldc, int gate_off, char* smem) {
  const int tid = opaque_tid(), lane = tid & 63, w = tid >> 6, wr = w >> 2, wcn = w & 3, fr = lane & 15, fq = lane >> 4;
  const int nk = K / 32;
  const int lrow = tid >> 2, lch = (tid & 3) ^ ((tid >> 4) & 3);
  const int fsw = (fq ^ ((fr >> 2) & 3)) * 16;
  const size_t apan = (size_t)NTOK * 32, bpan = (size_t)NBROWS * 32;
  const bf16_t* ga0; const bf16_t* ga1; const bf16_t* gb0;
  size_t bstr;
#define GEMM_PTRS(MT_, NT_)                                                                                                          \
  {                                                                                                                                  \
    int t_ = tid; asm volatile("" : "+v"(t_));                                                                                       \
    const int lrow_ = t_ >> 2, lch_ = (t_ & 3) ^ ((t_ >> 4) & 3);                                                                    \
    if (EPI == 2) {                                                                                                                  \
      const int wi0 = 2 * (MT_), wi1 = wi0 + 1;                                                                                      \
      const int t0 = 126 * (wi0 % 17) - 1 + lrow_, t1 = 126 * (wi1 % 17) - 1 + lrow_;                                                \
      ga0 = A + ((size_t)(wi0 / 17) * SEQL + t0) * 32 + lch_ * 8;                                                                    \
      ga1 = A + ((size_t)(wi1 / 17) * SEQL + t1) * 32 + lch_ * 8;                                                                    \
      const int rho2_ = lrow_ & 31, prow2_ = (lrow_ & ~31) | (8 * ((rho2_ & 15) >> 2) + 4 * (rho2_ >> 4) + (rho2_ & 3));              \
      gb0 = Bt + (size_t)((NT_) * 128 + prow2_) * 32 + lch_ * 8; bstr = (size_t)DFF * 32;                                            \
    } else {                                                                                                                         \
      ga0 = A + (size_t)((MT_) * 256 + lrow_) * 32 + lch_ * 8; ga1 = ga0 + (size_t)128 * 32;                                         \
      const int rho_ = lrow_ & 31, prow_ = (lrow_ & ~31) | (8 * ((rho_ & 15) >> 2) + 4 * (rho_ >> 4) + (rho_ & 3));                  \
      gb0 = Bt + (size_t)((NT_) * 256 + prow_) * 32 + lch_ * 8; bstr = (size_t)128 * 32;                                             \
    }                                                                                                                                \
  }
#define GEMM_LOAD(KT, SET)                                                                                                           \
    {                                                                                                                                \
      const size_t ko_ = (size_t)(KT) * apan, kb_ = (size_t)(KT) * bpan;                                                             \
      asm volatile("global_load_dwordx4 %0, %1, off" : "=v"(SET[0]) : "v"(ga0 + ko_) : "memory");                                     \
      asm volatile("global_load_dwordx4 %0, %1, off" : "=v"(SET[1]) : "v"(ga1 + ko_) : "memory");                                     \
      asm volatile("global_load_dwordx4 %0, %1, off" : "=v"(SET[2]) : "v"(gb0 + kb_) : "memory");                                     \
      asm volatile("global_load_dwordx4 %0, %1, off" : "=v"(SET[3]) : "v"(gb0 + bstr + kb_) : "memory");                              \
    }
#define GEMM_WRITE(SET, STAGE)                                                                                                       \
    {                                                                                                                                \
      asm volatile("" : "+v"(SET[0]), "+v"(SET[1]), "+v"(SET[2]), "+v"(SET[3]));      \
      char* dst_ = smem + (STAGE) * GB_BUF + tid * 16;                                                                               \
      *(u32x4*)(dst_) = SET[0]; *(u32x4*)(dst_ + 8192) = SET[1]; *(u32x4*)(dst_ + GB_A) = SET[2]; *(u32x4*)(dst_ + GB_A + 8192) = SET[3]; \
    }
#define GEMM_KSTEP(KT, WSET)                                                                                                         \
    {                                                                                                                                \
      asm volatile("s_waitcnt lgkmcnt(0)" ::: "memory");                                                                             \
      __builtin_amdgcn_s_barrier();                   \
      if ((KT) + 1 < nk) {                                                                                                           \
        if ((KT) + 2 < nk) asm volatile("s_waitcnt vmcnt(4)" ::: "memory"); else asm volatile("s_waitcnt vmcnt(0)" ::: "memory");     \
        GEMM_WRITE(WSET, ((KT) + 1) & 1)                                                                                             \
        if ((KT) + 3 < nk) GEMM_LOAD((KT) + 3, WSET)                                                                                 \
      }                                                                                                                              \
      const char* Ab = smem + ((KT) & 1) * GB_BUF;                                                                                   \
      const char* Bb = Ab + GB_A;                                                                                                    \
      bf16x8 bfr[4];                                                                                                                 \
      _Pragma("unroll") for (int n = 0; n < 4; ++n) {                                                                                \
        const int br = (EPI == 2) ? ((n >> 1) * 128 + 32 * wcn + 16 * (n & 1) + fr) : (64 * wcn + 16 * n + fr);                      \
        bfr[n] = *(const bf16x8*)(Bb + br * 64 + fsw);                                                                               \
      }                                                                                                                              \
      const char* Ap = Ab + (wr * 128 + fr) * 64 + fsw;                                                                              \
      bf16x8 af0 = *(const bf16x8*)(Ap), af1 = *(const bf16x8*)(Ap + 16 * 64);                                                       \
      _Pragma("unroll") for (int pr = 0; pr < 4; ++pr) {                                                                             \
        bf16x8 an0 = af0, an1 = af1;                                                                                                 \
        if (pr < 3) { an0 = *(const bf16x8*)(Ap + (2 * pr + 2) * 16 * 64); an1 = *(const bf16x8*)(Ap + (2 * pr + 3) * 16 * 64); }    \
        __builtin_amdgcn_sched_barrier(0);                                                                                           \
        _Pragma("unroll") for (int n = 0; n < 4; ++n) acc[2 * pr][n] = __builtin_amdgcn_mfma_f32_16x16x32_bf16(bfr[n], af0, acc[2 * pr][n], 0, 0, 0); \
        _Pragma("unroll") for (int n = 0; n < 4; ++n) acc[2 * pr + 1][n] = __builtin_amdgcn_mfma_f32_16x16x32_bf16(bfr[n], af1, acc[2 * pr + 1][n], 0, 0, 0); \
        __builtin_amdgcn_sched_barrier(0);                                                                                           \
        af0 = an0; af1 = an1;                                                                                                        \
      }                                                                                                                              \
    }
  int mt, nt;
  bool have = gemm_tile_id(0, MT, NT, NB, mt, nt);
  for (int it = 0; have; ++it) {
    GEMM_PTRS(mt, nt)
    u32x4 rsA[4], rsB[4];
    f32x4 acc[8][4];
#pragma unroll
    for (int m = 0; m < 8; ++m)
#pragma unroll
      for (int n = 0; n < 4; ++n) acc[m][n] = (f32x4){0.f, 0.f, 0.f, 0.f};
    asm volatile("s_waitcnt vmcnt(0) lgkmcnt(0)" ::: "memory");
    __builtin_amdgcn_s_barrier();
    GEMM_LOAD(0, rsA)
    GEMM_LOAD(1, rsB)
    asm volatile("s_waitcnt vmcnt(4)" ::: "memory");
    GEMM_WRITE(rsA, 0)
    GEMM_LOAD(2, rsA)
    for (int kt = 0; kt < nk; kt += 2) {
      GEMM_KSTEP(kt, rsB)
      GEMM_KSTEP(kt + 1, rsA)
    }
    const int mt_e = mt, nt_e = nt;
    have = gemm_tile_id(it + 1, MT, NT, NB, mt, nt);
    int lane_e = lane; asm volatile("" : "+v"(lane_e));
    const int fr_e = lane_e & 15, fq_e = lane_e >> 4;
    if (EPI == 0) {
      if (nt_e * 256 + 64 * wcn < NBROWS) {
#pragma unroll
        for (int m = 0; m < 8; ++m) {
          const int tok = mt_e * 256 + wr * 128 + 16 * m + fr_e;
#pragma unroll
          for (int q = 0; q < 2; ++q) {
            const int col = nt_e * 256 + 64 * wcn + 32 * q + 8 * fq_e;
            u32x4 o;
            o[0] = pk_bf16(acc[m][2 * q][0], acc[m][2 * q][1]); o[1] = pk_bf16(acc[m][2 * q][2], acc[m][2 * q][3]);
            o[2] = pk_bf16(acc[m][2 * q + 1][0], acc[m][2 * q + 1][1]); o[3] = pk_bf16(acc[m][2 * q + 1][2], acc[m][2 * q + 1][3]);
            *(u32x4*)(outb + (size_t)tok * ldc + col) = o;
          }
        }
      }
    } else if (EPI == 1) {
      const int b = (mt_e * 256) >> 11;
      const float* gate = p.mod + ((size_t)l * 48 + b) * 6144 + gate_off;
#pragma unroll
      for (int q = 0; q < 2; ++q) {
        const int col = nt_e * 256 + 64 * wcn + 32 * q + 8 * fq_e;
        const f32x4 gv0 = *(const f32x4*)(gate + col), gv1 = *(const f32x4*)(gate + col + 4);
#pragma unroll
        for (int mh = 0; mh < 2; ++mh) {
          f32x4 xv[4][2];
#pragma unroll
          for (int mm = 0; mm < 4; ++mm) {
            const float* xr = xin_row(p, first, mt_e * 256 + wr * 128 + 16 * (4 * mh + mm) + fr_e) + col;
            xv[mm][0] = *(const f32x4*)xr; xv[mm][1] = *(const f32x4*)(xr + 4);
          }
#pragma unroll
          for (int mm = 0; mm < 4; ++mm) {
            const int m = 4 * mh + mm, tok = mt_e * 256 + wr * 128 + 16 * m + fr_e;
            f32x4 o0, o1;
#pragma unroll
            for (int j = 0; j < 4; ++j) { o0[j] = xv[mm][0][j] + gv0[j] * acc[m][2 * q][j]; o1[j] = xv[mm][1][j] + gv1[j] * acc[m][2 * q + 1][j]; }
            float* orow = p.out + (size_t)tok * DM + col;
            *(f32x4*)orow = o0; *(f32x4*)(orow + 4) = o1;
          }
        }
      }
    } else {
      const float* cw = p.conv_w + (size_t)l * 3 * 5632;
      const float* cb = p.conv_b + (size_t)l * 5632;
      const int wi = 2 * mt_e + wr, seq = wi / 17, s0 = 126 * (wi % 17) - 1;
      if (s0 < 0 || s0 + 127 >= SEQL) {
#pragma unroll
        for (int m = 0; m < 8; ++m) {
          const int tp = s0 + 16 * m + fr_e;
          if (tp < 0 || tp >= SEQL) {
#pragma unroll
            for (int n = 0; n < 4; ++n) acc[m][n] = (f32x4){0.f, 0.f, 0.f, 0.f};
          }
        }
      }
#define UP_EPI_NN(NN)                                                                                                      \
      {                                                                                                                    \
        const int cbase = nt_e * 128 + 32 * wcn + 8 * fq_e + 4 * NN;     \
        bf16_t* obase = outb + blk_off(seq * SEQL, cbase, NTOK);                                                           \
                   \
        f32x4 cwv[2][4];                                                                                                   \
        _Pragma("unroll") for (int n = 0; n < 2; ++n) {                                                                    \
          const int c = n * DFF + cbase;                                                                                   \
          cwv[n][0] = *(const f32x4*)(cw + c); cwv[n][1] = *(const f32x4*)(cw + 5632 + c);                                 \
          cwv[n][2] = *(const f32x4*)(cw + 2 * 5632 + c); cwv[n][3] = *(const f32x4*)(cb + c);                             \
        }                                                                                                                  \
        up_epi_row<0, NN>(acc, cwv, lane_e, fr_e, s0, obase); up_epi_row<1, NN>(acc, cwv, lane_e, fr_e, s0, obase);          \
        up_epi_row<2, NN>(acc, cwv, lane_e, fr_e, s0, obase); up_epi_row<3, NN>(acc, cwv, lane_e, fr_e, s0, obase);          \
        up_epi_row<4, NN>(acc, cwv, lane_e, fr_e, s0, obase); up_epi_row<5, NN>(acc, cwv, lane_e, fr_e, s0, obase);          \
        up_epi_row<6, NN>(acc, cwv, lane_e, fr_e, s0, obase); up_epi_row<7, NN>(acc, cwv, lane_e, fr_e, s0, obase);          \
      }
      UP_EPI_NN(0)
      UP_EPI_NN(1)
#undef UP_EPI_NN
    }
  }
#undef GEMM_LOAD
#undef GEMM_WRITE
#undef GEMM_KSTEP
#undef GEMM_PTRS
}

struct AttnArgs {
  int qbase, qstride, qpos0;
  int ktokbase, ktokstep, kstride, kposbase, kposstep, ntiles;
  int qcol, kcol, vcol, ocol;
  const float *gq, *gk;
  float qscale;
  int hw, rmul, taboff0;
  float sinkv;
  float lam, outscale;
  const float* subg;
  int lsecol;
  float cshift;
  int r0, rs0;
};

template <int NQ, int NC, int MODE>
__device__ __forceinline__ void attn_item(const Params& p, const AttnArgs& a, bf16_t* Ks, bf16_t* Vts, const float* tab) {
  const int tid = opaque_tid(), lane = tid & 63, w = tid >> 6, fr = lane & 15, fq = lane >> 4;
  const int wq0 = a.qpos0 + w * 16 * NQ;
  const int lch = tid & 7;
  const int ntl = a.ntiles;
  u32x4 kA, vA, kB, vB;
  const int kkey = tid >> 3, vkey = tid & 63, vch = tid >> 6;
#define ATTN_PREFETCH(T, KR, VR)                                                                                 \
  {                                                                                                              \
    const int ktok0_ = a.ktokbase + (T) * a.ktokstep;                                                            \
    KR = *(const u32x4*)(p.proj + (size_t)(ktok0_ + kkey * a.kstride) * PW + a.kcol + lch * 8);                   \
    VR = *(const u32x4*)(p.proj + (size_t)(ktok0_ + vkey * a.kstride) * PW + a.vcol + vch * 8);                   \
  }
  ATTN_PREFETCH(0, kA, vA)
  if (ntl > 1) ATTN_PREFETCH(1, kB, vB)
  bf16x8 qf[NQ][2];
  int qpos[NQ];
#pragma unroll
  for (int qt = 0; qt < NQ; ++qt) {
    const int qp = wq0 + qt * 16 + fr;
    qpos[qt] = qp;
    const bf16_t* qrow = p.proj + (size_t)(a.qbase + qp * a.qstride) * PW + a.qcol;
    const u32x4 v0 = *(const u32x4*)(qrow + fq * 8), v1 = *(const u32x4*)(qrow + 32 + fq * 8);
    float f0[8], f1[8];
#pragma unroll
    for (int i = 0; i < 4; ++i) { f0[2 * i] = bf_lo(v0[i]); f0[2 * i + 1] = bf_hi(v0[i]); f1[2 * i] = bf_lo(v1[i]); f1[2 * i + 1] = bf_hi(v1[i]); }
    float s0 = 0.f, s1 = 0.f;
#pragma unroll
    for (int i = 0; i < 8; ++i) { s0 += f0[i] * f0[i]; s1 += f1[i] * f1[i]; }
    float r0, r1;
    if (NC == 1) {
      float s = s0 + s1; s += __shfl_xor(s, 16); s += __shfl_xor(s, 32);
      r0 = r1 = rsqrtf(s * (1.f / 64.f) + 1e-6f) * a.qscale;
    } else {
      s0 += __shfl_xor(s0, 16); s0 += __shfl_xor(s0, 32);
      s1 += __shfl_xor(s1, 16); s1 += __shfl_xor(s1, 32);
      r0 = rsqrtf(s0 * (1.f / 32.f) + 1e-6f) * a.qscale; r1 = rsqrtf(s1 * (1.f / 32.f) + 1e-6f) * a.qscale;
    }
    const float* g0p = a.gq + fq * 8;
    const float* g1p = (NC == 1) ? a.gq + 32 + fq * 8 : g0p;
    u32x4 q0, q1;
#pragma unroll
    for (int i = 0; i < 4; ++i) {
      q0[i] = pk_bf16(f0[2 * i] * r0 * g0p[2 * i], f0[2 * i + 1] * r0 * g0p[2 * i + 1]);
      q1[i] = pk_bf16(f1[2 * i] * r1 * g1p[2 * i], f1[2 * i + 1] * r1 * g1p[2 * i + 1]);
    }
    qf[qt][0] = __builtin_bit_cast(bf16x8, q0);
    qf[qt][1] = __builtin_bit_cast(bf16x8, q1);
  }
  f32x4 o[NC][NQ][4];
  float mrun[NC][NQ];
  f32x4 lsum[NC][NQ];
  const bf16x8 ones = {0x3F80, 0x3F80, 0x3F80, 0x3F80, 0x3F80, 0x3F80, 0x3F80, 0x3F80};
#pragma unroll
  for (int c = 0; c < NC; ++c)
#pragma unroll
    for (int qt = 0; qt < NQ; ++qt) {
      mrun[c][qt] = a.cshift;
      const float l0 = (MODE == 1) ? fexp2(a.sinkv - a.cshift) : 0.f;
      lsum[c][qt] = (f32x4){l0, l0, l0, l0};
#pragma unroll
      for (int dt = 0; dt < 4; ++dt) o[c][qt][dt] = (f32x4){0.f, 0.f, 0.f, 0.f};
    }
  float gkv[8];
#pragma unroll
  for (int i = 0; i < 8; ++i) gkv[i] = a.gk[((NC == 1) ? lch : (lch & 3)) * 8 + i];

  const int rw = a.r0 + ((w * 16 * NQ) >> 6);
  int rsw = rw - 4; rsw = rsw < 0 ? 0 : (rsw > 24 ? 24 : rsw);
  auto stage_write = [&](const u32x4& kr, const u32x4& vr, bf16_t* Ksb, bf16_t* Vtb) __attribute__((always_inline)) {
    float f[8];
#pragma unroll
    for (int i = 0; i < 4; ++i) { f[2 * i] = bf_lo(kr[i]); f[2 * i + 1] = bf_hi(kr[i]); }
    float s = 0.f;
#pragma unroll
    for (int i = 0; i < 8; ++i) s += f[i] * f[i];
    s += __shfl_xor(s, 1); s += __shfl_xor(s, 2);
    float rs;
    if (NC == 1) { s += __shfl_xor(s, 4); rs = rsqrtf(s * (1.f / 64.f) + 1e-6f); }
    else rs = rsqrtf(s * (1.f / 32.f) + 1e-6f);
    u32x4 kq;
#pragma unroll
    for (int i = 0; i < 4; ++i) kq[i] = pk_bf16(f[2 * i] * rs * gkv[2 * i], f[2 * i + 1] * rs * gkv[2 * i + 1]);
    *(u32x4*)(Ksb + kkey * LDSROW + lch * 8) = kq;
#pragma unroll
    for (int i = 0; i < 4; ++i) {
      Vtb[(vch * 8 + 2 * i) * LDSROW + vkey] = (bf16_t)(vr[i] & 0xffffu);
      Vtb[(vch * 8 + 2 * i + 1) * LDSROW + vkey] = (bf16_t)(vr[i] >> 16);
    }
  };
  auto tile_math = [&](int t, const bf16_t* Ksb, const bf16_t* Vtb) __attribute__((always_inline)) {
    if (MODE == 0) { const int kr_ = a.rs0 + t; if (kr_ < rsw || kr_ >= rsw + 8) return; }
    const int kp0 = a.kposbase + t * a.kposstep;
    const int taboff = (a.rs0 + t - rw + 7) * 31;
    bf16x8 pf[NC][NQ][2];
    bf16x8 kf[4][2];
#pragma unroll
    for (int kt = 0; kt < 4; ++kt) {
      kf[kt][0] = *(const bf16x8*)(Ksb + (kt * 16 + fr) * LDSROW + fq * 8);
      kf[kt][1] = *(const bf16x8*)(Ksb + (kt * 16 + fr) * LDSROW + 32 + fq * 8);
    }
    bf16x8 vfr[4][2];
#pragma unroll
    for (int ks = 0; ks < 2; ++ks)
#pragma unroll
      for (int dt = 0; dt < 4; ++dt) {
        const u32x2 lo = *(const u32x2*)(Vtb + (dt * 16 + fr) * LDSROW + ks * 32 + 4 * fq);
        const u32x2 hi = *(const u32x2*)(Vtb + (dt * 16 + fr) * LDSROW + ks * 32 + 16 + 4 * fq);
        u32x4 vv; vv[0] = lo[0]; vv[1] = lo[1]; vv[2] = hi[0]; vv[3] = hi[1];
        vfr[dt][ks] = __builtin_bit_cast(bf16x8, vv);
      }
#pragma unroll
    for (int qt = 0; qt < NQ; ++qt) {
      const int qp = (MODE == 0) ? (qpos[qt] & 63) : qpos[qt];
      int cs = qp - 8; cs = cs < 0 ? 0 : (cs > 48 ? 48 : cs);
      f32x4 bv[4];
      const bool far_hi = (MODE == 3) && (kp0 - (wq0 + 16 * NQ - 1) >= 128), far_lo = (MODE == 3) && (wq0 - (kp0 + 63) >= 128);
      if (far_hi || far_lo) {
        const float bu = tab[far_hi ? (DT_OFF + 256) : (DT_OFF - 256)];
#pragma unroll
        for (int kt = 0; kt < 4; ++kt) bv[kt] = (f32x4){bu, bu, bu, bu};
      } else if (MODE != 0) {
        const float* tb = tab + (kp0 - qp + 4 * fq + DT_OFF);
#pragma unroll
        for (int kt = 0; kt < 4; ++kt)
#pragma unroll
          for (int j = 0; j < 4; ++j) bv[kt][j] = tb[kt * 16 + j];
      } else
#pragma unroll
      for (int kt = 0; kt < 4; ++kt)
#pragma unroll
        for (int j = 0; j < 4; ++j) {
          const int kpos = kp0 + kt * 16 + 4 * fq + j;
          const int d = kpos - qp;
          const bool valid = kpos >= cs && kpos < cs + 16;
          int dd = d + 15; dd = dd < 0 ? 0 : (dd > 30 ? 30 : dd);
          const float bias = tab[taboff + dd];
          bv[kt][j] = valid ? bias : -INFINITY;
        }
#pragma unroll
      for (int c = 0; c < NC; ++c) {
        f32x4 s[4];
#pragma unroll
        for (int kt = 0; kt < 4; ++kt) {
          if (NC == 1) {
            const f32x4 r = __builtin_amdgcn_mfma_f32_16x16x32_bf16(kf[kt][0], qf[qt][0], bv[kt], 0, 0, 0);
            s[kt] = __builtin_amdgcn_mfma_f32_16x16x32_bf16(kf[kt][1], qf[qt][1], r, 0, 0, 0);
          } else {
            s[kt] = __builtin_amdgcn_mfma_f32_16x16x32_bf16(kf[kt][c], qf[qt][c], bv[kt], 0, 0, 0);
          }
        }
#pragma unroll
        for (int kt = 0; kt < 4; ++kt)
#pragma unroll
          for (int j = 0; j < 4; ++j) s[kt][j] = fexp2(s[kt][j]);
#pragma unroll
        for (int ks = 0; ks < 2; ++ks) {
          u32x4 pk;
          pk[0] = pk_bf16(s[2 * ks][0], s[2 * ks][1]); pk[1] = pk_bf16(s[2 * ks][2], s[2 * ks][3]);
          pk[2] = pk_bf16(s[2 * ks + 1][0], s[2 * ks + 1][1]); pk[3] = pk_bf16(s[2 * ks + 1][2], s[2 * ks + 1][3]);
          pf[c][qt][ks] = __builtin_bit_cast(bf16x8, pk);
        }
      }
    }
#pragma unroll
    for (int ks = 0; ks < 2; ++ks) {
#pragma unroll
      for (int dt = 0; dt < 4; ++dt) {
        const bf16x8 vf = vfr[dt][ks];
#pragma unroll
        for (int c = 0; c < NC; ++c)
#pragma unroll
          for (int qt = 0; qt < NQ; ++qt) o[c][qt][dt] = __builtin_amdgcn_mfma_f32_16x16x32_bf16(vf, pf[c][qt][ks], o[c][qt][dt], 0, 0, 0);
      }
#pragma unroll
      for (int c = 0; c < NC; ++c)
#pragma unroll
        for (int qt = 0; qt < NQ; ++qt) lsum[c][qt] = __builtin_amdgcn_mfma_f32_16x16x32_bf16(ones, pf[c][qt][ks], lsum[c][qt], 0, 0, 0);
    }
    };
  bf16_t* const Ks1 = Ks + 2 * 64 * LDSROW;
  bf16_t* const Vts1 = Vts + 2 * 64 * LDSROW;
  stage_write(kA, vA, Ks, Vts);
  if (ntl > 2) ATTN_PREFETCH(2, kA, vA)
  for (int t = 0; t < ntl; t += 2) {
    __syncthreads();
    if (t + 1 < ntl) { stage_write(kB, vB, Ks1, Vts1); if (t + 3 < ntl) ATTN_PREFETCH(t + 3, kB, vB) }
    tile_math(t, Ks, Vts);
    if (t + 1 < ntl) {
      __syncthreads();
      if (t + 2 < ntl) { stage_write(kA, vA, Ks, Vts); if (t + 4 < ntl) ATTN_PREFETCH(t + 4, kA, vA) }
      tile_math(t + 1, Ks1, Vts1);
    }
  }
#undef ATTN_PREFETCH
#pragma unroll
  for (int qt = 0; qt < NQ; ++qt) {
    float inv[NC], ltot[NC];
#pragma unroll
    for (int c = 0; c < NC; ++c) {
      const float lt = lsum[c][qt][0];
      ltot[c] = lt; inv[c] = 1.f / lt;
    }
    const int tok = a.qbase + qpos[qt] * a.qstride;
    if (MODE == 3) {
      f32x4 v[4];
      float ss = 0.f;
#pragma unroll
      for (int dt = 0; dt < 4; ++dt)
#pragma unroll
        for (int j = 0; j < 4; ++j) {
          const float x = o[0][qt][dt][j] * inv[0] - a.lam * (o[NC - 1][qt][dt][j] * inv[NC - 1]);
          v[dt][j] = x; ss += x * x;
        }
      ss += __shfl_xor(ss, 16); ss += __shfl_xor(ss, 32);
      const float rstd = rsqrtf(ss * (1.f / 64.f) + 1e-6f) * a.outscale;
#pragma unroll
      for (int dt = 0; dt < 4; ++dt) {
        const f32x4 g = *(const f32x4*)(a.subg + dt * 16 + 4 * fq);
        u32x2 ov; ov[0] = pk_bf16(v[dt][0] * rstd * g[0], v[dt][1] * rstd * g[1]); ov[1] = pk_bf16(v[dt][2] * rstd * g[2], v[dt][3] * rstd * g[3]);
        *(u32x2*)(p.hbuf + blk_off(tok, a.ocol + dt * 16 + 4 * fq, NTOK)) = ov;
      }
    } else {
#pragma unroll
      for (int dt = 0; dt < 4; ++dt) {
        u32x2 ov;
        ov[0] = pk_bf16(o[0][qt][dt][0] * inv[0], o[0][qt][dt][1] * inv[0]);
        ov[1] = pk_bf16(o[0][qt][dt][2] * inv[0], o[0][qt][dt][3] * inv[0]);
        *(u32x2*)(p.hbuf + blk_off(tok, a.ocol + dt * 16 + 4 * fq, NTOK)) = ov;
      }
      if (MODE == 2 && fq == 0) p.lse[(size_t)tok * 6 + a.lsecol] = (mrun[0][qt] + __log2f(ltot[0])) * LN2;
    }
  }
}

__device__ __forceinline__ void attn_phase(const Params& p, int l, char* smem) {
  bf16_t* Ks = (bf16_t*)smem;
  bf16_t* Vts = Ks + 64 * LDSROW;
  float* tab = (float*)(Ks + 4 * 64 * LDSROW);
  const int tid = opaque_tid();
  const int nD = 3072, nA = 3072, nB = 3072, nC = 4608;
  for (int item = blockIdx.x; item < nD + nA + nB + nC; item += gridDim.x) {
    AttnArgs a;
    a.taboff0 = 0; a.r0 = 0; a.rs0 = 0; a.sinkv = 0.f; a.cshift = 0.f; a.lam = 0.f; a.outscale = 1.f; a.subg = nullptr; a.lsecol = 0; a.hw = 1 << 20; a.rmul = 1;
    __syncthreads();
    if (item < nD) {
      const int b = item >> 6, h = (item >> 4) & 3, qb = item & 15;
      a.cshift = p.lam[4 + l * 4 + 3];
      for (int i = tid; i < DT_N; i += NTHR) { int dd = i - DT_OFF; dd = dd < -128 ? -128 : (dd > 128 ? 128 : dd); tab[i] = p.lut[(10 + h) * 257 + dd + 128] - a.cshift; }
      a.qbase = b * SEQL; a.qstride = 1; a.qpos0 = qb * 128;
      a.ktokbase = b * SEQL; a.ktokstep = 64; a.kstride = 1; a.kposbase = 0; a.kposstep = 64; a.ntiles = 32;
      a.qcol = 2432 + h * 64; a.kcol = 2432 + 256 + h * 64; a.vcol = 2432 + 512 + h * 64; a.ocol = 896 + h * 64;
      a.gq = p.qkn_d + l * 64; a.gk = a.gq + 32;
      a.qscale = 0.17677669529663687f * LOG2E;
      a.lam = p.lam[l]; a.outscale = 1.f - (0.8f - 0.6f * expf(-0.3f * (float)l)); a.subg = p.subln_d + l * 64;
      attn_item<1, 2, 3>(p, a, Ks, Vts, tab);
    } else if (item < nD + nA) {
      const int id = item - nD;
      const int b = id >> 6, h = (id >> 4) & 3, r = (id & 15) * 2;
      const float* rp = p.rpb_a + ((size_t)l * 4 + h) * 465;
      a.cshift = p.lam[4 + l * 4 + 0];
      for (int i = tid; i < 465; i += NTHR) tab[i] = rp[i] * LOG2E - a.cshift;
      int rs = r - 4; rs = rs < 0 ? 0 : (rs > 24 ? 24 : rs);
      int rs1 = r - 3; rs1 = rs1 < 0 ? 0 : (rs1 > 24 ? 24 : rs1);
      a.qbase = b * SEQL + r * 64; a.qstride = 1; a.qpos0 = 0; a.r0 = r; a.rs0 = rs;
      a.ktokbase = b * SEQL + rs * 64; a.ktokstep = 64; a.kstride = 1; a.kposbase = 0; a.kposstep = 0; a.ntiles = rs1 - rs + 8;
      a.qcol = h * 64; a.kcol = 256 + h * 64; a.vcol = 512 + h * 64; a.ocol = h * 64;
      a.gq = p.qkn_a + l * 128; a.gk = a.gq + 64;
      a.qscale = 0.125f * LOG2E;
      attn_item<1, 1, 0>(p, a, Ks, Vts, tab);
    } else if (item < nD + nA + nB) {
      const int id = item - nD - nA;
      const int b = id >> 6, h = (id >> 4) & 3, qb = id & 15;
      a.cshift = p.lam[4 + l * 4 + 1];
      for (int i = tid; i < DT_N; i += NTHR) { const int d = i - DT_OFF; tab[i] = (d >= -128 && d <= 128) ? p.lut[h * 257 + d + 128] - a.cshift : -INFINITY; }
      const int q0 = qb * 128;
      const int kstart = q0 - 128 < 0 ? 0 : q0 - 128, kend = q0 + 256 > SEQL ? SEQL : q0 + 256;
      a.qbase = b * SEQL; a.qstride = 1; a.qpos0 = q0;
      a.ktokbase = b * SEQL + kstart; a.ktokstep = 64; a.kstride = 1; a.kposbase = kstart; a.kposstep = 64; a.ntiles = (kend - kstart) >> 6;
      a.qcol = 768 + h * 64; a.kcol = 768 + 256 + (h >> 1) * 64; a.vcol = 768 + 384 + (h >> 1) * 64; a.ocol = 256 + h * 64;
      a.gq = p.qkn_b + l * 128; a.gk = a.gq + 64;
      a.qscale = 0.125f * LOG2E;
      a.hw = 128; a.rmul = 1; a.sinkv = p.sink_b[l * 4 + h] * LOG2E;
      attn_item<1, 1, 1>(p, a, Ks, Vts, tab);
    } else {
      const int id = item - nD - nA - nB;
      const int b = id / 96, rem = id % 96, g = rem >> 5, i2 = (rem >> 4) & 1, blk = rem & 15;
      const int r = g == 0 ? 1 : (g == 1 ? 4 : 16);
      const int L = SEQL / r, bps = L >> 7;
      const int pp = blk / bps, m0 = (blk % bps) * 128;
      const int hh = g * 2 + i2;
      a.cshift = p.lam[4 + l * 4 + 2];
      for (int i = tid; i < DT_N; i += NTHR) { const int d = i - DT_OFF; int dd = d * r; dd = dd < -128 ? -128 : (dd > 128 ? 128 : dd);
        tab[i] = (d >= -64 && d <= 64) ? p.lut[(4 + hh) * 257 + dd + 128] - a.cshift : -INFINITY; }
      const int kstart = m0 - 64 < 0 ? 0 : m0 - 64, kend = m0 + 192 > L ? L : m0 + 192;
      a.qbase = b * SEQL + pp; a.qstride = r; a.qpos0 = m0;
      a.ktokbase = a.qbase + kstart * r; a.ktokstep = 64 * r; a.kstride = r; a.kposbase = kstart; a.kposstep = 64; a.ntiles = (kend - kstart) >> 6;
      a.qcol = 1280 + hh * 64; a.kcol = 1280 + 384 + hh * 64; a.vcol = 1280 + 768 + hh * 64; a.ocol = 512 + hh * 64;
      a.gq = p.qkn_c + l * 128; a.gk = a.gq + 64;
      a.qscale = 0.125f * LOG2E;
      a.hw = 64; a.rmul = r; a.lsecol = hh;
      attn_item<1, 1, 2>(p, a, Ks, Vts, tab);
    }
  }
}

__device__ __forceinline__ void combine_phase(const Params& p) {
  const int nthr = gridDim.x * NTHR;
  for (int i = blockIdx.x * NTHR + opaque_tid(); i < NTOK * 48; i += nthr) {
    const int tok = i / 48, rem = i % 48, hh = rem >> 3, ch = rem & 7, ii = hh & 1, g = hh >> 1;
    const float* ls = p.lse + (size_t)tok * 6;
    const float l0 = ls[ii], l1 = ls[2 + ii], l2 = ls[4 + ii];
    const float mx = fmaxf(l0, fmaxf(l1, l2));
    const float e0 = __expf(l0 - mx), e1 = __expf(l1 - mx), e2 = __expf(l2 - mx);
    const float al = (g == 0 ? e0 : (g == 1 ? e1 : e2)) / (e0 + e1 + e2);
    bf16_t* ptr = p.hbuf + blk_off(tok, 512 + hh * 64 + ch * 8, NTOK);
    u32x4 v = *(const u32x4*)ptr;
#pragma unroll
    for (int k = 0; k < 4; ++k) v[k] = pk_bf16(bf_lo(v[k]) * al, bf_hi(v[k]) * al);
    *(u32x4*)ptr = v;
  }
}


#ifndef REP_GEMM
#define REP_GEMM 1
#endif
#ifndef REP_ATTN
#define REP_ATTN 1
#endif
#ifndef DBG_STOP
#define DBG_STOP 0
#endif
__global__ void __launch_bounds__(NTHR, 2) fwd_megakernel(Params p) {
  extern __shared__ __attribute__((aligned(16))) char smem[];
  cg::grid_group grid = cg::this_grid();
  prologue_phase(p, smem);
  grid.sync();
#define LAYER(L)                                                                                                   \
  {                                                                                                                \
    constexpr int l = (L);                                                                                         \
    constexpr bool first = (l == 0);                                                                               \
    const bf16_t* wt = p.wt + (size_t)l * WT_LAYER;                                                                \
    norm_phase(p, l, first, p.norm_attn_g + l * DM, 0, 1024);                                                      \
    grid.sync();                                                                                                   \
    gemm_phase<0>(p, l, false, p.hbuf, 3200, wt + WT_IN, 1024, 384, 13, 13, p.proj, PW, 0, smem);                  \
    grid.sync();                                                                                                   \
    attn_phase(p, l, smem);                                                                                        \
    grid.sync();                                                                                                   \
    combine_phase(p);                                                                                              \
    grid.sync();                                                                                                   \
    gemm_phase<1>(p, l, first, p.hbuf, 1024, wt + WT_OUT, 1152, 384, 4, 4, nullptr, 0, 2048, smem);                \
    grid.sync();                                                                                                   \
    norm_phase(p, l, false, p.norm_ffn_g + l * DM, 3072, 4096);                                                    \
    grid.sync();                                                                                                   \
    gemm_phase<2>(p, l, false, p.hbuf, 5632, wt + WT_UP, 1024, 408, 22, 22, p.proj, DFF, 0, smem);                 \
    grid.sync();                                                                                                   \
    gemm_phase<1>(p, l, false, p.proj, 1024, wt + WT_DOWN, 2816, 384, 4, 4, nullptr, 0, 5120, smem);               \
    grid.sync();                                                                                                   \
  }
  LAYER(0)
  LAYER(1)
  LAYER(2)
  LAYER(3)
#undef LAYER
}

extern "C" void kernel_launch(void* const* d_in, const int* in_sizes, int n_in, void* d_out, int out_size, void* d_ws, size_t ws_size,
                              hipStream_t stream) {
  static int grid_blocks = 0;
  if (!grid_blocks) {
    int dev = 0, cus = 0, per_cu = 0;
    hipGetDevice(&dev);
    hipDeviceGetAttribute(&cus, hipDeviceAttributeMultiprocessorCount, dev);
    hipFuncSetAttribute((const void*)fwd_megakernel, hipFuncAttributeMaxDynamicSharedMemorySize, SMEM_BYTES);
    hipOccupancyMaxActiveBlocksPerMultiprocessor(&per_cu, fwd_megakernel, NTHR, SMEM_BYTES);
    if (per_cu > 1) per_cu = 1;
    if (per_cu < 1) per_cu = 1;
    grid_blocks = cus * per_cu;
  }
  Params p{};
  const float* const* in = (const float* const*)d_in;
  p.x_prompt = in[0]; p.x_sample = in[1]; p.c_prompt = in[2]; p.c_sample = in[3]; p.norm_attn_g = in[4]; p.norm_ffn_g = in[5];
  p.w_ada = in[6]; p.b_ada = in[7]; p.w_in = in[8]; p.qkn_a = in[9]; p.qkn_b = in[10]; p.qkn_c = in[11]; p.qkn_d = in[12];
  p.rpb_a = in[13]; p.sink_b = in[14]; p.t5_table = in[15]; p.lam_d = in[16]; p.subln_d = in[17]; p.w_out = in[18]; p.w_up = in[19];
  p.conv_w = in[20]; p.conv_b = in[21]; p.w_down = in[22];
  p.out = (float*)d_out;
  char* ws = (char*)d_ws;
  size_t off = 0;
  p.wt = (bf16_t*)(ws + off); off += (size_t)4 * WT_LAYER * 2;
  p.mod = (float*)(ws + off); off += (size_t)4 * 48 * 6144 * 4;
  p.lut = (float*)(ws + off); off += 16384;
  p.lam = (float*)(ws + off); off += 256;
  p.zeros = (float*)(ws + off); off += 256;
  p.lse = (float*)(ws + off); off += (size_t)NTOK * 6 * 4;
  p.proj = (bf16_t*)(ws + off); off += (size_t)NTOK * PW * 2;
  p.hbuf = (bf16_t*)(ws + off); off += (size_t)NTOK * MW * 2;
  if (off > ws_size) { fprintf(stderr, "workspace too small: need %zu have %zu\n", off, ws_size); return; }
  void* args[] = {&p};
  hipError_t e = hipLaunchCooperativeKernel((void*)fwd_megakernel, dim3(grid_blocks), dim3(NTHR), args, SMEM_BYTES, stream);
  if (e != hipSuccess) fprintf(stderr, "cooperative launch failed: %s (grid %d)\n", hipGetErrorString(e), grid_blocks);
}
```

```cpp
#include <hip/hip_runtime.h>
#include <hip/hip_cooperative_groups.h>
#include <cstdint>
#include <cstdio>
namespace cg = cooperative_groups;

typedef unsigned short bf16_t;
typedef short bf16x8 __attribute__((ext_vector_type(8)));
typedef float f32x4 __attribute__((ext_vector_type(4)));
typedef unsigned u32x4 __attribute__((ext_vector_type(4)));
typedef unsigned u32x2 __attribute__((ext_vector_type(2)));

#define NTOK 98304
#define DM 1024
#define PW 3200
#define MW 1152
#define DFF 2816
#define NSEQ 48
#define SEQL 2048
#define LOG2E 1.4426950408889634f
#define LN2 0.6931471805599453f
#define LDSROW 72
#define DT_OFF 320
#define DT_N 641
#define NTHR 512
#define NWAVE 8

struct Params {
  const float *x_prompt, *x_sample, *c_prompt, *c_sample, *norm_attn_g, *norm_ffn_g, *w_ada, *b_ada, *w_in;
  const float *qkn_a, *qkn_b, *qkn_c, *qkn_d, *rpb_a, *sink_b, *t5_table, *lam_d, *subln_d, *w_out, *w_up, *conv_w, *conv_b, *w_down;
  float* out;
  bf16_t* wt; float* mod; float* lut; float* lam; float* lse; bf16_t* proj; bf16_t* hbuf; float* zeros;
};

#define WT_IN 0
#define WT_OUT (3200 * 1024)
#define WT_UP (WT_OUT + 1024 * 1152)
#define WT_DOWN (WT_UP + 5632 * 1024)
#define WT_LAYER (WT_DOWN + 1024 * 2816)

typedef __bf16 bf16x2_t __attribute__((ext_vector_type(2)));
typedef float f32x2_t __attribute__((ext_vector_type(2)));
__device__ __forceinline__ unsigned pk_bf16(float lo, float hi) {
  const f32x2_t v = {lo, hi};
  const bf16x2_t r = __builtin_convertvector(v, bf16x2_t);
  return __builtin_bit_cast(unsigned, r);
}
__device__ __forceinline__ float bf_lo(unsigned u) { return __uint_as_float(u << 16); }
__device__ __forceinline__ float bf_hi(unsigned u) { return __uint_as_float(u & 0xffff0000u); }
__device__ __forceinline__ float fexp2(float x) { return __builtin_amdgcn_exp2f(x); }

__device__ __forceinline__ const float* xin_row(const Params& p, bool first, int tok) {
  if (first) return tok < 65536 ? p.x_prompt + (size_t)tok * DM : p.x_sample + (size_t)(tok - 65536) * DM;
  return p.out + (size_t)tok * DM;
}

__device__ __forceinline__ int opaque_tid() { int t = threadIdx.x; asm volatile("" : "+v"(t)); return t; }

__device__ __forceinline__ size_t blk_off(int r, int k, int R) { return ((size_t)(k >> 5) * R + r) * 32 + (k & 31); }

__device__ __forceinline__ int t5_bucket(int rel) {
  const int n = rel < 0 ? -rel : rel;
  int v;
  if (n < 8) v = n;
  else v = 8 + (n >= 12) + (n >= 16) + (n >= 23) + (n >= 32) + (n >= 46) + (n >= 64) + (n >= 91);
  return (rel > 0 ? 16 : 0) + v;
}

__device__ __forceinline__ void prologue_phase(const Params& p, char* smem) {
  const int tid = opaque_tid(), nb = gridDim.x;
  const int N_TR = 4 * 3200, N_MOD = 192;
  for (int item = blockIdx.x; item < N_TR + N_MOD + 1; item += nb) {
    if (item < N_TR) {
      const int l = item / 3200; int r = item % 3200;
      const float* src; bf16_t* dst; int K, N, kt, nt;
      if (r < 800) { K = 1024; N = 3200; src = p.w_in + (size_t)l * K * N; dst = p.wt + (size_t)l * WT_LAYER + WT_IN; kt = r / 50; nt = r % 50; }
      else if (r < 1088) { r -= 800; K = 1152; N = 1024; src = p.w_out + (size_t)l * K * N; dst = p.wt + (size_t)l * WT_LAYER + WT_OUT; kt = r / 16; nt = r % 16; }
      else if (r < 2496) { r -= 1088; K = 1024; N = 5632; src = p.w_up + (size_t)l * K * N; dst = p.wt + (size_t)l * WT_LAYER + WT_UP; kt = r / 88; nt = r % 88; }
      else { r -= 2496; K = 2816; N = 1024; src = p.w_down + (size_t)l * K * N; dst = p.wt + (size_t)l * WT_LAYER + WT_DOWN; kt = r / 16; nt = r % 16; }
      float* tile = (float*)smem;
      const int k0 = kt * 64, n0 = nt * 64;
      __syncthreads();
#pragma unroll
      for (int i = 0; i < 8; ++i) {
        const int rr = (tid >> 6) + 8 * i, cc = tid & 63;
        tile[rr * 65 + cc] = src[(size_t)(k0 + rr) * N + n0 + cc];
      }
      __syncthreads();
#pragma unroll
      for (int i = 0; i < 4; ++i) {
        const int idx = tid + NTHR * i, n = idx >> 5, k2 = (idx & 31) * 2;
        *(unsigned*)(dst + blk_off(n0 + n, k0 + k2, N)) = pk_bf16(tile[k2 * 65 + n], tile[(k2 + 1) * 65 + n]);
      }
    } else if (item < N_TR + N_MOD) {
      int r = item - N_TR;
      const int l = r / 48; r %= 48;
      const int nc = r / 4, bg = r % 4;
      const int n = nc * NTHR + tid;
      float* sc = (float*)smem;
      float acc[12];
#pragma unroll
      for (int j = 0; j < 12; ++j) acc[j] = 0.f;
      const float* W = p.w_ada + (size_t)l * 1024 * 6144 + n;
      for (int kc = 0; kc < 2; ++kc) {
        __syncthreads();
        for (int i = tid; i < 12 * 512; i += NTHR) {
          const int j = i >> 9, k = i & 511, b = bg * 12 + j;
          const float c = b < 32 ? p.c_prompt[b * 1024 + kc * 512 + k] : p.c_sample[(b - 32) * 1024 + kc * 512 + k];
          sc[i] = c / (1.f + __expf(-c));
        }
        __syncthreads();
#pragma unroll 2
        for (int k = 0; k < 512; k += 4) {
          const float w0 = W[(size_t)(kc * 512 + k) * 6144], w1 = W[(size_t)(kc * 512 + k + 1) * 6144];
          const float w2 = W[(size_t)(kc * 512 + k + 2) * 6144], w3 = W[(size_t)(kc * 512 + k + 3) * 6144];
#pragma unroll
          for (int j = 0; j < 12; ++j) {
            const f32x4 s = *(const f32x4*)(sc + j * 512 + k);
            acc[j] += s[0] * w0 + s[1] * w1 + s[2] * w2 + s[3] * w3;
          }
        }
      }
      const float bias = p.b_ada[l * 6144 + n];
#pragma unroll
      for (int j = 0; j < 12; ++j) p.mod[((size_t)l * 48 + bg * 12 + j) * 6144 + n] = acc[j] + bias;
    } else {
      for (int i = tid; i < 14 * 257; i += NTHR) {
        const int hd = i / 257, idx = i % 257;
        p.lut[i] = p.t5_table[t5_bucket(idx - 128) * 14 + hd] * LOG2E;
      }
      if (tid < 64) p.zeros[tid] = 0.f;
      if (tid < 4) {
        const float* lp = p.lam_d + tid * 128;
        float s1 = 0.f, s2 = 0.f;
        for (int e = 0; e < 32; ++e) { s1 += lp[e] * lp[32 + e]; s2 += lp[64 + e] * lp[96 + e]; }
        const float li = 0.8f - 0.6f * expf(-0.3f * (float)tid);
        p.lam[tid] = expf(s1) - expf(s2) + li;
      }
      {
        const int pr = tid >> 5, ln = tid & 31, l = pr >> 2, m = pr & 3;
        const float* g = m == 0 ? p.qkn_a + l * 128 : (m == 1 ? p.qkn_b + l * 128 : (m == 2 ? p.qkn_c + l * 128 : p.qkn_d + l * 64));
        const int dd = m == 3 ? 32 : 64;
        float gq = 0.f, gk = 0.f, bmax = 0.f;
        for (int i = ln; i < dd; i += 32) { gq = fmaxf(gq, fabsf(g[i])); gk = fmaxf(gk, fabsf(g[dd + i])); }
        if (m == 0) { const float* rp = p.rpb_a + (size_t)l * 4 * 465; for (int i = ln; i < 4 * 465; i += 32) bmax = fmaxf(bmax, rp[i]); }
        else { for (int i = ln; i < 32 * 14; i += 32) bmax = fmaxf(bmax, p.t5_table[i]); }
#pragma unroll
        for (int o = 16; o >= 1; o >>= 1) { gq = fmaxf(gq, __shfl_xor(gq, o)); gk = fmaxf(gk, __shfl_xor(gk, o)); bmax = fmaxf(bmax, __shfl_xor(bmax, o)); }
        const float scale = m == 3 ? 0.17677669529663687f : 0.125f;
        if (ln == 0) p.lam[4 + pr] = ((float)dd * gq * gk * scale + bmax) * LOG2E;
      }
    }
  }
}

__device__ __forceinline__ void norm_phase(const Params& p, int l, bool first, const float* g, int shift_off, int scale_off) {
  const int tid0 = opaque_tid();
  const int lane = tid0 & 63, w = tid0 >> 6;
  const int stride = gridDim.x * NWAVE;
  for (int row0 = blockIdx.x * NWAVE + w; row0 < NTOK; row0 += 2 * stride) {
    const int row1 = row0 + stride;
    const bool has1 = row1 < NTOK;
    const int rows[2] = {row0, has1 ? row1 : row0};
    f32x4 v[2][4];
    float ss[2] = {0.f, 0.f};
#pragma unroll
    for (int r = 0; r < 2; ++r) {
      const float* xr = xin_row(p, first, rows[r]);
#pragma unroll
      for (int i = 0; i < 4; ++i) v[r][i] = *(const f32x4*)(xr + i * 256 + lane * 4);
    }
#pragma unroll
    for (int r = 0; r < 2; ++r) {
#pragma unroll
      for (int i = 0; i < 4; ++i) ss[r] += v[r][i][0] * v[r][i][0] + v[r][i][1] * v[r][i][1] + v[r][i][2] * v[r][i][2] + v[r][i][3] * v[r][i][3];
#pragma unroll
      for (int o = 32; o >= 1; o >>= 1) ss[r] += __shfl_xor(ss[r], o);
    }
#pragma unroll
    for (int r = 0; r < 2; ++r) {
      if (r == 1 && !has1) break;
      const int row = rows[r];
      const float* md = p.mod + ((size_t)l * 48 + (row >> 11)) * 6144;
      const float rstd = rsqrtf(ss[r] * (1.f / 1024.f) + 1e-6f);
#pragma unroll
      for (int i = 0; i < 4; ++i) {
        const int k = i * 256 + lane * 4;
        const f32x4 gg = *(const f32x4*)(g + k), sc = *(const f32x4*)(md + scale_off + k), sh = *(const f32x4*)(md + shift_off + k);
        f32x4 y;
#pragma unroll
        for (int j = 0; j < 4; ++j) y[j] = (v[r][i][j] * rstd) * gg[j] * (1.f + sc[j]) + sh[j];
        u32x2 o; o[0] = pk_bf16(y[0], y[1]); o[1] = pk_bf16(y[2], y[3]);
        *(u32x2*)(p.hbuf + blk_off(row, k, NTOK)) = o;
      }
    }
  }
}

__device__ __forceinline__ bool gemm_tile_id(int it, int MT, int NT, int NB, int& mt, int& nt) {
  const int nb = gridDim.x, bid = blockIdx.x;
  if ((nb & 7) == 0) {
    const int x = bid & 7, slot = bid >> 3, S = nb >> 3;
    const int TPS = 8 * NB, NSN = NT / NB, NS = (MT / 8) * NSN;
    const int pidx = slot + S * it, sidx = pidx / TPS, w = pidx % TPS, s = x + 8 * sidx;
    if (s >= NS) return false;
    mt = (s / NSN) * 8 + (w & 7); nt = (s % NSN) * NB + (w >> 3);
    return true;
  }
  const int t = bid + nb * it;
  if (t >= MT * NT) return false;
  mt = t / NT; nt = t % NT;
  return true;
}

template <int M, int NN>
__device__ __forceinline__ void up_epi_row(const f32x4 (&acc)[8][4], const f32x4 (&cwv)[2][4], int lane, int fr, int s0, bf16_t* obase) {
  constexpr int MP = M > 0 ? M - 1 : 0, MN = M < 7 ? M + 1 : 7;
  float y[2][4];
#pragma unroll
  for (int n = 0; n < 2; ++n) {
    const f32x4 w0 = cwv[n][0], w1 = cwv[n][1], w2 = cwv[n][2], bb = cwv[n][3];
#pragma unroll
    for (int j = 0; j < 4; ++j) {
      const float cur = acc[M][NN + 2 * n][j];
      const float zp = (fr == 15) ? acc[MP][NN + 2 * n][j] : cur, zn = (fr == 0) ? acc[MN][NN + 2 * n][j] : cur;
      const float pv = __builtin_bit_cast(float, __builtin_amdgcn_update_dpp(0, __builtin_bit_cast(int, zp), 0x121, 0xf, 0xf, false));
      const float nv = __builtin_bit_cast(float, __builtin_amdgcn_update_dpp(0, __builtin_bit_cast(int, zn), 0x12F, 0xf, 0xf, false));
      y[n][j] = w0[j] * pv + w1[j] * cur + w2[j] * nv + bb[j];
    }
  }
  const int row = 16 * M + fr, tpos = s0 + row;
  if (row >= 1 && row <= 126 && tpos >= 0 && tpos < SEQL) {
    float a[4];
#pragma unroll
    for (int j = 0; j < 4; ++j) { const float gte = y[1][j]; a[j] = y[0][j] * gte / (1.f + __expf(-gte)); }
    u32x2 o; o[0] = pk_bf16(a[0], a[1]); o[1] = pk_bf16(a[2], a[3]);
    *(u32x2*)(obase + (size_t)tpos * 32) = o;
  }
  __builtin_amdgcn_sched_barrier(0);
}

#define GB_A 16384
#define GB_BUF 32768
#define NSTAGE 2
#define SMEM_BYTES (NSTAGE * GB_BUF)
template <int EPI>
__device__ __forceinline__ void gemm_phase(const Params& p, int l, bool first, const bf16_t* A, int NBROWS, const bf16_t* Bt, int K, int MT, int NT, int NB,
                           bf16_t* outb, int ldc, int gate_off, char* smem) {
  const int tid = opaque_tid(), lane = tid & 63, w = tid >> 6, wr = w >> 2, wcn = w & 3, fr = lane & 15, fq = lane >> 4;
  const int nk = K / 32;
  const int lrow = tid >> 2, lch = (tid & 3) ^ ((tid >> 4) & 3);
  const int fsw = (fq ^ ((fr >> 2) & 3)) * 16;
  const size_t apan = (size_t)NTOK * 32, bpan = (size_t)NBROWS * 32;
  const bf16_t* ga0; const bf16_t* ga1; const bf16_t* gb0;
  size_t bstr;
#define GEMM_PTRS(MT_, NT_)                                                                                                          \
  {                                                                                                                                  \
    int t_ = tid; asm volatile("" : "+v"(t_));                                                                                       \
    const int lrow_ = t_ >> 2, lch_ = (t_ & 3) ^ ((t_ >> 4) & 3);                                                                    \
    if (EPI == 2) {                                                                                                                  \
      const int wi0 = 2 * (MT_), wi1 = wi0 + 1;                                                                                      \
      const int t0 = 126 * (wi0 % 17) - 1 + lrow_, t1 = 126 * (wi1 % 17) - 1 + lrow_;                                                \
      ga0 = A + ((size_t)(wi0 / 17) * SEQL + t0) * 32 + lch_ * 8;                                                                    \
      ga1 = A + ((size_t)(wi1 / 17) * SEQL + t1) * 32 + lch_ * 8;                                                                    \
      const int rho2_ = lrow_ & 31, prow2_ = (lrow_ & ~31) | (8 * ((rho2_ & 15) >> 2) + 4 * (rho2_ >> 4) + (rho2_ & 3));              \
      gb0 = Bt + (size_t)((NT_) * 128 + prow2_) * 32 + lch_ * 8; bstr = (size_t)DFF * 32;                                            \
    } else {                                                                                                                         \
      ga0 = A + (size_t)((MT_) * 256 + lrow_) * 32 + lch_ * 8; ga1 = ga0 + (size_t)128 * 32;                                         \
      const int rho_ = lrow_ & 31, prow_ = (lrow_ & ~31) | (8 * ((rho_ & 15) >> 2) + 4 * (rho_ >> 4) + (rho_ & 3));                  \
      gb0 = Bt + (size_t)((NT_) * 256 + prow_) * 32 + lch_ * 8; bstr = (size_t)128 * 32;                                             \
    }                                                                                                                                \
  }
#define GEMM_LOAD(KT, SET)                                                                                                           \
    {                                                                                                                                \
      const size_t ko_ = (size_t)(KT) * apan, kb_ = (size_t)(KT) * bpan;                                                             \
      asm volatile("global_load_dwordx4 %0, %1, off" : "=v"(SET[0]) : "v"(ga0 + ko_) : "memory");                                     \
      asm volatile("global_load_dwordx4 %0, %1, off" : "=v"(SET[1]) : "v"(ga1 + ko_) : "memory");                                     \
      asm volatile("global_load_dwordx4 %0, %1, off" : "=v"(SET[2]) : "v"(gb0 + kb_) : "memory");                                     \
      asm volatile("global_load_dwordx4 %0, %1, off" : "=v"(SET[3]) : "v"(gb0 + bstr + kb_) : "memory");                              \
    }
#define GEMM_WRITE(SET, STAGE)                                                                                                       \
    {                                                                                                                                \
      asm volatile("" : "+v"(SET[0]), "+v"(SET[1]), "+v"(SET[2]), "+v"(SET[3]));      \
      char* dst_ = smem + (STAGE) * GB_BUF + tid * 16;                                                                               \
      *(u32x4*)(dst_) = SET[0]; *(u32x4*)(dst_ + 8192) = SET[1]; *(u32x4*)(dst_ + GB_A) = SET[2]; *(u32x4*)(dst_ + GB_A + 8192) = SET[3]; \
    }
#define GEMM_KSTEP(KT, WSET)                                                                                                         \
    {                                                                                                                                \
      asm volatile("s_waitcnt lgkmcnt(0)" ::: "memory");                                                                             \
      __builtin_amdgcn_s_barrier();                   \
      if ((KT) + 1 < nk) {                                                                                                           \
        if ((KT) + 2 < nk) asm volatile("s_waitcnt vmcnt(4)" ::: "memory"); else asm volatile("s_waitcnt vmcnt(0)" ::: "memory");     \
        GEMM_WRITE(WSET, ((KT) + 1) & 1)                                                                                             \
        if ((KT) + 3 < nk) GEMM_LOAD((KT) + 3, WSET)                                                                                 \
      }                                                                                                                              \
      const char* Ab = smem + ((KT) & 1) * GB_BUF;                                                                                   \
      const char* Bb = Ab + GB_A;                                                                                                    \
      bf16x8 bfr[4];                                                                                                                 \
      _Pragma("unroll") for (int n = 0; n < 4; ++n) {                                                                                \
        const int br = (EPI == 2) ? ((n >> 1) * 128 + 32 * wcn + 16 * (n & 1) + fr) : (64 * wcn + 16 * n + fr);                      \
        bfr[n] = *(const bf16x8*)(Bb + br * 64 + fsw);                                                                               \
      }                                                                                                                              \
      const char* Ap = Ab + (wr * 128 + fr) * 64 + fsw;                                                                              \
      bf16x8 af0 = *(const bf16x8*)(Ap), af1 = *(const bf16x8*)(Ap + 16 * 64);                                                       \
      _Pragma("unroll") for (int pr = 0; pr < 4; ++pr) {                                                                             \
        bf16x8 an0 = af0, an1 = af1;                                                                                                 \
        if (pr < 3) { an0 = *(const bf16x8*)(Ap + (2 * pr + 2) * 16 * 64); an1 = *(const bf16x8*)(Ap + (2 * pr + 3) * 16 * 64); }    \
        __builtin_amdgcn_sched_barrier(0);                                                                                           \
        _Pragma("unroll") for (int n = 0; n < 4; ++n) acc[2 * pr][n] = __builtin_amdgcn_mfma_f32_16x16x32_bf16(bfr[n], af0, acc[2 * pr][n], 0, 0, 0); \
        _Pragma("unroll") for (int n = 0; n < 4; ++n) acc[2 * pr + 1][n] = __builtin_amdgcn_mfma_f32_16x16x32_bf16(bfr[n], af1, acc[2 * pr + 1][n], 0, 0, 0); \
        __builtin_amdgcn_sched_barrier(0);                                                                                           \
        af0 = an0; af1 = an1;                                                                                                        \
      }                                                                                                                              \
    }
  int mt, nt;
  bool have = gemm_tile_id(0, MT, NT, NB, mt, nt);
  u32x4 rsA[4], rsB[4];
  if (have) {
    GEMM_PTRS(mt, nt)
    GEMM_LOAD(0, rsA)
  }
  for (int it = 0; have; ++it) {
    GEMM_PTRS(mt, nt)
    f32x4 acc[8][4];
#pragma unroll
    for (int m = 0; m < 8; ++m)
#pragma unroll
      for (int n = 0; n < 4; ++n) acc[m][n] = (f32x4){0.f, 0.f, 0.f, 0.f};
    asm volatile("s_waitcnt lgkmcnt(0)" ::: "memory");
    __builtin_amdgcn_s_barrier();
    GEMM_LOAD(1, rsB)
    asm volatile("s_waitcnt vmcnt(4)" ::: "memory");
    GEMM_WRITE(rsA, 0)
    GEMM_LOAD(2, rsA)
    for (int kt = 0; kt < nk; kt += 2) {
      GEMM_KSTEP(kt, rsB)
      GEMM_KSTEP(kt + 1, rsA)
    }
    const int mt_e = mt, nt_e = nt;
    have = gemm_tile_id(it + 1, MT, NT, NB, mt, nt);
    if (have) {
      GEMM_PTRS(mt, nt)
      GEMM_LOAD(0, rsA)
    }
    int lane_e = lane; asm volatile("" : "+v"(lane_e));
    const int fr_e = lane_e & 15, fq_e = lane_e >> 4;
    if (EPI == 0) {
      if (nt_e * 256 + 64 * wcn < NBROWS) {
#pragma unroll
        for (int m = 0; m < 8; ++m) {
          const int tok = mt_e * 256 + wr * 128 + 16 * m + fr_e;
#pragma unroll
          for (int q = 0; q < 2; ++q) {
            const int col = nt_e * 256 + 64 * wcn + 32 * q + 8 * fq_e;
            u32x4 o;
            o[0] = pk_bf16(acc[m][2 * q][0], acc[m][2 * q][1]); o[1] = pk_bf16(acc[m][2 * q][2], acc[m][2 * q][3]);
            o[2] = pk_bf16(acc[m][2 * q + 1][0], acc[m][2 * q + 1][1]); o[3] = pk_bf16(acc[m][2 * q + 1][2], acc[m][2 * q + 1][3]);
            *(u32x4*)(outb + (size_t)tok * ldc + col) = o;
          }
        }
      }
    } else if (EPI == 1) {
      const int b = (mt_e * 256) >> 11;
      const float* gate = p.mod + ((size_t)l * 48 + b) * 6144 + gate_off;
#pragma unroll
      for (int q = 0; q < 2; ++q) {
        const int col = nt_e * 256 + 64 * wcn + 32 * q + 8 * fq_e;
        const f32x4 gv0 = *(const f32x4*)(gate + col), gv1 = *(const f32x4*)(gate + col + 4);
#pragma unroll
        for (int mh = 0; mh < 2; ++mh) {
          f32x4 xv[4][2];
#pragma unroll
          for (int mm = 0; mm < 4; ++mm) {
            const float* xr = xin_row(p, first, mt_e * 256 + wr * 128 + 16 * (4 * mh + mm) + fr_e) + col;
            xv[mm][0] = *(const f32x4*)xr; xv[mm][1] = *(const f32x4*)(xr + 4);
          }
#pragma unroll
          for (int mm = 0; mm < 4; ++mm) {
            const int m = 4 * mh + mm, tok = mt_e * 256 + wr * 128 + 16 * m + fr_e;
            f32x4 o0, o1;
#pragma unroll
            for (int j = 0; j < 4; ++j) { o0[j] = xv[mm][0][j] + gv0[j] * acc[m][2 * q][j]; o1[j] = xv[mm][1][j] + gv1[j] * acc[m][2 * q + 1][j]; }
            float* orow = p.out + (size_t)tok * DM + col;
            *(f32x4*)orow = o0; *(f32x4*)(orow + 4) = o1;
          }
        }
      }
    } else {
      const float* cw = p.conv_w + (size_t)l * 3 * 5632;
      const float* cb = p.conv_b + (size_t)l * 5632;
      const int wi = 2 * mt_e + wr, seq = wi / 17, s0 = 126 * (wi % 17) - 1;
      if (s0 < 0 || s0 + 127 >= SEQL) {
#pragma unroll
        for (int m = 0; m < 8; ++m) {
          const int tp = s0 + 16 * m + fr_e;
          if (tp < 0 || tp >= SEQL) {
#pragma unroll
            for (int n = 0; n < 4; ++n) acc[m][n] = (f32x4){0.f, 0.f, 0.f, 0.f};
          }
        }
      }
#define UP_EPI_NN(NN)                                                                                                      \
      {                                                                                                                    \
        const int cbase = nt_e * 128 + 32 * wcn + 8 * fq_e + 4 * NN;     \
        bf16_t* obase = outb + blk_off(seq * SEQL, cbase, NTOK);                                                           \
                   \
        f32x4 cwv[2][4];                                                                                                   \
        _Pragma("unroll") for (int n = 0; n < 2; ++n) {                                                                    \
          const int c = n * DFF + cbase;                                                                                   \
          cwv[n][0] = *(const f32x4*)(cw + c); cwv[n][1] = *(const f32x4*)(cw + 5632 + c);                                 \
          cwv[n][2] = *(const f32x4*)(cw + 2 * 5632 + c); cwv[n][3] = *(const f32x4*)(cb + c);                             \
        }                                                                                                                  \
        up_epi_row<0, NN>(acc, cwv, lane_e, fr_e, s0, obase); up_epi_row<1, NN>(acc, cwv, lane_e, fr_e, s0, obase);          \
        up_epi_row<2, NN>(acc, cwv, lane_e, fr_e, s0, obase); up_epi_row<3, NN>(acc, cwv, lane_e, fr_e, s0, obase);          \
        up_epi_row<4, NN>(acc, cwv, lane_e, fr_e, s0, obase); up_epi_row<5, NN>(acc, cwv, lane_e, fr_e, s0, obase);          \
        up_epi_row<6, NN>(acc, cwv, lane_e, fr_e, s0, obase); up_epi_row<7, NN>(acc, cwv, lane_e, fr_e, s0, obase);          \
      }
      UP_EPI_NN(0)
      UP_EPI_NN(1)
#undef UP_EPI_NN
    }
    asm volatile("s_waitcnt vmcnt(0)" ::: "memory");
  }
#undef GEMM_LOAD
#undef GEMM_WRITE
#undef GEMM_KSTEP
#undef GEMM_PTRS
}

struct AttnArgs {
  int qbase, qstride, qpos0;
  int ktokbase, ktokstep, kstride, kposbase, kposstep, ntiles;
  int qcol, kcol, vcol, ocol;
  const float *gq, *gk;
  float qscale;
  int hw, rmul, taboff0;
  float sinkv;
  float lam, outscale;
  const float* subg;
  int lsecol;
  float cshift;
  int r0, rs0;
};

template <int NQ, int NC, int MODE>
__device__ __forceinline__ void attn_item(const Params& p, const AttnArgs& a, bf16_t* Ks, bf16_t* Vts, const float* tab) {
  const int tid = opaque_tid(), lane = tid & 63, w = tid >> 6, fr = lane & 15, fq = lane >> 4;
  const int wq0 = a.qpos0 + w * 16 * NQ;
  const int lch = tid & 7;
  const int ntl = a.ntiles;
  u32x4 kA, vA, kB, vB;
  const int kkey = tid >> 3, vkey = tid & 63, vch = tid >> 6;
#define ATTN_PREFETCH(T, KR, VR)                                                                                 \
  {                                                                                                              \
    const int ktok0_ = a.ktokbase + (T) * a.ktokstep;                                                            \
    KR = *(const u32x4*)(p.proj + (size_t)(ktok0_ + kkey * a.kstride) * PW + a.kcol + lch * 8);                   \
    VR = *(const u32x4*)(p.proj + (size_t)(ktok0_ + vkey * a.kstride) * PW + a.vcol + vch * 8);                   \
  }
  ATTN_PREFETCH(0, kA, vA)
  if (ntl > 1) ATTN_PREFETCH(1, kB, vB)
  bf16x8 qf[NQ][2];
  int qpos[NQ];
#pragma unroll
  for (int qt = 0; qt < NQ; ++qt) {
    const int qp = wq0 + qt * 16 + fr;
    qpos[qt] = qp;
    const bf16_t* qrow = p.proj + (size_t)(a.qbase + qp * a.qstride) * PW + a.qcol;
    const u32x4 v0 = *(const u32x4*)(qrow + fq * 8), v1 = *(const u32x4*)(qrow + 32 + fq * 8);
    float f0[8], f1[8];
#pragma unroll
    for (int i = 0; i < 4; ++i) { f0[2 * i] = bf_lo(v0[i]); f0[2 * i + 1] = bf_hi(v0[i]); f1[2 * i] = bf_lo(v1[i]); f1[2 * i + 1] = bf_hi(v1[i]); }
    float s0 = 0.f, s1 = 0.f;
#pragma unroll
    for (int i = 0; i < 8; ++i) { s0 += f0[i] * f0[i]; s1 += f1[i] * f1[i]; }
    float r0, r1;
    if (NC == 1) {
      float s = s0 + s1; s += __shfl_xor(s, 16); s += __shfl_xor(s, 32);
      r0 = r1 = rsqrtf(s * (1.f / 64.f) + 1e-6f) * a.qscale;
    } else {
      s0 += __shfl_xor(s0, 16); s0 += __shfl_xor(s0, 32);
      s1 += __shfl_xor(s1, 16); s1 += __shfl_xor(s1, 32);
      r0 = rsqrtf(s0 * (1.f / 32.f) + 1e-6f) * a.qscale; r1 = rsqrtf(s1 * (1.f / 32.f) + 1e-6f) * a.qscale;
    }
    const float* g0p = a.gq + fq * 8;
    const float* g1p = (NC == 1) ? a.gq + 32 + fq * 8 : g0p;
    u32x4 q0, q1;
#pragma unroll
    for (int i = 0; i < 4; ++i) {
      q0[i] = pk_bf16(f0[2 * i] * r0 * g0p[2 * i], f0[2 * i + 1] * r0 * g0p[2 * i + 1]);
      q1[i] = pk_bf16(f1[2 * i] * r1 * g1p[2 * i], f1[2 * i + 1] * r1 * g1p[2 * i + 1]);
    }
    qf[qt][0] = __builtin_bit_cast(bf16x8, q0);
    qf[qt][1] = __builtin_bit_cast(bf16x8, q1);
  }
  f32x4 o[NC][NQ][4];
  float mrun[NC][NQ];
  f32x4 lsum[NC][NQ];
  const bf16x8 ones = {0x3F80, 0x3F80, 0x3F80, 0x3F80, 0x3F80, 0x3F80, 0x3F80, 0x3F80};
#pragma unroll
  for (int c = 0; c < NC; ++c)
#pragma unroll
    for (int qt = 0; qt < NQ; ++qt) {
      mrun[c][qt] = a.cshift;
      const float l0 = (MODE == 1) ? fexp2(a.sinkv - a.cshift) : 0.f;
      lsum[c][qt] = (f32x4){l0, l0, l0, l0};
#pragma unroll
      for (int dt = 0; dt < 4; ++dt) o[c][qt][dt] = (f32x4){0.f, 0.f, 0.f, 0.f};
    }
  float gkv[8];
#pragma unroll
  for (int i = 0; i < 8; ++i) gkv[i] = a.gk[((NC == 1) ? lch : (lch & 3)) * 8 + i];

  const int rw = a.r0 + ((w * 16 * NQ) >> 6);
  int rsw = rw - 4; rsw = rsw < 0 ? 0 : (rsw > 24 ? 24 : rsw);
  auto stage_write = [&](const u32x4& kr, const u32x4& vr, bf16_t* Ksb, bf16_t* Vtb) __attribute__((always_inline)) {
    float f[8];
#pragma unroll
    for (int i = 0; i < 4; ++i) { f[2 * i] = bf_lo(kr[i]); f[2 * i + 1] = bf_hi(kr[i]); }
    float s = 0.f;
#pragma unroll
    for (int i = 0; i < 8; ++i) s += f[i] * f[i];
    s += __shfl_xor(s, 1); s += __shfl_xor(s, 2);
    float rs;
    if (NC == 1) { s += __shfl_xor(s, 4); rs = rsqrtf(s * (1.f / 64.f) + 1e-6f); }
    else rs = rsqrtf(s * (1.f / 32.f) + 1e-6f);
    u32x4 kq;
#pragma unroll
    for (int i = 0; i < 4; ++i) kq[i] = pk_bf16(f[2 * i] * rs * gkv[2 * i], f[2 * i + 1] * rs * gkv[2 * i + 1]);
    *(u32x4*)(Ksb + kkey * LDSROW + lch * 8) = kq;
#pragma unroll
    for (int i = 0; i < 4; ++i) {
      const int d0 = vch * 8 + 2 * i, d1 = d0 + 1;
      const int s0 = (d0 & ~31) | (16 * ((d0 >> 2) & 1) + 4 * ((d0 & 31) >> 3) + (d0 & 3)), s1 = (d1 & ~31) | (16 * ((d1 >> 2) & 1) + 4 * ((d1 & 31) >> 3) + (d1 & 3));
      Vtb[s0 * LDSROW + vkey] = (bf16_t)(vr[i] & 0xffffu);
      Vtb[s1 * LDSROW + vkey] = (bf16_t)(vr[i] >> 16);
    }
  };
  auto tile_math = [&](int t, const bf16_t* Ksb, const bf16_t* Vtb) __attribute__((always_inline)) {
    if (MODE == 0) { const int kr_ = a.rs0 + t; if (kr_ < rsw || kr_ >= rsw + 8) return; }
    const int kp0 = a.kposbase + t * a.kposstep;
    const int taboff = (a.rs0 + t - rw + 7) * 31;
    bf16x8 pf[NC][NQ][2];
    bf16x8 kf[4][2];
#pragma unroll
    for (int kt = 0; kt < 4; ++kt) {
      kf[kt][0] = *(const bf16x8*)(Ksb + (kt * 16 + fr) * LDSROW + fq * 8);
      kf[kt][1] = *(const bf16x8*)(Ksb + (kt * 16 + fr) * LDSROW + 32 + fq * 8);
    }
    bf16x8 vfr[4][2];
#pragma unroll
    for (int ks = 0; ks < 2; ++ks)
#pragma unroll
      for (int dt = 0; dt < 4; ++dt) {
        const u32x2 lo = *(const u32x2*)(Vtb + (dt * 16 + fr) * LDSROW + ks * 32 + 4 * fq);
        const u32x2 hi = *(const u32x2*)(Vtb + (dt * 16 + fr) * LDSROW + ks * 32 + 16 + 4 * fq);
        u32x4 vv; vv[0] = lo[0]; vv[1] = lo[1]; vv[2] = hi[0]; vv[3] = hi[1];
        vfr[dt][ks] = __builtin_bit_cast(bf16x8, vv);
      }
#pragma unroll
    for (int qt = 0; qt < NQ; ++qt) {
      const int qp = (MODE == 0) ? (qpos[qt] & 63) : qpos[qt];
      int cs = qp - 8; cs = cs < 0 ? 0 : (cs > 48 ? 48 : cs);
      f32x4 bv[4];
      const bool far_hi = (MODE == 3) && (kp0 - (wq0 + 16 * NQ - 1) >= 128), far_lo = (MODE == 3) && (wq0 - (kp0 + 63) >= 128);
      if (far_hi || far_lo) {
        const float bu = tab[far_hi ? (DT_OFF + 256) : (DT_OFF - 256)];
#pragma unroll
        for (int kt = 0; kt < 4; ++kt) bv[kt] = (f32x4){bu, bu, bu, bu};
      } else if (MODE != 0) {
        const float* tb = tab + (kp0 - qp + 4 * fq + DT_OFF);
#pragma unroll
        for (int kt = 0; kt < 4; ++kt)
#pragma unroll
          for (int j = 0; j < 4; ++j) bv[kt][j] = tb[kt * 16 + j];
      } else
#pragma unroll
      for (int kt = 0; kt < 4; ++kt)
#pragma unroll
        for (int j = 0; j < 4; ++j) {
          const int kpos = kp0 + kt * 16 + 4 * fq + j;
          const int d = kpos - qp;
          const bool valid = kpos >= cs && kpos < cs + 16;
          int dd = d + 15; dd = dd < 0 ? 0 : (dd > 30 ? 30 : dd);
          const float bias = tab[taboff + dd];
          bv[kt][j] = valid ? bias : -INFINITY;
        }
#pragma unroll
      for (int c = 0; c < NC; ++c) {
        f32x4 s[4];
#pragma unroll
        for (int kt = 0; kt < 4; ++kt) {
          if (NC == 1) {
            const f32x4 r = __builtin_amdgcn_mfma_f32_16x16x32_bf16(kf[kt][0], qf[qt][0], bv[kt], 0, 0, 0);
            s[kt] = __builtin_amdgcn_mfma_f32_16x16x32_bf16(kf[kt][1], qf[qt][1], r, 0, 0, 0);
          } else {
            s[kt] = __builtin_amdgcn_mfma_f32_16x16x32_bf16(kf[kt][c], qf[qt][c], bv[kt], 0, 0, 0);
          }
        }
#pragma unroll
        for (int kt = 0; kt < 4; ++kt)
#pragma unroll
          for (int j = 0; j < 4; ++j) s[kt][j] = fexp2(s[kt][j]);
#pragma unroll
        for (int ks = 0; ks < 2; ++ks) {
          u32x4 pk;
          pk[0] = pk_bf16(s[2 * ks][0], s[2 * ks][1]); pk[1] = pk_bf16(s[2 * ks][2], s[2 * ks][3]);
          pk[2] = pk_bf16(s[2 * ks + 1][0], s[2 * ks + 1][1]); pk[3] = pk_bf16(s[2 * ks + 1][2], s[2 * ks + 1][3]);
          pf[c][qt][ks] = __builtin_bit_cast(bf16x8, pk);
        }
      }
    }
#pragma unroll
    for (int ks = 0; ks < 2; ++ks) {
#pragma unroll
      for (int dt = 0; dt < 4; ++dt) {
        const bf16x8 vf = vfr[dt][ks];
#pragma unroll
        for (int c = 0; c < NC; ++c)
#pragma unroll
          for (int qt = 0; qt < NQ; ++qt) o[c][qt][dt] = __builtin_amdgcn_mfma_f32_16x16x32_bf16(vf, pf[c][qt][ks], o[c][qt][dt], 0, 0, 0);
      }
#pragma unroll
      for (int c = 0; c < NC; ++c)
#pragma unroll
        for (int qt = 0; qt < NQ; ++qt) lsum[c][qt] = __builtin_amdgcn_mfma_f32_16x16x32_bf16(ones, pf[c][qt][ks], lsum[c][qt], 0, 0, 0);
    }
    };
  bf16_t* const Ks1 = Ks + 2 * 64 * LDSROW;
  bf16_t* const Vts1 = Vts + 2 * 64 * LDSROW;
  stage_write(kA, vA, Ks, Vts);
  if (ntl > 2) ATTN_PREFETCH(2, kA, vA)
  for (int t = 0; t < ntl; t += 2) {
    __syncthreads();
    if (t + 1 < ntl) { stage_write(kB, vB, Ks1, Vts1); if (t + 3 < ntl) ATTN_PREFETCH(t + 3, kB, vB) }
    tile_math(t, Ks, Vts);
    if (t + 1 < ntl) {
      __syncthreads();
      if (t + 2 < ntl) { stage_write(kA, vA, Ks, Vts); if (t + 4 < ntl) ATTN_PREFETCH(t + 4, kA, vA) }
      tile_math(t + 1, Ks1, Vts1);
    }
  }
#undef ATTN_PREFETCH
#pragma unroll
  for (int qt = 0; qt < NQ; ++qt) {
    float inv[NC], ltot[NC];
#pragma unroll
    for (int c = 0; c < NC; ++c) {
      const float lt = lsum[c][qt][0];
      ltot[c] = lt; inv[c] = 1.f / lt;
    }
    const int tok = a.qbase + qpos[qt] * a.qstride;
    if (MODE == 3) {
      f32x4 v[4];
      float ss = 0.f;
#pragma unroll
      for (int dt = 0; dt < 4; ++dt)
#pragma unroll
        for (int j = 0; j < 4; ++j) {
          const float x = o[0][qt][dt][j] * inv[0] - a.lam * (o[NC - 1][qt][dt][j] * inv[NC - 1]);
          v[dt][j] = x; ss += x * x;
        }
      ss += __shfl_xor(ss, 16); ss += __shfl_xor(ss, 32);
      const float rstd = rsqrtf(ss * (1.f / 64.f) + 1e-6f) * a.outscale;
#pragma unroll
      for (int q = 0; q < 2; ++q) {
        const f32x4 g0 = *(const f32x4*)(a.subg + 32 * q + 8 * fq), g1 = *(const f32x4*)(a.subg + 32 * q + 8 * fq + 4);
        u32x4 ov;
        ov[0] = pk_bf16(v[2 * q][0] * rstd * g0[0], v[2 * q][1] * rstd * g0[1]); ov[1] = pk_bf16(v[2 * q][2] * rstd * g0[2], v[2 * q][3] * rstd * g0[3]);
        ov[2] = pk_bf16(v[2 * q + 1][0] * rstd * g1[0], v[2 * q + 1][1] * rstd * g1[1]); ov[3] = pk_bf16(v[2 * q + 1][2] * rstd * g1[2], v[2 * q + 1][3] * rstd * g1[3]);
        *(u32x4*)(p.hbuf + blk_off(tok, a.ocol + 32 * q + 8 * fq, NTOK)) = ov;
      }
    } else {
#pragma unroll
      for (int q = 0; q < 2; ++q) {
        u32x4 ov;
        ov[0] = pk_bf16(o[0][qt][2 * q][0] * inv[0], o[0][qt][2 * q][1] * inv[0]); ov[1] = pk_bf16(o[0][qt][2 * q][2] * inv[0], o[0][qt][2 * q][3] * inv[0]);
        ov[2] = pk_bf16(o[0][qt][2 * q + 1][0] * inv[0], o[0][qt][2 * q + 1][1] * inv[0]); ov[3] = pk_bf16(o[0][qt][2 * q + 1][2] * inv[0], o[0][qt][2 * q + 1][3] * inv[0]);
        *(u32x4*)(p.hbuf + blk_off(tok, a.ocol + 32 * q + 8 * fq, NTOK)) = ov;
      }
      if (MODE == 2 && fq == 0) p.lse[(size_t)tok * 6 + a.lsecol] = (mrun[0][qt] + __log2f(ltot[0])) * LN2;
    }
  }
}

__device__ __forceinline__ void attn_phase(const Params& p, int l, char* smem) {
  bf16_t* Ks = (bf16_t*)smem;
  bf16_t* Vts = Ks + 64 * LDSROW;
  float* tab = (float*)(Ks + 4 * 64 * LDSROW);
  const int tid = opaque_tid();
  const int nD = 3072, nA = 3072, nB = 3072, nC = 4608;
  for (int item = blockIdx.x; item < nD + nA + nB + nC; item += gridDim.x) {
    AttnArgs a;
    a.taboff0 = 0; a.r0 = 0; a.rs0 = 0; a.sinkv = 0.f; a.cshift = 0.f; a.lam = 0.f; a.outscale = 1.f; a.subg = nullptr; a.lsecol = 0; a.hw = 1 << 20; a.rmul = 1;
    __syncthreads();
    if (item < nD) {
      const int b = item >> 6, h = (item >> 4) & 3, qb = item & 15;
      a.cshift = p.lam[4 + l * 4 + 3];
      for (int i = tid; i < DT_N; i += NTHR) { int dd = i - DT_OFF; dd = dd < -128 ? -128 : (dd > 128 ? 128 : dd); tab[i] = p.lut[(10 + h) * 257 + dd + 128] - a.cshift; }
      a.qbase = b * SEQL; a.qstride = 1; a.qpos0 = qb * 128;
      a.ktokbase = b * SEQL; a.ktokstep = 64; a.kstride = 1; a.kposbase = 0; a.kposstep = 64; a.ntiles = 32;
      a.qcol = 2432 + h * 64; a.kcol = 2432 + 256 + h * 64; a.vcol = 2432 + 512 + h * 64; a.ocol = 896 + h * 64;
      a.gq = p.qkn_d + l * 64; a.gk = a.gq + 32;
      a.qscale = 0.17677669529663687f * LOG2E;
      a.lam = p.lam[l]; a.outscale = 1.f - (0.8f - 0.6f * expf(-0.3f * (float)l)); a.subg = p.subln_d + l * 64;
      attn_item<1, 2, 3>(p, a, Ks, Vts, tab);
    } else if (item < nD + nA) {
      const int id = item - nD;
      const int b = id >> 6, h = (id >> 4) & 3, r = (id & 15) * 2;
      const float* rp = p.rpb_a + ((size_t)l * 4 + h) * 465;
      a.cshift = p.lam[4 + l * 4 + 0];
      for (int i = tid; i < 465; i += NTHR) tab[i] = rp[i] * LOG2E - a.cshift;
      int rs = r - 4; rs = rs < 0 ? 0 : (rs > 24 ? 24 : rs);
      int rs1 = r - 3; rs1 = rs1 < 0 ? 0 : (rs1 > 24 ? 24 : rs1);
      a.qbase = b * SEQL + r * 64; a.qstride = 1; a.qpos0 = 0; a.r0 = r; a.rs0 = rs;
      a.ktokbase = b * SEQL + rs * 64; a.ktokstep = 64; a.kstride = 1; a.kposbase = 0; a.kposstep = 0; a.ntiles = rs1 - rs + 8;
      a.qcol = h * 64; a.kcol = 256 + h * 64; a.vcol = 512 + h * 64; a.ocol = h * 64;
      a.gq = p.qkn_a + l * 128; a.gk = a.gq + 64;
      a.qscale = 0.125f * LOG2E;
      attn_item<1, 1, 0>(p, a, Ks, Vts, tab);
    } else if (item < nD + nA + nB) {
      const int id = item - nD - nA;
      const int b = id >> 6, h = (id >> 4) & 3, qb = id & 15;
      a.cshift = p.lam[4 + l * 4 + 1];
      for (int i = tid; i < DT_N; i += NTHR) { const int d = i - DT_OFF; tab[i] = (d >= -128 && d <= 128) ? p.lut[h * 257 + d + 128] - a.cshift : -INFINITY; }
      const int q0 = qb * 128;
      const int kstart = q0 - 128 < 0 ? 0 : q0 - 128, kend = q0 + 256 > SEQL ? SEQL : q0 + 256;
      a.qbase = b * SEQL; a.qstride = 1; a.qpos0 = q0;
      a.ktokbase = b * SEQL + kstart; a.ktokstep = 64; a.kstride = 1; a.kposbase = kstart; a.kposstep = 64; a.ntiles = (kend - kstart) >> 6;
      a.qcol = 768 + h * 64; a.kcol = 768 + 256 + (h >> 1) * 64; a.vcol = 768 + 384 + (h >> 1) * 64; a.ocol = 256 + h * 64;
      a.gq = p.qkn_b + l * 128; a.gk = a.gq + 64;
      a.qscale = 0.125f * LOG2E;
      a.hw = 128; a.rmul = 1; a.sinkv = p.sink_b[l * 4 + h] * LOG2E;
      attn_item<1, 1, 1>(p, a, Ks, Vts, tab);
    } else {
      const int id = item - nD - nA - nB;
      const int b = id / 96, rem = id % 96, g = rem >> 5, i2 = (rem >> 4) & 1, blk = rem & 15;
      const int r = g == 0 ? 1 : (g == 1 ? 4 : 16);
      const int L = SEQL / r, bps = L >> 7;
      const int pp = blk / bps, m0 = (blk % bps) * 128;
      const int hh = g * 2 + i2;
      a.cshift = p.lam[4 + l * 4 + 2];
      for (int i = tid; i < DT_N; i += NTHR) { const int d = i - DT_OFF; int dd = d * r; dd = dd < -128 ? -128 : (dd > 128 ? 128 : dd);
        tab[i] = (d >= -64 && d <= 64) ? p.lut[(4 + hh) * 257 + dd + 128] - a.cshift : -INFINITY; }
      const int kstart = m0 - 64 < 0 ? 0 : m0 - 64, kend = m0 + 192 > L ? L : m0 + 192;
      a.qbase = b * SEQL + pp; a.qstride = r; a.qpos0 = m0;
      a.ktokbase = a.qbase + kstart * r; a.ktokstep = 64 * r; a.kstride = r; a.kposbase = kstart; a.kposstep = 64; a.ntiles = (kend - kstart) >> 6;
      a.qcol = 1280 + hh * 64; a.kcol = 1280 + 384 + hh * 64; a.vcol = 1280 + 768 + hh * 64; a.ocol = 512 + hh * 64;
      a.gq = p.qkn_c + l * 128; a.gk = a.gq + 64;
      a.qscale = 0.125f * LOG2E;
      a.hw = 64; a.rmul = r; a.lsecol = hh;
      attn_item<1, 1, 2>(p, a, Ks, Vts, tab);
    }
  }
}

__device__ __forceinline__ void combine_phase(const Params& p) {
  const int nthr = gridDim.x * NTHR;
  for (int i = blockIdx.x * NTHR + opaque_tid(); i < NTOK * 48; i += nthr) {
    const int tok = i / 48, rem = i % 48, hh = rem >> 3, ch = rem & 7, ii = hh & 1, g = hh >> 1;
    const float* ls = p.lse + (size_t)tok * 6;
    const float l0 = ls[ii], l1 = ls[2 + ii], l2 = ls[4 + ii];
    const float mx = fmaxf(l0, fmaxf(l1, l2));
    const float e0 = __expf(l0 - mx), e1 = __expf(l1 - mx), e2 = __expf(l2 - mx);
    const float al = (g == 0 ? e0 : (g == 1 ? e1 : e2)) / (e0 + e1 + e2);
    bf16_t* ptr = p.hbuf + blk_off(tok, 512 + hh * 64 + ch * 8, NTOK);
    u32x4 v = *(const u32x4*)ptr;
#pragma unroll
    for (int k = 0; k < 4; ++k) v[k] = pk_bf16(bf_lo(v[k]) * al, bf_hi(v[k]) * al);
    *(u32x4*)ptr = v;
  }
}


#ifndef REP_GEMM
#define REP_GEMM 1
#endif
#ifndef REP_ATTN
#define REP_ATTN 1
#endif
#ifndef DBG_STOP
#define DBG_STOP 0
#endif
__global__ void __launch_bounds__(NTHR, 2) fwd_megakernel(Params p) {
  extern __shared__ __attribute__((aligned(16))) char smem[];
  cg::grid_group grid = cg::this_grid();
  prologue_phase(p, smem);
  grid.sync();
#define LAYER(L)                                                                                                   \
  {                                                                                                                \
    constexpr int l = (L);                                                                                         \
    constexpr bool first = (l == 0);                                                                               \
    const bf16_t* wt = p.wt + (size_t)l * WT_LAYER;                                                                \
    norm_phase(p, l, first, p.norm_attn_g + l * DM, 0, 1024);                                                      \
    grid.sync();                                                                                                   \
    gemm_phase<0>(p, l, false, p.hbuf, 3200, wt + WT_IN, 1024, 384, 13, 13, p.proj, PW, 0, smem);                  \
    grid.sync();                                                                                                   \
    attn_phase(p, l, smem);                                                                                        \
    grid.sync();                                                                                                   \
    combine_phase(p);                                                                                              \
    grid.sync();                                                                                                   \
    gemm_phase<1>(p, l, first, p.hbuf, 1024, wt + WT_OUT, 1152, 384, 4, 4, nullptr, 0, 2048, smem);                \
    grid.sync();                                                                                                   \
    norm_phase(p, l, false, p.norm_ffn_g + l * DM, 3072, 4096);                                                    \
    grid.sync();                                                                                                   \
    gemm_phase<2>(p, l, false, p.hbuf, 5632, wt + WT_UP, 1024, 408, 22, 22, p.proj, DFF, 0, smem);                 \
    grid.sync();                                                                                                   \
    gemm_phase<1>(p, l, false, p.proj, 1024, wt + WT_DOWN, 2816, 384, 4, 4, nullptr, 0, 5120, smem);               \
    grid.sync();                                                                                                   \
  }
  LAYER(0)
  LAYER(1)
  LAYER(2)
  LAYER(3)
#undef LAYER
}

extern "C" void kernel_launch(void* const* d_in, const int* in_sizes, int n_in, void* d_out, int out_size, void* d_ws, size_t ws_size,
                              hipStream_t stream) {
  static int grid_blocks = 0;
  if (!grid_blocks) {
    int dev = 0, cus = 0, per_cu = 0;
    hipGetDevice(&dev);
    hipDeviceGetAttribute(&cus, hipDeviceAttributeMultiprocessorCount, dev);
    hipFuncSetAttribute((const void*)fwd_megakernel, hipFuncAttributeMaxDynamicSharedMemorySize, SMEM_BYTES);
    hipOccupancyMaxActiveBlocksPerMultiprocessor(&per_cu, fwd_megakernel, NTHR, SMEM_BYTES);
    if (per_cu > 1) per_cu = 1;
    if (per_cu < 1) per_cu = 1;
    grid_blocks = cus * per_cu;
  }
  Params p{};
  const float* const* in = (const float* const*)d_in;
  p.x_prompt = in[0]; p.x_sample = in[1]; p.c_prompt = in[2]; p.c_sample = in[3]; p.norm_attn_g = in[4]; p.norm_ffn_g = in[5];
  p.w_ada = in[6]; p.b_ada = in[7]; p.w_in = in[8]; p.qkn_a = in[9]; p.qkn_b = in[10]; p.qkn_c = in[11]; p.qkn_d = in[12];
  p.rpb_a = in[13]; p.sink_b = in[14]; p.t5_table = in[15]; p.lam_d = in[16]; p.subln_d = in[17]; p.w_out = in[18]; p.w_up = in[19];
  p.conv_w = in[20]; p.conv_b = in[21]; p.w_down = in[22];
  p.out = (float*)d_out;
  char* ws = (char*)d_ws;
  size_t off = 0;
  p.wt = (bf16_t*)(ws + off); off += (size_t)4 * WT_LAYER * 2;
  p.mod = (float*)(ws + off); off += (size_t)4 * 48 * 6144 * 4;
  p.lut = (float*)(ws + off); off += 16384;
  p.lam = (float*)(ws + off); off += 256;
  p.zeros = (float*)(ws + off); off += 256;
  p.lse = (float*)(ws + off); off += (size_t)NTOK * 6 * 4;
  p.proj = (bf16_t*)(ws + off); off += (size_t)NTOK * PW * 2;
  p.hbuf = (bf16_t*)(ws + off); off += (size_t)NTOK * MW * 2;
  if (off > ws_size) { fprintf(stderr, "workspace too small: need %zu have %zu\n", off, ws_size); return; }
  void* args[] = {&p};
  hipError_t e = hipLaunchCooperativeKernel((void*)fwd_megakernel, dim3(grid_blocks), dim3(NTHR), args, SMEM_BYTES, stream);
  if (e != hipSuccess) fprintf(stderr, "cooperative launch failed: %s (grid %d)\n", hipGetErrorString(e), grid_blocks);
}
```

```cpp
#include <hip/hip_runtime.h>
#include <hip/hip_cooperative_groups.h>
#include <cstdint>
#include <cstdio>
namespace cg = cooperative_groups;

typedef unsigned short bf16_t;
typedef short bf16x8 __attribute__((ext_vector_type(8)));
typedef float f32x4 __attribute__((ext_vector_type(4)));
typedef unsigned u32x4 __attribute__((ext_vector_type(4)));
typedef unsigned u32x2 __attribute__((ext_vector_type(2)));

#define NTOK 98304
#define DM 1024
#define PW 3200
#define MW 1152
#define DFF 2816
#define NSEQ 48
#define SEQL 2048
#define LOG2E 1.4426950408889634f
#define LN2 0.6931471805599453f
#define LDSROW 72
#define DT_OFF 320
#define DT_N 641
#define NTHR 512
#define NWAVE 8

struct Params {
  const float *x_prompt, *x_sample, *c_prompt, *c_sample, *norm_attn_g, *norm_ffn_g, *w_ada, *b_ada, *w_in;
  const float *qkn_a, *qkn_b, *qkn_c, *qkn_d, *rpb_a, *sink_b, *t5_table, *lam_d, *subln_d, *w_out, *w_up, *conv_w, *conv_b, *w_down;
  float* out;
  bf16_t* wt; float* mod; float* lut; float* lam; float* lse; bf16_t* proj; bf16_t* hbuf; float* zeros;
};

#define WT_IN 0
#define WT_OUT (3200 * 1024)
#define WT_UP (WT_OUT + 1024 * 1152)
#define WT_DOWN (WT_UP + 5632 * 1024)
#define WT_LAYER (WT_DOWN + 1024 * 2816)

typedef __bf16 bf16x2_t __attribute__((ext_vector_type(2)));
typedef float f32x2_t __attribute__((ext_vector_type(2)));
__device__ __forceinline__ unsigned pk_bf16(float lo, float hi) {
  const f32x2_t v = {lo, hi};
  const bf16x2_t r = __builtin_convertvector(v, bf16x2_t);
  return __builtin_bit_cast(unsigned, r);
}
__device__ __forceinline__ float bf_lo(unsigned u) { return __uint_as_float(u << 16); }
__device__ __forceinline__ float bf_hi(unsigned u) { return __uint_as_float(u & 0xffff0000u); }
__device__ __forceinline__ float fexp2(float x) { return __builtin_amdgcn_exp2f(x); }

__device__ __forceinline__ const float* xin_row(const Params& p, bool first, int tok) {
  if (first) return tok < 65536 ? p.x_prompt + (size_t)tok * DM : p.x_sample + (size_t)(tok - 65536) * DM;
  return p.out + (size_t)tok * DM;
}

__device__ __forceinline__ int opaque_tid() { int t = threadIdx.x; asm volatile("" : "+v"(t)); return t; }

__device__ __forceinline__ size_t blk_off(int r, int k, int R) { return ((size_t)(k >> 5) * R + r) * 32 + (k & 31); }

__device__ __forceinline__ int t5_bucket(int rel) {
  const int n = rel < 0 ? -rel : rel;
  int v;
  if (n < 8) v = n;
  else v = 8 + (n >= 12) + (n >= 16) + (n >= 23) + (n >= 32) + (n >= 46) + (n >= 64) + (n >= 91);
  return (rel > 0 ? 16 : 0) + v;
}

__device__ __forceinline__ void prologue_phase(const Params& p, char* smem) {
  const int tid = opaque_tid(), nb = gridDim.x;
  const int N_TR = 4 * 3200, N_MOD = 192;
  for (int item = blockIdx.x; item < N_TR + N_MOD + 1; item += nb) {
    if (item < N_TR) {
      const int l = item / 3200; int r = item % 3200;
      const float* src; bf16_t* dst; int K, N, kt, nt;
      if (r < 800) { K = 1024; N = 3200; src = p.w_in + (size_t)l * K * N; dst = p.wt + (size_t)l * WT_LAYER + WT_IN; kt = r / 50; nt = r % 50; }
      else if (r < 1088) { r -= 800; K = 1152; N = 1024; src = p.w_out + (size_t)l * K * N; dst = p.wt + (size_t)l * WT_LAYER + WT_OUT; kt = r / 16; nt = r % 16; }
      else if (r < 2496) { r -= 1088; K = 1024; N = 5632; src = p.w_up + (size_t)l * K * N; dst = p.wt + (size_t)l * WT_LAYER + WT_UP; kt = r / 88; nt = r % 88; }
      else { r -= 2496; K = 2816; N = 1024; src = p.w_down + (size_t)l * K * N; dst = p.wt + (size_t)l * WT_LAYER + WT_DOWN; kt = r / 16; nt = r % 16; }
      float* tile = (float*)smem;
      const int k0 = kt * 64, n0 = nt * 64;
      __syncthreads();
#pragma unroll
      for (int i = 0; i < 8; ++i) {
        const int rr = (tid >> 6) + 8 * i, cc = tid & 63;
        tile[rr * 65 + cc] = src[(size_t)(k0 + rr) * N + n0 + cc];
      }
      __syncthreads();
#pragma unroll
      for (int i = 0; i < 4; ++i) {
        const int idx = tid + NTHR * i, n = idx >> 5, k2 = (idx & 31) * 2;
        *(unsigned*)(dst + blk_off(n0 + n, k0 + k2, N)) = pk_bf16(tile[k2 * 65 + n], tile[(k2 + 1) * 65 + n]);
      }
    } else if (item < N_TR + N_MOD) {
      int r = item - N_TR;
      const int l = r / 48; r %= 48;
      const int nc = r / 4, bg = r % 4;
      const int n = nc * NTHR + tid;
      float* sc = (float*)smem;
      float acc[12];
#pragma unroll
      for (int j = 0; j < 12; ++j) acc[j] = 0.f;
      const float* W = p.w_ada + (size_t)l * 1024 * 6144 + n;
      for (int kc = 0; kc < 2; ++kc) {
        __syncthreads();
        for (int i = tid; i < 12 * 512; i += NTHR) {
          const int j = i >> 9, k = i & 511, b = bg * 12 + j;
          const float c = b < 32 ? p.c_prompt[b * 1024 + kc * 512 + k] : p.c_sample[(b - 32) * 1024 + kc * 512 + k];
          sc[i] = c / (1.f + __expf(-c));
        }
        __syncthreads();
#pragma unroll 2
        for (int k = 0; k < 512; k += 4) {
          const float w0 = W[(size_t)(kc * 512 + k) * 6144], w1 = W[(size_t)(kc * 512 + k + 1) * 6144];
          const float w2 = W[(size_t)(kc * 512 + k + 2) * 6144], w3 = W[(size_t)(kc * 512 + k + 3) * 6144];
#pragma unroll
          for (int j = 0; j < 12; ++j) {
            const f32x4 s = *(const f32x4*)(sc + j * 512 + k);
            acc[j] += s[0] * w0 + s[1] * w1 + s[2] * w2 + s[3] * w3;
          }
        }
      }
      const float bias = p.b_ada[l * 6144 + n];
#pragma unroll
      for (int j = 0; j < 12; ++j) p.mod[((size_t)l * 48 + bg * 12 + j) * 6144 + n] = acc[j] + bias;
    } else {
      for (int i = tid; i < 14 * 257; i += NTHR) {
        const int hd = i / 257, idx = i % 257;
        p.lut[i] = p.t5_table[t5_bucket(idx - 128) * 14 + hd] * LOG2E;
      }
      if (tid < 64) p.zeros[tid] = 0.f;
      if (tid < 4) {
        const float* lp = p.lam_d + tid * 128;
        float s1 = 0.f, s2 = 0.f;
        for (int e = 0; e < 32; ++e) { s1 += lp[e] * lp[32 + e]; s2 += lp[64 + e] * lp[96 + e]; }
        const float li = 0.8f - 0.6f * expf(-0.3f * (float)tid);
        p.lam[tid] = expf(s1) - expf(s2) + li;
      }
      {
        const int pr = tid >> 5, ln = tid & 31, l = pr >> 2, m = pr & 3;
        const float* g = m == 0 ? p.qkn_a + l * 128 : (m == 1 ? p.qkn_b + l * 128 : (m == 2 ? p.qkn_c + l * 128 : p.qkn_d + l * 64));
        const int dd = m == 3 ? 32 : 64;
        float gq = 0.f, gk = 0.f, bmax = 0.f;
        for (int i = ln; i < dd; i += 32) { gq = fmaxf(gq, fabsf(g[i])); gk = fmaxf(gk, fabsf(g[dd + i])); }
        if (m == 0) { const float* rp = p.rpb_a + (size_t)l * 4 * 465; for (int i = ln; i < 4 * 465; i += 32) bmax = fmaxf(bmax, rp[i]); }
        else { for (int i = ln; i < 32 * 14; i += 32) bmax = fmaxf(bmax, p.t5_table[i]); }
#pragma unroll
        for (int o = 16; o >= 1; o >>= 1) { gq = fmaxf(gq, __shfl_xor(gq, o)); gk = fmaxf(gk, __shfl_xor(gk, o)); bmax = fmaxf(bmax, __shfl_xor(bmax, o)); }
        const float scale = m == 3 ? 0.17677669529663687f : 0.125f;
        if (ln == 0) p.lam[4 + pr] = ((float)dd * gq * gk * scale + bmax) * LOG2E;
      }
    }
  }
}

__device__ __forceinline__ void norm_phase(const Params& p, int l, bool first, const float* g, int shift_off, int scale_off) {
  const int tid0 = opaque_tid();
  const int lane = tid0 & 63, w = tid0 >> 6;
  const int stride = gridDim.x * NWAVE;
  for (int row0 = blockIdx.x * NWAVE + w; row0 < NTOK; row0 += 2 * stride) {
    const int row1 = row0 + stride;
    const bool has1 = row1 < NTOK;
    const int rows[2] = {row0, has1 ? row1 : row0};
    f32x4 v[2][4];
    float ss[2] = {0.f, 0.f};
#pragma unroll
    for (int r = 0; r < 2; ++r) {
      const float* xr = xin_row(p, first, rows[r]);
#pragma unroll
      for (int i = 0; i < 4; ++i) v[r][i] = *(const f32x4*)(xr + i * 256 + lane * 4);
    }
#pragma unroll
    for (int r = 0; r < 2; ++r) {
#pragma unroll
      for (int i = 0; i < 4; ++i) ss[r] += v[r][i][0] * v[r][i][0] + v[r][i][1] * v[r][i][1] + v[r][i][2] * v[r][i][2] + v[r][i][3] * v[r][i][3];
#pragma unroll
      for (int o = 32; o >= 1; o >>= 1) ss[r] += __shfl_xor(ss[r], o);
    }
#pragma unroll
    for (int r = 0; r < 2; ++r) {
      if (r == 1 && !has1) break;
      const int row = rows[r];
      const float* md = p.mod + ((size_t)l * 48 + (row >> 11)) * 6144;
      const float rstd = rsqrtf(ss[r] * (1.f / 1024.f) + 1e-6f);
#pragma unroll
      for (int i = 0; i < 4; ++i) {
        const int k = i * 256 + lane * 4;
        const f32x4 gg = *(const f32x4*)(g + k), sc = *(const f32x4*)(md + scale_off + k), sh = *(const f32x4*)(md + shift_off + k);
        f32x4 y;
#pragma unroll
        for (int j = 0; j < 4; ++j) y[j] = (v[r][i][j] * rstd) * gg[j] * (1.f + sc[j]) + sh[j];
        u32x2 o; o[0] = pk_bf16(y[0], y[1]); o[1] = pk_bf16(y[2], y[3]);
        *(u32x2*)(p.hbuf + blk_off(row, k, NTOK)) = o;
      }
    }
  }
}

__device__ __forceinline__ bool gemm_tile_id(int it, int MT, int NT, int NB, int& mt, int& nt) {
  const int nb = gridDim.x, bid = blockIdx.x;
  if ((nb & 7) == 0) {
    const int x = bid & 7, slot = bid >> 3, S = nb >> 3;
    const int TPS = 8 * NB, NSN = NT / NB, NS = (MT / 8) * NSN;
    const int pidx = slot + S * it, sidx = pidx / TPS, w = pidx % TPS, s = x + 8 * sidx;
    if (s >= NS) return false;
    mt = (s / NSN) * 8 + (w & 7); nt = (s % NSN) * NB + (w >> 3);
    return true;
  }
  const int t = bid + nb * it;
  if (t >= MT * NT) return false;
  mt = t / NT; nt = t % NT;
  return true;
}

template <int M, int NN>
__device__ __forceinline__ void up_epi_row(const f32x4 (&acc)[8][4], const f32x4 (&cwv)[2][4], int lane, int fr, int s0, bf16_t* obase) {
  constexpr int MP = M > 0 ? M - 1 : 0, MN = M < 7 ? M + 1 : 7;
  float y[2][4];
#pragma unroll
  for (int n = 0; n < 2; ++n) {
    const f32x4 w0 = cwv[n][0], w1 = cwv[n][1], w2 = cwv[n][2], bb = cwv[n][3];
#pragma unroll
    for (int j = 0; j < 4; ++j) {
      const float cur = acc[M][NN + 2 * n][j];
      const float zp = (fr == 15) ? acc[MP][NN + 2 * n][j] : cur, zn = (fr == 0) ? acc[MN][NN + 2 * n][j] : cur;
      const float pv = __builtin_bit_cast(float, __builtin_amdgcn_update_dpp(0, __builtin_bit_cast(int, zp), 0x121, 0xf, 0xf, false));
      const float nv = __builtin_bit_cast(float, __builtin_amdgcn_update_dpp(0, __builtin_bit_cast(int, zn), 0x12F, 0xf, 0xf, false));
      y[n][j] = w0[j] * pv + w1[j] * cur + w2[j] * nv + bb[j];
    }
  }
  const int row = 16 * M + fr, tpos = s0 + row;
  if (row >= 1 && row <= 126 && tpos >= 0 && tpos < SEQL) {
    float a[4];
#pragma unroll
    for (int j = 0; j < 4; ++j) { const float gte = y[1][j]; a[j] = y[0][j] * gte / (1.f + __expf(-gte)); }
    u32x2 o; o[0] = pk_bf16(a[0], a[1]); o[1] = pk_bf16(a[2], a[3]);
    *(u32x2*)(obase + (size_t)tpos * 32) = o;
  }
  __builtin_amdgcn_sched_barrier(0);
}

#define GB_A 16384
#define GB_BUF 32768
#define NSTAGE 2
#define SMEM_BYTES (NSTAGE * GB_BUF)
template <int EPI>
__device__ __forceinline__ void gemm_phase(const Params& p, int l, bool first, const bf16_t* A, int NBROWS, const bf16_t* Bt, int K, int MT, int NT, int NB,
                           bf16_t* outb, int ldc, int gate_off, char* smem) {
  const int tid = opaque_tid(), lane = tid & 63, w = tid >> 6, wr = w >> 2, wcn = w & 3, fr = lane & 15, fq = lane >> 4;
  const int nk = K / 32;
  const int lrow = tid >> 2, lch = (tid & 3) ^ ((tid >> 4) & 3);
  const int fsw = (fq ^ ((fr >> 2) & 3)) * 16;
  const size_t apan = (size_t)NTOK * 32, bpan = (size_t)NBROWS * 32;
  const bf16_t* ga0; const bf16_t* ga1; const bf16_t* gb0;
  size_t bstr;
#define GEMM_PTRS(MT_, NT_)                                                                                                          \
  {                                                                                                                                  \
    int t_ = tid; asm volatile("" : "+v"(t_));                                                                                       \
    const int lrow_ = t_ >> 2, lch_ = (t_ & 3) ^ ((t_ >> 4) & 3);                                                                    \
    if (EPI == 2) {                                                                                                                  \
      const int wi0 = 2 * (MT_), wi1 = wi0 + 1;                                                                                      \
      const int t0 = 126 * (wi0 % 17) - 1 + lrow_, t1 = 126 * (wi1 % 17) - 1 + lrow_;                                                \
      ga0 = A + ((size_t)(wi0 / 17) * SEQL + t0) * 32 + lch_ * 8;                                                                    \
      ga1 = A + ((size_t)(wi1 / 17) * SEQL + t1) * 32 + lch_ * 8;                                                                    \
      const int rho2_ = lrow_ & 31, prow2_ = (lrow_ & ~31) | (8 * ((rho2_ & 15) >> 2) + 4 * (rho2_ >> 4) + (rho2_ & 3));              \
      gb0 = Bt + (size_t)((NT_) * 128 + prow2_) * 32 + lch_ * 8; bstr = (size_t)DFF * 32;                                            \
    } else {                                                                                                                         \
      ga0 = A + (size_t)((MT_) * 256 + lrow_) * 32 + lch_ * 8; ga1 = ga0 + (size_t)128 * 32;                                         \
      const int rho_ = lrow_ & 31, prow_ = (lrow_ & ~31) | (8 * ((rho_ & 15) >> 2) + 4 * (rho_ >> 4) + (rho_ & 3));                  \
      gb0 = Bt + (size_t)((NT_) * 256 + prow_) * 32 + lch_ * 8; bstr = (size_t)128 * 32;                                             \
    }                                                                                                                                \
  }
#define GEMM_LOAD(KT, SET)                                                                                                           \
    {                                                                                                                                \
      const size_t ko_ = (size_t)(KT) * apan, kb_ = (size_t)(KT) * bpan;                                                             \
      asm volatile("global_load_dwordx4 %0, %1, off" : "=v"(SET[0]) : "v"(ga0 + ko_) : "memory");                                     \
      asm volatile("global_load_dwordx4 %0, %1, off" : "=v"(SET[1]) : "v"(ga1 + ko_) : "memory");                                     \
      asm volatile("global_load_dwordx4 %0, %1, off" : "=v"(SET[2]) : "v"(gb0 + kb_) : "memory");                                     \
      asm volatile("global_load_dwordx4 %0, %1, off" : "=v"(SET[3]) : "v"(gb0 + bstr + kb_) : "memory");                              \
    }
#define GEMM_WRITE(SET, STAGE)                                                                                                       \
    {                                                                                                                                \
      asm volatile("" : "+v"(SET[0]), "+v"(SET[1]), "+v"(SET[2]), "+v"(SET[3]));      \
      char* dst_ = smem + (STAGE) * GB_BUF + tid * 16;                                                                               \
      *(u32x4*)(dst_) = SET[0]; *(u32x4*)(dst_ + 8192) = SET[1]; *(u32x4*)(dst_ + GB_A) = SET[2]; *(u32x4*)(dst_ + GB_A + 8192) = SET[3]; \
    }
#define GEMM_KSTEP(KT, WSET)                                                                                                         \
    {                                                                                                                                \
      asm volatile("s_waitcnt lgkmcnt(0)" ::: "memory");                                                                             \
      __builtin_amdgcn_s_barrier();                   \
        \
      const char* Ab = smem + ((KT) & 1) * GB_BUF;                                                                                   \
      const char* Bb = Ab + GB_A;                                                                                                    \
      bf16x8 bfr[4];                                                                                                                 \
      _Pragma("unroll") for (int n = 0; n < 4; ++n) {                                                                                \
        const int br = (EPI == 2) ? ((n >> 1) * 128 + 32 * wcn + 16 * (n & 1) + fr) : (64 * wcn + 16 * n + fr);                      \
        bfr[n] = *(const bf16x8*)(Bb + br * 64 + fsw);                                                                               \
      }                                                                                                                              \
      const char* Ap = Ab + (wr * 128 + fr) * 64 + fsw;                                                                              \
      bf16x8 af0 = *(const bf16x8*)(Ap), af1 = *(const bf16x8*)(Ap + 16 * 64);                                                       \
      if ((KT) + 1 < nk) {                                                                                                           \
        if ((KT) + 2 < nk) asm volatile("s_waitcnt vmcnt(4)" ::: "memory"); else asm volatile("s_waitcnt vmcnt(0)" ::: "memory");     \
        GEMM_WRITE(WSET, ((KT) + 1) & 1)                                                                                             \
        if ((KT) + 3 < nk) GEMM_LOAD((KT) + 3, WSET)                                                                                 \
      }                                                                                                                              \
      _Pragma("unroll") for (int pr = 0; pr < 4; ++pr) {                                                                             \
        bf16x8 an0 = af0, an1 = af1;                                                                                                 \
        if (pr < 3) { an0 = *(const bf16x8*)(Ap + (2 * pr + 2) * 16 * 64); an1 = *(const bf16x8*)(Ap + (2 * pr + 3) * 16 * 64); }    \
        __builtin_amdgcn_sched_barrier(0);                                                                                           \
        _Pragma("unroll") for (int n = 0; n < 4; ++n) acc[2 * pr][n] = __builtin_amdgcn_mfma_f32_16x16x32_bf16(bfr[n], af0, acc[2 * pr][n], 0, 0, 0); \
        _Pragma("unroll") for (int n = 0; n < 4; ++n) acc[2 * pr + 1][n] = __builtin_amdgcn_mfma_f32_16x16x32_bf16(bfr[n], af1, acc[2 * pr + 1][n], 0, 0, 0); \
        __builtin_amdgcn_sched_barrier(0);                                                                                           \
        af0 = an0; af1 = an1;                                                                                                        \
      }                                                                                                                              \
    }
  int mt, nt;
  bool have = gemm_tile_id(0, MT, NT, NB, mt, nt);
  u32x4 rsA[4], rsB[4];
  if (have) {
    GEMM_PTRS(mt, nt)
    GEMM_LOAD(0, rsA)
  }
  for (int it = 0; have; ++it) {
    GEMM_PTRS(mt, nt)
    f32x4 acc[8][4];
#pragma unroll
    for (int m = 0; m < 8; ++m)
#pragma unroll
      for (int n = 0; n < 4; ++n) acc[m][n] = (f32x4){0.f, 0.f, 0.f, 0.f};
    asm volatile("s_waitcnt lgkmcnt(0)" ::: "memory");
    __builtin_amdgcn_s_barrier();
    GEMM_LOAD(1, rsB)
    asm volatile("s_waitcnt vmcnt(4)" ::: "memory");
    GEMM_WRITE(rsA, 0)
    GEMM_LOAD(2, rsA)
    for (int kt = 0; kt < nk; kt += 2) {
      GEMM_KSTEP(kt, rsB)
      GEMM_KSTEP(kt + 1, rsA)
    }
    const int mt_e = mt, nt_e = nt;
    have = gemm_tile_id(it + 1, MT, NT, NB, mt, nt);
    if (have) {
      GEMM_PTRS(mt, nt)
      GEMM_LOAD(0, rsA)
    }
    int lane_e = lane; asm volatile("" : "+v"(lane_e));
    const int fr_e = lane_e & 15, fq_e = lane_e >> 4;
    if (EPI == 0) {
      if (nt_e * 256 + 64 * wcn < NBROWS) {
#pragma unroll
        for (int m = 0; m < 8; ++m) {
          const int tok = mt_e * 256 + wr * 128 + 16 * m + fr_e;
#pragma unroll
          for (int q = 0; q < 2; ++q) {
            const int col = nt_e * 256 + 64 * wcn + 32 * q + 8 * fq_e;
            u32x4 o;
            o[0] = pk_bf16(acc[m][2 * q][0], acc[m][2 * q][1]); o[1] = pk_bf16(acc[m][2 * q][2], acc[m][2 * q][3]);
            o[2] = pk_bf16(acc[m][2 * q + 1][0], acc[m][2 * q + 1][1]); o[3] = pk_bf16(acc[m][2 * q + 1][2], acc[m][2 * q + 1][3]);
            *(u32x4*)(outb + (size_t)tok * ldc + col) = o;
          }
        }
      }
    } else if (EPI == 1) {
      const int b = (mt_e * 256) >> 11;
      const float* gate = p.mod + ((size_t)l * 48 + b) * 6144 + gate_off;
#pragma unroll
      for (int q = 0; q < 2; ++q) {
        const int col = nt_e * 256 + 64 * wcn + 32 * q + 8 * fq_e;
        const f32x4 gv0 = *(const f32x4*)(gate + col), gv1 = *(const f32x4*)(gate + col + 4);
#pragma unroll
        for (int mh = 0; mh < 2; ++mh) {
          f32x4 xv[4][2];
#pragma unroll
          for (int mm = 0; mm < 4; ++mm) {
            const float* xr = xin_row(p, first, mt_e * 256 + wr * 128 + 16 * (4 * mh + mm) + fr_e) + col;
            xv[mm][0] = *(const f32x4*)xr; xv[mm][1] = *(const f32x4*)(xr + 4);
          }
#pragma unroll
          for (int mm = 0; mm < 4; ++mm) {
            const int m = 4 * mh + mm, tok = mt_e * 256 + wr * 128 + 16 * m + fr_e;
            f32x4 o0, o1;
#pragma unroll
            for (int j = 0; j < 4; ++j) { o0[j] = xv[mm][0][j] + gv0[j] * acc[m][2 * q][j]; o1[j] = xv[mm][1][j] + gv1[j] * acc[m][2 * q + 1][j]; }
            float* orow = p.out + (size_t)tok * DM + col;
            *(f32x4*)orow = o0; *(f32x4*)(orow + 4) = o1;
          }
        }
      }
    } else {
      const float* cw = p.conv_w + (size_t)l * 3 * 5632;
      const float* cb = p.conv_b + (size_t)l * 5632;
      const int wi = 2 * mt_e + wr, seq = wi / 17, s0 = 126 * (wi % 17) - 1;
      if (s0 < 0 || s0 + 127 >= SEQL) {
#pragma unroll
        for (int m = 0; m < 8; ++m) {
          const int tp = s0 + 16 * m + fr_e;
          if (tp < 0 || tp >= SEQL) {
#pragma unroll
            for (int n = 0; n < 4; ++n) acc[m][n] = (f32x4){0.f, 0.f, 0.f, 0.f};
          }
        }
      }
#define UP_EPI_NN(NN)                                                                                                      \
      {                                                                                                                    \
        const int cbase = nt_e * 128 + 32 * wcn + 8 * fq_e + 4 * NN;     \
        bf16_t* obase = outb + blk_off(seq * SEQL, cbase, NTOK);                                                           \
                   \
        f32x4 cwv[2][4];                                                                                                   \
        _Pragma("unroll") for (int n = 0; n < 2; ++n) {                                                                    \
          const int c = n * DFF + cbase;                                                                                   \
          cwv[n][0] = *(const f32x4*)(cw + c); cwv[n][1] = *(const f32x4*)(cw + 5632 + c);                                 \
          cwv[n][2] = *(const f32x4*)(cw + 2 * 5632 + c); cwv[n][3] = *(const f32x4*)(cb + c);                             \
        }                                                                                                                  \
        up_epi_row<0, NN>(acc, cwv, lane_e, fr_e, s0, obase); up_epi_row<1, NN>(acc, cwv, lane_e, fr_e, s0, obase);          \
        up_epi_row<2, NN>(acc, cwv, lane_e, fr_e, s0, obase); up_epi_row<3, NN>(acc, cwv, lane_e, fr_e, s0, obase);          \
        up_epi_row<4, NN>(acc, cwv, lane_e, fr_e, s0, obase); up_epi_row<5, NN>(acc, cwv, lane_e, fr_e, s0, obase);          \
        up_epi_row<6, NN>(acc, cwv, lane_e, fr_e, s0, obase); up_epi_row<7, NN>(acc, cwv, lane_e, fr_e, s0, obase);          \
      }
      UP_EPI_NN(0)
      UP_EPI_NN(1)
#undef UP_EPI_NN
    }
    asm volatile("s_waitcnt vmcnt(0)" ::: "memory");
  }
#undef GEMM_LOAD
#undef GEMM_WRITE
#undef GEMM_KSTEP
#undef GEMM_PTRS
}

struct AttnArgs {
  int qbase, qstride, qpos0;
  int ktokbase, ktokstep, kstride, kposbase, kposstep, ntiles;
  int qcol, kcol, vcol, ocol;
  const float *gq, *gk;
  float qscale;
  int hw, rmul, taboff0;
  float sinkv;
  float lam, outscale;
  const float* subg;
  int lsecol;
  float cshift;
  int r0, rs0;
};

template <int NQ, int NC, int MODE>
__device__ __forceinline__ void attn_item(const Params& p, const AttnArgs& a, bf16_t* Ks, bf16_t* Vts, const float* tab) {
  const int tid = opaque_tid(), lane = tid & 63, w = tid >> 6, fr = lane & 15, fq = lane >> 4;
  const int wq0 = a.qpos0 + w * 16 * NQ;
  const int lch = tid & 7;
  const int ntl = a.ntiles;
  u32x4 kA, vA, kB, vB;
  const int kkey = tid >> 3, vkey = tid & 63, vch = tid >> 6;
#define ATTN_PREFETCH(T, KR, VR)                                                                                 \
  {                                                                                                              \
    const int ktok0_ = a.ktokbase + (T) * a.ktokstep;                                                            \
    KR = *(const u32x4*)(p.proj + (size_t)(ktok0_ + kkey * a.kstride) * PW + a.kcol + lch * 8);                   \
    VR = *(const u32x4*)(p.proj + (size_t)(ktok0_ + vkey * a.kstride) * PW + a.vcol + vch * 8);                   \
  }
  ATTN_PREFETCH(0, kA, vA)
  if (ntl > 1) ATTN_PREFETCH(1, kB, vB)
  bf16x8 qf[NQ][2];
  int qpos[NQ];
#pragma unroll
  for (int qt = 0; qt < NQ; ++qt) {
    const int qp = wq0 + qt * 16 + fr;
    qpos[qt] = qp;
    const bf16_t* qrow = p.proj + (size_t)(a.qbase + qp * a.qstride) * PW + a.qcol;
    const u32x4 v0 = *(const u32x4*)(qrow + fq * 8), v1 = *(const u32x4*)(qrow + 32 + fq * 8);
    float f0[8], f1[8];
#pragma unroll
    for (int i = 0; i < 4; ++i) { f0[2 * i] = bf_lo(v0[i]); f0[2 * i + 1] = bf_hi(v0[i]); f1[2 * i] = bf_lo(v1[i]); f1[2 * i + 1] = bf_hi(v1[i]); }
    float s0 = 0.f, s1 = 0.f;
#pragma unroll
    for (int i = 0; i < 8; ++i) { s0 += f0[i] * f0[i]; s1 += f1[i] * f1[i]; }
    float r0, r1;
    if (NC == 1) {
      float s = s0 + s1; s += __shfl_xor(s, 16); s += __shfl_xor(s, 32);
      r0 = r1 = rsqrtf(s * (1.f / 64.f) + 1e-6f) * a.qscale;
    } else {
      s0 += __shfl_xor(s0, 16); s0 += __shfl_xor(s0, 32);
      s1 += __shfl_xor(s1, 16); s1 += __shfl_xor(s1, 32);
      r0 = rsqrtf(s0 * (1.f / 32.f) + 1e-6f) * a.qscale; r1 = rsqrtf(s1 * (1.f / 32.f) + 1e-6f) * a.qscale;
    }
    const float* g0p = a.gq + fq * 8;
    const float* g1p = (NC == 1) ? a.gq + 32 + fq * 8 : g0p;
    u32x4 q0, q1;
#pragma unroll
    for (int i = 0; i < 4; ++i) {
      q0[i] = pk_bf16(f0[2 * i] * r0 * g0p[2 * i], f0[2 * i + 1] * r0 * g0p[2 * i + 1]);
      q1[i] = pk_bf16(f1[2 * i] * r1 * g1p[2 * i], f1[2 * i + 1] * r1 * g1p[2 * i + 1]);
    }
    qf[qt][0] = __builtin_bit_cast(bf16x8, q0);
    qf[qt][1] = __builtin_bit_cast(bf16x8, q1);
  }
  f32x4 o[NC][NQ][4];
  float mrun[NC][NQ];
  f32x4 lsum[NC][NQ];
  const bf16x8 ones = {0x3F80, 0x3F80, 0x3F80, 0x3F80, 0x3F80, 0x3F80, 0x3F80, 0x3F80};
#pragma unroll
  for (int c = 0; c < NC; ++c)
#pragma unroll
    for (int qt = 0; qt < NQ; ++qt) {
      mrun[c][qt] = a.cshift;
      const float l0 = (MODE == 1) ? fexp2(a.sinkv - a.cshift) : 0.f;
      lsum[c][qt] = (f32x4){l0, l0, l0, l0};
#pragma unroll
      for (int dt = 0; dt < 4; ++dt) o[c][qt][dt] = (f32x4){0.f, 0.f, 0.f, 0.f};
    }
  float gkv[8];
#pragma unroll
  for (int i = 0; i < 8; ++i) gkv[i] = a.gk[((NC == 1) ? lch : (lch & 3)) * 8 + i];

  const int rw = a.r0 + ((w * 16 * NQ) >> 6);
  int rsw = rw - 4; rsw = rsw < 0 ? 0 : (rsw > 24 ? 24 : rsw);
  auto stage_write = [&](const u32x4& kr, const u32x4& vr, bf16_t* Ksb, bf16_t* Vtb) __attribute__((always_inline)) {
    float f[8];
#pragma unroll
    for (int i = 0; i < 4; ++i) { f[2 * i] = bf_lo(kr[i]); f[2 * i + 1] = bf_hi(kr[i]); }
    float s = 0.f;
#pragma unroll
    for (int i = 0; i < 8; ++i) s += f[i] * f[i];
    s += __shfl_xor(s, 1); s += __shfl_xor(s, 2);
    float rs;
    if (NC == 1) { s += __shfl_xor(s, 4); rs = rsqrtf(s * (1.f / 64.f) + 1e-6f); }
    else rs = rsqrtf(s * (1.f / 32.f) + 1e-6f);
    u32x4 kq;
#pragma unroll
    for (int i = 0; i < 4; ++i) kq[i] = pk_bf16(f[2 * i] * rs * gkv[2 * i], f[2 * i + 1] * rs * gkv[2 * i + 1]);
    *(u32x4*)(Ksb + kkey * LDSROW + lch * 8) = kq;
#pragma unroll
    for (int i = 0; i < 4; ++i) {
      const int d0 = vch * 8 + 2 * i, d1 = d0 + 1;
      const int s0 = (d0 & ~31) | (16 * ((d0 >> 2) & 1) + 4 * ((d0 & 31) >> 3) + (d0 & 3)), s1 = (d1 & ~31) | (16 * ((d1 >> 2) & 1) + 4 * ((d1 & 31) >> 3) + (d1 & 3));
      Vtb[s0 * LDSROW + vkey] = (bf16_t)(vr[i] & 0xffffu);
      Vtb[s1 * LDSROW + vkey] = (bf16_t)(vr[i] >> 16);
    }
  };
  auto tile_math = [&](int t, const bf16_t* Ksb, const bf16_t* Vtb) __attribute__((always_inline)) {
    if (MODE == 0) { const int kr_ = a.rs0 + t; if (kr_ < rsw || kr_ >= rsw + 8) return; }
    const int kp0 = a.kposbase + t * a.kposstep;
    const int taboff = (a.rs0 + t - rw + 7) * 31;
    bf16x8 pf[NC][NQ][2];
    bf16x8 kf[4][2];
#pragma unroll
    for (int kt = 0; kt < 4; ++kt) {
      kf[kt][0] = *(const bf16x8*)(Ksb + (kt * 16 + fr) * LDSROW + fq * 8);
      kf[kt][1] = *(const bf16x8*)(Ksb + (kt * 16 + fr) * LDSROW + 32 + fq * 8);
    }
    bf16x8 vfr[4][2];
#pragma unroll
    for (int ks = 0; ks < 2; ++ks)
#pragma unroll
      for (int dt = 0; dt < 4; ++dt) {
        const u32x2 lo = *(const u32x2*)(Vtb + (dt * 16 + fr) * LDSROW + ks * 32 + 4 * fq);
        const u32x2 hi = *(const u32x2*)(Vtb + (dt * 16 + fr) * LDSROW + ks * 32 + 16 + 4 * fq);
        u32x4 vv; vv[0] = lo[0]; vv[1] = lo[1]; vv[2] = hi[0]; vv[3] = hi[1];
        vfr[dt][ks] = __builtin_bit_cast(bf16x8, vv);
      }
#pragma unroll
    for (int qt = 0; qt < NQ; ++qt) {
      const int qp = (MODE == 0) ? (qpos[qt] & 63) : qpos[qt];
      int cs = qp - 8; cs = cs < 0 ? 0 : (cs > 48 ? 48 : cs);
      f32x4 bv[4];
      const bool far_hi = (MODE == 3) && (kp0 - (wq0 + 16 * NQ - 1) >= 128), far_lo = (MODE == 3) && (wq0 - (kp0 + 63) >= 128);
      if (far_hi || far_lo) {
        const float bu = tab[far_hi ? (DT_OFF + 256) : (DT_OFF - 256)];
#pragma unroll
        for (int kt = 0; kt < 4; ++kt) bv[kt] = (f32x4){bu, bu, bu, bu};
      } else if (MODE != 0) {
        const float* tb = tab + (kp0 - qp + 4 * fq + DT_OFF);
#pragma unroll
        for (int kt = 0; kt < 4; ++kt)
#pragma unroll
          for (int j = 0; j < 4; ++j) bv[kt][j] = tb[kt * 16 + j];
      } else
#pragma unroll
      for (int kt = 0; kt < 4; ++kt)
#pragma unroll
        for (int j = 0; j < 4; ++j) {
          const int kpos = kp0 + kt * 16 + 4 * fq + j;
          const int d = kpos - qp;
          const bool valid = kpos >= cs && kpos < cs + 16;
          int dd = d + 15; dd = dd < 0 ? 0 : (dd > 30 ? 30 : dd);
          const float bias = tab[taboff + dd];
          bv[kt][j] = valid ? bias : -INFINITY;
        }
#pragma unroll
      for (int c = 0; c < NC; ++c) {
        f32x4 s[4];
#pragma unroll
        for (int kt = 0; kt < 4; ++kt) {
          if (NC == 1) {
            const f32x4 r = __builtin_amdgcn_mfma_f32_16x16x32_bf16(kf[kt][0], qf[qt][0], bv[kt], 0, 0, 0);
            s[kt] = __builtin_amdgcn_mfma_f32_16x16x32_bf16(kf[kt][1], qf[qt][1], r, 0, 0, 0);
          } else {
            s[kt] = __builtin_amdgcn_mfma_f32_16x16x32_bf16(kf[kt][c], qf[qt][c], bv[kt], 0, 0, 0);
          }
        }
#pragma unroll
        for (int kt = 0; kt < 4; ++kt)
#pragma unroll
          for (int j = 0; j < 4; ++j) s[kt][j] = fexp2(s[kt][j]);
#pragma unroll
        for (int ks = 0; ks < 2; ++ks) {
          u32x4 pk;
          pk[0] = pk_bf16(s[2 * ks][0], s[2 * ks][1]); pk[1] = pk_bf16(s[2 * ks][2], s[2 * ks][3]);
          pk[2] = pk_bf16(s[2 * ks + 1][0], s[2 * ks + 1][1]); pk[3] = pk_bf16(s[2 * ks + 1][2], s[2 * ks + 1][3]);
          pf[c][qt][ks] = __builtin_bit_cast(bf16x8, pk);
        }
      }
    }
#pragma unroll
    for (int ks = 0; ks < 2; ++ks) {
#pragma unroll
      for (int dt = 0; dt < 4; ++dt) {
        const bf16x8 vf = vfr[dt][ks];
#pragma unroll
        for (int c = 0; c < NC; ++c)
#pragma unroll
          for (int qt = 0; qt < NQ; ++qt) o[c][qt][dt] = __builtin_amdgcn_mfma_f32_16x16x32_bf16(vf, pf[c][qt][ks], o[c][qt][dt], 0, 0, 0);
      }
#pragma unroll
      for (int c = 0; c < NC; ++c)
#pragma unroll
        for (int qt = 0; qt < NQ; ++qt) lsum[c][qt] = __builtin_amdgcn_mfma_f32_16x16x32_bf16(ones, pf[c][qt][ks], lsum[c][qt], 0, 0, 0);
    }
    };
  bf16_t* const Ks1 = Ks + 2 * 64 * LDSROW;
  bf16_t* const Vts1 = Vts + 2 * 64 * LDSROW;
  stage_write(kA, vA, Ks, Vts);
  if (ntl > 2) ATTN_PREFETCH(2, kA, vA)
  for (int t = 0; t < ntl; t += 2) {
    __syncthreads();
    if (t + 1 < ntl) { stage_write(kB, vB, Ks1, Vts1); if (t + 3 < ntl) ATTN_PREFETCH(t + 3, kB, vB) }
    tile_math(t, Ks, Vts);
    if (t + 1 < ntl) {
      __syncthreads();
      if (t + 2 < ntl) { stage_write(kA, vA, Ks, Vts); if (t + 4 < ntl) ATTN_PREFETCH(t + 4, kA, vA) }
      tile_math(t + 1, Ks1, Vts1);
    }
  }
#undef ATTN_PREFETCH
#pragma unroll
  for (int qt = 0; qt < NQ; ++qt) {
    float inv[NC], ltot[NC];
#pragma unroll
    for (int c = 0; c < NC; ++c) {
      const float lt = lsum[c][qt][0];
      ltot[c] = lt; inv[c] = 1.f / lt;
    }
    const int tok = a.qbase + qpos[qt] * a.qstride;
    if (MODE == 3) {
      f32x4 v[4];
      float ss = 0.f;
#pragma unroll
      for (int dt = 0; dt < 4; ++dt)
#pragma unroll
        for (int j = 0; j < 4; ++j) {
          const float x = o[0][qt][dt][j] * inv[0] - a.lam * (o[NC - 1][qt][dt][j] * inv[NC - 1]);
          v[dt][j] = x; ss += x * x;
        }
      ss += __shfl_xor(ss, 16); ss += __shfl_xor(ss, 32);
      const float rstd = rsqrtf(ss * (1.f / 64.f) + 1e-6f) * a.outscale;
#pragma unroll
      for (int q = 0; q < 2; ++q) {
        const f32x4 g0 = *(const f32x4*)(a.subg + 32 * q + 8 * fq), g1 = *(const f32x4*)(a.subg + 32 * q + 8 * fq + 4);
        u32x4 ov;
        ov[0] = pk_bf16(v[2 * q][0] * rstd * g0[0], v[2 * q][1] * rstd * g0[1]); ov[1] = pk_bf16(v[2 * q][2] * rstd * g0[2], v[2 * q][3] * rstd * g0[3]);
        ov[2] = pk_bf16(v[2 * q + 1][0] * rstd * g1[0], v[2 * q + 1][1] * rstd * g1[1]); ov[3] = pk_bf16(v[2 * q + 1][2] * rstd * g1[2], v[2 * q + 1][3] * rstd * g1[3]);
        *(u32x4*)(p.hbuf + blk_off(tok, a.ocol + 32 * q + 8 * fq, NTOK)) = ov;
      }
    } else {
#pragma unroll
      for (int q = 0; q < 2; ++q) {
        u32x4 ov;
        ov[0] = pk_bf16(o[0][qt][2 * q][0] * inv[0], o[0][qt][2 * q][1] * inv[0]); ov[1] = pk_bf16(o[0][qt][2 * q][2] * inv[0], o[0][qt][2 * q][3] * inv[0]);
        ov[2] = pk_bf16(o[0][qt][2 * q + 1][0] * inv[0], o[0][qt][2 * q + 1][1] * inv[0]); ov[3] = pk_bf16(o[0][qt][2 * q + 1][2] * inv[0], o[0][qt][2 * q + 1][3] * inv[0]);
        *(u32x4*)(p.hbuf + blk_off(tok, a.ocol + 32 * q + 8 * fq, NTOK)) = ov;
      }
      if (MODE == 2 && fq == 0) p.lse[(size_t)tok * 6 + a.lsecol] = (mrun[0][qt] + __log2f(ltot[0])) * LN2;
    }
  }
}

__device__ __forceinline__ void attn_phase(const Params& p, int l, char* smem) {
  bf16_t* Ks = (bf16_t*)smem;
  bf16_t* Vts = Ks + 64 * LDSROW;
  float* tab = (float*)(Ks + 4 * 64 * LDSROW);
  const int tid = opaque_tid();
  const int nD = 3072, nA = 3072, nB = 3072, nC = 4608;
  for (int item = blockIdx.x; item < nD + nA + nB + nC; item += gridDim.x) {
    AttnArgs a;
    a.taboff0 = 0; a.r0 = 0; a.rs0 = 0; a.sinkv = 0.f; a.cshift = 0.f; a.lam = 0.f; a.outscale = 1.f; a.subg = nullptr; a.lsecol = 0; a.hw = 1 << 20; a.rmul = 1;
    __syncthreads();
    if (item < nD) {
      const int b = item >> 6, h = (item >> 4) & 3, qb = item & 15;
      a.cshift = p.lam[4 + l * 4 + 3];
      for (int i = tid; i < DT_N; i += NTHR) { int dd = i - DT_OFF; dd = dd < -128 ? -128 : (dd > 128 ? 128 : dd); tab[i] = p.lut[(10 + h) * 257 + dd + 128] - a.cshift; }
      a.qbase = b * SEQL; a.qstride = 1; a.qpos0 = qb * 128;
      a.ktokbase = b * SEQL; a.ktokstep = 64; a.kstride = 1; a.kposbase = 0; a.kposstep = 64; a.ntiles = 32;
      a.qcol = 2432 + h * 64; a.kcol = 2432 + 256 + h * 64; a.vcol = 2432 + 512 + h * 64; a.ocol = 896 + h * 64;
      a.gq = p.qkn_d + l * 64; a.gk = a.gq + 32;
      a.qscale = 0.17677669529663687f * LOG2E;
      a.lam = p.lam[l]; a.outscale = 1.f - (0.8f - 0.6f * expf(-0.3f * (float)l)); a.subg = p.subln_d + l * 64;
      attn_item<1, 2, 3>(p, a, Ks, Vts, tab);
    } else if (item < nD + nA) {
      const int id = item - nD;
      const int b = id >> 6, h = (id >> 4) & 3, r = (id & 15) * 2;
      const float* rp = p.rpb_a + ((size_t)l * 4 + h) * 465;
      a.cshift = p.lam[4 + l * 4 + 0];
      for (int i = tid; i < 465; i += NTHR) tab[i] = rp[i] * LOG2E - a.cshift;
      int rs = r - 4; rs = rs < 0 ? 0 : (rs > 24 ? 24 : rs);
      int rs1 = r - 3; rs1 = rs1 < 0 ? 0 : (rs1 > 24 ? 24 : rs1);
      a.qbase = b * SEQL + r * 64; a.qstride = 1; a.qpos0 = 0; a.r0 = r; a.rs0 = rs;
      a.ktokbase = b * SEQL + rs * 64; a.ktokstep = 64; a.kstride = 1; a.kposbase = 0; a.kposstep = 0; a.ntiles = rs1 - rs + 8;
      a.qcol = h * 64; a.kcol = 256 + h * 64; a.vcol = 512 + h * 64; a.ocol = h * 64;
      a.gq = p.qkn_a + l * 128; a.gk = a.gq + 64;
      a.qscale = 0.125f * LOG2E;
      attn_item<1, 1, 0>(p, a, Ks, Vts, tab);
    } else if (item < nD + nA + nB) {
      const int id = item - nD - nA;
      const int b = id >> 6, h = (id >> 4) & 3, qb = id & 15;
      a.cshift = p.lam[4 + l * 4 + 1];
      for (int i = tid; i < DT_N; i += NTHR) { const int d = i - DT_OFF; tab[i] = (d >= -128 && d <= 128) ? p.lut[h * 257 + d + 128] - a.cshift : -INFINITY; }
      const int q0 = qb * 128;
      const int kstart = q0 - 128 < 0 ? 0 : q0 - 128, kend = q0 + 256 > SEQL ? SEQL : q0 + 256;
      a.qbase = b * SEQL; a.qstride = 1; a.qpos0 = q0;
      a.ktokbase = b * SEQL + kstart; a.ktokstep = 64; a.kstride = 1; a.kposbase = kstart; a.kposstep = 64; a.ntiles = (kend - kstart) >> 6;
      a.qcol = 768 + h * 64; a.kcol = 768 + 256 + (h >> 1) * 64; a.vcol = 768 + 384 + (h >> 1) * 64; a.ocol = 256 + h * 64;
      a.gq = p.qkn_b + l * 128; a.gk = a.gq + 64;
      a.qscale = 0.125f * LOG2E;
      a.hw = 128; a.rmul = 1; a.sinkv = p.sink_b[l * 4 + h] * LOG2E;
      attn_item<1, 1, 1>(p, a, Ks, Vts, tab);
    } else {
      const int id = item - nD - nA - nB;
      const int b = id / 96, rem = id % 96, g = rem >> 5, i2 = (rem >> 4) & 1, blk = rem & 15;
      const int r = g == 0 ? 1 : (g == 1 ? 4 : 16);
      const int L = SEQL / r, bps = L >> 7;
      const int pp = blk / bps, m0 = (blk % bps) * 128;
      const int hh = g * 2 + i2;
      a.cshift = p.lam[4 + l * 4 + 2];
      for (int i = tid; i < DT_N; i += NTHR) { const int d = i - DT_OFF; int dd = d * r; dd = dd < -128 ? -128 : (dd > 128 ? 128 : dd);
        tab[i] = (d >= -64 && d <= 64) ? p.lut[(4 + hh) * 257 + dd + 128] - a.cshift : -INFINITY; }
      const int kstart = m0 - 64 < 0 ? 0 : m0 - 64, kend = m0 + 192 > L ? L : m0 + 192;
      a.qbase = b * SEQL + pp; a.qstride = r; a.qpos0 = m0;
      a.ktokbase = a.qbase + kstart * r; a.ktokstep = 64 * r; a.kstride = r; a.kposbase = kstart; a.kposstep = 64; a.ntiles = (kend - kstart) >> 6;
      a.qcol = 1280 + hh * 64; a.kcol = 1280 + 384 + hh * 64; a.vcol = 1280 + 768 + hh * 64; a.ocol = 512 + hh * 64;
      a.gq = p.qkn_c + l * 128; a.gk = a.gq + 64;
      a.qscale = 0.125f * LOG2E;
      a.hw = 64; a.rmul = r; a.lsecol = hh;
      attn_item<1, 1, 2>(p, a, Ks, Vts, tab);
    }
  }
}

__device__ __forceinline__ void combine_phase(const Params& p) {
  const int nthr = gridDim.x * NTHR;
  for (int i = blockIdx.x * NTHR + opaque_tid(); i < NTOK * 48; i += nthr) {
    const int tok = i / 48, rem = i % 48, hh = rem >> 3, ch = rem & 7, ii = hh & 1, g = hh >> 1;
    const float* ls = p.lse + (size_t)tok * 6;
    const float l0 = ls[ii], l1 = ls[2 + ii], l2 = ls[4 + ii];
    const float mx = fmaxf(l0, fmaxf(l1, l2));
    const float e0 = __expf(l0 - mx), e1 = __expf(l1 - mx), e2 = __expf(l2 - mx);
    const float al = (g == 0 ? e0 : (g == 1 ? e1 : e2)) / (e0 + e1 + e2);
    bf16_t* ptr = p.hbuf + blk_off(tok, 512 + hh * 64 + ch * 8, NTOK);
    u32x4 v = *(const u32x4*)ptr;
#pragma unroll
    for (int k = 0; k < 4; ++k) v[k] = pk_bf16(bf_lo(v[k]) * al, bf_hi(v[k]) * al);
    *(u32x4*)ptr = v;
  }
}


#ifndef REP_GEMM
#define REP_GEMM 1
#endif
#ifndef REP_ATTN
#define REP_ATTN 1
#endif
#ifndef DBG_STOP
#define DBG_STOP 0
#endif
__global__ void __launch_bounds__(NTHR, 2) fwd_megakernel(Params p) {
  extern __shared__ __attribute__((aligned(16))) char smem[];
  cg::grid_group grid = cg::this_grid();
  prologue_phase(p, smem);
  grid.sync();
#define LAYER(L)                                                                                                   \
  {                                                                                                                \
    constexpr int l = (L);                                                                                         \
    constexpr bool first = (l == 0);                                                                               \
    const bf16_t* wt = p.wt + (size_t)l * WT_LAYER;                                                                \
    norm_phase(p, l, first, p.norm_attn_g + l * DM, 0, 1024);                                                      \
    grid.sync();                                                                                                   \
    gemm_phase<0>(p, l, false, p.hbuf, 3200, wt + WT_IN, 1024, 384, 13, 13, p.proj, PW, 0, smem);                  \
    grid.sync();                                                                                                   \
    attn_phase(p, l, smem);                                                                                        \
    grid.sync();                                                                                                   \
    combine_phase(p);                                                                                              \
    grid.sync();                                                                                                   \
    gemm_phase<1>(p, l, first, p.hbuf, 1024, wt + WT_OUT, 1152, 384, 4, 4, nullptr, 0, 2048, smem);                \
    grid.sync();                                                                                                   \
    norm_phase(p, l, false, p.norm_ffn_g + l * DM, 3072, 4096);                                                    \
    grid.sync();                                                                                                   \
    gemm_phase<2>(p, l, false, p.hbuf, 5632, wt + WT_UP, 1024, 408, 22, 22, p.proj, DFF, 0, smem);                 \
    grid.sync();                                                                                                   \
    gemm_phase<1>(p, l, false, p.proj, 1024, wt + WT_DOWN, 2816, 384, 4, 4, nullptr, 0, 5120, smem);               \
    grid.sync();                                                                                                   \
  }
  LAYER(0)
  LAYER(1)
  LAYER(2)
  LAYER(3)
#undef LAYER
}

extern "C" void kernel_launch(void* const* d_in, const int* in_sizes, int n_in, void* d_out, int out_size, void* d_ws, size_t ws_size,
                              hipStream_t stream) {
  static int grid_blocks = 0;
  if (!grid_blocks) {
    int dev = 0, cus = 0, per_cu = 0;
    hipGetDevice(&dev);
    hipDeviceGetAttribute(&cus, hipDeviceAttributeMultiprocessorCount, dev);
    hipFuncSetAttribute((const void*)fwd_megakernel, hipFuncAttributeMaxDynamicSharedMemorySize, SMEM_BYTES);
    hipOccupancyMaxActiveBlocksPerMultiprocessor(&per_cu, fwd_megakernel, NTHR, SMEM_BYTES);
    if (per_cu > 1) per_cu = 1;
    if (per_cu < 1) per_cu = 1;
    grid_blocks = cus * per_cu;
  }
  Params p{};
  const float* const* in = (const float* const*)d_in;
  p.x_prompt = in[0]; p.x_sample = in[1]; p.c_prompt = in[2]; p.c_sample = in[3]; p.norm_attn_g = in[4]; p.norm_ffn_g = in[5];
  p.w_ada = in[6]; p.b_ada = in[7]; p.w_in = in[8]; p.qkn_a = in[9]; p.qkn_b = in[10]; p.qkn_c = in[11]; p.qkn_d = in[12];
  p.rpb_a = in[13]; p.sink_b = in[14]; p.t5_table = in[15]; p.lam_d = in[16]; p.subln_d = in[17]; p.w_out = in[18]; p.w_up = in[19];
  p.conv_w = in[20]; p.conv_b = in[21]; p.w_down = in[22];
  p.out = (float*)d_out;
  char* ws = (char*)d_ws;
  size_t off = 0;
  p.wt = (bf16_t*)(ws + off); off += (size_t)4 * WT_LAYER * 2;
  p.mod = (float*)(ws + off); off += (size_t)4 * 48 * 6144 * 4;
  p.lut = (float*)(ws + off); off += 16384;
  p.lam = (float*)(ws + off); off += 256;
  p.zeros = (float*)(ws + off); off += 256;
  p.lse = (float*)(ws + off); off += (size_t)NTOK * 6 * 4;
  p.proj = (bf16_t*)(ws + off); off += (size_t)NTOK * PW * 2;
  p.hbuf = (bf16_t*)(ws + off); off += (size_t)NTOK * MW * 2;
  if (off > ws_size) { fprintf(stderr, "workspace too small: need %zu have %zu\n", off, ws_size); return; }
  void* args[] = {&p};
  hipError_t e = hipLaunchCooperativeKernel((void*)fwd_megakernel, dim3(grid_blocks), dim3(NTHR), args, SMEM_BYTES, stream);
  if (e != hipSuccess) fprintf(stderr, "cooperative launch failed: %s (grid %d)\n", hipGetErrorString(e), grid_blocks);
}
```

```cpp
#include <hip/hip_runtime.h>
#include <hip/hip_cooperative_groups.h>
#include <cstdint>
#include <cstdio>
namespace cg = cooperative_groups;

typedef unsigned short bf16_t;
typedef short bf16x8 __attribute__((ext_vector_type(8)));
typedef float f32x4 __attribute__((ext_vector_type(4)));
typedef unsigned u32x4 __attribute__((ext_vector_type(4)));
typedef unsigned u32x2 __attribute__((ext_vector_type(2)));

#define NTOK 98304
#define DM 1024
#define PW 3200
#define MW 1152
#define DFF 2816
#define NSEQ 48
#define SEQL 2048
#define LOG2E 1.4426950408889634f
#define LN2 0.6931471805599453f
#define LDSROW 72
#define DT_OFF 320
#define DT_N 641
#define NTHR 512
#define NWAVE 8

struct Params {
  const float *x_prompt, *x_sample, *c_prompt, *c_sample, *norm_attn_g, *norm_ffn_g, *w_ada, *b_ada, *w_in;
  const float *qkn_a, *qkn_b, *qkn_c, *qkn_d, *rpb_a, *sink_b, *t5_table, *lam_d, *subln_d, *w_out, *w_up, *conv_w, *conv_b, *w_down;
  float* out;
  bf16_t* wt; float* mod; float* lut; float* lam; float* lse; bf16_t* proj; bf16_t* hbuf; float* zeros;
};

#define WT_IN 0
#define WT_OUT (3200 * 1024)
#define WT_UP (WT_OUT + 1024 * 1152)
#define WT_DOWN (WT_UP + 5632 * 1024)
#define WT_LAYER (WT_DOWN + 1024 * 2816)

typedef __bf16 bf16x2_t __attribute__((ext_vector_type(2)));
typedef float f32x2_t __attribute__((ext_vector_type(2)));
__device__ __forceinline__ unsigned pk_bf16(float lo, float hi) {
  const f32x2_t v = {lo, hi};
  const bf16x2_t r = __builtin_convertvector(v, bf16x2_t);
  return __builtin_bit_cast(unsigned, r);
}
__device__ __forceinline__ float bf_lo(unsigned u) { return __uint_as_float(u << 16); }
__device__ __forceinline__ float bf_hi(unsigned u) { return __uint_as_float(u & 0xffff0000u); }
__device__ __forceinline__ float fexp2(float x) { return __builtin_amdgcn_exp2f(x); }

__device__ __forceinline__ const float* xin_row(const Params& p, bool first, int tok) {
  if (first) return tok < 65536 ? p.x_prompt + (size_t)tok * DM : p.x_sample + (size_t)(tok - 65536) * DM;
  return p.out + (size_t)tok * DM;
}

__device__ __forceinline__ int opaque_tid() { int t = threadIdx.x; asm volatile("" : "+v"(t)); return t; }

__device__ __forceinline__ size_t blk_off(int r, int k, int R) { return ((size_t)(k >> 5) * R + r) * 32 + (k & 31); }

__device__ __forceinline__ int t5_bucket(int rel) {
  const int n = rel < 0 ? -rel : rel;
  int v;
  if (n < 8) v = n;
  else v = 8 + (n >= 12) + (n >= 16) + (n >= 23) + (n >= 32) + (n >= 46) + (n >= 64) + (n >= 91);
  return (rel > 0 ? 16 : 0) + v;
}

__device__ __forceinline__ void prologue_phase(const Params& p, char* smem) {
  const int tid = opaque_tid(), nb = gridDim.x;
  const int N_TR = 4 * 3200, N_MOD = 192;
  for (int item = blockIdx.x; item < N_TR + N_MOD + 1; item += nb) {
    if (item < N_TR) {
      const int l = item / 3200; int r = item % 3200;
      const float* src; bf16_t* dst; int K, N, kt, nt;
      if (r < 800) { K = 1024; N = 3200; src = p.w_in + (size_t)l * K * N; dst = p.wt + (size_t)l * WT_LAYER + WT_IN; kt = r / 50; nt = r % 50; }
      else if (r < 1088) { r -= 800; K = 1152; N = 1024; src = p.w_out + (size_t)l * K * N; dst = p.wt + (size_t)l * WT_LAYER + WT_OUT; kt = r / 16; nt = r % 16; }
      else if (r < 2496) { r -= 1088; K = 1024; N = 5632; src = p.w_up + (size_t)l * K * N; dst = p.wt + (size_t)l * WT_LAYER + WT_UP; kt = r / 88; nt = r % 88; }
      else { r -= 2496; K = 2816; N = 1024; src = p.w_down + (size_t)l * K * N; dst = p.wt + (size_t)l * WT_LAYER + WT_DOWN; kt = r / 16; nt = r % 16; }
      float* tile = (float*)smem;
      const int k0 = kt * 64, n0 = nt * 64;
      __syncthreads();
#pragma unroll
      for (int i = 0; i < 8; ++i) {
        const int rr = (tid >> 6) + 8 * i, cc = tid & 63;
        tile[rr * 65 + cc] = src[(size_t)(k0 + rr) * N + n0 + cc];
      }
      __syncthreads();
#pragma unroll
      for (int i = 0; i < 4; ++i) {
        const int idx = tid + NTHR * i, n = idx >> 5, k2 = (idx & 31) * 2;
        *(unsigned*)(dst + blk_off(n0 + n, k0 + k2, N)) = pk_bf16(tile[k2 * 65 + n], tile[(k2 + 1) * 65 + n]);
      }
    } else if (item < N_TR + N_MOD) {
      int r = item - N_TR;
      const int l = r / 48; r %= 48;
      const int nc = r / 4, bg = r % 4;
      const int n = nc * NTHR + tid;
      float* sc = (float*)smem;
      float acc[12];
#pragma unroll
      for (int j = 0; j < 12; ++j) acc[j] = 0.f;
      const float* W = p.w_ada + (size_t)l * 1024 * 6144 + n;
      for (int kc = 0; kc < 2; ++kc) {
        __syncthreads();
        for (int i = tid; i < 12 * 512; i += NTHR) {
          const int j = i >> 9, k = i & 511, b = bg * 12 + j;
          const float c = b < 32 ? p.c_prompt[b * 1024 + kc * 512 + k] : p.c_sample[(b - 32) * 1024 + kc * 512 + k];
          sc[i] = c / (1.f + __expf(-c));
        }
        __syncthreads();
#pragma unroll 8
        for (int k = 0; k < 512; k += 4) {
          const float w0 = W[(size_t)(kc * 512 + k) * 6144], w1 = W[(size_t)(kc * 512 + k + 1) * 6144];
          const float w2 = W[(size_t)(kc * 512 + k + 2) * 6144], w3 = W[(size_t)(kc * 512 + k + 3) * 6144];
#pragma unroll
          for (int j = 0; j < 12; ++j) {
            const f32x4 s = *(const f32x4*)(sc + j * 512 + k);
            acc[j] += s[0] * w0 + s[1] * w1 + s[2] * w2 + s[3] * w3;
          }
        }
      }
      const float bias = p.b_ada[l * 6144 + n];
#pragma unroll
      for (int j = 0; j < 12; ++j) p.mod[((size_t)l * 48 + bg * 12 + j) * 6144 + n] = acc[j] + bias;
    } else {
      for (int i = tid; i < 14 * 257; i += NTHR) {
        const int hd = i / 257, idx = i % 257;
        p.lut[i] = p.t5_table[t5_bucket(idx - 128) * 14 + hd] * LOG2E;
      }
      if (tid < 64) p.zeros[tid] = 0.f;
      if (tid < 4) {
        const float* lp = p.lam_d + tid * 128;
        float s1 = 0.f, s2 = 0.f;
        for (int e = 0; e < 32; ++e) { s1 += lp[e] * lp[32 + e]; s2 += lp[64 + e] * lp[96 + e]; }
        const float li = 0.8f - 0.6f * expf(-0.3f * (float)tid);
        p.lam[tid] = expf(s1) - expf(s2) + li;
      }
      {
        const int pr = tid >> 5, ln = tid & 31, l = pr >> 2, m = pr & 3;
        const float* g = m == 0 ? p.qkn_a + l * 128 : (m == 1 ? p.qkn_b + l * 128 : (m == 2 ? p.qkn_c + l * 128 : p.qkn_d + l * 64));
        const int dd = m == 3 ? 32 : 64;
        float gq = 0.f, gk = 0.f, bmax = 0.f;
        for (int i = ln; i < dd; i += 32) { gq = fmaxf(gq, fabsf(g[i])); gk = fmaxf(gk, fabsf(g[dd + i])); }
        if (m == 0) { const float* rp = p.rpb_a + (size_t)l * 4 * 465; for (int i = ln; i < 4 * 465; i += 32) bmax = fmaxf(bmax, rp[i]); }
        else { for (int i = ln; i < 32 * 14; i += 32) bmax = fmaxf(bmax, p.t5_table[i]); }
#pragma unroll
        for (int o = 16; o >= 1; o >>= 1) { gq = fmaxf(gq, __shfl_xor(gq, o)); gk = fmaxf(gk, __shfl_xor(gk, o)); bmax = fmaxf(bmax, __shfl_xor(bmax, o)); }
        const float scale = m == 3 ? 0.17677669529663687f : 0.125f;
        if (ln == 0) p.lam[4 + pr] = ((float)dd * gq * gk * scale + bmax) * LOG2E;
      }
    }
  }
}

__device__ __forceinline__ void norm_phase(const Params& p, int l, bool first, const float* g, int shift_off, int scale_off) {
  const int tid0 = opaque_tid();
  const int lane = tid0 & 63, w = tid0 >> 6;
  const int stride = gridDim.x * NWAVE;
  for (int row0 = blockIdx.x * NWAVE + w; row0 < NTOK; row0 += 2 * stride) {
    const int row1 = row0 + stride;
    const bool has1 = row1 < NTOK;
    const int rows[2] = {row0, has1 ? row1 : row0};
    f32x4 v[2][4];
    float ss[2] = {0.f, 0.f};
#pragma unroll
    for (int r = 0; r < 2; ++r) {
      const float* xr = xin_row(p, first, rows[r]);
#pragma unroll
      for (int i = 0; i < 4; ++i) v[r][i] = *(const f32x4*)(xr + i * 256 + lane * 4);
    }
#pragma unroll
    for (int r = 0; r < 2; ++r) {
#pragma unroll
      for (int i = 0; i < 4; ++i) ss[r] += v[r][i][0] * v[r][i][0] + v[r][i][1] * v[r][i][1] + v[r][i][2] * v[r][i][2] + v[r][i][3] * v[r][i][3];
#pragma unroll
      for (int o = 32; o >= 1; o >>= 1) ss[r] += __shfl_xor(ss[r], o);
    }
#pragma unroll
    for (int r = 0; r < 2; ++r) {
      if (r == 1 && !has1) break;
      const int row = rows[r];
      const float* md = p.mod + ((size_t)l * 48 + (row >> 11)) * 6144;
      const float rstd = rsqrtf(ss[r] * (1.f / 1024.f) + 1e-6f);
#pragma unroll
      for (int i = 0; i < 4; ++i) {
        const int k = i * 256 + lane * 4;
        const f32x4 gg = *(const f32x4*)(g + k), sc = *(const f32x4*)(md + scale_off + k), sh = *(const f32x4*)(md + shift_off + k);
        f32x4 y;
#pragma unroll
        for (int j = 0; j < 4; ++j) y[j] = (v[r][i][j] * rstd) * gg[j] * (1.f + sc[j]) + sh[j];
        u32x2 o; o[0] = pk_bf16(y[0], y[1]); o[1] = pk_bf16(y[2], y[3]);
        *(u32x2*)(p.hbuf + blk_off(row, k, NTOK)) = o;
      }
    }
  }
}

__device__ __forceinline__ bool gemm_tile_id(int it, int MT, int NT, int NB, int& mt, int& nt) {
  const int nb = gridDim.x, bid = blockIdx.x;
  if ((nb & 7) == 0) {
    const int x = bid & 7, slot = bid >> 3, S = nb >> 3;
    const int TPS = 8 * NB, NSN = NT / NB, NS = (MT / 8) * NSN;
    const int pidx = slot + S * it, sidx = pidx / TPS, w = pidx % TPS, s = x + 8 * sidx;
    if (s >= NS) return false;
    mt = (s / NSN) * 8 + (w & 7); nt = (s % NSN) * NB + (w >> 3);
    return true;
  }
  const int t = bid + nb * it;
  if (t >= MT * NT) return false;
  mt = t / NT; nt = t % NT;
  return true;
}

template <int M, int NN>
__device__ __forceinline__ void up_epi_row(const f32x4 (&acc)[8][4], const f32x4 (&cwv)[2][4], int lane, int fr, int s0, bf16_t* obase) {
  constexpr int MP = M > 0 ? M - 1 : 0, MN = M < 7 ? M + 1 : 7;
  float y[2][4];
#pragma unroll
  for (int n = 0; n < 2; ++n) {
    const f32x4 w0 = cwv[n][0], w1 = cwv[n][1], w2 = cwv[n][2], bb = cwv[n][3];
#pragma unroll
    for (int j = 0; j < 4; ++j) {
      const float cur = acc[M][NN + 2 * n][j];
      const float zp = (fr == 15) ? acc[MP][NN + 2 * n][j] : cur, zn = (fr == 0) ? acc[MN][NN + 2 * n][j] : cur;
      const float pv = __builtin_bit_cast(float, __builtin_amdgcn_update_dpp(0, __builtin_bit_cast(int, zp), 0x121, 0xf, 0xf, false));
      const float nv = __builtin_bit_cast(float, __builtin_amdgcn_update_dpp(0, __builtin_bit_cast(int, zn), 0x12F, 0xf, 0xf, false));
      y[n][j] = w0[j] * pv + w1[j] * cur + w2[j] * nv + bb[j];
    }
  }
  const int row = 16 * M + fr, tpos = s0 + row;
  if (row >= 1 && row <= 126 && tpos >= 0 && tpos < SEQL) {
    float a[4];
#pragma unroll
    for (int j = 0; j < 4; ++j) { const float gte = y[1][j]; a[j] = y[0][j] * gte / (1.f + __expf(-gte)); }
    u32x2 o; o[0] = pk_bf16(a[0], a[1]); o[1] = pk_bf16(a[2], a[3]);
    *(u32x2*)(obase + (size_t)tpos * 32) = o;
  }
  __builtin_amdgcn_sched_barrier(0);
}

#define GB_A 16384
#define GB_BUF 32768
#define NSTAGE 2
#define SMEM_BYTES (NSTAGE * GB_BUF)
template <int EPI>
__device__ __forceinline__ void gemm_phase(const Params& p, int l, bool first, const bf16_t* A, int NBROWS, const bf16_t* Bt, int K, int MT, int NT, int NB,
                           bf16_t* outb, int ldc, int gate_off, char* smem) {
  const int tid = opaque_tid(), lane = tid & 63, w = tid >> 6, wr = w >> 2, wcn = w & 3, fr = lane & 15, fq = lane >> 4;
  const int nk = K / 32;
  const int lrow = tid >> 2, lch = (tid & 3) ^ ((tid >> 4) & 3);
  const int fsw = (fq ^ ((fr >> 2) & 3)) * 16;
  const size_t apan = (size_t)NTOK * 32, bpan = (size_t)NBROWS * 32;
  const bf16_t* ga0; const bf16_t* ga1; const bf16_t* gb0;
  size_t bstr;
#define GEMM_PTRS(MT_, NT_)                                                                                                          \
  {                                                                                                                                  \
    int t_ = tid; asm volatile("" : "+v"(t_));                                                                                       \
    const int lrow_ = t_ >> 2, lch_ = (t_ & 3) ^ ((t_ >> 4) & 3);                                                                    \
    if (EPI == 2) {                                                                                                                  \
      const int wi0 = 2 * (MT_), wi1 = wi0 + 1;                                                                                      \
      const int t0 = 126 * (wi0 % 17) - 1 + lrow_, t1 = 126 * (wi1 % 17) - 1 + lrow_;                                                \
      ga0 = A + ((size_t)(wi0 / 17) * SEQL + t0) * 32 + lch_ * 8;                                                                    \
      ga1 = A + ((size_t)(wi1 / 17) * SEQL + t1) * 32 + lch_ * 8;                                                                    \
      const int rho2_ = lrow_ & 31, prow2_ = (lrow_ & ~31) | (8 * ((rho2_ & 15) >> 2) + 4 * (rho2_ >> 4) + (rho2_ & 3));              \
      gb0 = Bt + (size_t)((NT_) * 128 + prow2_) * 32 + lch_ * 8; bstr = (size_t)DFF * 32;                                            \
    } else {                                                                                                                         \
      ga0 = A + (size_t)((MT_) * 256 + lrow_) * 32 + lch_ * 8; ga1 = ga0 + (size_t)128 * 32;                                         \
      const int rho_ = lrow_ & 31, prow_ = (lrow_ & ~31) | (8 * ((rho_ & 15) >> 2) + 4 * (rho_ >> 4) + (rho_ & 3));                  \
      gb0 = Bt + (size_t)((NT_) * 256 + prow_) * 32 + lch_ * 8; bstr = (size_t)128 * 32;                                             \
    }                                                                                                                                \
  }
#define GEMM_LOAD(KT, SET)                                                                                                           \
    {                                                                                                                                \
      const size_t ko_ = (size_t)(KT) * apan, kb_ = (size_t)(KT) * bpan;                                                             \
      asm volatile("global_load_dwordx4 %0, %1, off" : "=v"(SET[0]) : "v"(ga0 + ko_) : "memory");                                     \
      asm volatile("global_load_dwordx4 %0, %1, off" : "=v"(SET[1]) : "v"(ga1 + ko_) : "memory");                                     \
      asm volatile("global_load_dwordx4 %0, %1, off" : "=v"(SET[2]) : "v"(gb0 + kb_) : "memory");                                     \
      asm volatile("global_load_dwordx4 %0, %1, off" : "=v"(SET[3]) : "v"(gb0 + bstr + kb_) : "memory");                              \
    }
#define GEMM_WRITE(SET, STAGE)                                                                                                       \
    {                                                                                                                                \
      asm volatile("" : "+v"(SET[0]), "+v"(SET[1]), "+v"(SET[2]), "+v"(SET[3]));      \
      char* dst_ = smem + (STAGE) * GB_BUF + tid * 16;                                                                               \
      *(u32x4*)(dst_) = SET[0]; *(u32x4*)(dst_ + 8192) = SET[1]; *(u32x4*)(dst_ + GB_A) = SET[2]; *(u32x4*)(dst_ + GB_A + 8192) = SET[3]; \
    }
#define GEMM_KSTEP(KT, WSET)                                                                                                         \
    {                                                                                                                                \
      asm volatile("s_waitcnt lgkmcnt(0)" ::: "memory");                                                                             \
      __builtin_amdgcn_s_barrier();                   \
        \
      const char* Ab = smem + ((KT) & 1) * GB_BUF;                                                                                   \
      const char* Bb = Ab + GB_A;                                                                                                    \
      bf16x8 bfr[4];                                                                                                                 \
      _Pragma("unroll") for (int n = 0; n < 4; ++n) {                                                                                \
        const int br = (EPI == 2) ? ((n >> 1) * 128 + 32 * wcn + 16 * (n & 1) + fr) : (64 * wcn + 16 * n + fr);                      \
        bfr[n] = *(const bf16x8*)(Bb + br * 64 + fsw);                                                                               \
      }                                                                                                                              \
      const char* Ap = Ab + (wr * 128 + fr) * 64 + fsw;                                                                              \
      bf16x8 af0 = *(const bf16x8*)(Ap), af1 = *(const bf16x8*)(Ap + 16 * 64);                                                       \
      if ((KT) + 1 < nk) {                                                                                                           \
        if ((KT) + 2 < nk) asm volatile("s_waitcnt vmcnt(4)" ::: "memory"); else asm volatile("s_waitcnt vmcnt(0)" ::: "memory");     \
        GEMM_WRITE(WSET, ((KT) + 1) & 1)                                                                                             \
        if ((KT) + 3 < nk) GEMM_LOAD((KT) + 3, WSET)                                                                                 \
      }                                                                                                                              \
      _Pragma("unroll") for (int pr = 0; pr < 4; ++pr) {                                                                             \
        bf16x8 an0 = af0, an1 = af1;                                                                                                 \
        if (pr < 3) { an0 = *(const bf16x8*)(Ap + (2 * pr + 2) * 16 * 64); an1 = *(const bf16x8*)(Ap + (2 * pr + 3) * 16 * 64); }    \
        __builtin_amdgcn_sched_barrier(0);                                                                                           \
        _Pragma("unroll") for (int n = 0; n < 4; ++n) acc[2 * pr][n] = __builtin_amdgcn_mfma_f32_16x16x32_bf16(bfr[n], af0, acc[2 * pr][n], 0, 0, 0); \
        _Pragma("unroll") for (int n = 0; n < 4; ++n) acc[2 * pr + 1][n] = __builtin_amdgcn_mfma_f32_16x16x32_bf16(bfr[n], af1, acc[2 * pr + 1][n], 0, 0, 0); \
        __builtin_amdgcn_sched_barrier(0);                                                                                           \
        af0 = an0; af1 = an1;                                                                                                        \
      }                                                                                                                              \
    }
  int mt, nt;
  bool have = gemm_tile_id(0, MT, NT, NB, mt, nt);
  u32x4 rsA[4], rsB[4];
  if (have) {
    GEMM_PTRS(mt, nt)
    GEMM_LOAD(0, rsA)
  }
  for (int it = 0; have; ++it) {
    GEMM_PTRS(mt, nt)
    f32x4 acc[8][4];
#pragma unroll
    for (int m = 0; m < 8; ++m)
#pragma unroll
      for (int n = 0; n < 4; ++n) acc[m][n] = (f32x4){0.f, 0.f, 0.f, 0.f};
    asm volatile("s_waitcnt lgkmcnt(0)" ::: "memory");
    __builtin_amdgcn_s_barrier();
    GEMM_LOAD(1, rsB)
    asm volatile("s_waitcnt vmcnt(4)" ::: "memory");
    GEMM_WRITE(rsA, 0)
    GEMM_LOAD(2, rsA)
    for (int kt = 0; kt < nk; kt += 2) {
      GEMM_KSTEP(kt, rsB)
      GEMM_KSTEP(kt + 1, rsA)
    }
    const int mt_e = mt, nt_e = nt;
    have = gemm_tile_id(it + 1, MT, NT, NB, mt, nt);
    if (have) {
      GEMM_PTRS(mt, nt)
      GEMM_LOAD(0, rsA)
    }
    int lane_e = lane; asm volatile("" : "+v"(lane_e));
    const int fr_e = lane_e & 15, fq_e = lane_e >> 4;
    if (EPI == 0) {
      if (nt_e * 256 + 64 * wcn < NBROWS) {
#pragma unroll
        for (int m = 0; m < 8; ++m) {
          const int tok = mt_e * 256 + wr * 128 + 16 * m + fr_e;
#pragma unroll
          for (int q = 0; q < 2; ++q) {
            const int col = nt_e * 256 + 64 * wcn + 32 * q + 8 * fq_e;
            u32x4 o;
            o[0] = pk_bf16(acc[m][2 * q][0], acc[m][2 * q][1]); o[1] = pk_bf16(acc[m][2 * q][2], acc[m][2 * q][3]);
            o[2] = pk_bf16(acc[m][2 * q + 1][0], acc[m][2 * q + 1][1]); o[3] = pk_bf16(acc[m][2 * q + 1][2], acc[m][2 * q + 1][3]);
            *(u32x4*)(outb + (size_t)tok * ldc + col) = o;
          }
        }
      }
    } else if (EPI == 1) {
      const int b = (mt_e * 256) >> 11;
      const float* gate = p.mod + ((size_t)l * 48 + b) * 6144 + gate_off;
#pragma unroll
      for (int q = 0; q < 2; ++q) {
        const int col = nt_e * 256 + 64 * wcn + 32 * q + 8 * fq_e;
        const f32x4 gv0 = *(const f32x4*)(gate + col), gv1 = *(const f32x4*)(gate + col + 4);
#pragma unroll
        for (int mh = 0; mh < 2; ++mh) {
          f32x4 xv[4][2];
#pragma unroll
          for (int mm = 0; mm < 4; ++mm) {
            const float* xr = xin_row(p, first, mt_e * 256 + wr * 128 + 16 * (4 * mh + mm) + fr_e) + col;
            xv[mm][0] = *(const f32x4*)xr; xv[mm][1] = *(const f32x4*)(xr + 4);
          }
#pragma unroll
          for (int mm = 0; mm < 4; ++mm) {
            const int m = 4 * mh + mm, tok = mt_e * 256 + wr * 128 + 16 * m + fr_e;
            f32x4 o0, o1;
#pragma unroll
            for (int j = 0; j < 4; ++j) { o0[j] = xv[mm][0][j] + gv0[j] * acc[m][2 * q][j]; o1[j] = xv[mm][1][j] + gv1[j] * acc[m][2 * q + 1][j]; }
            float* orow = p.out + (size_t)tok * DM + col;
            *(f32x4*)orow = o0; *(f32x4*)(orow + 4) = o1;
          }
        }
      }
    } else {
      const float* cw = p.conv_w + (size_t)l * 3 * 5632;
      const float* cb = p.conv_b + (size_t)l * 5632;
      const int wi = 2 * mt_e + wr, seq = wi / 17, s0 = 126 * (wi % 17) - 1;
      if (s0 < 0 || s0 + 127 >= SEQL) {
#pragma unroll
        for (int m = 0; m < 8; ++m) {
          const int tp = s0 + 16 * m + fr_e;
          if (tp < 0 || tp >= SEQL) {
#pragma unroll
            for (int n = 0; n < 4; ++n) acc[m][n] = (f32x4){0.f, 0.f, 0.f, 0.f};
          }
        }
      }
#define UP_EPI_NN(NN)                                                                                                      \
      {                                                                                                                    \
        const int cbase = nt_e * 128 + 32 * wcn + 8 * fq_e + 4 * NN;     \
        bf16_t* obase = outb + blk_off(seq * SEQL, cbase, NTOK);                                                           \
                   \
        f32x4 cwv[2][4];                                                                                                   \
        _Pragma("unroll") for (int n = 0; n < 2; ++n) {                                                                    \
          const int c = n * DFF + cbase;                                                                                   \
          cwv[n][0] = *(const f32x4*)(cw + c); cwv[n][1] = *(const f32x4*)(cw + 5632 + c);                                 \
          cwv[n][2] = *(const f32x4*)(cw + 2 * 5632 + c); cwv[n][3] = *(const f32x4*)(cb + c);                             \
        }                                                                                                                  \
        up_epi_row<0, NN>(acc, cwv, lane_e, fr_e, s0, obase); up_epi_row<1, NN>(acc, cwv, lane_e, fr_e, s0, obase);          \
        up_epi_row<2, NN>(acc, cwv, lane_e, fr_e, s0, obase); up_epi_row<3, NN>(acc, cwv, lane_e, fr_e, s0, obase);          \
        up_epi_row<4, NN>(acc, cwv, lane_e, fr_e, s0, obase); up_epi_row<5, NN>(acc, cwv, lane_e, fr_e, s0, obase);          \
        up_epi_row<6, NN>(acc, cwv, lane_e, fr_e, s0, obase); up_epi_row<7, NN>(acc, cwv, lane_e, fr_e, s0, obase);          \
      }
      UP_EPI_NN(0)
      UP_EPI_NN(1)
#undef UP_EPI_NN
    }
    asm volatile("s_waitcnt vmcnt(0)" ::: "memory");
  }
#undef GEMM_LOAD
#undef GEMM_WRITE
#undef GEMM_KSTEP
#undef GEMM_PTRS
}

struct AttnArgs {
  int qbase, qstride, qpos0;
  int ktokbase, ktokstep, kstride, kposbase, kposstep, ntiles;
  int qcol, kcol, vcol, ocol;
  const float *gq, *gk;
  float qscale;
  int hw, rmul, taboff0;
  float sinkv;
  float lam, outscale;
  const float* subg;
  int lsecol;
  float cshift;
  int r0, rs0;
};

template <int NQ, int NC, int MODE>
__device__ __forceinline__ void attn_item(const Params& p, const AttnArgs& a, bf16_t* Ks, bf16_t* Vts, const float* tab) {
  const int tid = opaque_tid(), lane = tid & 63, w = tid >> 6, fr = lane & 15, fq = lane >> 4;
  const int wq0 = a.qpos0 + w * 16 * NQ;
  const int lch = tid & 7;
  const int ntl = a.ntiles;
  u32x4 kA, vA, kB, vB;
  const int kkey = tid >> 3, vkey = tid & 63, vch = tid >> 6;
#define ATTN_PREFETCH(T, KR, VR)                                                                                 \
  {                                                                                                              \
    const int ktok0_ = a.ktokbase + (T) * a.ktokstep;                                                            \
    KR = *(const u32x4*)(p.proj + (size_t)(ktok0_ + kkey * a.kstride) * PW + a.kcol + lch * 8);                   \
    VR = *(const u32x4*)(p.proj + (size_t)(ktok0_ + vkey * a.kstride) * PW + a.vcol + vch * 8);                   \
  }
  ATTN_PREFETCH(0, kA, vA)
  if (ntl > 1) ATTN_PREFETCH(1, kB, vB)
  bf16x8 qf[NQ][2];
  int qpos[NQ];
#pragma unroll
  for (int qt = 0; qt < NQ; ++qt) {
    const int qp = wq0 + qt * 16 + fr;
    qpos[qt] = qp;
    const bf16_t* qrow = p.proj + (size_t)(a.qbase + qp * a.qstride) * PW + a.qcol;
    const u32x4 v0 = *(const u32x4*)(qrow + fq * 8), v1 = *(const u32x4*)(qrow + 32 + fq * 8);
    float f0[8], f1[8];
#pragma unroll
    for (int i = 0; i < 4; ++i) { f0[2 * i] = bf_lo(v0[i]); f0[2 * i + 1] = bf_hi(v0[i]); f1[2 * i] = bf_lo(v1[i]); f1[2 * i + 1] = bf_hi(v1[i]); }
    float s0 = 0.f, s1 = 0.f;
#pragma unroll
    for (int i = 0; i < 8; ++i) { s0 += f0[i] * f0[i]; s1 += f1[i] * f1[i]; }
    float r0, r1;
    if (NC == 1) {
      float s = s0 + s1; s += __shfl_xor(s, 16); s += __shfl_xor(s, 32);
      r0 = r1 = rsqrtf(s * (1.f / 64.f) + 1e-6f) * a.qscale;
    } else {
      s0 += __shfl_xor(s0, 16); s0 += __shfl_xor(s0, 32);
      s1 += __shfl_xor(s1, 16); s1 += __shfl_xor(s1, 32);
      r0 = rsqrtf(s0 * (1.f / 32.f) + 1e-6f) * a.qscale; r1 = rsqrtf(s1 * (1.f / 32.f) + 1e-6f) * a.qscale;
    }
    const float* g0p = a.gq + fq * 8;
    const float* g1p = (NC == 1) ? a.gq + 32 + fq * 8 : g0p;
    u32x4 q0, q1;
#pragma unroll
    for (int i = 0; i < 4; ++i) {
      q0[i] = pk_bf16(f0[2 * i] * r0 * g0p[2 * i], f0[2 * i + 1] * r0 * g0p[2 * i + 1]);
      q1[i] = pk_bf16(f1[2 * i] * r1 * g1p[2 * i], f1[2 * i + 1] * r1 * g1p[2 * i + 1]);
    }
    qf[qt][0] = __builtin_bit_cast(bf16x8, q0);
    qf[qt][1] = __builtin_bit_cast(bf16x8, q1);
  }
  f32x4 o[NC][NQ][4];
  float mrun[NC][NQ];
  f32x4 lsum[NC][NQ];
  const bf16x8 ones = {0x3F80, 0x3F80, 0x3F80, 0x3F80, 0x3F80, 0x3F80, 0x3F80, 0x3F80};
#pragma unroll
  for (int c = 0; c < NC; ++c)
#pragma unroll
    for (int qt = 0; qt < NQ; ++qt) {
      mrun[c][qt] = a.cshift;
      const float l0 = (MODE == 1) ? fexp2(a.sinkv - a.cshift) : 0.f;
      lsum[c][qt] = (f32x4){l0, l0, l0, l0};
#pragma unroll
      for (int dt = 0; dt < 4; ++dt) o[c][qt][dt] = (f32x4){0.f, 0.f, 0.f, 0.f};
    }
  float gkv[8];
#pragma unroll
  for (int i = 0; i < 8; ++i) gkv[i] = a.gk[((NC == 1) ? lch : (lch & 3)) * 8 + i];

  const int rw = a.r0 + ((w * 16 * NQ) >> 6);
  int rsw = rw - 4; rsw = rsw < 0 ? 0 : (rsw > 24 ? 24 : rsw);
  auto stage_write = [&](const u32x4& kr, const u32x4& vr, bf16_t* Ksb, bf16_t* Vtb) __attribute__((always_inline)) {
    float f[8];
#pragma unroll
    for (int i = 0; i < 4; ++i) { f[2 * i] = bf_lo(kr[i]); f[2 * i + 1] = bf_hi(kr[i]); }
    float s = 0.f;
#pragma unroll
    for (int i = 0; i < 8; ++i) s += f[i] * f[i];
    s += __shfl_xor(s, 1); s += __shfl_xor(s, 2);
    float rs;
    if (NC == 1) { s += __shfl_xor(s, 4); rs = rsqrtf(s * (1.f / 64.f) + 1e-6f); }
    else rs = rsqrtf(s * (1.f / 32.f) + 1e-6f);
    u32x4 kq;
#pragma unroll
    for (int i = 0; i < 4; ++i) kq[i] = pk_bf16(f[2 * i] * rs * gkv[2 * i], f[2 * i + 1] * rs * gkv[2 * i + 1]);
    *(u32x4*)(Ksb + kkey * LDSROW + lch * 8) = kq;
#pragma unroll
    for (int i = 0; i < 4; ++i) {
      const int d0 = vch * 8 + 2 * i, d1 = d0 + 1;
      const int s0 = (d0 & ~31) | (16 * ((d0 >> 2) & 1) + 4 * ((d0 & 31) >> 3) + (d0 & 3)), s1 = (d1 & ~31) | (16 * ((d1 >> 2) & 1) + 4 * ((d1 & 31) >> 3) + (d1 & 3));
      Vtb[s0 * LDSROW + vkey] = (bf16_t)(vr[i] & 0xffffu);
      Vtb[s1 * LDSROW + vkey] = (bf16_t)(vr[i] >> 16);
    }
  };
  auto tile_math = [&](int t, const bf16_t* Ksb, const bf16_t* Vtb) __attribute__((always_inline)) {
    if (MODE == 0) { const int kr_ = a.rs0 + t; if (kr_ < rsw || kr_ >= rsw + 8) return; }
    const int kp0 = a.kposbase + t * a.kposstep;
    const int taboff = (a.rs0 + t - rw + 7) * 31;
    bf16x8 pf[NC][NQ][2];
    bf16x8 kf[4][2];
#pragma unroll
    for (int kt = 0; kt < 4; ++kt) {
      kf[kt][0] = *(const bf16x8*)(Ksb + (kt * 16 + fr) * LDSROW + fq * 8);
      kf[kt][1] = *(const bf16x8*)(Ksb + (kt * 16 + fr) * LDSROW + 32 + fq * 8);
    }
    bf16x8 vfr[4][2];
#pragma unroll
    for (int ks = 0; ks < 2; ++ks)
#pragma unroll
      for (int dt = 0; dt < 4; ++dt) {
        const u32x2 lo = *(const u32x2*)(Vtb + (dt * 16 + fr) * LDSROW + ks * 32 + 4 * fq);
        const u32x2 hi = *(const u32x2*)(Vtb + (dt * 16 + fr) * LDSROW + ks * 32 + 16 + 4 * fq);
        u32x4 vv; vv[0] = lo[0]; vv[1] = lo[1]; vv[2] = hi[0]; vv[3] = hi[1];
        vfr[dt][ks] = __builtin_bit_cast(bf16x8, vv);
      }
#pragma unroll
    for (int qt = 0; qt < NQ; ++qt) {
      const int qp = (MODE == 0) ? (qpos[qt] & 63) : qpos[qt];
      int cs = qp - 8; cs = cs < 0 ? 0 : (cs > 48 ? 48 : cs);
      f32x4 bv[4];
      const bool far_hi = (MODE == 3) && (kp0 - (wq0 + 16 * NQ - 1) >= 128), far_lo = (MODE == 3) && (wq0 - (kp0 + 63) >= 128);
      if (far_hi || far_lo) {
        const float bu = tab[far_hi ? (DT_OFF + 256) : (DT_OFF - 256)];
#pragma unroll
        for (int kt = 0; kt < 4; ++kt) bv[kt] = (f32x4){bu, bu, bu, bu};
      } else if (MODE != 0) {
        const float* tb = tab + (kp0 - qp + 4 * fq + DT_OFF);
#pragma unroll
        for (int kt = 0; kt < 4; ++kt)
#pragma unroll
          for (int j = 0; j < 4; ++j) bv[kt][j] = tb[kt * 16 + j];
      } else
#pragma unroll
      for (int kt = 0; kt < 4; ++kt)
#pragma unroll
        for (int j = 0; j < 4; ++j) {
          const int kpos = kp0 + kt * 16 + 4 * fq + j;
          const int d = kpos - qp;
          const bool valid = kpos >= cs && kpos < cs + 16;
          int dd = d + 15; dd = dd < 0 ? 0 : (dd > 30 ? 30 : dd);
          const float bias = tab[taboff + dd];
          bv[kt][j] = valid ? bias : -INFINITY;
        }
#pragma unroll
      for (int c = 0; c < NC; ++c) {
        f32x4 s[4];
#pragma unroll
        for (int kt = 0; kt < 4; ++kt) {
          if (NC == 1) {
            const f32x4 r = __builtin_amdgcn_mfma_f32_16x16x32_bf16(kf[kt][0], qf[qt][0], bv[kt], 0, 0, 0);
            s[kt] = __builtin_amdgcn_mfma_f32_16x16x32_bf16(kf[kt][1], qf[qt][1], r, 0, 0, 0);
          } else {
            s[kt] = __builtin_amdgcn_mfma_f32_16x16x32_bf16(kf[kt][c], qf[qt][c], bv[kt], 0, 0, 0);
          }
        }
#pragma unroll
        for (int kt = 0; kt < 4; ++kt)
#pragma unroll
          for (int j = 0; j < 4; ++j) s[kt][j] = fexp2(s[kt][j]);
#pragma unroll
        for (int ks = 0; ks < 2; ++ks) {
          u32x4 pk;
          pk[0] = pk_bf16(s[2 * ks][0], s[2 * ks][1]); pk[1] = pk_bf16(s[2 * ks][2], s[2 * ks][3]);
          pk[2] = pk_bf16(s[2 * ks + 1][0], s[2 * ks + 1][1]); pk[3] = pk_bf16(s[2 * ks + 1][2], s[2 * ks + 1][3]);
          pf[c][qt][ks] = __builtin_bit_cast(bf16x8, pk);
        }
      }
    }
#pragma unroll
    for (int ks = 0; ks < 2; ++ks) {
#pragma unroll
      for (int dt = 0; dt < 4; ++dt) {
        const bf16x8 vf = vfr[dt][ks];
#pragma unroll
        for (int c = 0; c < NC; ++c)
#pragma unroll
          for (int qt = 0; qt < NQ; ++qt) o[c][qt][dt] = __builtin_amdgcn_mfma_f32_16x16x32_bf16(vf, pf[c][qt][ks], o[c][qt][dt], 0, 0, 0);
      }
#pragma unroll
      for (int c = 0; c < NC; ++c)
#pragma unroll
        for (int qt = 0; qt < NQ; ++qt) lsum[c][qt] = __builtin_amdgcn_mfma_f32_16x16x32_bf16(ones, pf[c][qt][ks], lsum[c][qt], 0, 0, 0);
    }
    };
  bf16_t* const Ks1 = Ks + 2 * 64 * LDSROW;
  bf16_t* const Vts1 = Vts + 2 * 64 * LDSROW;
  stage_write(kA, vA, Ks, Vts);
  if (ntl > 2) ATTN_PREFETCH(2, kA, vA)
  for (int t = 0; t < ntl; t += 2) {
    __syncthreads();
    if (t + 1 < ntl) { stage_write(kB, vB, Ks1, Vts1); if (t + 3 < ntl) ATTN_PREFETCH(t + 3, kB, vB) }
    tile_math(t, Ks, Vts);
    if (t + 1 < ntl) {
      __syncthreads();
      if (t + 2 < ntl) { stage_write(kA, vA, Ks, Vts); if (t + 4 < ntl) ATTN_PREFETCH(t + 4, kA, vA) }
      tile_math(t + 1, Ks1, Vts1);
    }
  }
#undef ATTN_PREFETCH
#pragma unroll
  for (int qt = 0; qt < NQ; ++qt) {
    float inv[NC], ltot[NC];
#pragma unroll
    for (int c = 0; c < NC; ++c) {
      const float lt = lsum[c][qt][0];
      ltot[c] = lt; inv[c] = 1.f / lt;
    }
    const int tok = a.qbase + qpos[qt] * a.qstride;
    if (MODE == 3) {
      f32x4 v[4];
      float ss = 0.f;
#pragma unroll
      for (int dt = 0; dt < 4; ++dt)
#pragma unroll
        for (int j = 0; j < 4; ++j) {
          const float x = o[0][qt][dt][j] * inv[0] - a.lam * (o[NC - 1][qt][dt][j] * inv[NC - 1]);
          v[dt][j] = x; ss += x * x;
        }
      ss += __shfl_xor(ss, 16); ss += __shfl_xor(ss, 32);
      const float rstd = rsqrtf(ss * (1.f / 64.f) + 1e-6f) * a.outscale;
#pragma unroll
      for (int q = 0; q < 2; ++q) {
        const f32x4 g0 = *(const f32x4*)(a.subg + 32 * q + 8 * fq), g1 = *(const f32x4*)(a.subg + 32 * q + 8 * fq + 4);
        u32x4 ov;
        ov[0] = pk_bf16(v[2 * q][0] * rstd * g0[0], v[2 * q][1] * rstd * g0[1]); ov[1] = pk_bf16(v[2 * q][2] * rstd * g0[2], v[2 * q][3] * rstd * g0[3]);
        ov[2] = pk_bf16(v[2 * q + 1][0] * rstd * g1[0], v[2 * q + 1][1] * rstd * g1[1]); ov[3] = pk_bf16(v[2 * q + 1][2] * rstd * g1[2], v[2 * q + 1][3] * rstd * g1[3]);
        *(u32x4*)(p.hbuf + blk_off(tok, a.ocol + 32 * q + 8 * fq, NTOK)) = ov;
      }
    } else {
#pragma unroll
      for (int q = 0; q < 2; ++q) {
        u32x4 ov;
        ov[0] = pk_bf16(o[0][qt][2 * q][0] * inv[0], o[0][qt][2 * q][1] * inv[0]); ov[1] = pk_bf16(o[0][qt][2 * q][2] * inv[0], o[0][qt][2 * q][3] * inv[0]);
        ov[2] = pk_bf16(o[0][qt][2 * q + 1][0] * inv[0], o[0][qt][2 * q + 1][1] * inv[0]); ov[3] = pk_bf16(o[0][qt][2 * q + 1][2] * inv[0], o[0][qt][2 * q + 1][3] * inv[0]);
        *(u32x4*)(p.hbuf + blk_off(tok, a.ocol + 32 * q + 8 * fq, NTOK)) = ov;
      }
      if (MODE == 2 && fq == 0) p.lse[(size_t)tok * 6 + a.lsecol] = (mrun[0][qt] + __log2f(ltot[0])) * LN2;
    }
  }
}

__device__ __forceinline__ void attn_phase(const Params& p, int l, char* smem) {
  bf16_t* Ks = (bf16_t*)smem;
  bf16_t* Vts = Ks + 64 * LDSROW;
  float* tab = (float*)(Ks + 4 * 64 * LDSROW);
  const int tid = opaque_tid();
  const int nD = 3072, nA = 3072, nB = 3072, nC = 4608;
  for (int item = blockIdx.x; item < nD + nA + nB + nC; item += gridDim.x) {
    AttnArgs a;
    a.taboff0 = 0; a.r0 = 0; a.rs0 = 0; a.sinkv = 0.f; a.cshift = 0.f; a.lam = 0.f; a.outscale = 1.f; a.subg = nullptr; a.lsecol = 0; a.hw = 1 << 20; a.rmul = 1;
    __syncthreads();
    if (item < nD) {
      const int b = item >> 6, h = (item >> 4) & 3, qb = item & 15;
      a.cshift = p.lam[4 + l * 4 + 3];
      for (int i = tid; i < DT_N; i += NTHR) { int dd = i - DT_OFF; dd = dd < -128 ? -128 : (dd > 128 ? 128 : dd); tab[i] = p.lut[(10 + h) * 257 + dd + 128] - a.cshift; }
      a.qbase = b * SEQL; a.qstride = 1; a.qpos0 = qb * 128;
      a.ktokbase = b * SEQL; a.ktokstep = 64; a.kstride = 1; a.kposbase = 0; a.kposstep = 64; a.ntiles = 32;
      a.qcol = 2432 + h * 64; a.kcol = 2432 + 256 + h * 64; a.vcol = 2432 + 512 + h * 64; a.ocol = 896 + h * 64;
      a.gq = p.qkn_d + l * 64; a.gk = a.gq + 32;
      a.qscale = 0.17677669529663687f * LOG2E;
      a.lam = p.lam[l]; a.outscale = 1.f - (0.8f - 0.6f * expf(-0.3f * (float)l)); a.subg = p.subln_d + l * 64;
      attn_item<1, 2, 3>(p, a, Ks, Vts, tab);
    } else if (item < nD + nA) {
      const int id = item - nD;
      const int b = id >> 6, h = (id >> 4) & 3, r = (id & 15) * 2;
      const float* rp = p.rpb_a + ((size_t)l * 4 + h) * 465;
      a.cshift = p.lam[4 + l * 4 + 0];
      for (int i = tid; i < 465; i += NTHR) tab[i] = rp[i] * LOG2E - a.cshift;
      int rs = r - 4; rs = rs < 0 ? 0 : (rs > 24 ? 24 : rs);
      int rs1 = r - 3; rs1 = rs1 < 0 ? 0 : (rs1 > 24 ? 24 : rs1);
      a.qbase = b * SEQL + r * 64; a.qstride = 1; a.qpos0 = 0; a.r0 = r; a.rs0 = rs;
      a.ktokbase = b * SEQL + rs * 64; a.ktokstep = 64; a.kstride = 1; a.kposbase = 0; a.kposstep = 0; a.ntiles = rs1 - rs + 8;
      a.qcol = h * 64; a.kcol = 256 + h * 64; a.vcol = 512 + h * 64; a.ocol = h * 64;
      a.gq = p.qkn_a + l * 128; a.gk = a.gq + 64;
      a.qscale = 0.125f * LOG2E;
      attn_item<1, 1, 0>(p, a, Ks, Vts, tab);
    } else if (item < nD + nA + nB) {
      const int id = item - nD - nA;
      const int b = id >> 6, h = (id >> 4) & 3, qb = id & 15;
      a.cshift = p.lam[4 + l * 4 + 1];
      for (int i = tid; i < DT_N; i += NTHR) { const int d = i - DT_OFF; tab[i] = (d >= -128 && d <= 128) ? p.lut[h * 257 + d + 128] - a.cshift : -INFINITY; }
      const int q0 = qb * 128;
      const int kstart = q0 - 128 < 0 ? 0 : q0 - 128, kend = q0 + 256 > SEQL ? SEQL : q0 + 256;
      a.qbase = b * SEQL; a.qstride = 1; a.qpos0 = q0;
      a.ktokbase = b * SEQL + kstart; a.ktokstep = 64; a.kstride = 1; a.kposbase = kstart; a.kposstep = 64; a.ntiles = (kend - kstart) >> 6;
      a.qcol = 768 + h * 64; a.kcol = 768 + 256 + (h >> 1) * 64; a.vcol = 768 + 384 + (h >> 1) * 64; a.ocol = 256 + h * 64;
      a.gq = p.qkn_b + l * 128; a.gk = a.gq + 64;
      a.qscale = 0.125f * LOG2E;
      a.hw = 128; a.rmul = 1; a.sinkv = p.sink_b[l * 4 + h] * LOG2E;
      attn_item<1, 1, 1>(p, a, Ks, Vts, tab);
    } else {
      const int id = item - nD - nA - nB;
      const int b = id / 96, rem = id % 96, g = rem >> 5, i2 = (rem >> 4) & 1, blk = rem & 15;
      const int r = g == 0 ? 1 : (g == 1 ? 4 : 16);
      const int L = SEQL / r, bps = L >> 7;
      const int pp = blk / bps, m0 = (blk % bps) * 128;
      const int hh = g * 2 + i2;
      a.cshift = p.lam[4 + l * 4 + 2];
      for (int i = tid; i < DT_N; i += NTHR) { const int d = i - DT_OFF; int dd = d * r; dd = dd < -128 ? -128 : (dd > 128 ? 128 : dd);
        tab[i] = (d >= -64 && d <= 64) ? p.lut[(4 + hh) * 257 + dd + 128] - a.cshift : -INFINITY; }
      const int kstart = m0 - 64 < 0 ? 0 : m0 - 64, kend = m0 + 192 > L ? L : m0 + 192;
      a.qbase = b * SEQL + pp; a.qstride = r; a.qpos0 = m0;
      a.ktokbase = a.qbase + kstart * r; a.ktokstep = 64 * r; a.kstride = r; a.kposbase = kstart; a.kposstep = 64; a.ntiles = (kend - kstart) >> 6;
      a.qcol = 1280 + hh * 64; a.kcol = 1280 + 384 + hh * 64; a.vcol = 1280 + 768 + hh * 64; a.ocol = 512 + hh * 64;
      a.gq = p.qkn_c + l * 128; a.gk = a.gq + 64;
      a.qscale = 0.125f * LOG2E;
      a.hw = 64; a.rmul = r; a.lsecol = hh;
      attn_item<1, 1, 2>(p, a, Ks, Vts, tab);
    }
  }
}

__device__ __forceinline__ void combine_phase(const Params& p) {
  const int nthr = gridDim.x * NTHR;
  for (int i = blockIdx.x * NTHR + opaque_tid(); i < NTOK * 48; i += nthr) {
    const int tok = i / 48, rem = i % 48, hh = rem >> 3, ch = rem & 7, ii = hh & 1, g = hh >> 1;
    const float* ls = p.lse + (size_t)tok * 6;
    const float l0 = ls[ii], l1 = ls[2 + ii], l2 = ls[4 + ii];
    const float mx = fmaxf(l0, fmaxf(l1, l2));
    const float e0 = __expf(l0 - mx), e1 = __expf(l1 - mx), e2 = __expf(l2 - mx);
    const float al = (g == 0 ? e0 : (g == 1 ? e1 : e2)) / (e0 + e1 + e2);
    bf16_t* ptr = p.hbuf + blk_off(tok, 512 + hh * 64 + ch * 8, NTOK);
    u32x4 v = *(const u32x4*)ptr;
#pragma unroll
    for (int k = 0; k < 4; ++k) v[k] = pk_bf16(bf_lo(v[k]) * al, bf_hi(v[k]) * al);
    *(u32x4*)ptr = v;
  }
}


#ifndef REP_GEMM
#define REP_GEMM 1
#endif
#ifndef REP_ATTN
#define REP_ATTN 1
#endif
#ifndef DBG_STOP
#define DBG_STOP 0
#endif
__global__ void __launch_bounds__(NTHR, 2) fwd_megakernel(Params p) {
  extern __shared__ __attribute__((aligned(16))) char smem[];
  cg::grid_group grid = cg::this_grid();
  prologue_phase(p, smem);
  grid.sync();
#define LAYER(L)                                                                                                   \
  {                                                                                                                \
    constexpr int l = (L);                                                                                         \
    constexpr bool first = (l == 0);                                                                               \
    const bf16_t* wt = p.wt + (size_t)l * WT_LAYER;                                                                \
    norm_phase(p, l, first, p.norm_attn_g + l * DM, 0, 1024);                                                      \
    grid.sync();                                                                                                   \
    gemm_phase<0>(p, l, false, p.hbuf, 3200, wt + WT_IN, 1024, 384, 13, 13, p.proj, PW, 0, smem);                  \
    grid.sync();                                                                                                   \
    attn_phase(p, l, smem);                                                                                        \
    grid.sync();                                                                                                   \
    combine_phase(p);                                                                                              \
    grid.sync();                                                                                                   \
    gemm_phase<1>(p, l, first, p.hbuf, 1024, wt + WT_OUT, 1152, 384, 4, 4, nullptr, 0, 2048, smem);                \
    grid.sync();                                                                                                   \
    norm_phase(p, l, false, p.norm_ffn_g + l * DM, 3072, 4096);                                                    \
    grid.sync();                                                                                                   \
    gemm_phase<2>(p, l, false, p.hbuf, 5632, wt + WT_UP, 1024, 408, 22, 22, p.proj, DFF, 0, smem);                 \
    grid.sync();                                                                                                   \
    gemm_phase<1>(p, l, false, p.proj, 1024, wt + WT_DOWN, 2816, 384, 4, 4, nullptr, 0, 5120, smem);               \
    grid.sync();                                                                                                   \
  }
  LAYER(0)
  LAYER(1)
  LAYER(2)
  LAYER(3)
#undef LAYER
}

extern "C" void kernel_launch(void* const* d_in, const int* in_sizes, int n_in, void* d_out, int out_size, void* d_ws, size_t ws_size,
                              hipStream_t stream) {
  static int grid_blocks = 0;
  if (!grid_blocks) {
    int dev = 0, cus = 0, per_cu = 0;
    hipGetDevice(&dev);
    hipDeviceGetAttribute(&cus, hipDeviceAttributeMultiprocessorCount, dev);
    hipFuncSetAttribute((const void*)fwd_megakernel, hipFuncAttributeMaxDynamicSharedMemorySize, SMEM_BYTES);
    hipOccupancyMaxActiveBlocksPerMultiprocessor(&per_cu, fwd_megakernel, NTHR, SMEM_BYTES);
    if (per_cu > 1) per_cu = 1;
    if (per_cu < 1) per_cu = 1;
    grid_blocks = cus * per_cu;
  }
  Params p{};
  const float* const* in = (const float* const*)d_in;
  p.x_prompt = in[0]; p.x_sample = in[1]; p.c_prompt = in[2]; p.c_sample = in[3]; p.norm_attn_g = in[4]; p.norm_ffn_g = in[5];
  p.w_ada = in[6]; p.b_ada = in[7]; p.w_in = in[8]; p.qkn_a = in[9]; p.qkn_b = in[10]; p.qkn_c = in[11]; p.qkn_d = in[12];
  p.rpb_a = in[13]; p.sink_b = in[14]; p.t5_table = in[15]; p.lam_d = in[16]; p.subln_d = in[17]; p.w_out = in[18]; p.w_up = in[19];
  p.conv_w = in[20]; p.conv_b = in[21]; p.w_down = in[22];
  p.out = (float*)d_out;
  char* ws = (char*)d_ws;
  size_t off = 0;
  p.wt = (bf16_t*)(ws + off); off += (size_t)4 * WT_LAYER * 2;
  p.mod = (float*)(ws + off); off += (size_t)4 * 48 * 6144 * 4;
  p.lut = (float*)(ws + off); off += 16384;
  p.lam = (float*)(ws + off); off += 256;
  p.zeros = (float*)(ws + off); off += 256;
  p.lse = (float*)(ws + off); off += (size_t)NTOK * 6 * 4;
  p.proj = (bf16_t*)(ws + off); off += (size_t)NTOK * PW * 2;
  p.hbuf = (bf16_t*)(ws + off); off += (size_t)NTOK * MW * 2;
  if (off > ws_size) { fprintf(stderr, "workspace too small: need %zu have %zu\n", off, ws_size); return; }
  void* args[] = {&p};
  hipError_t e = hipLaunchCooperativeKernel((void*)fwd_megakernel, dim3(grid_blocks), dim3(NTHR), args, SMEM_BYTES, stream);
  if (e != hipSuccess) fprintf(stderr, "cooperative launch failed: %s (grid %d)\n", hipGetErrorString(e), grid_blocks);
}
```
